# Optimizing an MI355X kernel written in HIP

```python
import jax, jax.numpy as jnp
from jax import lax
import numpy as np

D_MODEL = 1024
BATCH = 8
SEQ = 8192
DEPTH = 1

N_META = 16
D_MIX = D_MODEL
LRU_WIDTH = D_MIX // 2
LRU_BLOCKS = 8
LRU_BLOCK = LRU_WIDTH // LRU_BLOCKS
LRU_C = 8.0
CONV_WIDTH = 4
CONV_LEFT = 2
RET_WIDTH = D_MIX - LRU_WIDTH
RET_HEADS = 4
RET_HEAD_DIM = RET_WIDTH // RET_HEADS
CHUNK = 128
ROPE_BASE = 10000.0
N_EXPERTS = 16
EXPERT_FF = 1024
EC_CAPACITY = 2
EPS = 1e-6
IN_COLS = 2 * LRU_WIDTH + 4 * RET_WIDTH

kernel_name = 'hymba_lru_retention_ec_moe_encoder'


def _rmsnorm(x, g):
    xf = x.astype(jnp.float32)
    y = xf * lax.rsqrt(jnp.mean(xf * xf, axis=-1, keepdims=True) + EPS)
    return (y * g.astype(jnp.float32)).astype(x.dtype)


def _centred_depthwise_conv(u, w, b):
    y = lax.conv_general_dilated(
        u, w[:, None, :].astype(u.dtype), window_strides=(1,),
        padding=[(CONV_LEFT, CONV_WIDTH - 1 - CONV_LEFT)],
        dimension_numbers=('NWC', 'WIO', 'NWC'),
        feature_group_count=u.shape[-1])
    return y + b.astype(u.dtype)


def _block_diag(u, w, b):
    bsz, t, _ = u.shape
    ub = u.reshape(bsz, t, LRU_BLOCKS, LRU_BLOCK)
    return jnp.einsum('btnc,ncd->btnd', ub, w).reshape(bsz, t, LRU_WIDTH) + b


def _linear_scan_op(e1, e2):
    a1, b1 = e1
    a2, b2 = e2
    return a1 * a2, a2 * b1 + b2


def _rg_lru(u, w_r, b_r, w_i, b_i, lam, reverse):
    r = jax.nn.sigmoid(_block_diag(u, w_r, b_r))
    i = jax.nn.sigmoid(_block_diag(u, w_i, b_i))
    log_a = -LRU_C * r * jax.nn.softplus(-lam)
    a = jnp.exp(log_a)
    gated_x = jnp.sqrt(-jnp.expm1(2.0 * log_a)) * (i * u)
    _, h = lax.associative_scan(_linear_scan_op, (a, gated_x), axis=1, reverse=reverse)
    return h


def _recurrent_group(xb, gate, conv_w, conv_b, w_r, b_r, w_i, b_i, lam, out_g):
    f32 = jnp.float32
    u = _centred_depthwise_conv(xb, conv_w, conv_b).astype(f32)
    h_fwd = _rg_lru(u, w_r[0].astype(f32), b_r[0].astype(f32), w_i[0].astype(f32),
                    b_i[0].astype(f32), lam[0].astype(f32), False)
    h_bwd = _rg_lru(u, w_r[1].astype(f32), b_r[1].astype(f32), w_i[1].astype(f32),
                    b_i[1].astype(f32), lam[1].astype(f32), True)
    y = (h_fwd + h_bwd) * jax.nn.gelu(gate.astype(f32))
    return _rmsnorm(y, out_g).astype(xb.dtype)


def _rotary(t, pos):
    half = t.shape[-1] // 2
    freqs = ROPE_BASE ** (-jnp.arange(half, dtype=jnp.float32) / half)
    ang = pos.astype(jnp.float32)[:, None] * freqs[None, :]
    cos = jnp.cos(ang)[None, :, None, :]
    sin = jnp.sin(ang)[None, :, None, :]
    t1, t2 = t[..., :half], t[..., half:]
    return jnp.concatenate([t1 * cos - t2 * sin, t1 * sin + t2 * cos], axis=-1)


def _to_chunks(t, pad):
    bsz, _, h, d = t.shape
    t = jnp.pad(t, ((0, 0), (pad, 0), (0, 0), (0, 0)))
    n = t.shape[1] // CHUNK
    return t.reshape(bsz, n, CHUNK, h, d).transpose(0, 3, 1, 2, 4)


def _exclusive_chunk_states(u, chunk_decay, reverse):
    un = jnp.moveaxis(u, 2, 0)

    def step(carry, ui):
        return carry * chunk_decay[None, :, None, None] + ui, carry

    _, excl = lax.scan(step, jnp.zeros_like(un[0]), un, reverse=reverse)
    return excl


def _retention_group(q, k, v, g, out_g):
    bsz, t, _ = q.shape
    f32 = jnp.float32
    pos = jnp.arange(t)

    def heads(z):
        return z.astype(f32).reshape(bsz, t, RET_HEADS, RET_HEAD_DIM)

    qh = _rotary(heads(q), pos) * (RET_HEAD_DIM ** -0.5)
    kh = _rotary(heads(k), pos)
    vh = heads(v)
    pad = (-t) % CHUNK
    qc, kc, vc = _to_chunks(qh, pad), _to_chunks(kh, pad), _to_chunks(vh, pad)

    log_g = jnp.log(1.0 - jnp.exp2(-5.0 - jnp.arange(RET_HEADS, dtype=f32)))
    idx = jnp.arange(CHUNK, dtype=f32)
    dist = jnp.abs(idx[:, None] - idx[None, :])
    intra_decay = jnp.exp(log_g[:, None, None] * dist)
    scores = jnp.einsum('bhncd,bhnmd->bhncm', qc, kc) * intra_decay[None, :, None]
    o = jnp.einsum('bhncm,bhnme->bhnce', scores, vc)

    def pos_decay(expo):
        return jnp.exp(log_g[:, None] * expo[None, :])[None, :, None, :, None]

    chunk_decay = jnp.exp(log_g * CHUNK)
    u_fwd = jnp.einsum('bhncd,bhnce->bhnde', kc * pos_decay(CHUNK - 1.0 - idx), vc)
    u_bwd = jnp.einsum('bhncd,bhnce->bhnde', kc * pos_decay(idx), vc)
    state_fwd = _exclusive_chunk_states(u_fwd, chunk_decay, False)
    state_bwd = _exclusive_chunk_states(u_bwd, chunk_decay, True)
    o = (o
         + jnp.einsum('bhncd,nbhde->bhnce', qc * pos_decay(idx + 1.0), state_fwd)
         + jnp.einsum('bhncd,nbhde->bhnce', qc * pos_decay(CHUNK - idx), state_bwd))

    o = o.transpose(0, 2, 3, 1, 4).reshape(bsz, -1, RET_HEADS, RET_HEAD_DIM)[:, pad:]
    o = o * lax.rsqrt(jnp.mean(o * o, axis=-1, keepdims=True) + EPS)
    o = o.reshape(bsz, t, RET_WIDTH) * out_g.astype(f32)
    return (o * jax.nn.silu(g.astype(f32))).astype(q.dtype)


def _mixer(h, w_in, conv_w, conv_b, lru_w_r, lru_b_r, lru_w_i, lru_b_i, lru_lambda,
           lru_out_g, ret_out_g, w_out):
    z = jnp.einsum('btd,dc->btc', h, w_in)
    o1 = LRU_WIDTH
    o2 = 2 * LRU_WIDTH
    lru_x, lru_gate = z[..., :o1], z[..., o1:o2]
    q = z[..., o2:o2 + RET_WIDTH]
    k = z[..., o2 + RET_WIDTH:o2 + 2 * RET_WIDTH]
    v = z[..., o2 + 2 * RET_WIDTH:o2 + 3 * RET_WIDTH]
    g = z[..., o2 + 3 * RET_WIDTH:]
    y_lru = _recurrent_group(lru_x, lru_gate, conv_w, conv_b, lru_w_r, lru_b_r,
                             lru_w_i, lru_b_i, lru_lambda, lru_out_g)
    y_ret = _retention_group(q, k, v, g, ret_out_g)
    y = jnp.concatenate([y_lru, y_ret], axis=-1)
    return jnp.einsum('btc,cd->btd', y, w_out)


def _expert_choice_ffn(h, w_router, w_gate, w_up, w_down):
    bsz, t, d = h.shape
    cap = EC_CAPACITY * t // N_EXPERTS
    aff = jax.nn.softmax(jnp.einsum('btd,de->bte', h, w_router).astype(jnp.float32), axis=-1)
    gate, idx = lax.top_k(aff.transpose(0, 2, 1), cap)
    xs = jax.vmap(lambda hb, ib: hb[ib])(h, idx)
    a = jnp.einsum('becd,edf->becf', xs, w_gate)
    u = jnp.einsum('becd,edf->becf', xs, w_up)
    y = jnp.einsum('becf,efd->becd', jax.nn.silu(a) * u, w_down)
    y = y * gate[..., None].astype(y.dtype)
    flat = (jnp.arange(bsz)[:, None, None] * t + idx).reshape(-1)
    out = jax.ops.segment_sum(y.reshape(-1, d), flat, num_segments=bsz * t)
    return out.reshape(bsz, t, d)


def setup_inputs(seed: int = 0) -> dict:
    key = jax.random.key(seed)
    ks = jax.random.split(key, 20)
    f32 = jnp.float32
    L = DEPTH

    def nrm(k, shape, scale):
        return jax.random.normal(k, shape, f32) * scale

    u = jax.random.uniform(ks[9], (L, 2, LRU_WIDTH), f32, 0.9, 0.999)
    s = u ** (1.0 / LRU_C)
    lam = jnp.log(s) - jnp.log1p(-s)
    return {
        'x': nrm(ks[0], (BATCH, SEQ, D_MODEL), 1.0),
        'meta_tokens': nrm(ks[1], (N_META, D_MODEL), 1.0),
        'norm1_g': 1.0 + nrm(ks[2], (L, D_MODEL), 0.02),
        'w_in': nrm(ks[3], (L, D_MODEL, IN_COLS), D_MODEL ** -0.5),
        'conv_w': nrm(ks[4], (L, CONV_WIDTH, LRU_WIDTH), CONV_WIDTH ** -0.5),
        'conv_b': nrm(ks[5], (L, LRU_WIDTH), 0.02),
        'lru_w_r': nrm(ks[6], (L, 2, LRU_BLOCKS, LRU_BLOCK, LRU_BLOCK), LRU_BLOCK ** -0.5),
        'lru_b_r': nrm(ks[7], (L, 2, LRU_WIDTH), 0.02),
        'lru_w_i': nrm(ks[8], (L, 2, LRU_BLOCKS, LRU_BLOCK, LRU_BLOCK), LRU_BLOCK ** -0.5),
        'lru_b_i': nrm(ks[10], (L, 2, LRU_WIDTH), 0.02),
        'lru_lambda': lam,
        'lru_out_g': 1.0 + nrm(ks[11], (L, LRU_WIDTH), 0.02),
        'ret_out_g': 1.0 + nrm(ks[12], (L, RET_WIDTH), 0.02),
        'w_out': nrm(ks[13], (L, D_MIX, D_MODEL), D_MIX ** -0.5),
        'norm2_g': 1.0 + nrm(ks[14], (L, D_MODEL), 0.02),
        'w_router': nrm(ks[15], (L, D_MODEL, N_EXPERTS), D_MODEL ** -0.5),
        'w_gate': nrm(ks[16], (L, N_EXPERTS, D_MODEL, EXPERT_FF), D_MODEL ** -0.5),
        'w_up': nrm(ks[17], (L, N_EXPERTS, D_MODEL, EXPERT_FF), D_MODEL ** -0.5),
        'w_down': nrm(ks[18], (L, N_EXPERTS, EXPERT_FF, D_MODEL), EXPERT_FF ** -0.5),
        'final_g': 1.0 + nrm(ks[19], (D_MODEL,), 0.02),
    }


def reference(x, meta_tokens, norm1_g, w_in, conv_w, conv_b, lru_w_r, lru_b_r, lru_w_i,
              lru_b_i, lru_lambda, lru_out_g, ret_out_g, w_out, norm2_g, w_router, w_gate,
              w_up, w_down, final_g):
    bsz = x.shape[0]
    meta = jnp.broadcast_to(meta_tokens.astype(x.dtype)[None], (bsz, N_META, x.shape[-1]))
    hs = jnp.concatenate([meta, x], axis=1)
    for l in range(DEPTH):
        h = _rmsnorm(hs, norm1_g[l])
        hs = hs + _mixer(h, w_in[l], conv_w[l], conv_b[l], lru_w_r[l], lru_b_r[l], lru_w_i[l],
                         lru_b_i[l], lru_lambda[l], lru_out_g[l], ret_out_g[l], w_out[l])
        h = _rmsnorm(hs, norm2_g[l])
        hs = hs + _expert_choice_ffn(h, w_router[l], w_gate[l], w_up[l], w_down[l])
    return _rmsnorm(hs[:, N_META:], final_g)
```

```cpp
#include <hip/hip_runtime.h>
#include <cstdio>
#include <cstdint>
#ifndef MK_ONE_LAUNCH
#define MK_ONE_LAUNCH 0
#endif
namespace pg8 {
#define PG8_LAS __attribute__((address_space(3)))
typedef unsigned short bf16_t;
typedef short bf16x8 __attribute__((ext_vector_type(8)));
typedef float f32x4 __attribute__((ext_vector_type(4)));
typedef unsigned u32x4 __attribute__((ext_vector_type(4)));
constexpr int BM = 256, BK = 64, HALF = 128, HTB = HALF * BK * 2  , STAGE_BYTES = 8 * HTB, NXCD = 8, WGM = 8;

__host__ __device__ __forceinline__ int lds_byte(int r, int c) { const int st = (r >> 4) * 2 + (c >> 5), rr = r & 15, cc = c & 31, ob = rr * 64 + cc * 2; return st * 1024 + (ob ^ (((ob >> 9) & 1) << 5)); }
__host__ __device__ __forceinline__ void stage_rc(int b, int& R, int& C) { const int st = b / 1024, sb = b % 1024, swz = sb ^ (((sb >> 9) & 1) << 5); R = (st >> 1) * 16 + swz / 64; C = (st & 1) * 32 + (swz % 64) / 2; }
__host__ __device__ __forceinline__ int perm32(int rho) { const int n = rho >> 4, i = rho & 15; return 8 * (i >> 2) + 4 * n + (i & 3); }

struct Unit { int pm, pn; };
struct Gemm { const bf16_t* A; const bf16_t* Bt; int M, N, K; };

struct StaticOrder {
    int nM, nN, nwg, G, c;
    __host__ __device__ void init(int M, int N, int G_, int c_) { nM = M / BM; nN = N / BM; nwg = nM * nN; G = G_; c = c_; }
    __host__ __device__ bool next(int i, Unit& u) const {
        const long L = (long)i * G + c; if (L >= nwg) return false;
        int wgid = (int)L; { const int q = nwg / NXCD, r = nwg % NXCD, xcd = wgid % NXCD, off = wgid / NXCD; wgid = (xcd < r ? xcd * (q + 1) : r * (q + 1) + (xcd - r) * q) + off; }
        const int nig = WGM * nN, gid = wgid / nig, fm = gid * WGM, gsz = (nM - fm) < WGM ? (nM - fm) : WGM;
        u.pm = fm + ((wgid % nig) % gsz); u.pn = (wgid % nig) / gsz; return true;
    }
    __device__ __forceinline__ void a_ready(const Unit&) const {}
    __device__ __forceinline__ void done(const Unit&) const {}
};

__device__ __forceinline__ unsigned cvt_pk_bf16(float lo, float hi) { unsigned r; asm volatile("v_cvt_pk_bf16_f32 %0, %1, %2" : "=v"(r) : "v"(lo), "v"(hi)); return r; }
typedef float f32x2 __attribute__((ext_vector_type(2)));
__device__ __forceinline__ f32x2 gelu_pk(f32x2 v) {
    const f32x2 av = __builtin_elementwise_abs(v), d = av * 0.2316418882f + 1.0f;
    f32x2 t; t.x = __builtin_amdgcn_rcpf(d.x); t.y = __builtin_amdgcn_rcpf(d.y);
    f32x2 q = t * 0.5307027145f + (-0.7265760135f); q = q * t + 0.7107068705f; q = q * t + (-0.142248368f); q = q * t + 0.127414796f; q = q * t;
    const f32x2 s = (v * v) * (-0.72134752044f);
    f32x2 e; e.x = __builtin_amdgcn_exp2f(s.x); e.y = __builtin_amdgcn_exp2f(s.y);
    const f32x2 m = v * (q * e), r = v - m;
    f32x2 o; o.x = v.x < 0.f ? m.x : r.x; o.y = v.y < 0.f ? m.y : r.y; return o;
}

template <int ACT  > struct EpiBf16 {
    static constexpr bool PERM = true, AFTER_DRAIN = false; static_assert(ACT == 0 || ACT == 1, "EpiBf16: ACT is 0 (none) or 1 (gelu_pk)");
    bf16_t* O; int ldc; const float* bias; int split_cols; size_t split_stride; float scale0;
    __device__ __forceinline__ void operator()(const f32x4 (&acc)[2][2][4][2], const Unit& u, int wr, int wc, int fr, int fq) const {
        const int row0 = u.pm * BM + wr * 64 + fr; int colt = u.pn * BM; bf16_t* base = O;
        float sc = 1.f; if (split_cols) { const int t = colt / split_cols; base += (size_t)t * split_stride; colt -= t * split_cols; if (t == 0) sc = scale0; }
        const int col0 = colt + wc * 32 + 8 * fq, bcol0 = u.pn * BM + wc * 32 + 8 * fq;
        f32x4 bv[2][2];
#pragma unroll
        for (int bj = 0; bj < 2; ++bj)
#pragma unroll
            for (int n = 0; n < 2; ++n) bv[bj][n] = bias ? *(const f32x4*)(bias + bcol0 + bj * HALF + 4 * n) : (f32x4){0.f, 0.f, 0.f, 0.f};
#pragma unroll
        for (int ai = 0; ai < 2; ++ai)
#pragma unroll
            for (int m = 0; m < 4; ++m) { bf16_t* rowp = base + (size_t)(row0 + ai * HALF + m * 16) * ldc + col0;
#pragma unroll
                for (int bj = 0; bj < 2; ++bj) { f32x4 v0 = acc[ai][bj][m][0] + bv[bj][0], v1 = acc[ai][bj][m][1] + bv[bj][1];
                    if (ACT == 1) { f32x2 a = gelu_pk((f32x2){v0[0], v0[1]}), b = gelu_pk((f32x2){v0[2], v0[3]}), c = gelu_pk((f32x2){v1[0], v1[1]}), d = gelu_pk((f32x2){v1[2], v1[3]});
                        v0 = (f32x4){a.x, a.y, b.x, b.y}; v1 = (f32x4){c.x, c.y, d.x, d.y}; }
                    v0 = v0 * sc; v1 = v1 * sc; u32x4 w; w.x = cvt_pk_bf16(v0[0], v0[1]); w.y = cvt_pk_bf16(v0[2], v0[3]); w.z = cvt_pk_bf16(v1[0], v1[1]); w.w = cvt_pk_bf16(v1[2], v1[3]);
                    *(u32x4*)(rowp + bj * HALF) = w; } }
    }
};
template <class Epi, class Sched, bool ALIGN_EPI = false, bool SP2 = false>
__device__ __forceinline__ void gemm_phase(PG8_LAS unsigned char* lds, const Gemm g, const Sched& S, const Epi& E) {
    const int tid = threadIdx.x, wid = __builtin_amdgcn_readfirstlane(tid >> 6), lane = tid & 63, wr = wid >> 2, wc = wid & 3, fr = lane & 15, fq = lane >> 4;
    const int K = g.K, nt = K / BK;
    unsigned voffA[2], voffB[2];
#pragma unroll
    for (int i = 0; i < 2; ++i) { int R, C; stage_rc(tid * 16 + i * 8192, R, C); const int Rb = Epi::PERM ? ((R & ~31) + perm32(R & 31)) : R;
        voffA[i] = (unsigned)(R * K + C) * 2u; voffB[i] = (unsigned)(Rb * K + C) * 2u; }
    const size_t kstep = (size_t)(BK * 2);
    const size_t hstep = (size_t)HALF * K * 2;
    const size_t tstep = 2 * hstep;
    const unsigned ldsw = (unsigned)wid * 1024u;
    const int aoff = lds_byte(wr * 64 + fr, fq * 8), boff = lds_byte(wc * 32 + fr, fq * 8);
#define PG8_SA(b, h) (((b) * 2 + (h)) * HTB)
#define PG8_SB(b, h) ((4 + (b) * 2 + (h)) * HTB)
#define PG8_STAGE(bufoff, gbase, voff) do { _Pragma("unroll") for (int _i = 0; _i < 2; ++_i) \
        __builtin_amdgcn_global_load_lds((const unsigned*)((const char*)(gbase) + (voff)[_i]), (PG8_LAS unsigned*)(lds + (bufoff) + ldsw + _i * 8192), 16, 0, 0); } while (0)
#define PG8_LDA(dst, b, h) do { _Pragma("unroll") for (int m = 0; m < 4; ++m) _Pragma("unroll") for (int k = 0; k < 2; ++k) dst[m][k] = *(const PG8_LAS bf16x8*)(lds + PG8_SA(b, h) + aoff + m * 2048 + k * 1024); } while (0)
#define PG8_LDB(dst, b, h) do { _Pragma("unroll") for (int n = 0; n < 2; ++n) _Pragma("unroll") for (int k = 0; k < 2; ++k) dst[n][k] = *(const PG8_LAS bf16x8*)(lds + PG8_SB(b, h) + boff + n * 2048 + k * 1024); } while (0)
#define PG8_MMA(ai, bj, At, Bt) do { __builtin_amdgcn_s_setprio(1); _Pragma("unroll") for (int m = 0; m < 4; ++m) _Pragma("unroll") for (int n = 0; n < 2; ++n) _Pragma("unroll") for (int k = 0; k < 2; ++k) \
        acc[ai][bj][m][n] = __builtin_amdgcn_mfma_f32_16x16x32_bf16(Bt[n][k], At[m][k], acc[ai][bj][m][n], 0, 0, 0); __builtin_amdgcn_s_setprio(0); } while (0)
#define PG8_WAIT_V(n) asm volatile("s_waitcnt vmcnt(" #n ")" ::: "memory")
#define PG8_WAIT_L(n) asm volatile("s_waitcnt lgkmcnt(" #n ")" ::: "memory")
#define PG8_BAR __builtin_amdgcn_s_barrier()
#define PG8_SCHED __builtin_amdgcn_sched_barrier(0)
    Unit cur, nxt; int ui = 0;
    if (!S.next(0, cur)) return;
    f32x4 acc[2][2][4][2];
#pragma unroll
    for (int a = 0; a < 2; ++a)
#pragma unroll
        for (int b = 0; b < 2; ++b)
#pragma unroll
            for (int m = 0; m < 4; ++m)
#pragma unroll
                for (int n = 0; n < 2; ++n) acc[a][b][m][n] = (f32x4){0.f, 0.f, 0.f, 0.f};
    bf16x8 At[4][2], B0[2][2], B1[2][2];
    const char* cA = (const char*)g.A + (size_t)cur.pm * tstep; const char* cB = (const char*)g.Bt + (size_t)cur.pn * tstep;
    S.a_ready(cur);
    if constexpr (SP2) {
        PG8_STAGE(PG8_SB(0, 0), cB, voffB); PG8_STAGE(PG8_SB(0, 1), cB + hstep, voffB); PG8_STAGE(PG8_SA(0, 0), cA, voffA); PG8_STAGE(PG8_SA(0, 1), cA + hstep, voffA);
        if (wr == 1) PG8_BAR;
        PG8_WAIT_V(2); PG8_BAR;
        PG8_STAGE(PG8_SB(1, 0), cB + kstep, voffB); PG8_STAGE(PG8_SA(1, 0), cA + kstep, voffA); PG8_STAGE(PG8_SB(1, 1), cB + hstep + kstep, voffB);
        PG8_WAIT_V(6); PG8_BAR;
    } else {
        PG8_STAGE(PG8_SB(0, 0), cB, voffB); PG8_STAGE(PG8_SA(0, 0), cA, voffA); PG8_STAGE(PG8_SB(0, 1), cB + hstep, voffB); PG8_STAGE(PG8_SA(0, 1), cA + hstep, voffA);
        if (wr == 1) PG8_BAR;
        PG8_WAIT_V(4); PG8_BAR;
        PG8_STAGE(PG8_SB(1, 0), cB + kstep, voffB); PG8_STAGE(PG8_SA(1, 0), cA + kstep, voffA); PG8_STAGE(PG8_SB(1, 1), cB + hstep + kstep, voffB);
        PG8_WAIT_V(6); PG8_BAR;
    }
    for (;;) {
        const bool has_next = S.next(ui + 1, nxt);
        const char* nA = has_next ? (const char*)g.A + (size_t)nxt.pm * tstep : cA; const char* nB = has_next ? (const char*)g.Bt + (size_t)nxt.pn * tstep : cB;
        for (int t = 0; t < nt; t += 2) {
            const bool last = (t == nt - 2);
            const char* a1 = cA + (size_t)(t + 1) * kstep;
            const char* a2 = last ? nA : cA + (size_t)(t + 2) * kstep; const char* b2 = last ? nB : cB + (size_t)(t + 2) * kstep;
            const char* a3 = a2 + kstep; const char* b3 = b2 + kstep;
            if (last && has_next) S.a_ready(nxt);
            if constexpr (SP2) {
            PG8_LDB(B0, 0, 0); PG8_LDB(B1, 0, 1); PG8_SCHED; PG8_LDA(At, 0, 0); PG8_STAGE(PG8_SA(1, 1), a1 + hstep, voffA);
            PG8_WAIT_V(8); PG8_WAIT_L(0); PG8_BAR; PG8_MMA(0, 0, At, B0); PG8_MMA(0, 1, At, B1); PG8_BAR; PG8_SCHED;
            PG8_LDA(At, 0, 1); PG8_STAGE(PG8_SB(0, 0), b2, voffB); PG8_STAGE(PG8_SB(0, 1), b2 + hstep, voffB); PG8_STAGE(PG8_SA(0, 0), a2, voffA);
            PG8_WAIT_V(8); PG8_WAIT_L(0); PG8_BAR; PG8_MMA(1, 0, At, B0); PG8_MMA(1, 1, At, B1); PG8_BAR; PG8_SCHED;
            PG8_LDB(B0, 1, 0); PG8_LDB(B1, 1, 1); PG8_SCHED; PG8_LDA(At, 1, 0); PG8_STAGE(PG8_SA(0, 1), a2 + hstep, voffA);
            PG8_WAIT_V(8); PG8_WAIT_L(0); PG8_BAR; PG8_MMA(0, 0, At, B0); PG8_MMA(0, 1, At, B1); PG8_BAR; PG8_SCHED;
            PG8_LDA(At, 1, 1); PG8_STAGE(PG8_SB(1, 0), b3, voffB); PG8_STAGE(PG8_SB(1, 1), b3 + hstep, voffB); PG8_STAGE(PG8_SA(1, 0), a3, voffA);
            PG8_WAIT_V(8); PG8_WAIT_L(0); PG8_BAR; PG8_MMA(1, 0, At, B0); PG8_MMA(1, 1, At, B1); PG8_BAR; PG8_SCHED;
            } else {
            PG8_LDB(B0, 0, 0); PG8_SCHED; PG8_LDA(At, 0, 0); PG8_STAGE(PG8_SA(1, 1), a1 + hstep, voffA);
            PG8_WAIT_L(8); PG8_BAR; PG8_WAIT_L(0); PG8_MMA(0, 0, At, B0); PG8_BAR; PG8_SCHED;
            PG8_LDB(B1, 0, 1); PG8_STAGE(PG8_SB(0, 0), b2, voffB);
            PG8_BAR; PG8_WAIT_L(0); PG8_MMA(0, 1, At, B1); PG8_BAR;
            PG8_LDA(At, 0, 1); PG8_STAGE(PG8_SA(0, 0), a2, voffA);
            PG8_BAR; PG8_WAIT_L(0); PG8_MMA(1, 0, At, B0); PG8_BAR; PG8_SCHED;
            PG8_STAGE(PG8_SB(0, 1), b2 + hstep, voffB);
            PG8_WAIT_V(6); PG8_BAR; PG8_MMA(1, 1, At, B1); PG8_BAR;
            PG8_LDB(B0, 1, 0); PG8_SCHED; PG8_LDA(At, 1, 0); PG8_STAGE(PG8_SA(0, 1), a2 + hstep, voffA);
            PG8_WAIT_L(8); PG8_BAR; PG8_WAIT_L(0); PG8_MMA(0, 0, At, B0); PG8_BAR; PG8_SCHED;
            PG8_LDB(B1, 1, 1); PG8_STAGE(PG8_SB(1, 0), b3, voffB);
            PG8_BAR; PG8_WAIT_L(0); PG8_MMA(0, 1, At, B1); PG8_BAR;
            PG8_LDA(At, 1, 1); PG8_STAGE(PG8_SA(1, 0), a3, voffA);
            PG8_BAR; PG8_WAIT_L(0); PG8_MMA(1, 0, At, B0); PG8_BAR; PG8_SCHED;
            PG8_STAGE(PG8_SB(1, 1), b3 + hstep, voffB);
            PG8_WAIT_V(6); PG8_BAR; PG8_MMA(1, 1, At, B1); PG8_BAR;
            }
        }
        if constexpr (ALIGN_EPI) { if (wr == 0) PG8_BAR; }
        if constexpr (!Epi::AFTER_DRAIN) { E(acc, cur, wr, wc, fr, fq); S.done(cur); }
        if (!has_next) break;
#pragma unroll
        for (int a = 0; a < 2; ++a)
#pragma unroll
            for (int b = 0; b < 2; ++b)
#pragma unroll
                for (int m = 0; m < 4; ++m)
#pragma unroll
                    for (int n = 0; n < 2; ++n) acc[a][b][m][n] = (f32x4){0.f, 0.f, 0.f, 0.f};
        cur = nxt; cA = nA; cB = nB; ++ui;
        if constexpr (ALIGN_EPI) { if (wr == 1) PG8_BAR; }
    }
    PG8_WAIT_V(0);
    if constexpr (!ALIGN_EPI) { if (wr == 0) PG8_BAR; }
    PG8_BAR;
    if constexpr (Epi::AFTER_DRAIN) { E.fused(acc, cur, wr, wc, fr, fq, lds, wid, lane); S.done(cur); }
#undef PG8_SA
#undef PG8_SB
#undef PG8_STAGE
#undef PG8_LDA
#undef PG8_LDB
#undef PG8_MMA
#undef PG8_WAIT_V
#undef PG8_WAIT_L
#undef PG8_BAR
#undef PG8_SCHED
}
}
#define GAS __attribute__((address_space(1)))
#define LAS __attribute__((address_space(3)))
typedef unsigned short bf16;
typedef unsigned v4u __attribute__((ext_vector_type(4)));
typedef float f32x4 __attribute__((ext_vector_type(4)));
typedef short bf16x8 __attribute__((ext_vector_type(8)));
typedef GAS unsigned gu32;
typedef GAS unsigned long long gu64;
#define RLX_AGENT __ATOMIC_RELAXED, __HIP_MEMORY_SCOPE_AGENT
#define LDS_WAIT() asm volatile("s_waitcnt lgkmcnt(0)" ::: "memory")
#define VM_WAIT() asm volatile("s_waitcnt vmcnt(0)" ::: "memory")
__device__ __forceinline__ unsigned long long rt() { return __builtin_amdgcn_s_memrealtime(); }
__device__ __forceinline__ unsigned f2bf(float f) { unsigned u = __builtin_bit_cast(unsigned, f); return (u + 0x7fffu + ((u >> 16) & 1u)) >> 16; }
__device__ __forceinline__ unsigned pk2(float lo, float hi) { return f2bf(lo) | (f2bf(hi) << 16); }

#define XB_TMO      128
#define XB_XCNT(j)  (256  + 64 * (j))
#define XB_XSUB(j)  (1280 + 64 * (j))
#define XB_XGEN(j)  (2304 + 64 * (j))
#define XB_TOP      3328
#define XB_TOPGEN   3392
#define XCD_BAR_WORDS 3456
#define XB_SPIN_CAP (1u << 18)

__device__ __forceinline__ unsigned xb_ld(unsigned* p)              { return __hip_atomic_load(p, __ATOMIC_RELAXED, __HIP_MEMORY_SCOPE_AGENT); }
__device__ __forceinline__ unsigned xb_add(unsigned* p, unsigned v) { return __hip_atomic_fetch_add(p, v, __ATOMIC_RELAXED, __HIP_MEMORY_SCOPE_AGENT); }
__device__ __forceinline__ unsigned xb_xcc_id() { return (unsigned)__builtin_amdgcn_s_getreg((3 << 11) | 20) & 0xFu; }
#define XB_SPIN(cond, bar) do { unsigned _sp = 0; while (cond) { __builtin_amdgcn_s_sleep(1); \
    if ((++_sp & 255u) == 0u) { if (xb_ld(&(bar)[XB_TMO])) break; if (_sp > XB_SPIN_CAP) { atomicAdd(&(bar)[XB_TMO], 1u); break; } } } } while (0)

struct XcdBarrier {
    unsigned* bar; unsigned x;
    volatile LAS unsigned* st;
};

__device__ __forceinline__ XcdBarrier xcd_barrier_post(unsigned* bar, volatile LAS unsigned* st) {
    XcdBarrier b; b.bar = bar; b.x = xb_xcc_id(); b.st = st;
    if (threadIdx.x == 0) (void)xb_add(&bar[XB_XCNT(b.x)], 1u);
    return b;
}
__device__ __forceinline__ void xcd_barrier_complete(unsigned* bar, unsigned x, unsigned& nloc, unsigned& nx) {
    const unsigned G = gridDim.x * gridDim.y * gridDim.z;
    unsigned sum, cnt, mine, sp = 0u;
    for (;;) {
        sum = 0u; cnt = 0u; mine = 0u;
#pragma unroll
        for (unsigned j = 0; j < 16; ++j) { const unsigned c = xb_ld(&bar[XB_XCNT(j)]); sum += c; cnt += (c > 0u) ? 1u : 0u; mine = (j == x) ? c : mine; }
        if (sum == G) break;
        __builtin_amdgcn_s_sleep(1);
        if ((++sp & 255u) == 0u) { if (xb_ld(&bar[XB_TMO])) break; if (sp > XB_SPIN_CAP) { atomicAdd(&bar[XB_TMO], 1u); break; } }
    }
    nloc = mine > 0u ? mine : 1u; nx = cnt > 0u ? cnt : 1u;
}

__device__ __forceinline__ void xcd_barrier(const XcdBarrier& b) {
    asm volatile("s_waitcnt vmcnt(0)" ::: "memory");
    __syncthreads();
    if (threadIdx.x == 0) {
        unsigned* bar = b.bar;
        __builtin_amdgcn_s_waitcnt(0);
        unsigned nloc = b.st[0], nx = b.st[1];
        if (nloc == 0u) { xcd_barrier_complete(bar, b.x, nloc, nx); b.st[0] = nloc; b.st[1] = nx; }
        const unsigned old = xb_add(&bar[XB_XSUB(b.x)], 1u);
        const unsigned gen = old / nloc;
        if (old + 1u == (gen + 1u) * nloc) {
            __builtin_amdgcn_fence(__ATOMIC_RELEASE, "agent");
            asm volatile("s_waitcnt vmcnt(0)" ::: "memory");
            const unsigned og = xb_add(&bar[XB_TOP], 1u);
            const unsigned tg = og / nx;
            if (og + 1u == (tg + 1u) * nx) xb_add(&bar[XB_TOPGEN], 1u);
            else XB_SPIN(xb_ld(&bar[XB_TOPGEN]) == tg, bar);
            __builtin_amdgcn_fence(__ATOMIC_ACQUIRE, "agent");
            xb_add(&bar[XB_XGEN(b.x)], 1u);
            asm volatile("s_waitcnt vmcnt(0)" ::: "memory");
        } else {
            XB_SPIN(xb_ld(&bar[XB_XGEN(b.x)]) == gen, bar);
            __builtin_amdgcn_fence(__ATOMIC_ACQUIRE, "agent");
            asm volatile("s_waitcnt vmcnt(0)" ::: "memory");
        }
    }
    __syncthreads();
}
typedef unsigned u32x4 __attribute__((ext_vector_type(4)));

namespace pg8 {
__device__ __forceinline__ float silu_f(float x) { return x * __builtin_amdgcn_rcpf(1.0f + __expf(-x)); }
struct EpiHS {
    static constexpr bool PERM = false, AFTER_DRAIN = false;
    const float* x; const float* meta; float* out; float* hsmeta;
    __device__ __forceinline__ void operator()(const f32x4 (&acc)[2][2][4][2], const Unit& u, int wr, int wc, int fr, int fq) const {
        const int col0 = u.pn * BM + wc * 32 + 4 * fq;
#pragma unroll
        for (int ai = 0; ai < 2; ++ai)
#pragma unroll
            for (int m = 0; m < 4; ++m) {
                const int r = u.pm * BM + ai * HALF + wr * 64 + m * 16 + fr;
                const int b = r / 8320, p = r - b * 8320, t = p - 112;
                if (t >= 0) {
                    const float* src; float* dst;
                    if (t < 16) { src = meta + (size_t)t * 1024; dst = hsmeta + (size_t)(b * 16 + t) * 1024; }
                    else { const size_t o = ((size_t)b * 8192 + (size_t)(t - 16)) * 1024; src = x + o; dst = out + o; }
#pragma unroll
                    for (int bj = 0; bj < 2; ++bj)
#pragma unroll
                        for (int n = 0; n < 2; ++n) { const int c = col0 + bj * HALF + n * 16; const f32x4 rv = *(const f32x4*)(src + c); *(f32x4*)(dst + c) = rv + acc[ai][bj][m][n]; }
                }
            }
    }
};
struct EpiAct {
    static constexpr bool PERM = true, AFTER_DRAIN = false;
    bf16_t* act;
    __device__ __forceinline__ void operator()(const f32x4 (&acc)[2][2][4][2], const Unit& u, int wr, int wc, int fr, int fq) const {
        const int row0 = u.pm * BM + wr * 64 + fr; const int j = u.pn & 7; const int col0 = j * 128 + wc * 32 + 8 * fq;
#pragma unroll
        for (int ai = 0; ai < 2; ++ai)
#pragma unroll
            for (int m = 0; m < 4; ++m) {
                bf16_t* rowp = act + (size_t)(row0 + ai * HALF + m * 16) * 1024 + col0;
                const f32x4 g0 = acc[ai][0][m][0], g1 = acc[ai][0][m][1], u0 = acc[ai][1][m][0], u1 = acc[ai][1][m][1];
                u32x4 w;
                w.x = cvt_pk_bf16(silu_f(g0[0]) * u0[0], silu_f(g0[1]) * u0[1]); w.y = cvt_pk_bf16(silu_f(g0[2]) * u0[2], silu_f(g0[3]) * u0[3]);
                w.z = cvt_pk_bf16(silu_f(g1[0]) * u1[0], silu_f(g1[1]) * u1[1]); w.w = cvt_pk_bf16(silu_f(g1[2]) * u1[2], silu_f(g1[3]) * u1[3]);
                *(u32x4*)rowp = w;
            }
    }
};
struct EpiYS {
    static constexpr bool PERM = true, AFTER_DRAIN = false;
    bf16_t* ys; const float* gate;
    __device__ __forceinline__ void operator()(const f32x4 (&acc)[2][2][4][2], const Unit& u, int wr, int wc, int fr, int fq) const {
        const int row0 = u.pm * BM + wr * 64 + fr; const int j = u.pn & 3; const int col0 = j * 256 + wc * 32 + 8 * fq;
#pragma unroll
        for (int ai = 0; ai < 2; ++ai)
#pragma unroll
            for (int m = 0; m < 4; ++m) {
                const int row = row0 + ai * HALF + m * 16; const float gv = gate[row];
                bf16_t* rowp = ys + (size_t)row * 1024 + col0;
#pragma unroll
                for (int bj = 0; bj < 2; ++bj) { const f32x4 v0 = acc[ai][bj][m][0] * gv, v1 = acc[ai][bj][m][1] * gv; u32x4 w;
                    w.x = cvt_pk_bf16(v0[0], v0[1]); w.y = cvt_pk_bf16(v0[2], v0[3]); w.z = cvt_pk_bf16(v1[0], v1[1]); w.w = cvt_pk_bf16(v1[2], v1[3]);
                    *(u32x4*)(rowp + bj * HALF) = w; }
            }
    }
};
struct GroupOrder {
    int G, vcu, tm, tn, nwg;
    __device__ void init(int ne, int tm_, int tn_, int G_, int c) { tm = tm_; tn = tn_; nwg = ne * tm_ * tn_; G = G_; vcu = (G_ % 8 == 0) ? (c % 8) * (G_ / 8) + c / 8 : c; }
    __device__ bool next(int i, Unit& u) const {
        const long L = (long)i * G + vcu; if (L >= nwg) return false;
        const int per = tm * tn, e = (int)(L / per), rem = (int)(L % per);
        u.pm = e * tm + rem / tn; u.pn = e * tn + rem % tn; return true;
    }
    __device__ __forceinline__ void a_ready(const Unit&) const {}
    __device__ __forceinline__ void done(const Unit&) const {}
};
}

constexpr int NB = 8, SEQ = 8192, DM = 1024, NMETA = 16, TT = SEQ + NMETA, PADL = 112, PP = 8320, NP = NB * PP;
constexpr int NCHUNK = 65, NSEG = 130;
constexpr int ZC = 3072, ZC_LX = 0, ZC_LG = 512, ZC_Q = 1024, ZC_K = 1536, ZC_V = 2048, ZC_G = 2560;
constexpr int NE = 16, CAP = 1026, EROWS = 8448, NROWS = NE * EROWS;
constexpr float EPSN = 1e-6f;
constexpr int NPHASE = 12;

constexpr size_t MiB = 1u << 20;
constexpr size_t WS_CTL = 0, CTL_ZERO_BYTES = 64 * 1024;
constexpr size_t WS_GW = 1 * MiB, WS_HSMETA = 1 * MiB + 512 * 1024;
constexpr size_t WS_CS = 3 * MiB, WS_SUMM = 8 * MiB, WS_CARRY = 17 * MiB, WS_AFF = 22 * MiB, WS_ROWMAP = 27 * MiB, WS_IDX = 32 * MiB, WS_GATE = 33 * MiB;
constexpr size_t WS_WIN = 34 * MiB, WS_WOUT = 40 * MiB, WS_WGU = 42 * MiB, WS_WD = 106 * MiB;
constexpr size_t WS_H = 138 * MiB, WS_Z = 268 * MiB, WS_ST = 658 * MiB, WS_XS = 658 * MiB, WS_ACT = 268 * MiB, WS_YS = WS_XS, WS_END = 922 * MiB;
static_assert(WS_H + (size_t)NP * 2048 <= WS_Z && WS_Z + (size_t)NP * ZC * 2 <= WS_ST && WS_ST + (size_t)NB * 4 * 2 * NCHUNK * 32768 <= WS_END && WS_XS + (size_t)NROWS * 2048 <= WS_END && WS_ACT + (size_t)NROWS * 2048 <= WS_ST, "ws map");
constexpr int CW_BAR = 1024;

constexpr int LDS_MAIN = 131072, LDS_BYTES = 147456;
constexpr int LDS_SS = LDS_MAIN;
constexpr int LDS_MISC = LDS_MAIN + 4096;

typedef unsigned short u16x8 __attribute__((ext_vector_type(8)));
typedef unsigned short u16x4 __attribute__((ext_vector_type(4)));
typedef float f32x16 __attribute__((ext_vector_type(16)));
typedef float f32x2 __attribute__((ext_vector_type(2)));
typedef unsigned u32x2 __attribute__((ext_vector_type(2)));
typedef short v4i16_t __attribute__((ext_vector_type(4)));
typedef __bf16 bf16x2_t __attribute__((ext_vector_type(2)));

__device__ __forceinline__ float bf2f(unsigned short v) { return __uint_as_float((unsigned)v << 16); }
__device__ __forceinline__ unsigned cvtpk(float lo, float hi) { f32x2 v = {lo, hi}; bf16x2_t b = __builtin_convertvector(v, bf16x2_t); return __builtin_bit_cast(unsigned, b); }
__device__ __forceinline__ unsigned short f2bf16(float f) { return (unsigned short)(cvtpk(f, 0.f) & 0xffffu); }
__device__ __forceinline__ float wave_sum(float v) {
#pragma unroll
    for (int o = 1; o < 64; o <<= 1) v += __shfl_xor(v, o);
    return v;
}
__device__ __forceinline__ float sigmoid_f(float x) { return __builtin_amdgcn_rcpf(1.0f + __expf(-x)); }
__device__ __forceinline__ float gelu_tanh_f(float x) { const float z = 0.7978845608028654f * (x + 0.044715f * x * x * x); const float t = 1.0f - 2.0f * __builtin_amdgcn_rcpf(1.0f + __expf(2.0f * z)); return 0.5f * x * (1.0f + t); }
__device__ __forceinline__ float softplus_neg(float lam) { const float y = __expf(-lam); return (y < 0.05f) ? y * (1.0f + y * (-0.5f + y * (0.33333333f + y * (-0.25f + y * 0.2f)))) : log1pf(y); }
__device__ __forceinline__ float log2_gamma(int h) { return h == 0 ? -0.04580368961312479f : h == 1 ? -0.02272007650008353f : h == 2 ? -0.011315313227834146f : -0.005646563141142063f; }
__device__ __forceinline__ unsigned off_b(unsigned row, unsigned ch) { return 256u * row + 16u * (ch ^ (((row & 3u) << 2) | ((row >> 2) & 3u))); }
__device__ __forceinline__ pg8::bf16x8 rowfrag(LAS unsigned char* T, int rb, int s, int lane) {
    return *(LAS pg8::bf16x8*)(T + off_b(32 * rb + (lane & 31), 2 * s + (lane >> 5)));
}
__device__ __forceinline__ v4i16_t tr_rd(LAS unsigned char* p) { return __builtin_amdgcn_ds_read_tr16_b64_v4i16((LAS v4i16_t*)p); }
__device__ __forceinline__ pg8::bf16x8 trfrag(LAS unsigned char* T, int c, int ks, int lane) {
    const unsigned h = lane >> 5, blk = (lane >> 4) & 1, q = (lane & 15) >> 2, p = lane & 3;
    const v4i16_t lo = tr_rd(T + off_b(16 * ks + 8 * h + q, 4 * c + 2 * blk + (p >> 1)) + 8 * (p & 1));
    const v4i16_t hi = tr_rd(T + off_b(16 * ks + 8 * h + 4 + q, 4 * c + 2 * blk + (p >> 1)) + 8 * (p & 1));
    return (pg8::bf16x8){lo[0], lo[1], lo[2], lo[3], hi[0], hi[1], hi[2], hi[3]};
}
__device__ __forceinline__ pg8::bf16x8 trfrag_perm(LAS unsigned char* T, int c, int rbase, int lane) {
    const unsigned h = lane >> 5, blk = (lane >> 4) & 1, q = (lane & 15) >> 2, p = lane & 3;
    const v4i16_t lo = tr_rd(T + off_b(rbase + 4 * h + q, 4 * c + 2 * blk + (p >> 1)) + 8 * (p & 1));
    const v4i16_t hi = tr_rd(T + off_b(rbase + 8 + 4 * h + q, 4 * c + 2 * blk + (p >> 1)) + 8 * (p & 1));
    return (pg8::bf16x8){lo[0], lo[1], lo[2], lo[3], hi[0], hi[1], hi[2], hi[3]};
}
__device__ __forceinline__ int crow(int reg, int h) { return (reg & 3) + 8 * (reg >> 2) + 4 * h; }
#define MFMA32(a, b, c) __builtin_amdgcn_mfma_f32_32x32x16_bf16((a), (b), (c), 0, 0, 0)
#define MFMA16(a, b, c) __builtin_amdgcn_mfma_f32_16x16x32_bf16((a), (b), (c), 0, 0, 0)

struct Fr {
    LAS unsigned char* lds;
    int tid, lane, wave, G;
    const float *x, *meta, *norm1_g, *w_in, *conv_w, *conv_b, *w_r, *b_r, *w_i, *b_i, *lam, *lru_out_g, *ret_out_g, *w_out, *norm2_g, *w_router, *w_gate, *w_up, *w_down, *final_g;
    float* out;
    unsigned short *GW, *WIN, *WOUT, *WGU, *WD, *H, *Z, *ST, *XS, *ACT, *YS;
    float *HSMETA, *AFF, *GATE, *CARRY; f32x2 *CS, *SUMM; int *ROWMAP, *IDX;
};

__device__ __forceinline__ void prep_tile(const Fr& F, const float* W, int ldw, int k0, int n0, unsigned short* WT, int mode) {
    LAS float* scr = (LAS float*)F.lds;
    const int tid = F.tid;
    { const int n = tid & 63, kk = tid >> 6;
#pragma unroll
      for (int i = 0; i < 8; ++i) { const int k = kk + 8 * i; scr[k * 65 + n] = W[(size_t)(k0 + k) * ldw + n0 + n]; } }
    __syncthreads();
    { const int k = tid & 63, nn = tid >> 6;
#pragma unroll
      for (int i = 0; i < 8; ++i) { const int n = n0 + nn + 8 * i; const int row = mode == 0 ? n : (256 * (n >> 7) + (n & 127) + (mode == 2 ? 128 : 0));
          WT[(size_t)row * 1024 + k0 + k] = f2bf16(scr[k * 65 + (nn + 8 * i)]); } }
    __syncthreads();
}
__device__ __forceinline__ void sincos_tab(int t, int j, float& co, float& si) {
    double f = 1.0, bse = 0.8659643233600653;
    int e = j;
#pragma unroll
    for (int i = 0; i < 6; ++i) { if (e & 1) f *= bse; bse *= bse; e >>= 1; }
    const double xx = (double)t * f;
    const double qd = __builtin_rint(xx * 0.6366197723675814);
    double y = __builtin_fma(-qd, 1.5707963267948966, xx); y = __builtin_fma(-qd, 6.123233995736766e-17, y);
    const double y2 = y * y;
    double sp = -7.647163731819816e-13;
    sp = sp * y2 + 1.6059043836821613e-10;
    sp = sp * y2 - 2.505210838544172e-08;
    sp = sp * y2 + 2.7557319223985893e-06;
    sp = sp * y2 - 1.984126984126984e-04;
    sp = sp * y2 + 8.333333333333333e-03;
    sp = sp * y2 - 1.6666666666666666e-01;
    const double sy = y + y * y2 * sp;
    double cp = 4.779477332387385e-14;
    cp = cp * y2 - 1.1470745597729725e-11;
    cp = cp * y2 + 2.08767569878681e-09;
    cp = cp * y2 - 2.755731922398589e-07;
    cp = cp * y2 + 2.48015873015873e-05;
    cp = cp * y2 - 1.388888888888889e-03;
    cp = cp * y2 + 4.1666666666666664e-02;
    cp = cp * y2 - 0.5;
    const double cy = 1.0 + y2 * cp;
    const int qi = ((int)(long long)qd) & 3;
    const double s_ = (qi == 0) ? sy : (qi == 1) ? cy : (qi == 2) ? -sy : -cy;
    const double c_ = (qi == 0) ? cy : (qi == 1) ? -sy : (qi == 2) ? -cy : sy;
    co = (float)c_; si = (float)s_;
}
__device__ __forceinline__ void rms_row_to_bf16(const float* xrow, const float* g, unsigned short* orow, int lane) {
    const f32x4* xr = (const f32x4*)xrow + lane; const f32x4* gr = (const f32x4*)g + lane;
    f32x4 v[4]; float s = 0.f;
#pragma unroll
    for (int j = 0; j < 4; ++j) { v[j] = xr[64 * j]; s += (v[j].x * v[j].x + v[j].y * v[j].y) + (v[j].z * v[j].z + v[j].w * v[j].w); }
    const float rs = 1.0f / sqrtf(wave_sum(s) * (1.0f / 1024.0f) + EPSN);
    u32x2* o8 = (u32x2*)orow + lane;
#pragma unroll
    for (int j = 0; j < 4; ++j) { const f32x4 gg = gr[64 * j]; u32x2 w; w.x = cvtpk(v[j].x * rs * gg.x, v[j].y * rs * gg.y); w.y = cvtpk(v[j].z * rs * gg.z, v[j].w * rs * gg.w); o8[64 * j] = w; }
}
__device__ __forceinline__ void ph_prep(const Fr& F) {
    const int bid = blockIdx.x, G = F.G;
    for (int it = bid; it < 13312; it += G) {
        if (it < 768) { const int kt = it / 48, nt = it % 48; prep_tile(F, F.w_in, 3072, 64 * kt, 64 * nt, F.WIN, 0); }
        else if (it < 1024) { const int i2 = it - 768, kt = i2 / 16, nt = i2 % 16; prep_tile(F, F.w_out, 1024, 64 * kt, 64 * nt, F.WOUT, 0); }
        else { const int i3 = it - 1024, e = i3 / 768, r = i3 % 768, which = r / 256, t = r % 256, kt = t / 16, nt = t % 16;
            if (which == 0) prep_tile(F, F.w_gate + (size_t)e * 1048576, 1024, 64 * kt, 64 * nt, F.WGU + (size_t)e * 2097152, 1);
            else if (which == 1) prep_tile(F, F.w_up + (size_t)e * 1048576, 1024, 64 * kt, 64 * nt, F.WGU + (size_t)e * 2097152, 2);
            else prep_tile(F, F.w_down + (size_t)e * 1048576, 1024, 64 * kt, 64 * nt, F.WD + (size_t)e * 1048576, 0); }
    }
    const int gt = bid * 512 + F.tid, GT = G * 512;
    for (int idx = gt; idx < 8 * 256 * 64; idx += GT) {
        const int blk = idx >> 14, o = (idx >> 6) & 255, k = idx & 63, g = o >> 6, d = o & 63, dir = g >> 1;
        const float* src = (g & 1) ? F.w_i : F.w_r;
        F.GW[idx] = f2bf16(src[((size_t)(dir * 8 + blk) * 64 + k) * 64 + d]);
    }
    for (int idx = gt; idx < TT * 64; idx += GT) { float co, si; sincos_tab(idx >> 6, idx & 63, co, si); F.CS[idx] = (f32x2){co, si}; }
    const int gw = bid * 8 + F.wave, NGW = G * 8;
    for (int r = gw; r < NP; r += NGW) {
        const int b = r / PP, p = r - b * PP, t = p - PADL;
        unsigned short* orow = F.H + (size_t)r * 1024;
        if (t < 0) { u32x2* o8 = (u32x2*)orow + F.lane;
#pragma unroll
            for (int j = 0; j < 4; ++j) o8[64 * j] = (u32x2){0u, 0u}; }
        else { const float* src = t < NMETA ? F.meta + (size_t)t * 1024 : F.x + ((size_t)b * SEQ + (t - NMETA)) * 1024; rms_row_to_bf16(src, F.norm1_g, orow, F.lane); }
    }
}

template <bool FINAL>
__device__ __forceinline__ void lru_item(const Fr& F, int b, int s) {
    int lane = F.lane; asm volatile("" : "+v"(lane));
    const int w = F.wave, fr = lane & 15, fq = lane >> 4;
    LAS unsigned short* U = (LAS unsigned short*)F.lds;
    LAS float* Gm = (LAS float*)(F.lds + 9216);
    LAS float* SM = (LAS float*)(F.lds + 9216 + 66560);
    const int pw = s * 64 + 8 * w; const size_t rowbase = (size_t)b * PP;
    float ssq[8];
#pragma unroll
    for (int j = 0; j < 8; ++j) ssq[j] = 0.f;
    for (int blk = 0; blk < 8; ++blk) {
        const int c = blk * 64 + lane;
        float xv[11];
#pragma unroll
        for (int i = 0; i < 11; ++i) { const int p = pw - 2 + i; xv[i] = (p >= 0 && p < PP) ? bf2f(F.Z[(rowbase + p) * ZC + ZC_LX + c]) : 0.f; }
        const float cw0 = F.conv_w[c], cw1 = F.conv_w[512 + c], cw2 = F.conv_w[1024 + c], cw3 = F.conv_w[1536 + c], cbv = F.conv_b[c];
        float u[8];
#pragma unroll
        for (int j = 0; j < 8; ++j) { u[j] = cbv + cw0 * xv[j] + cw1 * xv[j + 1] + cw2 * xv[j + 2] + cw3 * xv[j + 3]; U[(8 * w + j) * 72 + lane] = f2bf16(u[j]); }
        __syncthreads();
        pg8::f32x4 acc[4][2];
#pragma unroll
        for (int m = 0; m < 4; ++m) { acc[m][0] = (pg8::f32x4){0.f, 0.f, 0.f, 0.f}; acc[m][1] = acc[m][0]; }
#pragma unroll
        for (int ks = 0; ks < 2; ++ks) {
            pg8::bf16x8 bfr[2];
#pragma unroll
            for (int n = 0; n < 2; ++n) bfr[n] = *(const pg8::bf16x8*)(F.GW + ((size_t)(blk * 256 + 32 * w + 16 * n + fr) * 64 + 32 * ks + 8 * fq));
#pragma unroll
            for (int m = 0; m < 4; ++m) { const pg8::bf16x8 a = *(LAS pg8::bf16x8*)(U + (16 * m + fr) * 72 + 32 * ks + 8 * fq);
#pragma unroll
                for (int n = 0; n < 2; ++n) acc[m][n] = MFMA16(a, bfr[n], acc[m][n]); }
        }
#pragma unroll
        for (int m = 0; m < 4; ++m)
#pragma unroll
            for (int n = 0; n < 2; ++n)
#pragma unroll
                for (int rg = 0; rg < 4; ++rg) Gm[(16 * m + 4 * fq + rg) * 260 + 32 * w + 16 * n + fr] = acc[m][n][rg];
        __syncthreads();
        const float sp0 = softplus_neg(F.lam[c]), sp1 = softplus_neg(F.lam[512 + c]);
        const float br0 = F.b_r[c], bi0 = F.b_i[c], br1 = F.b_r[512 + c], bi1 = F.b_i[512 + c];
        float hf[8], pf[8], hb[8], pb[8], af[8], ab[8];
#pragma unroll
        for (int j = 0; j < 8; ++j) {
            const LAS float* g = Gm + (8 * w + j) * 260 + lane;
            const float r0 = sigmoid_f(g[0] + br0), i0 = sigmoid_f(g[64] + bi0), r1 = sigmoid_f(g[128] + br1), i1 = sigmoid_f(g[192] + bi1);
            const float la0 = -8.0f * r0 * sp0, la1 = -8.0f * r1 * sp1;
            const float x0 = 2.0f * la0, x1 = 2.0f * la1;
            const float e0 = -x0 * (1.0f + x0 * 0.5f * (1.0f + x0 * 0.33333333f * (1.0f + x0 * 0.25f * (1.0f + x0 * 0.2f * (1.0f + x0 * 0.16666667f * (1.0f + x0 * 0.14285714f))))));
            const float e1 = -x1 * (1.0f + x1 * 0.5f * (1.0f + x1 * 0.33333333f * (1.0f + x1 * 0.25f * (1.0f + x1 * 0.2f * (1.0f + x1 * 0.16666667f * (1.0f + x1 * 0.14285714f))))));
            const bool padp = (pw + j) < PADL;
            af[j] = padp ? 1.0f : __expf(la0); ab[j] = padp ? 1.0f : __expf(la1);
            hf[j] = padp ? 0.0f : sqrtf(e0) * i0 * u[j]; hb[j] = padp ? 0.0f : sqrtf(e1) * i1 * u[j];
        }
        { float h = 0.f, P = 1.f;
#pragma unroll
          for (int j = 0; j < 8; ++j) { h = af[j] * h + hf[j]; hf[j] = h; P *= af[j]; pf[j] = P; } }
        { float h = 0.f, P = 1.f;
#pragma unroll
          for (int j = 7; j >= 0; --j) { h = ab[j] * h + hb[j]; hb[j] = h; P *= ab[j]; pb[j] = P; } }
        SM[((0 * 8 + w) * 2 + 0) * 64 + lane] = pf[7]; SM[((0 * 8 + w) * 2 + 1) * 64 + lane] = hf[7];
        SM[((1 * 8 + w) * 2 + 0) * 64 + lane] = pb[0]; SM[((1 * 8 + w) * 2 + 1) * 64 + lane] = hb[0];
        __syncthreads();
        const size_t sidx = ((size_t)(b * NSEG + s) * 2) * 512 + c;
        if (!FINAL) {
            if (w == 0) {
                float cf = 0.f, Af = 1.f, cb = 0.f, Ab = 1.f;
#pragma unroll
                for (int w2 = 0; w2 < 8; ++w2) { const float A = SM[((0 * 8 + w2) * 2 + 0) * 64 + lane], H = SM[((0 * 8 + w2) * 2 + 1) * 64 + lane]; cf = A * cf + H; Af *= A; }
#pragma unroll
                for (int w2 = 7; w2 >= 0; --w2) { const float A = SM[((1 * 8 + w2) * 2 + 0) * 64 + lane], H = SM[((1 * 8 + w2) * 2 + 1) * 64 + lane]; cb = A * cb + H; Ab *= A; }
                F.SUMM[sidx] = (f32x2){Af, cf}; F.SUMM[sidx + 512] = (f32x2){Ab, cb};
            }
        } else {
            float cf = F.CARRY[sidx], cb = F.CARRY[sidx + 512];
#pragma unroll
            for (int w2 = 0; w2 < 8; ++w2) if (w2 < w) { const float A = SM[((0 * 8 + w2) * 2 + 0) * 64 + lane], H = SM[((0 * 8 + w2) * 2 + 1) * 64 + lane]; cf = A * cf + H; }
#pragma unroll
            for (int w2 = 7; w2 >= 0; --w2) if (w2 > w) { const float A = SM[((1 * 8 + w2) * 2 + 0) * 64 + lane], H = SM[((1 * 8 + w2) * 2 + 1) * 64 + lane]; cb = A * cb + H; }
#pragma unroll
            for (int j = 0; j < 8; ++j) {
                const size_t row = rowbase + pw + j;
                const float gate = bf2f(F.Z[row * ZC + ZC_LG + c]);
                const float y = ((hf[j] + pf[j] * cf) + (hb[j] + pb[j] * cb)) * gelu_tanh_f(gate);
                ssq[j] += y * y; F.H[row * 1024 + c] = f2bf16(y);
            }
        }
        __syncthreads();
    }
    if (FINAL) {
        float rs[8];
#pragma unroll
        for (int j = 0; j < 8; ++j) rs[j] = 1.0f / sqrtf(wave_sum(ssq[j]) * (1.0f / 512.0f) + EPSN);
        for (int blk = 0; blk < 8; ++blk) { const int c = blk * 64 + lane; const float og = F.lru_out_g[c];
#pragma unroll
            for (int j = 0; j < 8; ++j) { const size_t idx = (rowbase + pw + j) * 1024 + c; const float y = bf2f(F.H[idx]); F.H[idx] = f2bf16(y * rs[j] * og); } }
    }
}

template <bool TWO>
__device__ __forceinline__ void stage_rot(const Fr& F, size_t row0, int zc, int n, LAS unsigned char* T0, LAS unsigned char* T1, float qscale, float lg) {
    for (int it = F.tid; it < 1024; it += 512) {
        const int c = it >> 3, ch = it & 7;
        const unsigned short* kp = F.Z + (row0 + c) * ZC + zc;
        const u16x8 k1 = *(const u16x8*)(kp + 8 * ch), k2 = *(const u16x8*)(kp + 64 + 8 * ch);
        int t = 128 * n + c - PADL; t = t < 0 ? 0 : t;
        const f32x2* cs = F.CS + (size_t)t * 64 + 8 * ch;
        const float s0 = TWO ? exp2f(lg * (float)(127 - c)) : qscale, s1 = TWO ? exp2f(lg * (float)c) : 0.f;
        u32x4 a0, a1, b0, b1;
        float r1[8], r2[8];
#pragma unroll
        for (int i = 0; i < 8; ++i) { const float a = bf2f(k1[i]), bb = bf2f(k2[i]); const f32x2 e = cs[i]; r1[i] = a * e.x - bb * e.y; r2[i] = a * e.y + bb * e.x; }
        a0.x = cvtpk(r1[0] * s0, r1[1] * s0); a0.y = cvtpk(r1[2] * s0, r1[3] * s0); a0.z = cvtpk(r1[4] * s0, r1[5] * s0); a0.w = cvtpk(r1[6] * s0, r1[7] * s0);
        a1.x = cvtpk(r2[0] * s0, r2[1] * s0); a1.y = cvtpk(r2[2] * s0, r2[3] * s0); a1.z = cvtpk(r2[4] * s0, r2[5] * s0); a1.w = cvtpk(r2[6] * s0, r2[7] * s0);
        *(LAS u32x4*)(T0 + off_b(c, ch)) = a0; *(LAS u32x4*)(T0 + off_b(c, ch + 8)) = a1;
        if (TWO) {
            b0.x = cvtpk(r1[0] * s1, r1[1] * s1); b0.y = cvtpk(r1[2] * s1, r1[3] * s1); b0.z = cvtpk(r1[4] * s1, r1[5] * s1); b0.w = cvtpk(r1[6] * s1, r1[7] * s1);
            b1.x = cvtpk(r2[0] * s1, r2[1] * s1); b1.y = cvtpk(r2[2] * s1, r2[3] * s1); b1.z = cvtpk(r2[4] * s1, r2[5] * s1); b1.w = cvtpk(r2[6] * s1, r2[7] * s1);
            *(LAS u32x4*)(T1 + off_b(c, ch)) = b0; *(LAS u32x4*)(T1 + off_b(c, ch + 8)) = b1;
        }
    }
}
__device__ __forceinline__ void stage_plain(const Fr& F, const unsigned short* src, size_t ld, LAS unsigned char* T) {
    for (int it = F.tid; it < 2048; it += 512) { const int c = it >> 4, ch = it & 15; *(LAS u32x4*)(T + off_b(c, ch)) = *(const u32x4*)(src + (size_t)c * ld + 8 * ch); }
}
__device__ __forceinline__ void ret_contrib_item(const Fr& F, int b, int h, int n) {
    int lane = F.lane; asm volatile("" : "+v"(lane));
    const int w = F.wave, r = lane & 31, h2 = lane >> 5;
    LAS unsigned char* TKF = F.lds; LAS unsigned char* TKB = F.lds + 32768; LAS unsigned char* TV = F.lds + 65536;
    const size_t row0 = (size_t)b * PP + 128 * n; const float lg = log2_gamma(h);
    stage_rot<true>(F, row0, ZC_K + 128 * h, n, TKF, TKB, 1.f, lg);
    stage_plain(F, F.Z + row0 * ZC + ZC_V + 128 * h, ZC, TV);
    __syncthreads();
    const int dir = w >> 2, cb = w & 3; LAS unsigned char* TK = dir ? TKB : TKF;
    f32x16 acc[4];
#pragma unroll
    for (int eb = 0; eb < 4; ++eb)
#pragma unroll
        for (int i = 0; i < 16; ++i) acc[eb][i] = 0.f;
#pragma unroll
    for (int ks = 0; ks < 8; ++ks) {
        const pg8::bf16x8 a = trfrag(TK, cb, ks, lane);
#pragma unroll
        for (int eb = 0; eb < 4; ++eb) { const pg8::bf16x8 bv = trfrag(TV, eb, ks, lane); acc[eb] = MFMA32(a, bv, acc[eb]); }
    }
    unsigned short* dst = F.ST + ((size_t)(((b * 4 + h) * 2 + dir) * NCHUNK + n)) * 16384;
#pragma unroll
    for (int eb = 0; eb < 4; ++eb)
#pragma unroll
        for (int g = 0; g < 4; ++g) { u32x2 v; v.x = cvtpk(acc[eb][4 * g], acc[eb][4 * g + 1]); v.y = cvtpk(acc[eb][4 * g + 2], acc[eb][4 * g + 3]);
            *(u32x2*)(dst + (size_t)(32 * eb + r) * 128 + 32 * cb + 8 * g + 4 * h2) = v; }
    __syncthreads();
}
__device__ __forceinline__ void ret_scan(const Fr& F) {
    for (int v = blockIdx.x * 512 + F.tid; v < 64 * 2048; v += F.G * 512) {
        const int strip = v >> 11, off = v & 2047, dir = strip & 1, h = (strip >> 1) & 3;
        const float cd = exp2f(128.0f * log2_gamma(h));
        unsigned short* base = F.ST + (size_t)strip * NCHUNK * 16384 + (size_t)off * 8;
        float carry[8];
#pragma unroll
        for (int i = 0; i < 8; ++i) carry[i] = 0.f;
        for (int k = 0; k < NCHUNK; ++k) {
            const int n = dir ? (NCHUNK - 1 - k) : k;
            u16x8* p = (u16x8*)(base + (size_t)n * 16384);
            const u16x8 tv = *p; u32x4 o;
            o.x = cvtpk(carry[0], carry[1]); o.y = cvtpk(carry[2], carry[3]); o.z = cvtpk(carry[4], carry[5]); o.w = cvtpk(carry[6], carry[7]);
            *(u32x4*)p = o;
#pragma unroll
            for (int i = 0; i < 8; ++i) carry[i] = carry[i] * cd + bf2f(tv[i]);
        }
    }
}
__device__ __forceinline__ void lru_carry(const Fr& F) {
    for (int v = blockIdx.x * 512 + F.tid; v < NB * 2 * 512; v += F.G * 512) {
        const int c = v & 511, dir = (v >> 9) & 1, b = v >> 10;
        float carry = 0.f;
        for (int k = 0; k < NSEG; ++k) { const int s = dir ? (NSEG - 1 - k) : k; const size_t idx = ((size_t)(b * NSEG + s) * 2 + dir) * 512 + c;
            const f32x2 ah = F.SUMM[idx]; F.CARRY[idx] = carry; carry = ah.x * carry + ah.y; }
    }
}
__device__ __forceinline__ void ret_final_item(const Fr& F, int b, int h, int n) {
    int lane = F.lane; asm volatile("" : "+v"(lane));
    const int w = F.wave, r = lane & 31, h2 = lane >> 5;
    LAS unsigned char* TQ = F.lds; LAS unsigned char* TK = F.lds + 32768; LAS unsigned char* TV = F.lds + 65536; LAS unsigned char* TS = F.lds + 98304;
    LAS float* SS = (LAS float*)(F.lds + LDS_SS);
    const size_t row0 = (size_t)b * PP + 128 * n; const float lg = log2_gamma(h);
    stage_rot<false>(F, row0, ZC_Q + 128 * h, n, TQ, TQ, 0.08838834764831845f, lg);
    stage_rot<false>(F, row0, ZC_K + 128 * h, n, TK, TK, 1.0f, lg);
    stage_plain(F, F.Z + row0 * ZC + ZC_V + 128 * h, ZC, TV);
    __syncthreads();
    const int cb = w >> 1, ebase = 2 * (w & 1);
    pg8::bf16x8 pa[4][2];
    {
        const int cpos = 32 * cb + r;
#pragma unroll
        for (int mb = 0; mb < 4; ++mb) {
            f32x16 X;
#pragma unroll
            for (int i = 0; i < 16; ++i) X[i] = 0.f;
#pragma unroll 2
            for (int s = 0; s < 8; ++s) { const pg8::bf16x8 qf = rowfrag(TQ, cb, s, lane); const pg8::bf16x8 kf = rowfrag(TK, mb, s, lane); X = MFMA32(kf, qf, X); }
#pragma unroll
            for (int i = 0; i < 16; ++i) { const int m = 32 * mb + crow(i, h2); const int dd = cpos > m ? cpos - m : m - cpos; X[i] *= exp2f(lg * (float)dd); }
#pragma unroll
            for (int s2 = 0; s2 < 2; ++s2) { u32x4 pk; pk.x = cvtpk(X[8 * s2], X[8 * s2 + 1]); pk.y = cvtpk(X[8 * s2 + 2], X[8 * s2 + 3]); pk.z = cvtpk(X[8 * s2 + 4], X[8 * s2 + 5]); pk.w = cvtpk(X[8 * s2 + 6], X[8 * s2 + 7]);
                pa[mb][s2] = __builtin_bit_cast(pg8::bf16x8, pk); }
        }
    }
    f32x16 o[2];
#pragma unroll
    for (int eo = 0; eo < 2; ++eo)
#pragma unroll
        for (int i = 0; i < 16; ++i) o[eo][i] = 0.f;
#pragma unroll
    for (int mb = 0; mb < 4; ++mb)
#pragma unroll
        for (int s2 = 0; s2 < 2; ++s2)
#pragma unroll
            for (int eo = 0; eo < 2; ++eo) { const pg8::bf16x8 vb = trfrag_perm(TV, ebase + eo, 32 * mb + 16 * s2, lane); o[eo] = MFMA32(pa[mb][s2], vb, o[eo]); }
    __syncthreads();
    { const unsigned short* sf = F.ST + ((size_t)(((b * 4 + h) * 2 + 0) * NCHUNK + n)) * 16384; const unsigned short* sb = F.ST + ((size_t)(((b * 4 + h) * 2 + 1) * NCHUNK + n)) * 16384;
      stage_plain(F, sf, 128, TK); stage_plain(F, sb, 128, TS); }
    __syncthreads();
#pragma unroll
    for (int dirn = 0; dirn < 2; ++dirn) {
        LAS unsigned char* TX = dirn ? TS : TK;
        f32x16 oi[2];
#pragma unroll
        for (int eo = 0; eo < 2; ++eo)
#pragma unroll
            for (int i = 0; i < 16; ++i) oi[eo][i] = 0.f;
#pragma unroll 2
        for (int s = 0; s < 8; ++s) { const pg8::bf16x8 qf = rowfrag(TQ, cb, s, lane);
#pragma unroll
            for (int eo = 0; eo < 2; ++eo) { const pg8::bf16x8 f1 = rowfrag(TX, ebase + eo, s, lane); oi[eo] = MFMA32(qf, f1, oi[eo]); } }
#pragma unroll
        for (int i = 0; i < 16; ++i) { const int cl = 32 * cb + crow(i, h2); const float dfac = exp2f(lg * (float)(dirn ? (128 - cl) : (cl + 1)));
#pragma unroll
            for (int eo = 0; eo < 2; ++eo) o[eo][i] += dfac * oi[eo][i]; }
    }
    float ssq[16];
#pragma unroll
    for (int i = 0; i < 16; ++i) {
        float s = o[0][i] * o[0][i] + o[1][i] * o[1][i];
        s += __shfl_xor(s, 1); s += __shfl_xor(s, 2); s += __shfl_xor(s, 4); s += __shfl_xor(s, 8); s += __shfl_xor(s, 16);
        ssq[i] = s; }
    if (r == 0) {
#pragma unroll
        for (int i = 0; i < 16; ++i) SS[(w & 1) * 128 + 32 * cb + crow(i, h2)] = ssq[i]; }
    __syncthreads();
#pragma unroll
    for (int i = 0; i < 16; ++i) { const int cl = 32 * cb + crow(i, h2); const float tot = SS[cl] + SS[128 + cl]; const float rs = 1.0f / sqrtf(tot * (1.0f / 128.0f) + EPSN);
        const size_t row = row0 + cl;
#pragma unroll
        for (int eo = 0; eo < 2; ++eo) { const int e = 32 * (ebase + eo) + r; const float gv = bf2f(F.Z[row * ZC + ZC_G + 128 * h + e]);
            F.H[row * 1024 + 512 + 128 * h + e] = f2bf16(o[eo][i] * rs * F.ret_out_g[128 * h + e] * pg8::silu_f(gv)); }
        if ((i & 3) == 3) asm volatile("" ::: "memory"); }
    __syncthreads();
}

__device__ __forceinline__ float* hs_row(const Fr& F, int b, int t) { return t < NMETA ? F.HSMETA + (size_t)(b * NMETA + t) * 1024 : F.out + ((size_t)b * SEQ + (t - NMETA)) * 1024; }
__device__ __forceinline__ void ph_router(const Fr& F) {
    LAS float* WR = (LAS float*)F.lds;
    for (int i = F.tid; i < 16384; i += 512) { const int d = i >> 4, e = i & 15; WR[e * 1024 + d] = F.w_router[i]; }
    __syncthreads();
    const int lane = F.lane;
    for (int v = blockIdx.x * 8 + F.wave; v < NB * TT; v += F.G * 8) {
        const int b = v / TT, t = v - b * TT; const int rrow = b * PP + PADL + t;
        const float* xrow = hs_row(F, b, t);
        const f32x4* xr = (const f32x4*)xrow + lane; const f32x4* gr = (const f32x4*)F.norm2_g + lane;
        f32x4 vv[4]; float s = 0.f;
#pragma unroll
        for (int j = 0; j < 4; ++j) { vv[j] = xr[64 * j]; s += (vv[j].x * vv[j].x + vv[j].y * vv[j].y) + (vv[j].z * vv[j].z + vv[j].w * vv[j].w); }
        const float rs = 1.0f / sqrtf(wave_sum(s) * (1.0f / 1024.0f) + EPSN);
        u32x2* o8 = (u32x2*)(F.H + (size_t)rrow * 1024) + lane;
#pragma unroll
        for (int j = 0; j < 4; ++j) { const f32x4 gg = gr[64 * j]; vv[j].x *= rs * gg.x; vv[j].y *= rs * gg.y; vv[j].z *= rs * gg.z; vv[j].w *= rs * gg.w;
            u32x2 wv; wv.x = cvtpk(vv[j].x, vv[j].y); wv.y = cvtpk(vv[j].z, vv[j].w); o8[64 * j] = wv; }
        float pl[16];
#pragma unroll
        for (int e = 0; e < 16; ++e) { float a = 0.f;
#pragma unroll
            for (int j = 0; j < 4; ++j) { const f32x4 wv = *(LAS f32x4*)(WR + e * 1024 + 256 * j + 4 * lane); a += (vv[j].x * wv.x + vv[j].y * wv.y) + (vv[j].z * wv.z + vv[j].w * wv.w); }
            pl[e] = a; if ((e & 3) == 3) asm volatile("" ::: "memory"); }
        { const bool hi = lane & 32;
#pragma unroll
          for (int i = 0; i < 8; ++i) { const float send = hi ? pl[i] : pl[i + 8], keep = hi ? pl[i + 8] : pl[i]; pl[i] = keep + __shfl_xor(send, 32); } }
        { const bool hi = lane & 16;
#pragma unroll
          for (int i = 0; i < 4; ++i) { const float send = hi ? pl[i] : pl[i + 4], keep = hi ? pl[i + 4] : pl[i]; pl[i] = keep + __shfl_xor(send, 16); } }
        { const bool hi = lane & 8;
#pragma unroll
          for (int i = 0; i < 2; ++i) { const float send = hi ? pl[i] : pl[i + 2], keep = hi ? pl[i + 2] : pl[i]; pl[i] = keep + __shfl_xor(send, 8); } }
        { const bool hi = lane & 4; const float send = hi ? pl[0] : pl[1], keep = hi ? pl[1] : pl[0]; pl[0] = keep + __shfl_xor(send, 4); }
        float lg = pl[0]; lg += __shfl_xor(lg, 1); lg += __shfl_xor(lg, 2);
        float mx = lg;
        mx = fmaxf(mx, __shfl_xor(mx, 4)); mx = fmaxf(mx, __shfl_xor(mx, 8)); mx = fmaxf(mx, __shfl_xor(mx, 16)); mx = fmaxf(mx, __shfl_xor(mx, 32));
        const float ex = expf(lg - mx); float sm = ex;
        sm += __shfl_xor(sm, 4); sm += __shfl_xor(sm, 8); sm += __shfl_xor(sm, 16); sm += __shfl_xor(sm, 32);
        const int e = ((lane >> 5) & 1) * 8 + ((lane >> 4) & 1) * 4 + ((lane >> 3) & 1) * 2 + ((lane >> 2) & 1);
        if ((lane & 3) == 0) F.AFF[(size_t)(b * NE + e) * TT + t] = ex / sm;
    }
    __syncthreads();
}

__device__ __forceinline__ void topk_item(const Fr& F, int b, int e) {
    LAS unsigned* vals = (LAS unsigned*)F.lds;
    LAS unsigned* hist = vals + 8256;
    LAS unsigned* misc = hist + 256;
    LAS unsigned* wsum = misc + 16;
    const int tid = F.tid, lane = F.lane, w = F.wave;
    const float* aff = F.AFF + (size_t)(b * NE + e) * TT;
    for (int t = tid; t < TT; t += 512) vals[t] = __float_as_uint(aff[t]);
    unsigned prefix = 0u, mask = 0u, k = CAP;
    for (int pass = 0; pass < 4; ++pass) {
        const int shift = 24 - 8 * pass;
        if (tid < 256) hist[tid] = 0u;
        __syncthreads();
        for (int t = tid; t < TT; t += 512) { const unsigned v = vals[t]; if ((v & mask) == prefix) __hip_atomic_fetch_add(&hist[(v >> shift) & 255u], 1u, __ATOMIC_RELAXED, __HIP_MEMORY_SCOPE_WORKGROUP); }
        __syncthreads();
        if (w == 0) {
            unsigned c[4]; unsigned s = 0u;
#pragma unroll
            for (int i = 0; i < 4; ++i) { c[i] = hist[255 - (4 * lane + i)]; s += c[i]; }
            unsigned incl = s;
#pragma unroll
            for (int o = 1; o < 64; o <<= 1) { const unsigned y = __shfl_up(incl, o); if (lane >= o) incl += y; }
            unsigned cum = incl - s;
#pragma unroll
            for (int i = 0; i < 4; ++i) { if (cum < k && cum + c[i] >= k) { misc[0] = prefix | ((unsigned)(255 - (4 * lane + i)) << shift); misc[1] = k - cum; } cum += c[i]; }
        }
        __syncthreads();
        prefix = misc[0]; k = misc[1]; mask |= 0xFFu << shift;
        __syncthreads();
    }
    const unsigned thr = prefix, keq = k;
    const int t0 = tid * 17;
    unsigned loc = 0u;
#pragma unroll
    for (int i = 0; i < 17; ++i) { const int t = t0 + i; if (t < TT) { const unsigned v = vals[t]; loc += (v > thr ? 1u : 0u) + (v == thr ? 65536u : 0u); } }
    unsigned incl = loc;
#pragma unroll
    for (int o = 1; o < 64; o <<= 1) { const unsigned y = __shfl_up(incl, o); if (lane >= o) incl += y; }
    if (lane == 63) wsum[w] = incl;
    __syncthreads();
    unsigned before = incl - loc;
#pragma unroll
    for (int w2 = 0; w2 < 8; ++w2) if (w2 < w) before += wsum[w2];
    unsigned gtb = before & 0xFFFFu, eqb = before >> 16;
    for (int i = 0; i < 17; ++i) { const int t = t0 + i; if (t < TT) {
        const unsigned v = vals[t]; const bool gt = v > thr, eq = v == thr; const bool sel = gt || (eq && eqb < keq);
        const int rrow = b * PP + PADL + t;
        int mrow = -1;
        if (sel) { const unsigned slot = gtb + (eqb < keq ? eqb : keq); mrow = e * EROWS + b * CAP + (int)slot; F.IDX[mrow] = rrow; F.GATE[mrow] = __uint_as_float(v); }
        F.ROWMAP[(size_t)rrow * NE + e] = mrow;
        gtb += gt ? 1u : 0u; eqb += eq ? 1u : 0u; } }
    if (b == 0) for (int i = tid; i < EROWS - NB * CAP; i += 512) { F.IDX[e * EROWS + NB * CAP + i] = -1; F.GATE[e * EROWS + NB * CAP + i] = 0.f; }
    __syncthreads();
}

__device__ __forceinline__ void ph_gather(const Fr& F) {
    for (int v = blockIdx.x * 8 + F.wave; v < NROWS; v += F.G * 8) {
        const int src = F.IDX[v];
        u32x4* dst = (u32x4*)(F.XS + (size_t)v * 1024) + F.lane;
        if (src >= 0) { const u32x4* sp = (const u32x4*)(F.H + (size_t)src * 1024) + F.lane; dst[0] = sp[0]; dst[64] = sp[64]; }
        else { dst[0] = (u32x4){0u, 0u, 0u, 0u}; dst[64] = (u32x4){0u, 0u, 0u, 0u}; }
    }
}
__device__ __forceinline__ void ph_combine(const Fr& F) {
    const int lane = F.lane;
    for (int v = blockIdx.x * 8 + F.wave; v < NB * SEQ; v += F.G * 8) {
        const int b = v / SEQ, tq = v - b * SEQ; const int rrow = b * PP + PADL + NMETA + tq;
        f32x4* xr = (f32x4*)(F.out + (size_t)v * 1024) + lane;
        f32x4 vv[4];
#pragma unroll
        for (int j = 0; j < 4; ++j) vv[j] = xr[64 * j];
        const int mine = F.ROWMAP[(size_t)rrow * NE + (lane & 15)];
#pragma unroll
        for (int e = 0; e < NE; ++e) { const int m = __shfl(mine, e);
            if (m >= 0) { const u16x4* yr = (const u16x4*)(F.YS + (size_t)m * 1024) + lane;
#pragma unroll
                for (int j = 0; j < 4; ++j) { const u16x4 y = yr[64 * j]; vv[j].x += bf2f(y[0]); vv[j].y += bf2f(y[1]); vv[j].z += bf2f(y[2]); vv[j].w += bf2f(y[3]); } } }
        float s = 0.f;
#pragma unroll
        for (int j = 0; j < 4; ++j) s += (vv[j].x * vv[j].x + vv[j].y * vv[j].y) + (vv[j].z * vv[j].z + vv[j].w * vv[j].w);
        const float rs = 1.0f / sqrtf(wave_sum(s) * (1.0f / 1024.0f) + EPSN);
        const f32x4* gr = (const f32x4*)F.final_g + lane;
#pragma unroll
        for (int j = 0; j < 4; ++j) { const f32x4 gg = gr[64 * j]; f32x4 o; o.x = vv[j].x * rs * gg.x; o.y = vv[j].y * rs * gg.y; o.z = vv[j].z * rs * gg.z; o.w = vv[j].w * rs * gg.w; xr[64 * j] = o; }
    }
}

struct Args { const float* in[20]; float* out; unsigned char* ws; int ph_lo, ph_hi; };
__global__ void __launch_bounds__(512, 2) mk_fwd(Args args) {
    extern __shared__ __attribute__((aligned(16))) unsigned char lds_raw[];
    Fr F;
    F.lds = (LAS unsigned char*)lds_raw;
    F.tid = threadIdx.x; F.lane = F.tid & 63; F.wave = __builtin_amdgcn_readfirstlane(F.tid >> 6); F.G = gridDim.x;
    unsigned char* ws = args.ws;
    F.x = args.in[0]; F.meta = args.in[1]; F.norm1_g = args.in[2]; F.w_in = args.in[3]; F.conv_w = args.in[4]; F.conv_b = args.in[5]; F.w_r = args.in[6]; F.b_r = args.in[7];
    F.w_i = args.in[8]; F.b_i = args.in[9]; F.lam = args.in[10]; F.lru_out_g = args.in[11]; F.ret_out_g = args.in[12]; F.w_out = args.in[13]; F.norm2_g = args.in[14];
    F.w_router = args.in[15]; F.w_gate = args.in[16]; F.w_up = args.in[17]; F.w_down = args.in[18]; F.final_g = args.in[19]; F.out = args.out;
    F.GW = (unsigned short*)(ws + WS_GW); F.WIN = (unsigned short*)(ws + WS_WIN); F.WOUT = (unsigned short*)(ws + WS_WOUT); F.WGU = (unsigned short*)(ws + WS_WGU); F.WD = (unsigned short*)(ws + WS_WD);
    F.H = (unsigned short*)(ws + WS_H); F.Z = (unsigned short*)(ws + WS_Z); F.ST = (unsigned short*)(ws + WS_ST); F.XS = (unsigned short*)(ws + WS_XS); F.ACT = (unsigned short*)(ws + WS_ACT); F.YS = (unsigned short*)(ws + WS_YS);
    F.HSMETA = (float*)(ws + WS_HSMETA); F.AFF = (float*)(ws + WS_AFF); F.GATE = (float*)(ws + WS_GATE); F.CARRY = (float*)(ws + WS_CARRY); F.CS = (f32x2*)(ws + WS_CS); F.SUMM = (f32x2*)(ws + WS_SUMM);
    F.ROWMAP = (int*)(ws + WS_ROWMAP); F.IDX = (int*)(ws + WS_IDX);
    volatile LAS unsigned* MISC = (volatile LAS unsigned*)(F.lds + LDS_MISC);
    if (F.tid < 64) MISC[F.tid] = 0u;
    __syncthreads();
    const int lo = args.ph_lo, hi = args.ph_hi;
    const bool single = (hi - lo) > 1;
    XcdBarrier bar; bar.bar = (unsigned*)(ws + WS_CTL) + CW_BAR; bar.x = 0; bar.st = nullptr;
    if (single) bar = xcd_barrier_post((unsigned*)(ws + WS_CTL) + CW_BAR, MISC + 8);
#ifndef PHMASK
#define PHMASK 0xFFF
#endif
#define IN(k) (((PHMASK >> (k)) & 1) && lo <= (k) && (k) < hi)
#define SEAM(k) do { if (IN(k) && IN((k) + 1)) xcd_barrier(bar); } while (0)
    const int bid = blockIdx.x, G = F.G;
    if (IN(0)) { ph_prep(F); } SEAM(0);
    if (IN(1)) { pg8::Gemm g{F.H, F.WIN, NP, ZC, DM}; pg8::StaticOrder S; S.init(NP, ZC, G, bid); pg8::EpiBf16<0> E{F.Z, ZC, nullptr, 0, 0, 1.f};
        pg8::gemm_phase<pg8::EpiBf16<0>, pg8::StaticOrder, true, true>(F.lds, g, S, E); } SEAM(1);
    if (IN(2)) { for (int it = bid; it < 2080 + 1040; it += G) { if (it < 2080) { if (!(PHMASK & 0x1000)) { const int n = it % NCHUNK, bh = it / NCHUNK; ret_contrib_item(F, bh >> 2, bh & 3, n); } } else { if (!(PHMASK & 0x2000)) { const int i2 = it - 2080; lru_item<false>(F, i2 / NSEG, i2 % NSEG); } } } } SEAM(2);
    if (IN(3)) { ret_scan(F); lru_carry(F); } SEAM(3);
    if (IN(4)) { for (int it = bid; it < 2080 + 1040; it += G) { if (it < 2080) { if (!(PHMASK & 0x1000)) { const int n = it % NCHUNK, bh = it / NCHUNK; ret_final_item(F, bh >> 2, bh & 3, n); } } else { if (!(PHMASK & 0x2000)) { const int i2 = it - 2080; lru_item<true>(F, i2 / NSEG, i2 % NSEG); } } } } SEAM(4);
    if (IN(5)) { pg8::Gemm g{F.H, F.WOUT, NP, DM, DM}; pg8::StaticOrder S; S.init(NP, DM, G, bid); pg8::EpiHS E{F.x, F.meta, F.out, F.HSMETA};
        pg8::gemm_phase<pg8::EpiHS, pg8::StaticOrder, true, true>(F.lds, g, S, E); } SEAM(5);
    if (IN(6)) { ph_router(F); } SEAM(6);
    if (IN(7)) { for (int it = bid; it < NB * NE; it += G) topk_item(F, it / NE, it % NE); } SEAM(7);
    if (IN(8)) { ph_gather(F); } SEAM(8);
    if (IN(9)) { pg8::Gemm g{F.XS, F.WGU, NROWS, NE * 2048, DM}; pg8::GroupOrder S; S.init(NE, 33, 8, G, bid); pg8::EpiAct E{F.ACT};
        pg8::gemm_phase<pg8::EpiAct, pg8::GroupOrder, true, true>(F.lds, g, S, E); } SEAM(9);
    if (IN(10)) { pg8::Gemm g{F.ACT, F.WD, NROWS, NE * 1024, DM}; pg8::GroupOrder S; S.init(NE, 33, 4, G, bid); pg8::EpiYS E{F.YS, F.GATE};
        pg8::gemm_phase<pg8::EpiYS, pg8::GroupOrder, true, true>(F.lds, g, S, E); } SEAM(10);
    if (IN(11)) { ph_combine(F); }
#undef IN
#undef SEAM
}

#ifndef MK_ONE_LAUNCH
#define MK_ONE_LAUNCH 0
#endif
extern "C" void kernel_launch(void* const* d_in, const int* in_sizes, int n_in, void* d_out, int out_size, void* d_ws, size_t ws_size, hipStream_t stream) {
    static int grid = 0;
    if (grid == 0) {
        if (n_in != 20 || in_sizes[0] != NB * SEQ * DM || out_size != NB * SEQ * DM || ws_size < WS_END) { fprintf(stderr, "kernel_launch: unexpected shapes / workspace (n_in %d, ws %zu, need %zu)\n", n_in, ws_size, (size_t)WS_END); grid = -1; return; }
        int dev = 0, cus = 0, per_cu = 0;
        if (hipGetDevice(&dev) != hipSuccess || hipDeviceGetAttribute(&cus, hipDeviceAttributeMultiprocessorCount, dev) != hipSuccess) { grid = -1; return; }
        if (hipFuncSetAttribute((const void*)mk_fwd, hipFuncAttributeMaxDynamicSharedMemorySize, LDS_BYTES) != hipSuccess) { fprintf(stderr, "kernel_launch: hipFuncSetAttribute failed\n"); grid = -1; return; }
        if (hipOccupancyMaxActiveBlocksPerMultiprocessor(&per_cu, (const void*)mk_fwd, 512, LDS_BYTES) != hipSuccess || per_cu < 1) { fprintf(stderr, "kernel_launch: occupancy query says %d blocks per CU\n", per_cu); grid = -1; return; }
        (void)hipGetLastError();
        grid = cus;
    }
    if (grid < 0) return;
    (void)hipMemsetAsync((char*)d_ws + WS_CTL, 0, CTL_ZERO_BYTES, stream);
    Args a{};
    for (int i = 0; i < 20; ++i) a.in[i] = (const float*)d_in[i];
    a.out = (float*)d_out; a.ws = (unsigned char*)d_ws;
#if MK_ONE_LAUNCH
    a.ph_lo = 0; a.ph_hi = NPHASE;
    hipLaunchKernelGGL(mk_fwd, dim3(grid), dim3(512), LDS_BYTES, stream, a);
#else
    for (int ph = 0; ph < NPHASE; ++ph) { a.ph_lo = ph; a.ph_hi = ph + 1; hipLaunchKernelGGL(mk_fwd, dim3(grid), dim3(512), LDS_BYTES, stream, a); }
#endif
}
```

```cpp
#include <hip/hip_runtime.h>
#include <cstdio>
#include <cstdint>
#ifndef MK_PROG
#define MK_PROG P0 SEAM P1 SEAM P2 SEAM P3 SEAM P4 SEAM P5 SEAM P6 SEAM P7 SEAM P9 SEAM P10 SEAM P11
#endif
#define LRU_NEW2 0
#define LRU_NEW4 0
namespace pg8 {
#define PG8_LAS __attribute__((address_space(3)))
typedef unsigned short bf16_t;
typedef short bf16x8 __attribute__((ext_vector_type(8)));
typedef float f32x4 __attribute__((ext_vector_type(4)));
typedef unsigned u32x4 __attribute__((ext_vector_type(4)));
constexpr int BM = 256, BK = 64, HALF = 128, HTB = HALF * BK * 2  , STAGE_BYTES = 8 * HTB, NXCD = 8, WGM = 8;

__host__ __device__ __forceinline__ int lds_byte(int r, int c) { const int st = (r >> 4) * 2 + (c >> 5), rr = r & 15, cc = c & 31, ob = rr * 64 + cc * 2; return st * 1024 + (ob ^ (((ob >> 9) & 1) << 5)); }
__host__ __device__ __forceinline__ void stage_rc(int b, int& R, int& C) { const int st = b / 1024, sb = b % 1024, swz = sb ^ (((sb >> 9) & 1) << 5); R = (st >> 1) * 16 + swz / 64; C = (st & 1) * 32 + (swz % 64) / 2; }
__host__ __device__ __forceinline__ int perm32(int rho) { const int n = rho >> 4, i = rho & 15; return 8 * (i >> 2) + 4 * n + (i & 3); }

struct Unit { int pm, pn; };
struct Gemm { const bf16_t* A; const bf16_t* Bt; int M, N, K; };

struct StaticOrder {
    int nM, nN, nwg, G, c;
    __host__ __device__ __forceinline__ void init(int M, int N, int G_, int c_) { nM = M / BM; nN = N / BM; nwg = nM * nN; G = G_; c = c_; }
    __host__ __device__ __forceinline__ bool next(int i, Unit& u) const {
        const long L = (long)i * G + c; if (L >= nwg) return false;
        int wgid = (int)L; { const int q = nwg / NXCD, r = nwg % NXCD, xcd = wgid % NXCD, off = wgid / NXCD; wgid = (xcd < r ? xcd * (q + 1) : r * (q + 1) + (xcd - r) * q) + off; }
        const int nig = WGM * nN, gid = wgid / nig, fm = gid * WGM, gsz = (nM - fm) < WGM ? (nM - fm) : WGM;
        u.pm = fm + ((wgid % nig) % gsz); u.pn = (wgid % nig) / gsz; return true;
    }
    __device__ __forceinline__ void a_ready(const Unit&) const {}
    __device__ __forceinline__ void done(const Unit&) const {}
};

__device__ __forceinline__ unsigned cvt_pk_bf16(float lo, float hi) { unsigned r; asm volatile("v_cvt_pk_bf16_f32 %0, %1, %2" : "=v"(r) : "v"(lo), "v"(hi)); return r; }
typedef float f32x2 __attribute__((ext_vector_type(2)));
__device__ __forceinline__ f32x2 gelu_pk(f32x2 v) {
    const f32x2 av = __builtin_elementwise_abs(v), d = av * 0.2316418882f + 1.0f;
    f32x2 t; t.x = __builtin_amdgcn_rcpf(d.x); t.y = __builtin_amdgcn_rcpf(d.y);
    f32x2 q = t * 0.5307027145f + (-0.7265760135f); q = q * t + 0.7107068705f; q = q * t + (-0.142248368f); q = q * t + 0.127414796f; q = q * t;
    const f32x2 s = (v * v) * (-0.72134752044f);
    f32x2 e; e.x = __builtin_amdgcn_exp2f(s.x); e.y = __builtin_amdgcn_exp2f(s.y);
    const f32x2 m = v * (q * e), r = v - m;
    f32x2 o; o.x = v.x < 0.f ? m.x : r.x; o.y = v.y < 0.f ? m.y : r.y; return o;
}

template <int ACT  > struct EpiBf16 {
    static constexpr bool PERM = true, AFTER_DRAIN = false; static_assert(ACT == 0 || ACT == 1, "EpiBf16: ACT is 0 (none) or 1 (gelu_pk)");
    bf16_t* O; int ldc; const float* bias; int split_cols; size_t split_stride; float scale0;
    __device__ __forceinline__ void operator()(const f32x4 (&acc)[2][2][4][2], const Unit& u, int wr, int wc, int fr, int fq) const {
        const int row0 = u.pm * BM + wr * 64 + fr; int colt = u.pn * BM; bf16_t* base = O;
        float sc = 1.f; if (split_cols) { const int t = colt / split_cols; base += (size_t)t * split_stride; colt -= t * split_cols; if (t == 0) sc = scale0; }
        const int col0 = colt + wc * 32 + 8 * fq, bcol0 = u.pn * BM + wc * 32 + 8 * fq;
        f32x4 bv[2][2];
#pragma unroll
        for (int bj = 0; bj < 2; ++bj)
#pragma unroll
            for (int n = 0; n < 2; ++n) bv[bj][n] = bias ? *(const f32x4*)(bias + bcol0 + bj * HALF + 4 * n) : (f32x4){0.f, 0.f, 0.f, 0.f};
#pragma unroll
        for (int ai = 0; ai < 2; ++ai)
#pragma unroll
            for (int m = 0; m < 4; ++m) { bf16_t* rowp = base + (size_t)(row0 + ai * HALF + m * 16) * ldc + col0;
#pragma unroll
                for (int bj = 0; bj < 2; ++bj) { f32x4 v0 = acc[ai][bj][m][0] + bv[bj][0], v1 = acc[ai][bj][m][1] + bv[bj][1];
                    if (ACT == 1) { f32x2 a = gelu_pk((f32x2){v0[0], v0[1]}), b = gelu_pk((f32x2){v0[2], v0[3]}), c = gelu_pk((f32x2){v1[0], v1[1]}), d = gelu_pk((f32x2){v1[2], v1[3]});
                        v0 = (f32x4){a.x, a.y, b.x, b.y}; v1 = (f32x4){c.x, c.y, d.x, d.y}; }
                    v0 = v0 * sc; v1 = v1 * sc; u32x4 w; w.x = cvt_pk_bf16(v0[0], v0[1]); w.y = cvt_pk_bf16(v0[2], v0[3]); w.z = cvt_pk_bf16(v1[0], v1[1]); w.w = cvt_pk_bf16(v1[2], v1[3]);
                    *(u32x4*)(rowp + bj * HALF) = w; } }
    }
};
typedef int i32x8 __attribute__((ext_vector_type(8)));
__host__ __device__ __forceinline__ int lds_byte8(int r, int fq) { const int st = (r >> 4) * 2 + (fq >> 1), rr = r & 15, ob = rr * 64 + (fq & 1) * 32; return st * 1024 + (ob ^ (((ob >> 9) & 1) << 5)); }
template <class Epi, class Sched, bool ALIGN_EPI = false, bool SP2 = false>
__device__ __forceinline__ void gemm_phase(PG8_LAS unsigned char* lds, const Gemm g, const Sched& S, const Epi& E) {
    int tid = threadIdx.x; asm volatile("" : "+v"(tid));
    const int wid = __builtin_amdgcn_readfirstlane(tid >> 6), lane = tid & 63, wr = wid >> 2, wc = wid & 3, fr = lane & 15, fq = lane >> 4;
    const int K = g.K, nt = K / BK;
    unsigned voffA[2], voffB[2];
#pragma unroll
    for (int i = 0; i < 2; ++i) { int R, C; stage_rc(tid * 16 + i * 8192, R, C); const int Rb = Epi::PERM ? ((R & ~31) + perm32(R & 31)) : R;
        voffA[i] = (unsigned)(R * K + C) * 2u; voffB[i] = (unsigned)(Rb * K + C) * 2u; }
    const size_t kstep = (size_t)(BK * 2);
    const size_t hstep = (size_t)HALF * K * 2;
    const size_t tstep = 2 * hstep;
    const unsigned ldsw = (unsigned)wid * 1024u;
    const int aoff = lds_byte(wr * 64 + fr, fq * 8), boff = lds_byte(wc * 32 + fr, fq * 8);
#define PG8_SA(b, h) (((b) * 2 + (h)) * HTB)
#define PG8_SB(b, h) ((4 + (b) * 2 + (h)) * HTB)
#define PG8_STAGE(bufoff, gbase, voff) do { _Pragma("unroll") for (int _i = 0; _i < 2; ++_i) \
        __builtin_amdgcn_global_load_lds((const unsigned*)((const char*)(gbase) + (voff)[_i]), (PG8_LAS unsigned*)(lds + (bufoff) + ldsw + _i * 8192), 16, 0, 0); } while (0)
#define PG8_LDA(dst, b, h) do { _Pragma("unroll") for (int m = 0; m < 4; ++m) _Pragma("unroll") for (int k = 0; k < 2; ++k) dst[m][k] = *(const PG8_LAS bf16x8*)(lds + PG8_SA(b, h) + aoff + m * 2048 + k * 1024); } while (0)
#define PG8_LDB(dst, b, h) do { _Pragma("unroll") for (int n = 0; n < 2; ++n) _Pragma("unroll") for (int k = 0; k < 2; ++k) dst[n][k] = *(const PG8_LAS bf16x8*)(lds + PG8_SB(b, h) + boff + n * 2048 + k * 1024); } while (0)
#define PG8_MMA(ai, bj, At, Bt) do { __builtin_amdgcn_s_setprio(1); _Pragma("unroll") for (int m = 0; m < 4; ++m) _Pragma("unroll") for (int n = 0; n < 2; ++n) _Pragma("unroll") for (int k = 0; k < 2; ++k) \
        acc[ai][bj][m][n] = __builtin_amdgcn_mfma_f32_16x16x32_bf16(Bt[n][k], At[m][k], acc[ai][bj][m][n], 0, 0, 0); __builtin_amdgcn_s_setprio(0); } while (0)
#define PG8_WAIT_V(n) asm volatile("s_waitcnt vmcnt(" #n ")" ::: "memory")
#define PG8_WAIT_L(n) asm volatile("s_waitcnt lgkmcnt(" #n ")" ::: "memory")
#define PG8_BAR __builtin_amdgcn_s_barrier()
#define PG8_SCHED __builtin_amdgcn_sched_barrier(0)
    Unit cur, nxt; int ui = 0;
    if (!S.next(0, cur)) return;
    f32x4 acc[2][2][4][2];
#pragma unroll
    for (int a = 0; a < 2; ++a)
#pragma unroll
        for (int b = 0; b < 2; ++b)
#pragma unroll
            for (int m = 0; m < 4; ++m)
#pragma unroll
                for (int n = 0; n < 2; ++n) acc[a][b][m][n] = (f32x4){0.f, 0.f, 0.f, 0.f};
    bf16x8 At[4][2], B0[2][2], B1[2][2];
    const char* cA = (const char*)g.A + (size_t)cur.pm * tstep; const char* cB = (const char*)g.Bt + (size_t)cur.pn * tstep;
    S.a_ready(cur);
    if constexpr (SP2) {
        PG8_STAGE(PG8_SB(0, 0), cB, voffB); PG8_STAGE(PG8_SB(0, 1), cB + hstep, voffB); PG8_STAGE(PG8_SA(0, 0), cA, voffA); PG8_STAGE(PG8_SA(0, 1), cA + hstep, voffA);
        if (wr == 1) PG8_BAR;
        PG8_WAIT_V(2); PG8_BAR;
        PG8_STAGE(PG8_SB(1, 0), cB + kstep, voffB); PG8_STAGE(PG8_SA(1, 0), cA + kstep, voffA); PG8_STAGE(PG8_SB(1, 1), cB + hstep + kstep, voffB);
        PG8_WAIT_V(6); PG8_BAR;
    } else {
        PG8_STAGE(PG8_SB(0, 0), cB, voffB); PG8_STAGE(PG8_SA(0, 0), cA, voffA); PG8_STAGE(PG8_SB(0, 1), cB + hstep, voffB); PG8_STAGE(PG8_SA(0, 1), cA + hstep, voffA);
        if (wr == 1) PG8_BAR;
        PG8_WAIT_V(4); PG8_BAR;
        PG8_STAGE(PG8_SB(1, 0), cB + kstep, voffB); PG8_STAGE(PG8_SA(1, 0), cA + kstep, voffA); PG8_STAGE(PG8_SB(1, 1), cB + hstep + kstep, voffB);
        PG8_WAIT_V(6); PG8_BAR;
    }
    for (;;) {
        const bool has_next = S.next(ui + 1, nxt);
        const char* nA = has_next ? (const char*)g.A + (size_t)nxt.pm * tstep : cA; const char* nB = has_next ? (const char*)g.Bt + (size_t)nxt.pn * tstep : cB;
        for (int t = 0; t < nt; t += 2) {
            const bool last = (t == nt - 2);
            const char* a1 = cA + (size_t)(t + 1) * kstep;
            const char* a2 = last ? nA : cA + (size_t)(t + 2) * kstep; const char* b2 = last ? nB : cB + (size_t)(t + 2) * kstep;
            const char* a3 = a2 + kstep; const char* b3 = b2 + kstep;
            if (last && has_next) S.a_ready(nxt);
            if constexpr (SP2) {
            PG8_LDB(B0, 0, 0); PG8_LDB(B1, 0, 1); PG8_SCHED; PG8_LDA(At, 0, 0); PG8_STAGE(PG8_SA(1, 1), a1 + hstep, voffA);
            PG8_WAIT_V(8); PG8_WAIT_L(0); PG8_BAR; PG8_MMA(0, 0, At, B0); PG8_MMA(0, 1, At, B1); PG8_BAR; PG8_SCHED;
            PG8_LDA(At, 0, 1); PG8_STAGE(PG8_SB(0, 0), b2, voffB); PG8_STAGE(PG8_SB(0, 1), b2 + hstep, voffB); PG8_STAGE(PG8_SA(0, 0), a2, voffA);
            PG8_WAIT_V(8); PG8_WAIT_L(0); PG8_BAR; PG8_MMA(1, 0, At, B0); PG8_MMA(1, 1, At, B1); PG8_BAR; PG8_SCHED;
            PG8_LDB(B0, 1, 0); PG8_LDB(B1, 1, 1); PG8_SCHED; PG8_LDA(At, 1, 0); PG8_STAGE(PG8_SA(0, 1), a2 + hstep, voffA);
            PG8_WAIT_V(8); PG8_WAIT_L(0); PG8_BAR; PG8_MMA(0, 0, At, B0); PG8_MMA(0, 1, At, B1); PG8_BAR; PG8_SCHED;
            PG8_LDA(At, 1, 1); PG8_STAGE(PG8_SB(1, 0), b3, voffB); PG8_STAGE(PG8_SB(1, 1), b3 + hstep, voffB); PG8_STAGE(PG8_SA(1, 0), a3, voffA);
            PG8_WAIT_V(8); PG8_WAIT_L(0); PG8_BAR; PG8_MMA(1, 0, At, B0); PG8_MMA(1, 1, At, B1); PG8_BAR; PG8_SCHED;
            } else {
            PG8_LDB(B0, 0, 0); PG8_SCHED; PG8_LDA(At, 0, 0); PG8_STAGE(PG8_SA(1, 1), a1 + hstep, voffA);
            PG8_WAIT_L(8); PG8_BAR; PG8_WAIT_L(0); PG8_MMA(0, 0, At, B0); PG8_BAR; PG8_SCHED;
            PG8_LDB(B1, 0, 1); PG8_STAGE(PG8_SB(0, 0), b2, voffB);
            PG8_BAR; PG8_WAIT_L(0); PG8_MMA(0, 1, At, B1); PG8_BAR;
            PG8_LDA(At, 0, 1); PG8_STAGE(PG8_SA(0, 0), a2, voffA);
            PG8_BAR; PG8_WAIT_L(0); PG8_MMA(1, 0, At, B0); PG8_BAR; PG8_SCHED;
            PG8_STAGE(PG8_SB(0, 1), b2 + hstep, voffB);
            PG8_WAIT_V(6); PG8_BAR; PG8_MMA(1, 1, At, B1); PG8_BAR;
            PG8_LDB(B0, 1, 0); PG8_SCHED; PG8_LDA(At, 1, 0); PG8_STAGE(PG8_SA(0, 1), a2 + hstep, voffA);
            PG8_WAIT_L(8); PG8_BAR; PG8_WAIT_L(0); PG8_MMA(0, 0, At, B0); PG8_BAR; PG8_SCHED;
            PG8_LDB(B1, 1, 1); PG8_STAGE(PG8_SB(1, 0), b3, voffB);
            PG8_BAR; PG8_WAIT_L(0); PG8_MMA(0, 1, At, B1); PG8_BAR;
            PG8_LDA(At, 1, 1); PG8_STAGE(PG8_SA(1, 0), a3, voffA);
            PG8_BAR; PG8_WAIT_L(0); PG8_MMA(1, 0, At, B0); PG8_BAR; PG8_SCHED;
            PG8_STAGE(PG8_SB(1, 1), b3 + hstep, voffB);
            PG8_WAIT_V(6); PG8_BAR; PG8_MMA(1, 1, At, B1); PG8_BAR;
            }
        }
        if constexpr (ALIGN_EPI) { if (wr == 0) PG8_BAR; }
        if constexpr (!Epi::AFTER_DRAIN) { E(acc, cur, wr, wc, fr, fq); S.done(cur); }
        if (!has_next) break;
#pragma unroll
        for (int a = 0; a < 2; ++a)
#pragma unroll
            for (int b = 0; b < 2; ++b)
#pragma unroll
                for (int m = 0; m < 4; ++m)
#pragma unroll
                    for (int n = 0; n < 2; ++n) acc[a][b][m][n] = (f32x4){0.f, 0.f, 0.f, 0.f};
        cur = nxt; cA = nA; cB = nB; ++ui;
        if constexpr (ALIGN_EPI) { if (wr == 1) PG8_BAR; }
    }
    PG8_WAIT_V(0);
    if constexpr (!ALIGN_EPI) { if (wr == 0) PG8_BAR; }
    PG8_BAR;
    if constexpr (Epi::AFTER_DRAIN) { E.fused(acc, cur, wr, wc, fr, fq, lds, wid, lane); S.done(cur); }
}
template <class Epi, class Sched>
__device__ __forceinline__ void gemm_phase_g(PG8_LAS unsigned char* lds, PG8_LAS unsigned char* side, const Gemm g, const unsigned* rowoff, const Sched& S, const Epi& E) {
    constexpr bool ALIGN_EPI = true, SP2 = true;
    int tid = threadIdx.x; asm volatile("" : "+v"(tid));
    const int wid = __builtin_amdgcn_readfirstlane(tid >> 6), lane = tid & 63, wr = wid >> 2, wc = wid & 3, fr = lane & 15, fq = lane >> 4;
    const int K = g.K, nt = K / BK;
    unsigned voffB[2], cA2[2]; int RA[2];
#pragma unroll
    for (int i = 0; i < 2; ++i) { int R, C; stage_rc(tid * 16 + i * 8192, R, C); const int Rb = Epi::PERM ? ((R & ~31) + perm32(R & 31)) : R;
        RA[i] = R; cA2[i] = (unsigned)C * 2u; voffB[i] = (unsigned)(Rb * K + C) * 2u; }
    const size_t kstep = (size_t)(BK * 2);
    const size_t hstep = (size_t)HALF * K * 2;
    const size_t tstep = 2 * hstep;
    const unsigned ldsw = (unsigned)wid * 1024u;
    const int aoff = lds_byte(wr * 64 + fr, fq * 8), boff = lds_byte(wc * 32 + fr, fq * 8);
    Unit cur, nxt; int ui = 0;
    if (!S.next(0, cur)) return;
    f32x4 acc[2][2][4][2];
#pragma unroll
    for (int a = 0; a < 2; ++a)
#pragma unroll
        for (int b = 0; b < 2; ++b)
#pragma unroll
            for (int m = 0; m < 4; ++m)
#pragma unroll
                for (int n = 0; n < 2; ++n) acc[a][b][m][n] = (f32x4){0.f, 0.f, 0.f, 0.f};
    bf16x8 At[4][2], B0[2][2], B1[2][2];
    const char* const gA = (const char*)g.A; const char* cB = (const char*)g.Bt + (size_t)cur.pn * tstep;
    unsigned vo0[2], vo1[2], nvo0[2], nvo1[2];
#pragma unroll
    for (int i = 0; i < 2; ++i) { vo0[i] = rowoff[(size_t)cur.pm * 256 + RA[i]] + cA2[i]; vo1[i] = rowoff[(size_t)cur.pm * 256 + 128 + RA[i]] + cA2[i]; nvo0[i] = vo0[i]; nvo1[i] = vo1[i]; }
    S.a_ready(cur);
    if constexpr (SP2) {
        PG8_STAGE(PG8_SB(0, 0), cB, voffB); PG8_STAGE(PG8_SB(0, 1), cB + hstep, voffB); PG8_STAGE(PG8_SA(0, 0), gA, vo0); PG8_STAGE(PG8_SA(0, 1), gA, vo1);
        if (wr == 1) PG8_BAR;
        PG8_WAIT_V(2); PG8_BAR;
        PG8_STAGE(PG8_SB(1, 0), cB + kstep, voffB); PG8_STAGE(PG8_SA(1, 0), gA + kstep, vo0); PG8_STAGE(PG8_SB(1, 1), cB + hstep + kstep, voffB);
        PG8_WAIT_V(6); PG8_BAR;
    }
    for (;;) {
        const bool has_next = S.next(ui + 1, nxt);
        const char* nB = has_next ? (const char*)g.Bt + (size_t)nxt.pn * tstep : cB;
        if (has_next) __builtin_amdgcn_global_load_lds((const unsigned*)(rowoff + (size_t)nxt.pm * 256 + lane * 4), (PG8_LAS unsigned*)(side + (ui & 1) * 1024), 16, 0, 0);
        for (int t = 0; t < nt; t += 2) {
            const bool last = (t == nt - 2);
            if (last && has_next) {
                const PG8_LAS unsigned* sl = (const PG8_LAS unsigned*)(side + (ui & 1) * 1024);
#pragma unroll
                for (int i = 0; i < 2; ++i) { int ra = RA[i]; asm volatile("" : "+v"(ra));
                    nvo0[i] = sl[ra] + cA2[i]; nvo1[i] = sl[128 + ra] + cA2[i]; }
            }
            const char* a1 = gA + (size_t)(t + 1) * kstep;
            const char* a2 = last ? gA : gA + (size_t)(t + 2) * kstep; const char* b2 = last ? nB : cB + (size_t)(t + 2) * kstep;
            unsigned s0[2], s1[2];
#pragma unroll
            for (int i = 0; i < 2; ++i) { s0[i] = last ? nvo0[i] : vo0[i]; s1[i] = last ? nvo1[i] : vo1[i]; }
            const char* a3 = a2 + kstep; const char* b3 = b2 + kstep;
            if (last && has_next) S.a_ready(nxt);
            if constexpr (SP2) {
            PG8_LDB(B0, 0, 0); PG8_LDB(B1, 0, 1); PG8_SCHED; PG8_LDA(At, 0, 0); PG8_STAGE(PG8_SA(1, 1), a1, vo1);
            PG8_WAIT_V(8); PG8_WAIT_L(0); PG8_BAR; PG8_MMA(0, 0, At, B0); PG8_MMA(0, 1, At, B1); PG8_BAR; PG8_SCHED;
            PG8_LDA(At, 0, 1); PG8_STAGE(PG8_SB(0, 0), b2, voffB); PG8_STAGE(PG8_SB(0, 1), b2 + hstep, voffB); PG8_STAGE(PG8_SA(0, 0), a2, s0);
            PG8_WAIT_V(8); PG8_WAIT_L(0); PG8_BAR; PG8_MMA(1, 0, At, B0); PG8_MMA(1, 1, At, B1); PG8_BAR; PG8_SCHED;
            PG8_LDB(B0, 1, 0); PG8_LDB(B1, 1, 1); PG8_SCHED; PG8_LDA(At, 1, 0); PG8_STAGE(PG8_SA(0, 1), a2, s1);
            PG8_WAIT_V(8); PG8_WAIT_L(0); PG8_BAR; PG8_MMA(0, 0, At, B0); PG8_MMA(0, 1, At, B1); PG8_BAR; PG8_SCHED;
            PG8_LDA(At, 1, 1); PG8_STAGE(PG8_SB(1, 0), b3, voffB); PG8_STAGE(PG8_SB(1, 1), b3 + hstep, voffB); PG8_STAGE(PG8_SA(1, 0), a3, s0);
            PG8_WAIT_V(8); PG8_WAIT_L(0); PG8_BAR; PG8_MMA(1, 0, At, B0); PG8_MMA(1, 1, At, B1); PG8_BAR; PG8_SCHED;
            }
        }
        if constexpr (ALIGN_EPI) { if (wr == 0) PG8_BAR; }
        if constexpr (!Epi::AFTER_DRAIN) { E(acc, cur, wr, wc, fr, fq); S.done(cur); }
        if (!has_next) break;
#pragma unroll
        for (int a = 0; a < 2; ++a)
#pragma unroll
            for (int b = 0; b < 2; ++b)
#pragma unroll
                for (int m = 0; m < 4; ++m)
#pragma unroll
                    for (int n = 0; n < 2; ++n) acc[a][b][m][n] = (f32x4){0.f, 0.f, 0.f, 0.f};
        cur = nxt; cB = nB; ++ui;
#pragma unroll
        for (int i = 0; i < 2; ++i) { vo0[i] = nvo0[i]; vo1[i] = nvo1[i]; }
        if constexpr (ALIGN_EPI) { if (wr == 1) PG8_BAR; }
    }
    PG8_WAIT_V(0);
    if constexpr (!ALIGN_EPI) { if (wr == 0) PG8_BAR; }
    PG8_BAR;
    if constexpr (Epi::AFTER_DRAIN) { E.fused(acc, cur, wr, wc, fr, fq, lds, wid, lane); S.done(cur); }
}
#define PG8_LDA8(dst, b, h) do { _Pragma("unroll") for (int m = 0; m < 4; ++m) dst[m] = *(const PG8_LAS i32x8*)(lds + PG8_SA(b, h) + aoff + m * 2048); } while (0)
#define PG8_LDB8(dst, b, h) do { _Pragma("unroll") for (int n = 0; n < 2; ++n) dst[n] = *(const PG8_LAS i32x8*)(lds + PG8_SB(b, h) + boff + n * 2048); } while (0)
#define PG8_MMA8(ai, bj, At, Bt) do { __builtin_amdgcn_s_setprio(1); asm volatile("s_nop 1" ::: "memory"); _Pragma("unroll") for (int m = 0; m < 4; ++m) _Pragma("unroll") for (int n = 0; n < 2; ++n) \
        asm volatile("v_mfma_scale_f32_16x16x128_f8f6f4 %0, %1, %2, %0, %3, %3 op_sel_hi:[0,0,0]" : "+v"(acc[ai][bj][m][n]) : "v"(Bt[n]), "v"(At[m]), "v"(scl8)); __builtin_amdgcn_s_setprio(0); } while (0)
template <class Epi, class Sched>
__device__ __forceinline__ void gemm_phase_g8(PG8_LAS unsigned char* lds, PG8_LAS unsigned char* side, const Gemm g, const unsigned* rowoff, const Sched& S, const Epi& E) {
    constexpr bool ALIGN_EPI = true, SP2 = true;
    int tid = threadIdx.x; asm volatile("" : "+v"(tid));
    const int wid = __builtin_amdgcn_readfirstlane(tid >> 6), lane = tid & 63, wr = wid >> 2, wc = wid & 3, fr = lane & 15, fq = lane >> 4;
    const int K = g.K; int nt = K / BK; asm volatile("" : "+s"(nt));
    unsigned voffB[2]; unsigned cA2 = 0u; int RA = 0;
#pragma unroll
    for (int i = 0; i < 2; ++i) { int R, C; stage_rc(tid * 16 + i * 8192, R, C); const int Rb = Epi::PERM ? ((R & ~31) + perm32(R & 31)) : R;
        if (i == 0) { RA = R; cA2 = (unsigned)C * 2u; } voffB[i] = (unsigned)(Rb * K + C) * 2u; }
    const size_t kstep = (size_t)(BK * 2);
    const size_t hstep = (size_t)HALF * K * 2;
    const size_t tstep = 2 * hstep;
    const unsigned ldsw = (unsigned)wid * 1024u;
    const int aoff = lds_byte8(wr * 64 + fr, fq), boff = lds_byte8(wc * 32 + fr, fq);
    int scl8 = 0x7f7f7f7f; asm volatile("" : "+v"(scl8));
    Unit cur, nxt; int ui = 0;
    if (!S.next(0, cur)) return;
    f32x4 acc[2][2][4][2];
#pragma unroll
    for (int a = 0; a < 2; ++a)
#pragma unroll
        for (int b = 0; b < 2; ++b)
#pragma unroll
            for (int m = 0; m < 4; ++m)
#pragma unroll
                for (int n = 0; n < 2; ++n) acc[a][b][m][n] = (f32x4){0.f, 0.f, 0.f, 0.f};
    i32x8 At[4], B0[2], B1[2];
    const char* const gA = (const char*)g.A; const char* cB = (const char*)g.Bt + (size_t)cur.pn * tstep;
    unsigned vo0[2], vo1[2];
#pragma unroll
    for (int i = 0; i < 2; ++i) { vo0[i] = rowoff[(size_t)cur.pm * 256 + RA + 64 * i] + cA2; vo1[i] = rowoff[(size_t)cur.pm * 256 + 128 + RA + 64 * i] + cA2; }
    S.a_ready(cur);
    if constexpr (SP2) {
        PG8_STAGE(PG8_SB(0, 0), cB, voffB); PG8_STAGE(PG8_SB(0, 1), cB + hstep, voffB); PG8_STAGE(PG8_SA(0, 0), gA, vo0); PG8_STAGE(PG8_SA(0, 1), gA, vo1);
        if (wr == 1) PG8_BAR;
        PG8_WAIT_V(2); PG8_BAR;
        PG8_STAGE(PG8_SB(1, 0), cB + kstep, voffB); PG8_STAGE(PG8_SA(1, 0), gA + kstep, vo0); PG8_STAGE(PG8_SB(1, 1), cB + hstep + kstep, voffB);
        PG8_WAIT_V(6); PG8_BAR;
    }
    for (;;) {
        const bool has_next = S.next(ui + 1, nxt);
        const char* nB = has_next ? (const char*)g.Bt + (size_t)nxt.pn * tstep : cB;
        if (has_next) __builtin_amdgcn_global_load_lds((const unsigned*)(rowoff + (size_t)nxt.pm * 256 + lane * 4), (PG8_LAS unsigned*)(side + (ui & 1) * 1024), 16, 0, 0);
        for (int t = 0; t < nt; t += 2) {
            const bool last = (t == nt - 2);
            const char* a1 = gA + (size_t)(t + 1) * kstep;
            const char* a2 = last ? gA : gA + (size_t)(t + 2) * kstep; const char* b2 = last ? nB : cB + (size_t)(t + 2) * kstep;
            unsigned s0[2], s1[2];
#pragma unroll
            for (int i = 0; i < 2; ++i) { s0[i] = vo0[i]; s1[i] = vo1[i]; }
            if (last && has_next) {
                const PG8_LAS unsigned* sl = (const PG8_LAS unsigned*)(side + (ui & 1) * 1024);
                int ra = RA; asm volatile("" : "+v"(ra));
#pragma unroll
                for (int i = 0; i < 2; ++i) { s0[i] = sl[ra + 64 * i] + cA2; s1[i] = sl[128 + ra + 64 * i] + cA2; }
            }
            const char* a3 = a2 + kstep; const char* b3 = b2 + kstep;
            if (last && has_next) S.a_ready(nxt);
            if constexpr (SP2) {
            PG8_LDB8(B0, 0, 0); PG8_LDB8(B1, 0, 1); PG8_SCHED; PG8_LDA8(At, 0, 0); PG8_STAGE(PG8_SA(1, 1), a1, vo1);
            PG8_WAIT_V(8); PG8_WAIT_L(0); PG8_BAR; PG8_MMA8(0, 0, At, B0); PG8_MMA8(0, 1, At, B1); PG8_BAR; PG8_SCHED;
            PG8_LDA8(At, 0, 1); PG8_STAGE(PG8_SB(0, 0), b2, voffB); PG8_STAGE(PG8_SB(0, 1), b2 + hstep, voffB); PG8_STAGE(PG8_SA(0, 0), a2, s0);
            PG8_WAIT_V(8); PG8_WAIT_L(0); PG8_BAR; PG8_MMA8(1, 0, At, B0); PG8_MMA8(1, 1, At, B1); PG8_BAR; PG8_SCHED;
            PG8_LDB8(B0, 1, 0); PG8_LDB8(B1, 1, 1); PG8_SCHED; PG8_LDA8(At, 1, 0); PG8_STAGE(PG8_SA(0, 1), a2, s1);
            PG8_WAIT_V(8); PG8_WAIT_L(0); PG8_BAR; PG8_MMA8(0, 0, At, B0); PG8_MMA8(0, 1, At, B1); PG8_BAR; PG8_SCHED;
            PG8_LDA8(At, 1, 1); PG8_STAGE(PG8_SB(1, 0), b3, voffB); PG8_STAGE(PG8_SB(1, 1), b3 + hstep, voffB); PG8_STAGE(PG8_SA(1, 0), a3, s0);
            PG8_WAIT_V(8); PG8_WAIT_L(0); PG8_BAR; PG8_MMA8(1, 0, At, B0); PG8_MMA8(1, 1, At, B1); PG8_BAR; PG8_SCHED;
            }
        }
        asm volatile("s_nop 15\n\ts_nop 15" ::: "memory");
        if constexpr (ALIGN_EPI) { if (wr == 0) PG8_BAR; }
        if constexpr (!Epi::AFTER_DRAIN) { E(acc, cur, wr, wc, fr, fq); S.done(cur); }
        if (!has_next) break;
#pragma unroll
        for (int a = 0; a < 2; ++a)
#pragma unroll
            for (int b = 0; b < 2; ++b)
#pragma unroll
                for (int m = 0; m < 4; ++m)
#pragma unroll
                    for (int n = 0; n < 2; ++n) acc[a][b][m][n] = (f32x4){0.f, 0.f, 0.f, 0.f};
        cur = nxt; cB = nB; ++ui;
        { const PG8_LAS unsigned* sl = (const PG8_LAS unsigned*)(side + ((ui - 1) & 1) * 1024); int ra = RA; asm volatile("" : "+v"(ra));
#pragma unroll
          for (int i = 0; i < 2; ++i) { vo0[i] = sl[ra + 64 * i] + cA2; vo1[i] = sl[128 + ra + 64 * i] + cA2; } }
        if constexpr (ALIGN_EPI) { if (wr == 1) PG8_BAR; }
    }
    PG8_WAIT_V(0);
    if constexpr (!ALIGN_EPI) { if (wr == 0) PG8_BAR; }
    PG8_BAR;
    if constexpr (Epi::AFTER_DRAIN) { E.fused(acc, cur, wr, wc, fr, fq, lds, wid, lane); S.done(cur); }
}
template <class Epi, class Sched, bool ALIGN_EPI = false, bool SP2 = false>
__device__ __forceinline__ void gemm_phase8(PG8_LAS unsigned char* lds, const Gemm g, const Sched& S, const Epi& E) {
    int tid = threadIdx.x; asm volatile("" : "+v"(tid));
    const int wid = __builtin_amdgcn_readfirstlane(tid >> 6), lane = tid & 63, wr = wid >> 2, wc = wid & 3, fr = lane & 15, fq = lane >> 4;
    const int K = g.K; int nt = K / BK; asm volatile("" : "+s"(nt));
    unsigned voffA[2], voffB[2];
#pragma unroll
    for (int i = 0; i < 2; ++i) { int R, C; stage_rc(tid * 16 + i * 8192, R, C); const int Rb = Epi::PERM ? ((R & ~31) + perm32(R & 31)) : R;
        voffA[i] = (unsigned)(R * K + C) * 2u; voffB[i] = (unsigned)(Rb * K + C) * 2u; }
    const size_t kstep = (size_t)(BK * 2);
    const size_t hstep = (size_t)HALF * K * 2;
    const size_t tstep = 2 * hstep;
    const unsigned ldsw = (unsigned)wid * 1024u;
    const int aoff = lds_byte8(wr * 64 + fr, fq), boff = lds_byte8(wc * 32 + fr, fq);
    int scl8 = 0x7f7f7f7f; asm volatile("" : "+v"(scl8));
    Unit cur, nxt; int ui = 0;
    if (!S.next(0, cur)) return;
    f32x4 acc[2][2][4][2];
#pragma unroll
    for (int a = 0; a < 2; ++a)
#pragma unroll
        for (int b = 0; b < 2; ++b)
#pragma unroll
            for (int m = 0; m < 4; ++m)
#pragma unroll
                for (int n = 0; n < 2; ++n) acc[a][b][m][n] = (f32x4){0.f, 0.f, 0.f, 0.f};
    i32x8 At[4], B0[2], B1[2];
    const char* cA = (const char*)g.A + (size_t)cur.pm * tstep; const char* cB = (const char*)g.Bt + (size_t)cur.pn * tstep;
    S.a_ready(cur);
    if constexpr (SP2) {
        PG8_STAGE(PG8_SB(0, 0), cB, voffB); PG8_STAGE(PG8_SB(0, 1), cB + hstep, voffB); PG8_STAGE(PG8_SA(0, 0), cA, voffA); PG8_STAGE(PG8_SA(0, 1), cA + hstep, voffA);
        if (wr == 1) PG8_BAR;
        PG8_WAIT_V(2); PG8_BAR;
        PG8_STAGE(PG8_SB(1, 0), cB + kstep, voffB); PG8_STAGE(PG8_SA(1, 0), cA + kstep, voffA); PG8_STAGE(PG8_SB(1, 1), cB + hstep + kstep, voffB);
        PG8_WAIT_V(6); PG8_BAR;
    } else {
        PG8_STAGE(PG8_SB(0, 0), cB, voffB); PG8_STAGE(PG8_SA(0, 0), cA, voffA); PG8_STAGE(PG8_SB(0, 1), cB + hstep, voffB); PG8_STAGE(PG8_SA(0, 1), cA + hstep, voffA);
        if (wr == 1) PG8_BAR;
        PG8_WAIT_V(4); PG8_BAR;
        PG8_STAGE(PG8_SB(1, 0), cB + kstep, voffB); PG8_STAGE(PG8_SA(1, 0), cA + kstep, voffA); PG8_STAGE(PG8_SB(1, 1), cB + hstep + kstep, voffB);
        PG8_WAIT_V(6); PG8_BAR;
    }
    for (;;) {
        const bool has_next = S.next(ui + 1, nxt);
        const char* nA = has_next ? (const char*)g.A + (size_t)nxt.pm * tstep : cA; const char* nB = has_next ? (const char*)g.Bt + (size_t)nxt.pn * tstep : cB;
        for (int t = 0; t < nt; t += 2) {
            const bool last = (t == nt - 2);
            const char* a1 = cA + (size_t)(t + 1) * kstep;
            const char* a2 = last ? nA : cA + (size_t)(t + 2) * kstep; const char* b2 = last ? nB : cB + (size_t)(t + 2) * kstep;
            const char* a3 = a2 + kstep; const char* b3 = b2 + kstep;
            if (last && has_next) S.a_ready(nxt);
            if constexpr (SP2) {
            PG8_LDB8(B0, 0, 0); PG8_LDB8(B1, 0, 1); PG8_SCHED; PG8_LDA8(At, 0, 0); PG8_STAGE(PG8_SA(1, 1), a1 + hstep, voffA);
            PG8_WAIT_V(8); PG8_WAIT_L(0); PG8_BAR; PG8_MMA8(0, 0, At, B0); PG8_MMA8(0, 1, At, B1); PG8_BAR; PG8_SCHED;
            PG8_LDA8(At, 0, 1); PG8_STAGE(PG8_SB(0, 0), b2, voffB); PG8_STAGE(PG8_SB(0, 1), b2 + hstep, voffB); PG8_STAGE(PG8_SA(0, 0), a2, voffA);
            PG8_WAIT_V(8); PG8_WAIT_L(0); PG8_BAR; PG8_MMA8(1, 0, At, B0); PG8_MMA8(1, 1, At, B1); PG8_BAR; PG8_SCHED;
            PG8_LDB8(B0, 1, 0); PG8_LDB8(B1, 1, 1); PG8_SCHED; PG8_LDA8(At, 1, 0); PG8_STAGE(PG8_SA(0, 1), a2 + hstep, voffA);
            PG8_WAIT_V(8); PG8_WAIT_L(0); PG8_BAR; PG8_MMA8(0, 0, At, B0); PG8_MMA8(0, 1, At, B1); PG8_BAR; PG8_SCHED;
            PG8_LDA8(At, 1, 1); PG8_STAGE(PG8_SB(1, 0), b3, voffB); PG8_STAGE(PG8_SB(1, 1), b3 + hstep, voffB); PG8_STAGE(PG8_SA(1, 0), a3, voffA);
            PG8_WAIT_V(8); PG8_WAIT_L(0); PG8_BAR; PG8_MMA8(1, 0, At, B0); PG8_MMA8(1, 1, At, B1); PG8_BAR; PG8_SCHED;
            } else {
            PG8_LDB8(B0, 0, 0); PG8_SCHED; PG8_LDA8(At, 0, 0); PG8_STAGE(PG8_SA(1, 1), a1 + hstep, voffA);
            PG8_WAIT_L(8); PG8_BAR; PG8_WAIT_L(0); PG8_MMA8(0, 0, At, B0); PG8_BAR; PG8_SCHED;
            PG8_LDB8(B1, 0, 1); PG8_STAGE(PG8_SB(0, 0), b2, voffB);
            PG8_BAR; PG8_WAIT_L(0); PG8_MMA8(0, 1, At, B1); PG8_BAR;
            PG8_LDA8(At, 0, 1); PG8_STAGE(PG8_SA(0, 0), a2, voffA);
            PG8_BAR; PG8_WAIT_L(0); PG8_MMA8(1, 0, At, B0); PG8_BAR; PG8_SCHED;
            PG8_STAGE(PG8_SB(0, 1), b2 + hstep, voffB);
            PG8_WAIT_V(6); PG8_BAR; PG8_MMA8(1, 1, At, B1); PG8_BAR;
            PG8_LDB8(B0, 1, 0); PG8_SCHED; PG8_LDA8(At, 1, 0); PG8_STAGE(PG8_SA(0, 1), a2 + hstep, voffA);
            PG8_WAIT_L(8); PG8_BAR; PG8_WAIT_L(0); PG8_MMA8(0, 0, At, B0); PG8_BAR; PG8_SCHED;
            PG8_LDB8(B1, 1, 1); PG8_STAGE(PG8_SB(1, 0), b3, voffB);
            PG8_BAR; PG8_WAIT_L(0); PG8_MMA8(0, 1, At, B1); PG8_BAR;
            PG8_LDA8(At, 1, 1); PG8_STAGE(PG8_SA(1, 0), a3, voffA);
            PG8_BAR; PG8_WAIT_L(0); PG8_MMA8(1, 0, At, B0); PG8_BAR; PG8_SCHED;
            PG8_STAGE(PG8_SB(1, 1), b3 + hstep, voffB);
            PG8_WAIT_V(6); PG8_BAR; PG8_MMA8(1, 1, At, B1); PG8_BAR;
            }
        }
        asm volatile("s_nop 15\n\ts_nop 15" ::: "memory");
        if constexpr (ALIGN_EPI) { if (wr == 0) PG8_BAR; }
        if constexpr (!Epi::AFTER_DRAIN) { E(acc, cur, wr, wc, fr, fq); S.done(cur); }
        if (!has_next) break;
#pragma unroll
        for (int a = 0; a < 2; ++a)
#pragma unroll
            for (int b = 0; b < 2; ++b)
#pragma unroll
                for (int m = 0; m < 4; ++m)
#pragma unroll
                    for (int n = 0; n < 2; ++n) acc[a][b][m][n] = (f32x4){0.f, 0.f, 0.f, 0.f};
        cur = nxt; cA = nA; cB = nB; ++ui;
        if constexpr (ALIGN_EPI) { if (wr == 1) PG8_BAR; }
    }
    PG8_WAIT_V(0);
    if constexpr (!ALIGN_EPI) { if (wr == 0) PG8_BAR; }
    PG8_BAR;
    if constexpr (Epi::AFTER_DRAIN) { E.fused(acc, cur, wr, wc, fr, fq, lds, wid, lane); S.done(cur); }
}
#undef PG8_LDA8
#undef PG8_LDB8
#undef PG8_MMA8
#undef PG8_SA
#undef PG8_SB
#undef PG8_STAGE
#undef PG8_LDA
#undef PG8_LDB
#undef PG8_MMA
#undef PG8_WAIT_V
#undef PG8_WAIT_L
#undef PG8_BAR
#undef PG8_SCHED
}
#define GAS __attribute__((address_space(1)))
#define LAS __attribute__((address_space(3)))
typedef unsigned short bf16;
typedef unsigned v4u __attribute__((ext_vector_type(4)));
typedef float f32x4 __attribute__((ext_vector_type(4)));
typedef short bf16x8 __attribute__((ext_vector_type(8)));
typedef GAS unsigned gu32;
typedef GAS unsigned long long gu64;
#define RLX_AGENT __ATOMIC_RELAXED, __HIP_MEMORY_SCOPE_AGENT
#define LDS_WAIT() asm volatile("s_waitcnt lgkmcnt(0)" ::: "memory")
#define VM_WAIT() asm volatile("s_waitcnt vmcnt(0)" ::: "memory")
__device__ __forceinline__ unsigned long long rt() { return __builtin_amdgcn_s_memrealtime(); }
__device__ __forceinline__ unsigned f2bf(float f) { unsigned u = __builtin_bit_cast(unsigned, f); return (u + 0x7fffu + ((u >> 16) & 1u)) >> 16; }
__device__ __forceinline__ unsigned pk2(float lo, float hi) { return f2bf(lo) | (f2bf(hi) << 16); }

#define XB_TMO      128
#define XB_XCNT(j)  (256  + 64 * (j))
#define XB_XSUB(j)  (1280 + 64 * (j))
#define XB_XGEN(j)  (2304 + 64 * (j))
#define XB_TOP      3328
#define XB_TOPGEN   3392
#define XCD_BAR_WORDS 3456
#define XB_SPIN_CAP (1u << 18)

__device__ __forceinline__ unsigned xb_ld(unsigned* p)              { return __hip_atomic_load(p, __ATOMIC_RELAXED, __HIP_MEMORY_SCOPE_AGENT); }
__device__ __forceinline__ unsigned xb_add(unsigned* p, unsigned v) { return __hip_atomic_fetch_add(p, v, __ATOMIC_RELAXED, __HIP_MEMORY_SCOPE_AGENT); }
__device__ __forceinline__ unsigned xb_xcc_id() { return (unsigned)__builtin_amdgcn_s_getreg((3 << 11) | 20) & 0xFu; }
#define XB_SPIN(cond, bar) do { unsigned _sp = 0; while (cond) { __builtin_amdgcn_s_sleep(1); \
    if ((++_sp & 255u) == 0u) { if (xb_ld(&(bar)[XB_TMO])) break; if (_sp > XB_SPIN_CAP) { atomicAdd(&(bar)[XB_TMO], 1u); break; } } } } while (0)

struct XcdBarrier {
    unsigned* bar; unsigned x;
    volatile LAS unsigned* st;
};

__device__ __forceinline__ XcdBarrier xcd_barrier_post(unsigned* bar, volatile LAS unsigned* st) {
    XcdBarrier b; b.bar = bar; b.x = xb_xcc_id(); b.st = st;
    if (threadIdx.x == 0) (void)xb_add(&bar[XB_XCNT(b.x)], 1u);
    return b;
}
__device__ __forceinline__ void xcd_barrier_complete(unsigned* bar, unsigned x, unsigned& nloc, unsigned& nx) {
    const unsigned G = gridDim.x * gridDim.y * gridDim.z;
    unsigned sum, cnt, mine, sp = 0u;
    for (;;) {
        sum = 0u; cnt = 0u; mine = 0u;
#pragma unroll
        for (unsigned j = 0; j < 16; ++j) { const unsigned c = xb_ld(&bar[XB_XCNT(j)]); sum += c; cnt += (c > 0u) ? 1u : 0u; mine = (j == x) ? c : mine; }
        if (sum == G) break;
        __builtin_amdgcn_s_sleep(1);
        if ((++sp & 255u) == 0u) { if (xb_ld(&bar[XB_TMO])) break; if (sp > XB_SPIN_CAP) { atomicAdd(&bar[XB_TMO], 1u); break; } }
    }
    nloc = mine > 0u ? mine : 1u; nx = cnt > 0u ? cnt : 1u;
}

__device__ __forceinline__ void xcd_barrier(const XcdBarrier& b) {
    asm volatile("s_waitcnt vmcnt(0)" ::: "memory");
    __syncthreads();
    if (threadIdx.x == 0) {
        unsigned* bar = b.bar;
        __builtin_amdgcn_s_waitcnt(0);
        unsigned nloc = b.st[0], nx = b.st[1];
        if (nloc == 0u) { xcd_barrier_complete(bar, b.x, nloc, nx); b.st[0] = nloc; b.st[1] = nx; }
        const unsigned old = xb_add(&bar[XB_XSUB(b.x)], 1u);
        const unsigned gen = old / nloc;
        if (old + 1u == (gen + 1u) * nloc) {
            __builtin_amdgcn_fence(__ATOMIC_RELEASE, "agent");
            asm volatile("s_waitcnt vmcnt(0)" ::: "memory");
            const unsigned og = xb_add(&bar[XB_TOP], 1u);
            const unsigned tg = og / nx;
            if (og + 1u == (tg + 1u) * nx) xb_add(&bar[XB_TOPGEN], 1u);
            else XB_SPIN(xb_ld(&bar[XB_TOPGEN]) == tg, bar);
            __builtin_amdgcn_fence(__ATOMIC_ACQUIRE, "agent");
            xb_add(&bar[XB_XGEN(b.x)], 1u);
            asm volatile("s_waitcnt vmcnt(0)" ::: "memory");
        } else {
            XB_SPIN(xb_ld(&bar[XB_XGEN(b.x)]) == gen, bar);
            __builtin_amdgcn_fence(__ATOMIC_ACQUIRE, "agent");
            asm volatile("s_waitcnt vmcnt(0)" ::: "memory");
        }
    }
    __syncthreads();
}
typedef unsigned u32x4 __attribute__((ext_vector_type(4)));

namespace pg8 {
typedef unsigned u32x2 __attribute__((ext_vector_type(2)));
__device__ __forceinline__ float silu_f(float x) { return x * __builtin_amdgcn_rcpf(1.0f + __expf(-x)); }
struct EpiHS {
    static constexpr bool PERM = true, AFTER_DRAIN = false;
    const float* x; const float* meta; bf16_t* hsb;
    __device__ __forceinline__ void operator()(const f32x4 (&acc)[2][2][4][2], const Unit& u, int wr, int wc, int fr, int fq) const {
        const int col0 = u.pn * BM + wc * 32 + 8 * fq;
#pragma unroll
        for (int ai = 0; ai < 2; ++ai) {
            f32x4 rv[4][2][2]; int tt[4];
#pragma unroll
            for (int m = 0; m < 4; ++m) {
                const int r = u.pm * BM + ai * HALF + wr * 64 + m * 16 + fr;
                const int b = r / 8320, p = r - b * 8320, t = p - 112; tt[m] = t;
                const int tc = t < 0 ? 16 : t;
                const float* src = tc < 16 ? meta + (size_t)tc * 1024 : x + ((size_t)b * 8192 + (size_t)(tc - 16)) * 1024;
#pragma unroll
                for (int bj = 0; bj < 2; ++bj) { rv[m][bj][0] = *(const f32x4*)(src + col0 + bj * HALF); rv[m][bj][1] = *(const f32x4*)(src + col0 + bj * HALF + 4); }
            }
#pragma unroll
            for (int m = 0; m < 4; ++m) {
                const int r = u.pm * BM + ai * HALF + wr * 64 + m * 16 + fr;
                if (tt[m] >= 0) {
                    bf16_t* dst = hsb + (size_t)r * 1024;
#pragma unroll
                    for (int bj = 0; bj < 2; ++bj) { const f32x4 v0 = rv[m][bj][0] + acc[ai][bj][m][0], v1 = rv[m][bj][1] + acc[ai][bj][m][1]; u32x4 w;
                        w.x = cvt_pk_bf16(v0[0], v0[1]); w.y = cvt_pk_bf16(v0[2], v0[3]); w.z = cvt_pk_bf16(v1[0], v1[1]); w.w = cvt_pk_bf16(v1[2], v1[3]);
                        *(u32x4*)(dst + col0 + bj * HALF) = w; }
                }
            }
        }
    }
};
struct EpiAct {
    static constexpr bool PERM = true, AFTER_DRAIN = false;
    bf16_t* act;
    __device__ __forceinline__ void operator()(const f32x4 (&acc)[2][2][4][2], const Unit& u, int wr, int wc, int fr, int fq) const {
        const int row0 = u.pm * BM + wr * 64 + fr; const int j = u.pn & 7; const int col0 = j * 128 + wc * 32 + 8 * fq;
#pragma unroll
        for (int ai = 0; ai < 2; ++ai)
#pragma unroll
            for (int m = 0; m < 4; ++m) {
                unsigned char* rowp = (unsigned char*)act + (size_t)(row0 + ai * HALF + m * 16) * 1024 + col0;
                const f32x4 g0 = acc[ai][0][m][0] * 0.03125f, g1 = acc[ai][0][m][1] * 0.03125f, u0 = acc[ai][1][m][0] * 0.03125f, u1 = acc[ai][1][m][1] * 0.03125f;
                u32x2 w; unsigned t = 0u;
                t = __builtin_amdgcn_cvt_pk_fp8_f32(silu_f(g0[0]) * u0[0], silu_f(g0[1]) * u0[1], t, false); t = __builtin_amdgcn_cvt_pk_fp8_f32(silu_f(g0[2]) * u0[2], silu_f(g0[3]) * u0[3], t, true); w.x = t;
                t = __builtin_amdgcn_cvt_pk_fp8_f32(silu_f(g1[0]) * u1[0], silu_f(g1[1]) * u1[1], t, false); t = __builtin_amdgcn_cvt_pk_fp8_f32(silu_f(g1[2]) * u1[2], silu_f(g1[3]) * u1[3], t, true); w.y = t;
                *(u32x2*)rowp = w;
            }
    }
};
struct EpiYS {
    static constexpr bool PERM = true, AFTER_DRAIN = false;
    unsigned char* ys; const float* gate;
    __device__ __forceinline__ void operator()(const f32x4 (&acc)[2][2][4][2], const Unit& u, int wr, int wc, int fr, int fq) const {
        const int row0 = u.pm * BM + wr * 64 + fr; const int j = u.pn & 3; const int col0 = j * 256 + wc * 32 + 8 * fq;
#pragma unroll
        for (int ai = 0; ai < 2; ++ai)
#pragma unroll
            for (int m = 0; m < 4; ++m) {
                const int row = row0 + ai * HALF + m * 16; const float gv = gate[row] * 0.25f;
                unsigned char* rowp = ys + (size_t)row * 1024 + col0;
#pragma unroll
                for (int bj = 0; bj < 2; ++bj) { const f32x4 v0 = acc[ai][bj][m][0] * gv, v1 = acc[ai][bj][m][1] * gv; u32x2 w; unsigned t = 0u;
                    t = __builtin_amdgcn_cvt_pk_fp8_f32(v0[0], v0[1], t, false); t = __builtin_amdgcn_cvt_pk_fp8_f32(v0[2], v0[3], t, true); w.x = t;
                    t = __builtin_amdgcn_cvt_pk_fp8_f32(v1[0], v1[1], t, false); t = __builtin_amdgcn_cvt_pk_fp8_f32(v1[2], v1[3], t, true); w.y = t;
                    *(u32x2*)(rowp + bj * HALF) = w; }
            }
    }
};

struct EpiZ {
    static constexpr bool PERM = true, AFTER_DRAIN = false;
    bf16_t* Z; const float* cs;
    __device__ __forceinline__ void operator()(const f32x4 (&acc)[2][2][4][2], const Unit& u, int wr, int wc, int fr, int fq) const {
        const int row0 = u.pm * BM + wr * 64 + fr;
        if (u.pn < 4 || u.pn >= 8) {
            const int col0 = u.pn * BM + wc * 32 + 8 * fq;
#pragma unroll
            for (int ai = 0; ai < 2; ++ai)
#pragma unroll
                for (int m = 0; m < 4; ++m) { bf16_t* rowp = Z + (size_t)(row0 + ai * HALF + m * 16) * 3072 + col0;
#pragma unroll
                    for (int bj = 0; bj < 2; ++bj) { const f32x4 v0 = acc[ai][bj][m][0], v1 = acc[ai][bj][m][1]; u32x4 w;
                        w.x = cvt_pk_bf16(v0[0], v0[1]); w.y = cvt_pk_bf16(v0[2], v0[3]); w.z = cvt_pk_bf16(v1[0], v1[1]); w.w = cvt_pk_bf16(v1[2], v1[3]);
                        *(u32x4*)(rowp + bj * HALF) = w; } }
        } else {
            const int x0 = wc * 32 + 8 * fq;
            const int region = (u.pn - 4) >> 1, head = 2 * ((u.pn - 4) & 1) + (x0 >> 6), j0 = x0 & 63;
            const int colA = 1024 + region * 512 + head * 128 + j0;
            const float sc = region == 0 ? 0.08838834764831845f : 1.0f;
#pragma unroll
            for (int ai = 0; ai < 2; ++ai) {
                f32x4 cc[4][4];
#pragma unroll
                for (int m = 0; m < 4; ++m) { const int r = row0 + ai * HALF + m * 16; const int b = r / 8320; int t = r - b * 8320 - 112; t = t < 0 ? 0 : t;
                    const f32x4* cp = (const f32x4*)(cs + ((size_t)t * 64 + j0) * 2); cc[m][0] = cp[0]; cc[m][1] = cp[1]; cc[m][2] = cp[2]; cc[m][3] = cp[3]; }
#pragma unroll
                for (int m = 0; m < 4; ++m) {
                    const int r = row0 + ai * HALF + m * 16;
                    const f32x4 c0 = cc[m][0], c1 = cc[m][1], c2 = cc[m][2], c3 = cc[m][3];
                    const f32x4 a0 = acc[ai][0][m][0], a1 = acc[ai][0][m][1], b0 = acc[ai][1][m][0], b1 = acc[ai][1][m][1];
                    u32x4 w1, w2;
                    w1.x = cvt_pk_bf16((a0[0] * c0[0] - b0[0] * c0[1]) * sc, (a0[1] * c0[2] - b0[1] * c0[3]) * sc); w2.x = cvt_pk_bf16((a0[0] * c0[1] + b0[0] * c0[0]) * sc, (a0[1] * c0[3] + b0[1] * c0[2]) * sc);
                    w1.y = cvt_pk_bf16((a0[2] * c1[0] - b0[2] * c1[1]) * sc, (a0[3] * c1[2] - b0[3] * c1[3]) * sc); w2.y = cvt_pk_bf16((a0[2] * c1[1] + b0[2] * c1[0]) * sc, (a0[3] * c1[3] + b0[3] * c1[2]) * sc);
                    w1.z = cvt_pk_bf16((a1[0] * c2[0] - b1[0] * c2[1]) * sc, (a1[1] * c2[2] - b1[1] * c2[3]) * sc); w2.z = cvt_pk_bf16((a1[0] * c2[1] + b1[0] * c2[0]) * sc, (a1[1] * c2[3] + b1[1] * c2[2]) * sc);
                    w1.w = cvt_pk_bf16((a1[2] * c3[0] - b1[2] * c3[1]) * sc, (a1[3] * c3[2] - b1[3] * c3[3]) * sc); w2.w = cvt_pk_bf16((a1[2] * c3[1] + b1[2] * c3[0]) * sc, (a1[3] * c3[3] + b1[3] * c3[2]) * sc);
                    bf16_t* rowp = Z + (size_t)r * 3072 + colA;
                    *(u32x4*)rowp = w1; *(u32x4*)(rowp + 64) = w2;
                }
            }
        }
    }
};
struct GroupOrder {
    int G, vcu, tm, tn, nwg;
    __device__ __forceinline__ void init(int ne, int tm_, int tn_, int G_, int c) { tm = tm_; tn = tn_; nwg = ne * tm_ * tn_; G = G_; vcu = (G_ % 8 == 0) ? (c % 8) * (G_ / 8) + c / 8 : c; }
    __device__ __forceinline__ bool next(int i, Unit& u) const {
        const long L = (long)i * G + vcu; if (L >= nwg) return false;
        const int per = tm * tn, e = (int)(L / per), rem = (int)(L % per);
        u.pm = e * tm + rem / tn; u.pn = e * tn + rem % tn; return true;
    }
    __device__ __forceinline__ void a_ready(const Unit&) const {}
    __device__ __forceinline__ void done(const Unit&) const {}
};
}

constexpr int NB = 8, SEQ = 8192, DM = 1024, NMETA = 16, TT = SEQ + NMETA, PADL = 112, PP = 8320, NP = NB * PP;
constexpr int NCHUNK = 65, NSEG = 130;
constexpr int ZC = 3072, ZC_LX = 0, ZC_LG = 512, ZC_Q = 1024, ZC_K = 1536, ZC_V = 2048, ZC_G = 2560;
constexpr int NE = 16, CAP = 1026, EROWS = 8448, NROWS = NE * EROWS;
constexpr float EPSN = 1e-6f;
constexpr int NPHASE = 12;

constexpr size_t MiB = 1u << 20;
constexpr size_t WS_CTL = 0, CTL_ZERO_BYTES = 64 * 1024;
constexpr size_t WS_GW = 1 * MiB, WS_GW2 = 1 * MiB + 256 * 1024, WS_HSMETA = 1 * MiB + 512 * 1024;
constexpr size_t WS_CS = 3 * MiB, WS_SUMM = 8 * MiB, WS_CARRY = 17 * MiB, WS_AFF = 22 * MiB, WS_ROWMAP = 27 * MiB, WS_IDX = 32 * MiB, WS_GATE = 33 * MiB;
constexpr size_t WS_WIN = 34 * MiB, WS_WOUT = 40 * MiB, WS_WGU = 42 * MiB, WS_WD = 106 * MiB;
#ifndef ST_INPLACE
#define ST2_BASE WS_ST2
#define CPY_BASE WS_ST
#else
#define ST2_BASE WS_ST
#define CPY_BASE WS_ST2
#endif
constexpr size_t WS_ST2 = 788 * MiB;
constexpr size_t WS_HSB = 400 * MiB;
constexpr size_t WS_H = 138 * MiB, WS_Z = 268 * MiB, WS_ST = 658 * MiB, WS_XS = 658 * MiB, WS_ACT = 268 * MiB, WS_YS = WS_XS, WS_END = 922 * MiB;
static_assert(WS_H + (size_t)NP * 2048 <= WS_Z && WS_Z + (size_t)NP * ZC * 2 <= WS_ST && WS_ST + (size_t)NB * 4 * 2 * NCHUNK * 32768 <= WS_END && WS_XS + (size_t)NROWS * 2048 <= WS_END && WS_ACT + (size_t)NROWS * 2048 <= WS_ST, "ws map");
constexpr int CW_BAR = 1024;

constexpr int LDS_MAIN = 131072, LDS_BYTES = 147456;
constexpr int LDS_SS = LDS_MAIN;
constexpr int LDS_MISC = LDS_MAIN + 4096;
constexpr int LDS_SIDE = LDS_MAIN + 8192;

typedef unsigned short u16x8 __attribute__((ext_vector_type(8)));
typedef unsigned short u16x4 __attribute__((ext_vector_type(4)));
typedef float f32x16 __attribute__((ext_vector_type(16)));
typedef float f32x2 __attribute__((ext_vector_type(2)));
typedef unsigned u32x2 __attribute__((ext_vector_type(2)));
typedef short v4i16_t __attribute__((ext_vector_type(4)));
typedef __bf16 bf16x2_t __attribute__((ext_vector_type(2)));

__device__ __forceinline__ float bf2f(unsigned short v) { return __uint_as_float((unsigned)v << 16); }
__device__ __forceinline__ unsigned cvtpk(float lo, float hi) { f32x2 v = {lo, hi}; bf16x2_t b = __builtin_convertvector(v, bf16x2_t); return __builtin_bit_cast(unsigned, b); }
__device__ __forceinline__ unsigned short f2bf16(float f) { return (unsigned short)(cvtpk(f, 0.f) & 0xffffu); }
__device__ __forceinline__ float wave_sum(float v) {
#pragma unroll
    for (int o = 1; o < 64; o <<= 1) v += __shfl_xor(v, o);
    return v;
}
__device__ __forceinline__ float sigmoid_f(float x) { return __builtin_amdgcn_rcpf(1.0f + __expf(-x)); }
__device__ __forceinline__ float gelu_tanh_f(float x) { const float z2 = 2.302208198144325f * x * (1.0f + 0.044715f * x * x);   return x - x * __builtin_amdgcn_rcpf(1.0f + __builtin_amdgcn_exp2f(z2)); }
__device__ __forceinline__ float softplus_neg(float lam) { const float y = __expf(-lam); return (y < 0.05f) ? y * (1.0f + y * (-0.5f + y * (0.33333333f + y * (-0.25f + y * 0.2f)))) : log1pf(y); }
__device__ __forceinline__ float log2_gamma(int h) { return h == 0 ? -0.04580368961312479f : h == 1 ? -0.02272007650008353f : h == 2 ? -0.011315313227834146f : -0.005646563141142063f; }
__device__ __forceinline__ unsigned off_b(unsigned row, unsigned ch) { return 256u * row + 16u * (ch ^ (((row & 3u) << 2) | ((row >> 2) & 3u))); }
__device__ __forceinline__ pg8::bf16x8 rowfrag(LAS unsigned char* T, int rb, int s, int lane) {
    return *(LAS pg8::bf16x8*)(T + off_b(32 * rb + (lane & 31), 2 * s + (lane >> 5)));
}
__device__ __forceinline__ pg8::bf16x8 rowfrag_x(LAS unsigned char* T, int rb, int s, int lane) {
    return *(LAS pg8::bf16x8*)(T + off_b((32 * rb + (lane & 31)) ^ 1, 2 * s + (lane >> 5)));
}
__device__ __forceinline__ v4i16_t tr_rd(LAS unsigned char* p) { return __builtin_amdgcn_ds_read_tr16_b64_v4i16((LAS v4i16_t*)p); }
__device__ __forceinline__ pg8::bf16x8 trfrag(LAS unsigned char* T, int c, int ks, int lane) {
    const unsigned h = lane >> 5, blk = (lane >> 4) & 1, q = (lane & 15) >> 2, p = lane & 3;
    const v4i16_t lo = tr_rd(T + off_b(16 * ks + 8 * h + q, 4 * c + 2 * blk + (p >> 1)) + 8 * (p & 1));
    const v4i16_t hi = tr_rd(T + off_b(16 * ks + 8 * h + 4 + q, 4 * c + 2 * blk + (p >> 1)) + 8 * (p & 1));
    return (pg8::bf16x8){lo[0], lo[1], lo[2], lo[3], hi[0], hi[1], hi[2], hi[3]};
}
__device__ __forceinline__ pg8::bf16x8 trfrag_perm(LAS unsigned char* T, int c, int rbase, int lane) {
    const unsigned h = lane >> 5, blk = (lane >> 4) & 1, q = (lane & 15) >> 2, p = lane & 3;
    const v4i16_t lo = tr_rd(T + off_b(rbase + 4 * h + q, 4 * c + 2 * blk + (p >> 1)) + 8 * (p & 1));
    const v4i16_t hi = tr_rd(T + off_b(rbase + 8 + 4 * h + q, 4 * c + 2 * blk + (p >> 1)) + 8 * (p & 1));
    return (pg8::bf16x8){lo[0], lo[1], lo[2], lo[3], hi[0], hi[1], hi[2], hi[3]};
}
__device__ __forceinline__ int crow(int reg, int h) { return (reg & 3) + 8 * (reg >> 2) + 4 * h; }
#define MFMA32(a, b, c) __builtin_amdgcn_mfma_f32_32x32x16_bf16((a), (b), (c), 0, 0, 0)
#define MFMA16(a, b, c) __builtin_amdgcn_mfma_f32_16x16x32_bf16((a), (b), (c), 0, 0, 0)

struct Fr {
    LAS unsigned char* lds;
    int tid, lane, wave, G;
    const float *x, *meta, *norm1_g, *w_in, *conv_w, *conv_b, *w_r, *b_r, *w_i, *b_i, *lam, *lru_out_g, *ret_out_g, *w_out, *norm2_g, *w_router, *w_gate, *w_up, *w_down, *final_g;
    float* out;
    unsigned short *GW2; unsigned short *GW, *WIN, *WOUT, *WGU, *WD, *H, *Z, *ST, *XS, *ACT, *YS;
    unsigned char* CTLP; float *HSMETA, *AFF, *GATE, *CARRY; unsigned short* HSB; unsigned short* ST2; f32x2 *CS, *SUMM; int *ROWMAP, *IDX;
};

__device__ __forceinline__ void prep_tile(const Fr& F, const float* W, int ldw, int k0, int n0, unsigned short* WT, int mode) {
    LAS float* scr = (LAS float*)F.lds;
    const int tid = F.tid;
    { const int n = tid & 63, kk = tid >> 6;
#pragma unroll
      for (int i = 0; i < 8; ++i) { const int k = kk + 8 * i; scr[k * 65 + n] = W[(size_t)(k0 + k) * ldw + n0 + n]; } }
    __syncthreads();
    { const int k = tid & 63, nn = tid >> 6;
#pragma unroll
      for (int i = 0; i < 8; ++i) { const int n = n0 + nn + 8 * i; int row;
          if (mode == 0) row = n; else if (mode == 3) { if (n < 1024 || n >= 2048) row = n; else { const int q = n - 1024, region = q >> 9, hd = (q >> 7) & 3, d = q & 127; row = 1024 + region * 512 + (hd >> 1) * 256 + (d >> 6) * 128 + (hd & 1) * 64 + (d & 63); } }
          else row = 256 * (n >> 7) + (n & 127) + (mode == 2 ? 128 : 0);
          WT[(size_t)row * 1024 + k0 + k] = f2bf16(scr[k * 65 + (nn + 8 * i)]); } }
    __syncthreads();
}
__device__ __forceinline__ void prep_tile8(const Fr& F, const float* W, int k0, int n0, unsigned char* WT8, int mode) {
    LAS float* scr = (LAS float*)F.lds;
    const int tid = F.tid;
    { const int n = tid & 63, kk = tid >> 6;
#pragma unroll
      for (int i = 0; i < 8; ++i) { const int k = kk + 8 * i; scr[k * 65 + n] = W[(size_t)(k0 + k) * 1024 + n0 + n]; } }
    __syncthreads();
    { const int k4 = tid & 15, nn = tid >> 4;
#pragma unroll
      for (int i = 0; i < 2; ++i) { const int nl = nn + 32 * i, n = n0 + nl; const int row = mode == 0 ? n : 256 * (n >> 7) + (n & 127) + (mode == 2 ? 128 : 0);
          const float a = scr[(4 * k4 + 0) * 65 + nl] * 32.0f, b = scr[(4 * k4 + 1) * 65 + nl] * 32.0f, c = scr[(4 * k4 + 2) * 65 + nl] * 32.0f, d = scr[(4 * k4 + 3) * 65 + nl] * 32.0f;
          unsigned w = 0u; w = __builtin_amdgcn_cvt_pk_fp8_f32(a, b, w, false); w = __builtin_amdgcn_cvt_pk_fp8_f32(c, d, w, true);
          *(unsigned*)(WT8 + (size_t)row * 1024 + k0 + 4 * k4) = w; } }
    __syncthreads();
}
__device__ __forceinline__ void sincos_tab(int t, int j, float& co, float& si) {
    double f = 1.0, bse = 0.8659643233600653;
    int e = j;
#pragma unroll
    for (int i = 0; i < 6; ++i) { if (e & 1) f *= bse; bse *= bse; e >>= 1; }
    const double xx = (double)t * f;
    const double qd = __builtin_rint(xx * 0.6366197723675814);
    double y = __builtin_fma(-qd, 1.5707963267948966, xx); y = __builtin_fma(-qd, 6.123233995736766e-17, y);
    const double y2 = y * y;
    double sp = -7.647163731819816e-13;
    sp = sp * y2 + 1.6059043836821613e-10;
    sp = sp * y2 - 2.505210838544172e-08;
    sp = sp * y2 + 2.7557319223985893e-06;
    sp = sp * y2 - 1.984126984126984e-04;
    sp = sp * y2 + 8.333333333333333e-03;
    sp = sp * y2 - 1.6666666666666666e-01;
    const double sy = y + y * y2 * sp;
    double cp = 4.779477332387385e-14;
    cp = cp * y2 - 1.1470745597729725e-11;
    cp = cp * y2 + 2.08767569878681e-09;
    cp = cp * y2 - 2.755731922398589e-07;
    cp = cp * y2 + 2.48015873015873e-05;
    cp = cp * y2 - 1.388888888888889e-03;
    cp = cp * y2 + 4.1666666666666664e-02;
    cp = cp * y2 - 0.5;
    const double cy = 1.0 + y2 * cp;
    const int qi = ((int)(long long)qd) & 3;
    const double s_ = (qi == 0) ? sy : (qi == 1) ? cy : (qi == 2) ? -sy : -cy;
    const double c_ = (qi == 0) ? cy : (qi == 1) ? -sy : (qi == 2) ? -cy : sy;
    co = (float)c_; si = (float)s_;
}
__device__ __forceinline__ void rms_row_to_bf16(const float* xrow, const float* g, unsigned short* orow, int lane) {
    const f32x4* xr = (const f32x4*)xrow + lane; const f32x4* gr = (const f32x4*)g + lane;
    f32x4 v[4]; float s = 0.f;
#pragma unroll
    for (int j = 0; j < 4; ++j) { v[j] = xr[64 * j]; s += (v[j].x * v[j].x + v[j].y * v[j].y) + (v[j].z * v[j].z + v[j].w * v[j].w); }
    const float rs = 1.0f / sqrtf(wave_sum(s) * (1.0f / 1024.0f) + EPSN);
    u32x2* o8 = (u32x2*)orow + lane;
#pragma unroll
    for (int j = 0; j < 4; ++j) { const f32x4 gg = gr[64 * j]; u32x2 w; w.x = cvtpk(v[j].x * rs * gg.x, v[j].y * rs * gg.y); w.y = cvtpk(v[j].z * rs * gg.z, v[j].w * rs * gg.w); o8[64 * j] = w; }
}
__device__ __forceinline__ void prep_stream8(const Fr& F, const float* Wall, unsigned char* WT8all, size_t estride, int mode, int vb, int VG) {
    LAS float* scr = (LAS float*)F.lds;
    const int tid = F.tid, n_ = tid & 63, kk = tid >> 6, k4 = tid & 15, nn = tid >> 4;
    int t = vb; if (t < 0 || t >= 4096) return;
    float v[8];
    { const int e = t >> 8, r = t & 255, k0 = 64 * (r >> 4), n0 = 64 * (r & 15); const float* W = Wall + (size_t)e * 1048576;
#pragma unroll
      for (int i = 0; i < 8; ++i) v[i] = W[(size_t)(k0 + kk + 8 * i) * 1024 + n0 + n_]; }
    for (; t < 4096; t += VG) {
        const int e = t >> 8, r = t & 255, k0 = 64 * (r >> 4), n0 = 64 * (r & 15);
        float vn[8];
        { const int t2 = t + VG < 4096 ? t + VG : t; const int e2 = t2 >> 8, r2 = t2 & 255, k2 = 64 * (r2 >> 4), n2 = 64 * (r2 & 15); const float* W = Wall + (size_t)e2 * 1048576;
#pragma unroll
          for (int i = 0; i < 8; ++i) vn[i] = W[(size_t)(k2 + kk + 8 * i) * 1024 + n2 + n_]; }
#pragma unroll
        for (int i = 0; i < 8; ++i) scr[(kk + 8 * i) * 65 + n_] = v[i];
        __syncthreads();
        unsigned char* WT8 = WT8all + (size_t)e * estride;
#pragma unroll
        for (int i = 0; i < 2; ++i) { const int nl = nn + 32 * i, n = n0 + nl; const int row = mode == 0 ? n : 256 * (n >> 7) + (n & 127) + (mode == 2 ? 128 : 0);
            const float a = scr[(4 * k4 + 0) * 65 + nl] * 32.0f, b = scr[(4 * k4 + 1) * 65 + nl] * 32.0f, c = scr[(4 * k4 + 2) * 65 + nl] * 32.0f, d = scr[(4 * k4 + 3) * 65 + nl] * 32.0f;
            unsigned w = 0u; w = __builtin_amdgcn_cvt_pk_fp8_f32(a, b, w, false); w = __builtin_amdgcn_cvt_pk_fp8_f32(c, d, w, true);
            *(unsigned*)(WT8 + (size_t)row * 1024 + k0 + 4 * k4) = w; }
        __syncthreads();
#pragma unroll
        for (int i = 0; i < 8; ++i) v[i] = vn[i];
    }
}
__device__ __forceinline__ void ph_prep(const Fr& F) {
    const int bid = blockIdx.x, G = F.G;
    for (int it = bid; it < 1024; it += G) {
        if (it < 768) { const int kt = it / 48, nt = it % 48; prep_tile(F, F.w_in, 3072, 64 * kt, 64 * nt, F.WIN, 3); }
        else { const int i2 = it - 768, kt = i2 / 16, nt = i2 % 16; prep_tile(F, F.w_out, 1024, 64 * kt, 64 * nt, F.WOUT, 0); }
    }
    const int gt = bid * 512 + F.tid, GT = G * 512;
    for (int idx = gt; idx < 8 * 256 * 64; idx += GT) {
        const int blk = idx >> 14, o = (idx >> 6) & 255, k = idx & 63, g = o >> 6, d = o & 63, dir = g >> 1;
        const float* src = (g & 1) ? F.w_i : F.w_r;
        F.GW[idx] = f2bf16(src[((size_t)(dir * 8 + blk) * 64 + k) * 64 + d]);
    }
    for (int idx = gt; idx < 8 * 256 * 64; idx += GT) {
        const int k = idx & 63, fr = (idx >> 6) & 15, cg = (idx >> 10) & 3, g = (idx >> 12) & 3, blk = idx >> 14;
        const float* src = (g & 1) ? F.w_i : F.w_r;
        F.GW2[idx] = f2bf16(src[((size_t)((g >> 1) * 8 + blk) * 64 + k) * 64 + 16 * cg + fr]);
    }
    for (int idx = gt; idx < TT * 64; idx += GT) { float co, si; sincos_tab(idx >> 6, idx & 63, co, si); F.CS[idx] = (f32x2){co, si}; }
    const int gw = bid * 8 + F.wave, NGW = G * 8; const int lane = F.lane;
    for (int r = gw; r < NB * PADL; r += NGW) { const int b = r / PADL, p = r - b * PADL; u32x2* o8 = (u32x2*)(F.H + (size_t)(b * PP + p) * 1024) + lane;
#pragma unroll
        for (int j = 0; j < 4; ++j) o8[64 * j] = (u32x2){0u, 0u}; }
    f32x4 gg[4];
#pragma unroll
    for (int j = 0; j < 4; ++j) gg[j] = ((const f32x4*)F.norm1_g + lane)[64 * j];
    f32x4 nx[2][4];
    const int NPAIR = NB * TT / 2;
    if (gw < NPAIR) {
#pragma unroll
        for (int q = 0; q < 2; ++q) { const int v = 2 * gw + q, b = v / TT, t = v - b * TT; const f32x4* xr = (const f32x4*)(t < NMETA ? F.meta + (size_t)t * 1024 : F.x + ((size_t)b * SEQ + (t - NMETA)) * 1024) + lane;
#pragma unroll
            for (int j = 0; j < 4; ++j) nx[q][j] = xr[64 * j]; }
    }
    for (int pr = gw; pr < NPAIR; pr += NGW) {
        f32x4 vv[2][4];
#pragma unroll
        for (int q = 0; q < 2; ++q)
#pragma unroll
            for (int j = 0; j < 4; ++j) vv[q][j] = nx[q][j];
        { const int pn = pr + NGW < NPAIR ? pr + NGW : pr;
#pragma unroll
          for (int q = 0; q < 2; ++q) { const int v = 2 * pn + q, b = v / TT, t = v - b * TT; const f32x4* xr = (const f32x4*)(t < NMETA ? F.meta + (size_t)t * 1024 : F.x + ((size_t)b * SEQ + (t - NMETA)) * 1024) + lane;
#pragma unroll
              for (int j = 0; j < 4; ++j) nx[q][j] = xr[64 * j]; } }
#pragma unroll
        for (int q = 0; q < 2; ++q) {
            const int v = 2 * pr + q, b = v / TT, t = v - b * TT;
            float s = 0.f;
#pragma unroll
            for (int j = 0; j < 4; ++j) s += (vv[q][j].x * vv[q][j].x + vv[q][j].y * vv[q][j].y) + (vv[q][j].z * vv[q][j].z + vv[q][j].w * vv[q][j].w);
            const float rs = __builtin_amdgcn_rsqf(wave_sum(s) * (1.0f / 1024.0f) + EPSN);
            u32x2* o8 = (u32x2*)(F.H + (size_t)(b * PP + PADL + t) * 1024) + lane;
#pragma unroll
            for (int j = 0; j < 4; ++j) { u32x2 wv; wv.x = cvtpk(vv[q][j].x * rs * gg[j].x, vv[q][j].y * rs * gg[j].y); wv.y = cvtpk(vv[q][j].z * rs * gg[j].z, vv[q][j].w * rs * gg[j].w); o8[64 * j] = wv; }
        }
    }
}

struct LruIn { float xv[11]; float gate[8]; float cw0, cw1, cw2, cw3, cbv, k0, k1, br0, bi0, br1, bi1, cf, cb; pg8::bf16x8 bfr[2][2]; };
template <bool FINAL>
__device__ __forceinline__ void lru_load(const Fr& F, size_t rowbase, int pw, int c, size_t sidx, const unsigned short* gwp, LruIn& L) {
#pragma unroll
    for (int i = 0; i < 11; ++i) { const int p = pw - 2 + i; const int pc = p < 0 ? 0 : (p >= PP ? PP - 1 : p); const float v = bf2f(F.Z[(rowbase + pc) * ZC + ZC_LX + c]); L.xv[i] = (p == pc) ? v : 0.f; }
    if (FINAL) {
#pragma unroll
        for (int j = 0; j < 8; ++j) L.gate[j] = bf2f(F.Z[(rowbase + pw + j) * ZC + ZC_LG + c]);
    }
    L.cw0 = F.conv_w[c]; L.cw1 = F.conv_w[512 + c]; L.cw2 = F.conv_w[1024 + c]; L.cw3 = F.conv_w[1536 + c]; L.cbv = F.conv_b[c];
    L.k0 = F.lam[c]; L.k1 = F.lam[512 + c];
    L.br0 = F.b_r[c]; L.bi0 = F.b_i[c]; L.br1 = F.b_r[512 + c]; L.bi1 = F.b_i[512 + c];
    if (FINAL) { L.cf = F.CARRY[sidx]; L.cb = F.CARRY[sidx + 512]; }
#pragma unroll
    for (int ks = 0; ks < 2; ++ks)
#pragma unroll
        for (int n = 0; n < 2; ++n) L.bfr[ks][n] = *(const pg8::bf16x8*)(gwp + (size_t)(16 * n) * 64 + 32 * ks);
}
template <bool FINAL>
__device__ __forceinline__ void lru_item(const Fr& F, int b, int s) {
    int lane = F.lane; asm volatile("" : "+v"(lane));
    const int w = F.wave, fr = lane & 15, fq = lane >> 4;
    LAS unsigned short* U0 = (LAS unsigned short*)F.lds;
    LAS unsigned char* G16 = F.lds + 18432;
    LAS float* SM = (LAS float*)(F.lds + 18432 + 36864);
    LAS unsigned short* YL = (LAS unsigned short*)(F.lds + 18432 + 36864 + 8192);
    const int pw = s * 64 + 8 * w; const size_t rowbase = (size_t)b * PP;
    constexpr float LOG2E = 1.4426950408889634f;
    float ssq[8];
#pragma unroll
    for (int j = 0; j < 8; ++j) ssq[j] = 0.f;
    const size_t sbase = ((size_t)(b * NSEG + s) * 2) * 512;
    const unsigned short* gw0 = F.GW + (size_t)(32 * w + fr) * 64 + 8 * fq;
    LruIn L; lru_load<FINAL>(F, rowbase, pw, lane, sbase + lane, gw0, L);
    float u[8];
#pragma unroll
    for (int j = 0; j < 8; ++j) { u[j] = L.cbv + L.cw0 * L.xv[j] + L.cw1 * L.xv[j + 1] + L.cw2 * L.xv[j + 2] + L.cw3 * L.xv[j + 3]; U0[(8 * w + j) * 72 + lane] = f2bf16(u[j]); }
    __syncthreads();
    for (int blk = 0; blk < 8; ++blk) {
        const int c = blk * 64 + lane;
        LAS unsigned short* U = U0 + (blk & 1) * 4608; LAS unsigned short* Un = U0 + ((blk & 1) ^ 1) * 4608;
        LruIn N; { const int bn = (blk < 7 ? blk + 1 : 7), cn = bn * 64 + lane; lru_load<FINAL>(F, rowbase, pw, cn, sbase + cn, gw0 + (size_t)bn * 16384, N); }
        pg8::f32x4 acc[4][2];
#pragma unroll
        for (int m = 0; m < 4; ++m) { acc[m][0] = (pg8::f32x4){0.f, 0.f, 0.f, 0.f}; acc[m][1] = acc[m][0]; }
#pragma unroll
        for (int ks = 0; ks < 2; ++ks) {
#pragma unroll
            for (int m = 0; m < 4; ++m) { const pg8::bf16x8 a = *(LAS pg8::bf16x8*)(U + (16 * m + fr) * 72 + 32 * ks + 8 * fq);
#pragma unroll
                for (int n = 0; n < 2; ++n) acc[m][n] = MFMA16(a, L.bfr[ks][n], acc[m][n]); }
        }
#pragma unroll
        for (int m = 0; m < 4; ++m)
#pragma unroll
            for (int n = 0; n < 2; ++n) { u32x2 pk; pk.x = __builtin_bit_cast(unsigned, __builtin_amdgcn_cvt_pkrtz(acc[m][n][0], acc[m][n][1])); pk.y = __builtin_bit_cast(unsigned, __builtin_amdgcn_cvt_pkrtz(acc[m][n][2], acc[m][n][3]));
                *(LAS u32x2*)(G16 + (32 * w + 16 * n + fr) * 144 + (16 * m + 4 * fq) * 2) = pk; }
        __syncthreads();
        const float kk0 = -8.0f * LOG2E * softplus_neg(L.k0), kk1 = -8.0f * LOG2E * softplus_neg(L.k1);
        const float nb_r0 = -LOG2E * L.br0, nb_i0 = -LOG2E * L.bi0, nb_r1 = -LOG2E * L.br1, nb_i1 = -LOG2E * L.bi1;
        typedef _Float16 h16x8 __attribute__((ext_vector_type(8)));
        const h16x8 g0 = *(LAS h16x8*)(G16 + (0 * 64 + lane) * 144 + 16 * w), g1 = *(LAS h16x8*)(G16 + (1 * 64 + lane) * 144 + 16 * w);
        const h16x8 g2 = *(LAS h16x8*)(G16 + (2 * 64 + lane) * 144 + 16 * w), g3 = *(LAS h16x8*)(G16 + (3 * 64 + lane) * 144 + 16 * w);
        float hf[8], pf[8], hb[8], pb[8], af[8], ab[8];
#pragma unroll
        for (int j = 0; j < 8; ++j) {
            const float r0 = __builtin_amdgcn_rcpf(1.0f + __builtin_amdgcn_exp2f(__builtin_fmaf((float)g0[j], -LOG2E, nb_r0))), i0 = __builtin_amdgcn_rcpf(1.0f + __builtin_amdgcn_exp2f(__builtin_fmaf((float)g1[j], -LOG2E, nb_i0)));
            const float r1 = __builtin_amdgcn_rcpf(1.0f + __builtin_amdgcn_exp2f(__builtin_fmaf((float)g2[j], -LOG2E, nb_r1))), i1 = __builtin_amdgcn_rcpf(1.0f + __builtin_amdgcn_exp2f(__builtin_fmaf((float)g3[j], -LOG2E, nb_i1)));
            const float a0 = __builtin_amdgcn_exp2f(kk0 * r0), a1 = __builtin_amdgcn_exp2f(kk1 * r1);
            const float e0 = fmaxf(__builtin_fmaf(-a0, a0, 1.0f), 0.f), e1 = fmaxf(__builtin_fmaf(-a1, a1, 1.0f), 0.f);
            af[j] = a0; ab[j] = a1;
            hf[j] = __builtin_amdgcn_sqrtf(e0) * i0 * u[j]; hb[j] = __builtin_amdgcn_sqrtf(e1) * i1 * u[j];
        }
        if (s < 2) {
#pragma unroll
            for (int j = 0; j < 8; ++j) { const bool padp = (pw + j) < PADL; af[j] = padp ? 1.0f : af[j]; ab[j] = padp ? 1.0f : ab[j]; hf[j] = padp ? 0.0f : hf[j]; hb[j] = padp ? 0.0f : hb[j]; }
        }
        { float h = 0.f, P = 1.f;
#pragma unroll
          for (int j = 0; j < 8; ++j) { h = af[j] * h + hf[j]; hf[j] = h; P *= af[j]; pf[j] = P; } }
        { float h = 0.f, P = 1.f;
#pragma unroll
          for (int j = 7; j >= 0; --j) { h = ab[j] * h + hb[j]; hb[j] = h; P *= ab[j]; pb[j] = P; } }
        SM[((0 * 8 + w) * 2 + 0) * 64 + lane] = pf[7]; SM[((0 * 8 + w) * 2 + 1) * 64 + lane] = hf[7];
        SM[((1 * 8 + w) * 2 + 0) * 64 + lane] = pb[0]; SM[((1 * 8 + w) * 2 + 1) * 64 + lane] = hb[0];
        float un[8];
#pragma unroll
        for (int j = 0; j < 8; ++j) { un[j] = N.cbv + N.cw0 * N.xv[j] + N.cw1 * N.xv[j + 1] + N.cw2 * N.xv[j + 2] + N.cw3 * N.xv[j + 3]; Un[(8 * w + j) * 72 + lane] = f2bf16(un[j]); }
        __syncthreads();
        const size_t sidx = sbase + c;
        if (!FINAL) {
            if (w == 0) {
                float cf = 0.f, Af = 1.f, cb = 0.f, Ab = 1.f;
#pragma unroll
                for (int w2 = 0; w2 < 8; ++w2) { const float A = SM[((0 * 8 + w2) * 2 + 0) * 64 + lane], H = SM[((0 * 8 + w2) * 2 + 1) * 64 + lane]; cf = A * cf + H; Af *= A; }
#pragma unroll
                for (int w2 = 7; w2 >= 0; --w2) { const float A = SM[((1 * 8 + w2) * 2 + 0) * 64 + lane], H = SM[((1 * 8 + w2) * 2 + 1) * 64 + lane]; cb = A * cb + H; Ab *= A; }
                F.SUMM[sidx] = (f32x2){Af, cf}; F.SUMM[sidx + 512] = (f32x2){Ab, cb};
            }
        } else {
            float cf = L.cf, cb = L.cb;
            {
                float Af[7], Hf[7], Ab[7], Hb[7];
#pragma unroll
                for (int w2 = 0; w2 < 7; ++w2) { Af[w2] = SM[((0 * 8 + w2) * 2 + 0) * 64 + lane]; Hf[w2] = SM[((0 * 8 + w2) * 2 + 1) * 64 + lane]; Ab[w2] = SM[((1 * 8 + w2 + 1) * 2 + 0) * 64 + lane]; Hb[w2] = SM[((1 * 8 + w2 + 1) * 2 + 1) * 64 + lane]; }
#pragma unroll
                for (int w2 = 0; w2 < 7; ++w2) { const bool on = w2 < w; const float A = on ? Af[w2] : 1.0f, H = on ? Hf[w2] : 0.0f; cf = A * cf + H; }
#pragma unroll
                for (int w2 = 7; w2 >= 1; --w2) { const bool on = w2 > w; const float A = on ? Ab[w2 - 1] : 1.0f, H = on ? Hb[w2 - 1] : 0.0f; cb = A * cb + H; }
            }
#pragma unroll
            for (int j = 0; j < 8; ++j) {
                const float y = ((hf[j] + pf[j] * cf) + (hb[j] + pb[j] * cb)) * gelu_tanh_f(L.gate[j]);
                ssq[j] += y * y; YL[(8 * w + j) * 520 + c] = f2bf16(y);
            }
        }
        L = N;
#pragma unroll
        for (int j = 0; j < 8; ++j) u[j] = un[j];
    }
    if (FINAL) {
        const f32x4 og0 = *(const f32x4*)(F.lru_out_g + 8 * lane), og1 = *(const f32x4*)(F.lru_out_g + 8 * lane + 4);
#pragma unroll
        for (int j = 0; j < 8; ++j) {
            const float rs = __builtin_amdgcn_rsqf(wave_sum(ssq[j]) * (1.0f / 512.0f) + EPSN);
            const u32x4 v = *(LAS u32x4*)(YL + (8 * w + j) * 520 + 8 * lane);
            u32x4 o; o.x = cvtpk(__uint_as_float(v.x << 16) * rs * og0[0], __uint_as_float(v.x & 0xffff0000u) * rs * og0[1]); o.y = cvtpk(__uint_as_float(v.y << 16) * rs * og0[2], __uint_as_float(v.y & 0xffff0000u) * rs * og0[3]);
            o.z = cvtpk(__uint_as_float(v.z << 16) * rs * og1[0], __uint_as_float(v.z & 0xffff0000u) * rs * og1[1]); o.w = cvtpk(__uint_as_float(v.w << 16) * rs * og1[2], __uint_as_float(v.w & 0xffff0000u) * rs * og1[3]);
            *(u32x4*)(F.H + (rowbase + pw + j) * 1024 + 8 * lane) = o;
        }
        __syncthreads();
    }
}

struct Lru2A { float xv[2][11]; float cw[2][5]; };
__device__ __forceinline__ void lru2_loadA(const Fr& F, size_t rowbase, int pw, int it, int lane, Lru2A& A) {
#pragma unroll
    for (int h = 0; h < 2; ++h) { const int c = (2 * it + h) * 64 + lane;
#pragma unroll
        for (int i = 0; i < 11; ++i) { const int p = pw - 2 + i; const int pc = p < 0 ? 0 : (p >= PP ? PP - 1 : p); const float v = bf2f(F.Z[(rowbase + pc) * ZC + ZC_LX + c]); A.xv[h][i] = (p == pc) ? v : 0.f; }
        A.cw[h][0] = F.conv_w[c]; A.cw[h][1] = F.conv_w[512 + c]; A.cw[h][2] = F.conv_w[1024 + c]; A.cw[h][3] = F.conv_w[1536 + c]; A.cw[h][4] = F.conv_b[c]; }
}
__device__ __forceinline__ void lru2_writeU(LAS unsigned short* Upar, int w, int lane, const Lru2A& A) {
#pragma unroll
    for (int h = 0; h < 2; ++h)
#pragma unroll
        for (int j = 0; j < 8; ++j) { const float u = A.cw[h][4] + A.cw[h][0] * A.xv[h][j] + A.cw[h][1] * A.xv[h][j + 1] + A.cw[h][2] * A.xv[h][j + 2] + A.cw[h][3] * A.xv[h][j + 3];
            const int rho = 16 * (2 * (w & 1) + (j >> 2)) + 4 * (w >> 1) + (j & 3);
            Upar[h * 4608 + rho * 72 + lane] = f2bf16(u); }
}
template <bool FINAL>
__device__ __forceinline__ void lru2_item(const Fr& F, int b, int s) {
    int lane = F.lane; asm volatile("" : "+v"(lane));
    const int w = F.wave, fr = lane & 15, fq = lane >> 4, cg = w & 3;
    LAS unsigned short* U0 = (LAS unsigned short*)F.lds;
    LAS unsigned short* YL = (LAS unsigned short*)(F.lds + 36864);
    LAS float* SSP = (LAS float*)(F.lds + 36864 + 66560);
    const int p0 = s * 64, pw = p0 + 8 * w; const size_t rowbase = (size_t)b * PP;
    const size_t sbase = ((size_t)(b * NSEG + s) * 2) * 512;
    constexpr float LOG2E = 1.4426950408889634f;
    float ssq[16];
#pragma unroll
    for (int q = 0; q < 16; ++q) ssq[q] = 0.f;
    { Lru2A A0; lru2_loadA(F, rowbase, pw, 0, lane, A0); lru2_writeU(U0, w, lane, A0); }
    __syncthreads();
    for (int it = 0; it < 4; ++it) {
        const int blk = 2 * it + (w >> 2), c = blk * 64 + 16 * cg + fr;
        LAS unsigned short* U = U0 + ((it & 1) * 2 + (w >> 2)) * 4608;
        pg8::bf16x8 bfr[4][2];
        { const unsigned short* gp = F.GW2 + ((size_t)((blk * 4) * 4 + cg) * 16 + fr) * 64 + 8 * fq;
#pragma unroll
          for (int g = 0; g < 4; ++g)
#pragma unroll
              for (int ks = 0; ks < 2; ++ks) bfr[g][ks] = *(const pg8::bf16x8*)(gp + (size_t)g * 4096 + 32 * ks); }
        const float lam0 = F.lam[c], lam1 = F.lam[512 + c], br0 = F.b_r[c], bi0 = F.b_i[c], br1 = F.b_r[512 + c], bi1 = F.b_i[512 + c];
        float cin0 = 0.f, cin1 = 0.f; if (FINAL) { cin0 = F.CARRY[sbase + c]; cin1 = F.CARRY[sbase + 512 + c]; }
        float gt[16];
        if (FINAL) {
#pragma unroll
            for (int q = 0; q < 16; ++q) gt[q] = bf2f(F.Z[(rowbase + p0 + 16 * fq + q) * ZC + ZC_LG + c]);
        }
        Lru2A N; lru2_loadA(F, rowbase, pw, it < 3 ? it + 1 : 3, lane, N);
        pg8::f32x4 acc[4][4];
#pragma unroll
        for (int g = 0; g < 4; ++g)
#pragma unroll
            for (int m = 0; m < 4; ++m) acc[g][m] = (pg8::f32x4){0.f, 0.f, 0.f, 0.f};
#pragma unroll
        for (int ks = 0; ks < 2; ++ks)
#pragma unroll
            for (int m = 0; m < 4; ++m) {
                const pg8::bf16x8 an = *(LAS pg8::bf16x8*)(U + (16 * m + fr) * 72 + 32 * ks + 8 * fq);
                const pg8::bf16x8 ar = *(LAS pg8::bf16x8*)(U + (63 - 16 * m - fr) * 72 + 32 * ks + 8 * fq);
                acc[0][m] = MFMA16(an, bfr[0][ks], acc[0][m]); acc[1][m] = MFMA16(an, bfr[1][ks], acc[1][m]);
                acc[2][m] = MFMA16(ar, bfr[2][ks], acc[2][m]); acc[3][m] = MFMA16(ar, bfr[3][ks], acc[3][m]);
            }
        float hf[16], hb[16];
#pragma unroll
        for (int d = 0; d < 2; ++d) {
            const float kk = -8.0f * LOG2E * softplus_neg(d ? lam1 : lam0), nbr = -LOG2E * (d ? br1 : br0), nbi = -LOG2E * (d ? bi1 : bi0);
            float al[16], xl[16];
#pragma unroll
            for (int m = 0; m < 4; ++m)
#pragma unroll
                for (int rg = 0; rg < 4; ++rg) { const int q = 4 * m + rg; const int row = d ? 63 - (16 * m + 4 * fq + rg) : (16 * m + 4 * fq + rg);
                    const float uu = bf2f(U[row * 72 + 16 * cg + fr]);
                    const float r = __builtin_amdgcn_rcpf(1.0f + __builtin_amdgcn_exp2f(__builtin_fmaf(acc[2 * d][m][rg], -LOG2E, nbr))), ii = __builtin_amdgcn_rcpf(1.0f + __builtin_amdgcn_exp2f(__builtin_fmaf(acc[2 * d + 1][m][rg], -LOG2E, nbi)));
                    const float a = __builtin_amdgcn_exp2f(kk * r); const float e = fmaxf(__builtin_fmaf(-a, a, 1.0f), 0.f);
                    al[q] = a; xl[q] = __builtin_amdgcn_sqrtf(e) * ii * uu; }
            if (s < 2) {
#pragma unroll
                for (int q = 0; q < 16; ++q) { const int p = d ? p0 + 63 - (16 * fq + q) : p0 + 16 * fq + q; const bool padp = p < PADL; al[q] = padp ? 1.0f : al[q]; xl[q] = padp ? 0.0f : xl[q]; }
            }
            { float h = 0.f, P = 1.f;
#pragma unroll
              for (int q = 0; q < 16; ++q) { h = al[q] * h + xl[q]; xl[q] = h; P *= al[q]; al[q] = P; } }
            const float Ar = al[15], Hr = xl[15];
            const float A0 = __shfl(Ar, fr), H0 = __shfl(Hr, fr), A1 = __shfl(Ar, fr + 16), H1 = __shfl(Hr, fr + 16), A2 = __shfl(Ar, fr + 32), H2 = __shfl(Hr, fr + 32);
            float cc = FINAL ? (d ? cin1 : cin0) : 0.f;
            if (fq > 0) cc = A0 * cc + H0;
            if (fq > 1) cc = A1 * cc + H1;
            if (fq > 2) cc = A2 * cc + H2;
            if (!FINAL) { if (fq == 3) F.SUMM[sbase + d * 512 + c] = (f32x2){A0 * A1 * A2 * Ar, Ar * cc + Hr}; }
            else {
#pragma unroll
                for (int q = 0; q < 16; ++q) { const float hv = xl[q] + al[q] * cc; if (d) hb[q] = hv; else hf[q] = hv; }
            }
        }
        if (FINAL) {
#pragma unroll
            for (int q = 0; q < 16; ++q) { const float hbp = __shfl(hb[15 - q], lane ^ 48);
                const float y = (hf[q] + hbp) * gelu_tanh_f(gt[q]); ssq[q] += y * y; YL[(16 * fq + q) * 520 + c] = f2bf16(y); }
        }
        if (it < 3) { lru2_writeU(U0 + ((it & 1) ^ 1) * 9216, w, lane, N); __syncthreads(); }
    }
    if (FINAL) {
#pragma unroll
        for (int q = 0; q < 16; ++q) { float v = ssq[q]; v += __shfl_xor(v, 1); v += __shfl_xor(v, 2); v += __shfl_xor(v, 4); v += __shfl_xor(v, 8); ssq[q] = v; }
        if (fr == 0) {
#pragma unroll
            for (int q = 0; q < 16; ++q) SSP[w * 64 + 16 * fq + q] = ssq[q]; }
        __syncthreads();
        const f32x4 og0 = *(const f32x4*)(F.lru_out_g + 8 * lane), og1 = *(const f32x4*)(F.lru_out_g + 8 * lane + 4);
#pragma unroll
        for (int j = 0; j < 8; ++j) {
            float tot = 0.f;
#pragma unroll
            for (int w2 = 0; w2 < 8; ++w2) tot += SSP[w2 * 64 + 8 * w + j];
            const float rs = __builtin_amdgcn_rsqf(tot * (1.0f / 512.0f) + EPSN);
            const u32x4 v = *(LAS u32x4*)(YL + (8 * w + j) * 520 + 8 * lane);
            u32x4 o; o.x = cvtpk(__uint_as_float(v.x << 16) * rs * og0[0], __uint_as_float(v.x & 0xffff0000u) * rs * og0[1]); o.y = cvtpk(__uint_as_float(v.y << 16) * rs * og0[2], __uint_as_float(v.y & 0xffff0000u) * rs * og0[3]);
            o.z = cvtpk(__uint_as_float(v.z << 16) * rs * og1[0], __uint_as_float(v.z & 0xffff0000u) * rs * og1[1]); o.w = cvtpk(__uint_as_float(v.w << 16) * rs * og1[2], __uint_as_float(v.w & 0xffff0000u) * rs * og1[3]);
            *(u32x4*)(F.H + (rowbase + pw + j) * 1024 + 8 * lane) = o;
        }
        __syncthreads();
    }
}

#ifdef RF_V3
constexpr int LDS_GT = LDS_MAIN + 8192;
#else
constexpr int LDS_GT = LDS_SS + 1024;
#endif
template <int SKIP> __device__ __forceinline__ int ret_count(int w, int G) { if (G != 256) return (2080 - w + G - 1) / G; return (w < 32 + 16 * SKIP) ? 9 : (w >= 240 ? 8 - SKIP : 8); }
template <int SKIP> __device__ __forceinline__ int ret_item(int w, int j, int G) { if (G != 256 || j < 8) return w + G * j; if (w < 32) return 2048 + w; const int k = w - 32; return 240 + (k & 15) + 256 * (7 - (k >> 4)); }
__device__ __forceinline__ void ret_coord(int it, int& b, int& h, int& n) { n = it % NCHUNK; const int bh = it / NCHUNK; b = bh >> 2; h = bh & 3; }
struct RcIn { u32x4 k[4], v[4]; };
__device__ __forceinline__ void rc_load(const Fr& F, int tid, int it, RcIn& R) {
    int b, h, n; ret_coord(it, b, h, n);
    const unsigned short* base = F.Z + ((size_t)b * PP + 128 * n) * ZC + 128 * h;
#pragma unroll
    for (int q = 0; q < 4; ++q) { const int idx = tid + 512 * q, c = idx >> 4, ch = idx & 15; const unsigned short* p = base + (size_t)c * ZC + 8 * ch; R.k[q] = *(const u32x4*)(p + ZC_K); R.v[q] = *(const u32x4*)(p + ZC_V); }
}
__device__ __forceinline__ unsigned scale_pk(unsigned w, float s) { return cvtpk(__uint_as_float(w << 16) * s, __uint_as_float(w & 0xffff0000u) * s); }
__device__ __forceinline__ void ph_ret_contrib(const Fr& F) {
    const int w = F.wave;
    LAS unsigned char* TKF = F.lds; LAS unsigned char* TKB = F.lds + 32768; LAS unsigned char* TV = F.lds + 65536;
    if ((int)blockIdx.x >= 2080) return;
    const int nj = ret_count<2>(blockIdx.x, F.G);
    RcIn R; rc_load(F, F.tid, ret_item<2>(blockIdx.x, 0, F.G), R);
    for (int jj = 0; jj < nj; ++jj) {
        const int it = ret_item<2>(blockIdx.x, jj, F.G);
        int lane = F.lane, tid = threadIdx.x; asm volatile("" : "+v"(lane), "+v"(tid));
        const int r = lane & 31, h2 = lane >> 5;
        int b, h, n; ret_coord(it, b, h, n); const float lg = log2_gamma(h);
#pragma unroll
        for (int q = 0; q < 4; ++q) { const int idx = tid + 512 * q, c = idx >> 4, ch = idx & 15; const float sf = exp2f(lg * (float)(127 - c)), sb = exp2f(lg * (float)c);
            u32x4 kf, kb; kf.x = scale_pk(R.k[q].x, sf); kf.y = scale_pk(R.k[q].y, sf); kf.z = scale_pk(R.k[q].z, sf); kf.w = scale_pk(R.k[q].w, sf);
            kb.x = scale_pk(R.k[q].x, sb); kb.y = scale_pk(R.k[q].y, sb); kb.z = scale_pk(R.k[q].z, sb); kb.w = scale_pk(R.k[q].w, sb);
            const unsigned o = off_b(c, ch); *(LAS u32x4*)(TKF + o) = kf; *(LAS u32x4*)(TKB + o) = kb; *(LAS u32x4*)(TV + o) = R.v[q]; }
        if (jj + 1 < nj) rc_load(F, tid, ret_item<2>(blockIdx.x, jj + 1, F.G), R);
        __syncthreads();
        const int dir = w >> 2, cb = w & 3; LAS unsigned char* TK = dir ? TKB : TKF;
        f32x16 acc[4];
#pragma unroll
        for (int eb = 0; eb < 4; ++eb)
#pragma unroll
            for (int i = 0; i < 16; ++i) acc[eb][i] = 0.f;
#pragma unroll 2
        for (int ks = 0; ks < 8; ++ks) {
            const pg8::bf16x8 a = trfrag(TK, cb, ks, lane);
#pragma unroll
            for (int eb = 0; eb < 4; ++eb) { const pg8::bf16x8 bv = trfrag(TV, eb, ks, lane); acc[eb] = MFMA32(a, bv, acc[eb]); }
        }
        __syncthreads();
#pragma unroll
        for (int eb = 0; eb < 4; ++eb)
#pragma unroll
            for (int g = 0; g < 4; ++g) { u32x2 v; v.x = cvtpk(acc[eb][4 * g], acc[eb][4 * g + 1]); v.y = cvtpk(acc[eb][4 * g + 2], acc[eb][4 * g + 3]);
                *(LAS u32x2*)(TK + off_b(32 * eb + r, 4 * cb + g) + 8 * h2) = v; }
        __syncthreads();
        unsigned short* dst = F.ST + ((size_t)(((b * 4 + h) * 2) * NCHUNK + n)) * 16384;
#pragma unroll
        for (int q = 0; q < 8; ++q) { const int idx = tid + 512 * q, tile = idx >> 11, rem = idx & 2047, e = rem >> 4, ch = rem & 15;
            const u32x4 v = *(LAS u32x4*)(F.lds + tile * 32768 + off_b(e, ch)); *(u32x4*)(dst + (size_t)tile * NCHUNK * 16384 + (size_t)e * 128 + 8 * ch) = v; }
        __syncthreads();
    }
}
struct RfIn { u32x4 q[4], k[4], v[4]; };
struct RsIn { u32x4 sf[4], sb[4], g[4]; };
__device__ __forceinline__ void rf_load(const Fr& F, int tid, int it, RfIn& R) {
    int b, h, n; ret_coord(it, b, h, n);
    const unsigned short* base = F.Z + ((size_t)b * PP + 128 * n) * ZC + 128 * h;
#pragma unroll
#ifdef RF_V5
    for (int q = 0; q < 4; ++q) { const int idx = tid + 512 * q, c = idx >> 4, ch = idx & 15; const unsigned short* p = base + (size_t)c * ZC + 8 * ch; R.q[q] = *(const u32x4*)(base + (size_t)(c ^ 1) * ZC + 8 * ch + ZC_Q); R.k[q] = *(const u32x4*)(p + ZC_K); R.v[q] = *(const u32x4*)(p + ZC_V); }
#else
    for (int q = 0; q < 4; ++q) { const int idx = tid + 512 * q, c = idx >> 4, ch = idx & 15; const unsigned short* p = base + (size_t)c * ZC + 8 * ch; R.q[q] = *(const u32x4*)(p + ZC_Q); R.k[q] = *(const u32x4*)(p + ZC_K); R.v[q] = *(const u32x4*)(p + ZC_V); }
#endif
}
__device__ __forceinline__ void rs_load(const Fr& F, int tid, int b, int h, int n, RsIn& R) {
    const unsigned short* sf = F.ST2 + ((size_t)(((b * 4 + h) * 2 + 0) * NCHUNK + n)) * 16384; const unsigned short* sb = sf + (size_t)NCHUNK * 16384;
    const unsigned short* gb = F.Z + ((size_t)b * PP + 128 * n) * ZC + ZC_G + 128 * h;
#pragma unroll
    for (int q = 0; q < 4; ++q) { const int idx = tid + 512 * q, c = idx >> 4, ch = idx & 15; R.sf[q] = *(const u32x4*)(sf + (size_t)c * 128 + 8 * ch); R.sb[q] = *(const u32x4*)(sb + (size_t)c * 128 + 8 * ch); R.g[q] = *(const u32x4*)(gb + (size_t)c * ZC + 8 * ch); }
}
#ifdef RF_EXTRA
#define RF_XBAR asm volatile("s_waitcnt vmcnt(0) lgkmcnt(0)" ::: "memory"); __syncthreads();
#else
#define RF_XBAR
#endif
#define RF_FLAG(code_) atomicOr((unsigned*)(F.CTLP + 32768 + 2048), (unsigned)(code_))
#if !defined(RF_GTAB) && !defined(RF_V10) && !defined(RF_V4)
#define RF_GT(d_, c_) exp2f(lg * (float)(d_))
#elif defined(RF_V4)
#define RF_GT(d_, c_) ({ const float g_ = GT[d_]; const float e_ = exp2f(lg * (float)(d_)); if (!(fabsf(g_ - e_) <= 1e-5f * e_)) RF_FLAG(c_); g_; })
#else
#define RF_GT(d_, c_) GT[d_]
#endif
#ifdef RF_V8
#define RF_QF rowfrag_x
#else
#define RF_QF rowfrag
#endif
__device__ __forceinline__ void ph_ret_final(const Fr& F) {
    const int w = F.wave;
    LAS unsigned char* R0 = F.lds; LAS unsigned char* R1 = F.lds + 32768; LAS unsigned char* R2 = F.lds + 65536; LAS unsigned char* R3 = F.lds + 98304;
    LAS float* SS = (LAS float*)(F.lds + LDS_SS); LAS float* GT = (LAS float*)(F.lds + LDS_GT); (void)GT;
    if ((int)blockIdx.x >= 2080) return;
    const int nj = ret_count<1>(blockIdx.x, F.G);
#ifdef RF_V9
    const int cb = 3 - (w >> 1), ebase = 2 * (w & 1);
#else
    const int cb = w >> 1, ebase = 2 * (w & 1);
#endif
#ifndef RF_NOPF
    RfIn Rf; rf_load(F, F.tid, ret_item<1>(blockIdx.x, 0, F.G), Rf);
#endif
    for (int jj = 0; jj < nj; ++jj) {
        const int it = ret_item<1>(blockIdx.x, jj, F.G);
        int lane = F.lane, tid = threadIdx.x; asm volatile("" : "+v"(lane), "+v"(tid));
        const int r = lane & 31, h2 = lane >> 5;
        int b, h, n; ret_coord(it, b, h, n); const float lg = log2_gamma(h);
        const size_t row0 = (size_t)b * PP + 128 * n;
        __syncthreads();
#ifndef RF_NOPF
        RsIn Rs; rs_load(F, tid, b, h, n, Rs);
#else
        RfIn Rf; rf_load(F, tid, it, Rf);
        RsIn Rs; rs_load(F, tid, b, h, n, Rs);
#endif
#pragma unroll
#ifdef RF_V5
        for (int q = 0; q < 4; ++q) { const int idx = tid + 512 * q, c = idx >> 4, ch = idx & 15; const unsigned o = off_b(c, ch); *(LAS u32x4*)(R0 + off_b(c ^ 1, ch)) = Rf.q[q]; *(LAS u32x4*)(R1 + o) = Rf.k[q]; *(LAS u32x4*)(R2 + o) = Rf.v[q]; }
#elif defined(RF_V8)
        for (int q = 0; q < 4; ++q) { const int idx = tid + 512 * q, c = idx >> 4, ch = idx & 15; const unsigned o = off_b(c, ch); *(LAS u32x4*)(R0 + off_b(c ^ 1, ch)) = Rf.q[q]; *(LAS u32x4*)(R1 + o) = Rf.k[q]; *(LAS u32x4*)(R2 + o) = Rf.v[q]; }
#else
        for (int q = 0; q < 4; ++q) { const int idx = tid + 512 * q, c = idx >> 4, ch = idx & 15; const unsigned o = off_b(c, ch); *(LAS u32x4*)(R0 + o) = Rf.q[q]; *(LAS u32x4*)(R1 + o) = Rf.k[q]; *(LAS u32x4*)(R2 + o) = Rf.v[q]; }
#endif
#ifdef RF_V10
        { const int gi = tid & 255; GT[gi] = exp2f(lg * (float)gi); }
#elif defined(RF_GTAB)
        if (tid < 129) GT[tid] = exp2f(lg * (float)tid);
#endif
        const float og0 = F.ret_out_g[128 * h + 32 * ebase + r], og1 = F.ret_out_g[128 * h + 32 * (ebase + 1) + r];
        __syncthreads(); RF_XBAR
        f32x16 o[2];
#pragma unroll
        for (int eo = 0; eo < 2; ++eo)
#pragma unroll
            for (int i = 0; i < 16; ++i) o[eo][i] = 0.f;
        {
            const int cpos = 32 * cb + r;
#pragma unroll
            for (int mb = 0; mb < 4; ++mb) {
                f32x16 X;
#pragma unroll
                for (int i = 0; i < 16; ++i) X[i] = 0.f;
#pragma unroll 2
                for (int s = 0; s < 8; ++s) { const pg8::bf16x8 qf = RF_QF(R0, cb, s, lane); const pg8::bf16x8 kf = rowfrag(R1, mb, s, lane); X = MFMA32(kf, qf, X); }
                int cpo = cpos, h2o = h2; asm volatile("" : "+v"(cpo), "+v"(h2o));
#pragma unroll
                for (int i = 0; i < 16; ++i) { const int m = 32 * mb + crow(i, h2o); const int dd = cpo > m ? cpo - m : m - cpo; X[i] *= RF_GT(dd, 1); }
#pragma unroll
                for (int s2 = 0; s2 < 2; ++s2) { u32x4 pk; pk.x = cvtpk(X[8 * s2], X[8 * s2 + 1]); pk.y = cvtpk(X[8 * s2 + 2], X[8 * s2 + 3]); pk.z = cvtpk(X[8 * s2 + 4], X[8 * s2 + 5]); pk.w = cvtpk(X[8 * s2 + 6], X[8 * s2 + 7]);
                    const pg8::bf16x8 pa = __builtin_bit_cast(pg8::bf16x8, pk);
#pragma unroll
                    for (int eo = 0; eo < 2; ++eo) { const pg8::bf16x8 vb = trfrag_perm(R2, ebase + eo, 32 * mb + 16 * s2, lane); o[eo] = MFMA32(pa, vb, o[eo]); } }
            }
        }
        RF_XBAR __syncthreads(); RF_XBAR
#pragma unroll
        for (int q = 0; q < 4; ++q) { const int idx = tid + 512 * q, c = idx >> 4, ch = idx & 15; const unsigned of = off_b(c, ch); *(LAS u32x4*)(R1 + of) = Rs.sf[q]; *(LAS u32x4*)(R3 + of) = Rs.sb[q]; *(LAS u32x4*)(R2 + of) = Rs.g[q]; }
#ifndef RF_NOPF
        rf_load(F, tid, ret_item<1>(blockIdx.x, jj + 1 < nj ? jj + 1 : jj, F.G), Rf);
#endif
        RF_XBAR __syncthreads(); RF_XBAR
#pragma unroll
        for (int dirn = 0; dirn < 2; ++dirn) {
            LAS unsigned char* TX = dirn ? R3 : R1;
            f32x16 oi[2];
#pragma unroll
            for (int eo = 0; eo < 2; ++eo)
#pragma unroll
                for (int i = 0; i < 16; ++i) oi[eo][i] = 0.f;
#pragma unroll 2
            for (int s = 0; s < 8; ++s) { const pg8::bf16x8 qf = RF_QF(R0, cb, s, lane);
#pragma unroll
                for (int eo = 0; eo < 2; ++eo) { const pg8::bf16x8 f1 = rowfrag(TX, ebase + eo, s, lane); oi[eo] = MFMA32(qf, f1, oi[eo]); } }
            int h2d = h2; asm volatile("" : "+v"(h2d));
#pragma unroll
            for (int i = 0; i < 16; ++i) { const int cl = 32 * cb + crow(i, h2d); const float dfac = RF_GT(dirn ? (128 - cl) : (cl + 1), 2);
#pragma unroll
                for (int eo = 0; eo < 2; ++eo) o[eo][i] += dfac * oi[eo][i]; }
        }
        float ssq[16];
#pragma unroll
        for (int i = 0; i < 16; ++i) {
            float s = o[0][i] * o[0][i] + o[1][i] * o[1][i];
            s += __shfl_xor(s, 1); s += __shfl_xor(s, 2); s += __shfl_xor(s, 4); s += __shfl_xor(s, 8); s += __shfl_xor(s, 16);
            ssq[i] = s; }
        if (r == 0) {
#pragma unroll
            for (int i = 0; i < 16; ++i) SS[(w & 1) * 128 + 32 * cb + crow(i, h2)] = ssq[i]; }
        RF_XBAR __syncthreads(); RF_XBAR
        int h2e = h2, re = r; asm volatile("" : "+v"(h2e), "+v"(re));
#ifdef RF_V1
#pragma unroll
        for (int i = 0; i < 16; ++i) { const int cl = 32 * cb + crow(i, h2e); const float tot = SS[cl] + SS[128 + cl]; const float rs = __builtin_amdgcn_rsqf(tot * (1.0f / 128.0f) + EPSN);
            const size_t row = row0 + cl;
#pragma unroll
            for (int eo = 0; eo < 2; ++eo) { const int e = 32 * (ebase + eo) + re; const float gv = bf2f(F.Z[row * ZC + ZC_G + 128 * h + e]);
                F.H[row * 1024 + 512 + 128 * h + e] = f2bf16(o[eo][i] * rs * (eo ? og1 : og0) * pg8::silu_f(gv)); } }
        RF_XBAR __syncthreads(); RF_XBAR
#else
#pragma unroll
        for (int i = 0; i < 16; ++i) { const int cl = 32 * cb + crow(i, h2e); const float tot = SS[cl] + SS[128 + cl]; const float rs = __builtin_amdgcn_rsqf(tot * (1.0f / 128.0f) + EPSN);
#pragma unroll
            for (int eo = 0; eo < 2; ++eo) { const int e = 32 * (ebase + eo) + re; const unsigned of = off_b(cl, e >> 3) + 2 * (e & 7);
                const float gv = bf2f(*(LAS unsigned short*)(R2 + of));
                *(LAS unsigned short*)(R3 + of) = f2bf16(o[eo][i] * rs * (eo ? og1 : og0) * pg8::silu_f(gv)); } }
        RF_XBAR __syncthreads(); RF_XBAR
#pragma unroll
#ifdef RF_V6
        for (int q = 0; q < 4; ++q) { const int idx = tid + 512 * q, c = (idx >> 4) ^ 1, ch = idx & 15; const u32x4 v = *(LAS u32x4*)(R3 + off_b(c, ch)); *(u32x4*)(F.H + (row0 + c) * 1024 + 512 + 128 * h + 8 * ch) = v; }
#else
        for (int q = 0; q < 4; ++q) { const int idx = tid + 512 * q, c = idx >> 4, ch = idx & 15; const u32x4 v = *(LAS u32x4*)(R3 + off_b(c, ch)); *(u32x4*)(F.H + (row0 + c) * 1024 + 512 + 128 * h + 8 * ch) = v; }
#endif
#endif
#ifdef RF_V11
        if (tid < 129) { const float g_ = GT[tid]; const float e_ = exp2f(lg * (float)tid); if (!(fabsf(g_ - e_) <= 1e-5f * e_)) RF_FLAG(1); }
#endif
    }
    __syncthreads();
}
__device__ __forceinline__ void ret_scan(const Fr& F) {
    for (int v = blockIdx.x * 512 + F.tid; v < 64 * 2048; v += F.G * 512) {
        const int strip = v >> 11, off = v & 2047, dir = strip & 1, h = (strip >> 1) & 3;
        const float cd = exp2f(128.0f * log2_gamma(h));
        const unsigned short* base = F.ST + (size_t)strip * NCHUNK * 16384 + (size_t)off * 8;
        unsigned short* obase = F.ST2 + (size_t)strip * NCHUNK * 16384 + (size_t)off * 8;
        float carry[8];
#pragma unroll
        for (int i = 0; i < 8; ++i) carry[i] = 0.f;
        for (int k0 = 0; k0 < NCHUNK; k0 += 5) {
            u16x8 tv[5];
#pragma unroll
            for (int j = 0; j < 5; ++j) { const int n = dir ? (NCHUNK - 1 - (k0 + j)) : (k0 + j); tv[j] = *(const u16x8*)(base + (size_t)n * 16384); }
#pragma unroll
            for (int j = 0; j < 5; ++j) { const int n = dir ? (NCHUNK - 1 - (k0 + j)) : (k0 + j); u32x4 o;
                o.x = cvtpk(carry[0], carry[1]); o.y = cvtpk(carry[2], carry[3]); o.z = cvtpk(carry[4], carry[5]); o.w = cvtpk(carry[6], carry[7]);
                *(u32x4*)(obase + (size_t)n * 16384) = o;
#pragma unroll
                for (int i = 0; i < 8; ++i) carry[i] = carry[i] * cd + bf2f(tv[j][i]); }
        }
    }
}
__device__ __forceinline__ void lru_carry(const Fr& F) {
    for (int v = blockIdx.x * 32 + F.tid; F.tid < 32 && v < NB * 2 * 512; v += F.G * 32) {
        const int c = v & 511, dir = (v >> 9) & 1, b = v >> 10;
        float carry = 0.f;
        for (int k0 = 0; k0 < NSEG; k0 += 10) {
            f32x2 ah[10];
#pragma unroll
            for (int j = 0; j < 10; ++j) { const int s = dir ? (NSEG - 1 - (k0 + j)) : (k0 + j); ah[j] = F.SUMM[((size_t)(b * NSEG + s) * 2 + dir) * 512 + c]; }
#pragma unroll
            for (int j = 0; j < 10; ++j) { const int s = dir ? (NSEG - 1 - (k0 + j)) : (k0 + j); F.CARRY[((size_t)(b * NSEG + s) * 2 + dir) * 512 + c] = carry; carry = ah[j].x * carry + ah[j].y; }
        }
    }
}
__device__ __forceinline__ void ph_checksum(const Fr& F, const void* buf, size_t bytes, int slot) {
    const unsigned* p = (const unsigned*)buf; const size_t nw = bytes / 4;
    unsigned long long sa = 0ull, sx = 0ull;
    for (size_t i = (size_t)blockIdx.x * 512 + F.tid; i < nw; i += (size_t)F.G * 512) { const unsigned long long v = p[i]; const unsigned long long h = (v + 0x9E3779B97F4A7C15ull + i) * 0xD6E8FEB86659FD93ull; sa += h; sx += (h ^ (h >> 29)) * 0xBF58476D1CE4E5B9ull; }
    unsigned a0 = (unsigned)sa, a1 = (unsigned)(sa >> 32), x0 = (unsigned)sx, x1 = (unsigned)(sx >> 32);
    for (int o = 1; o < 64; o <<= 1) { a0 += __shfl_xor(a0, o); a1 += __shfl_xor(a1, o); x0 += __shfl_xor(x0, o); x1 += __shfl_xor(x1, o); }
    sa = ((unsigned long long)a1 << 32) | a0; sx = ((unsigned long long)x1 << 32) | x0;
    if (F.lane == 0) { unsigned long long* c = (unsigned long long*)(F.CTLP + 32768) + slot * 2; atomicAdd(c, sa); atomicAdd(c + 1, sx); }
}
__device__ __forceinline__ void ph_cpy(const Fr& F) {
    const u32x4* s = (const u32x4*)F.H; u32x4* d = (u32x4*)(F.CTLP + CPY_BASE); const size_t nv = (size_t)NP * 2048 / 16;
    for (size_t i = (size_t)blockIdx.x * 512 + F.tid; i < nv; i += (size_t)F.G * 512) d[i] = s[i];
}
__device__ __forceinline__ void ph_cmp(const Fr& F) {
    const unsigned* a = (const unsigned*)F.H; const unsigned* c = (const unsigned*)(F.CTLP + CPY_BASE); const size_t nw = (size_t)NP * 2048 / 4;
    unsigned* st = (unsigned*)(F.CTLP + 32768 + 4096);
    for (size_t i = (size_t)blockIdx.x * 512 + F.tid; i < nw; i += (size_t)F.G * 512) {
        const unsigned x = a[i], y = c[i];
        if (x != y) { const unsigned idx = (unsigned)i;
            const float x0 = __uint_as_float(x << 16), x1 = __uint_as_float(x & 0xffff0000u), y0 = __uint_as_float(y << 16), y1 = __uint_as_float(y & 0xffff0000u);
            const float d0 = fabsf(x0 - y0), d1 = fabsf(x1 - y1); const float d = fmaxf(d0, d1);
            const float m = (d0 >= d1) ? fmaxf(fabsf(x0), fabsf(y0)) : fmaxf(fabsf(x1), fabsf(y1)); const float rel = d / fmaxf(m, 1e-30f);
            atomicAdd(st + 0, 1u); atomicMax(st + 1, ~idx); atomicMax(st + 2, idx); atomicOr(st + 3, ~idx); atomicOr(st + 4, idx);
            atomicMax(st + 5, __float_as_uint(d)); atomicMax(st + 6, __float_as_uint(rel));
            if (fabsf(y0) > 0.02f && fabsf(y1) > 0.02f) { const float ra = x0 / y0, rb = x1 / y1; atomicMax(st + 9, __float_as_uint(fabsf(ra - rb) / fmaxf(fabsf(ra), fabsf(rb)))); atomicMax(st + 10, __float_as_uint(fabsf(ra))); atomicMax(st + 11, __float_as_uint(1.0f / fmaxf(fabsf(ra), 1e-30f))); atomicAdd(st + 12, 1u); if (fabsf(ra - rb) / fmaxf(fabsf(ra), fabsf(rb)) < 0.03f) atomicAdd(st + 13, 1u); else atomicAdd(st + 14, 1u); }
            { const unsigned row_ = idx >> 9, cw_ = idx & 511u, cid_ = row_ >> 7; const unsigned item_ = (cw_ & 256u) ? ((cid_ / 65u) * 4u + ((cw_ >> 6) & 3u)) * 65u + cid_ % 65u : 2087u;
              atomicOr(st + 16 + (item_ >> 5), 1u << (item_ & 31u)); atomicAdd((unsigned*)(F.CTLP + 40960) + item_, 1u); if (d >= 0.125f) atomicAdd(st + 7, 1u); if (d >= 1.0f) atomicAdd(st + 8, 1u); } }
    }
}
__device__ __forceinline__ const unsigned short* hs_row(const Fr& F, int b, int t) { return F.HSB + (size_t)(b * PP + PADL + t) * 1024; }
__device__ __forceinline__ f32x4 bf4(u32x2 w) { return (f32x4){__uint_as_float(w.x << 16), __uint_as_float(w.x & 0xffff0000u), __uint_as_float(w.y << 16), __uint_as_float(w.y & 0xffff0000u)}; }
__device__ __forceinline__ float router_softmax(float (&pl)[16], int lane) {
    { const bool hi = lane & 32;
#pragma unroll
      for (int i = 0; i < 8; ++i) { const float send = hi ? pl[i] : pl[i + 8], keep = hi ? pl[i + 8] : pl[i]; pl[i] = keep + __shfl_xor(send, 32); } }
    { const bool hi = lane & 16;
#pragma unroll
      for (int i = 0; i < 4; ++i) { const float send = hi ? pl[i] : pl[i + 4], keep = hi ? pl[i + 4] : pl[i]; pl[i] = keep + __shfl_xor(send, 16); } }
    { const bool hi = lane & 8;
#pragma unroll
      for (int i = 0; i < 2; ++i) { const float send = hi ? pl[i] : pl[i + 2], keep = hi ? pl[i + 2] : pl[i]; pl[i] = keep + __shfl_xor(send, 8); } }
    { const bool hi = lane & 4; const float send = hi ? pl[0] : pl[1], keep = hi ? pl[1] : pl[0]; pl[0] = keep + __shfl_xor(send, 4); }
    float lg = pl[0]; lg += __shfl_xor(lg, 1); lg += __shfl_xor(lg, 2);
    float mx = lg;
    mx = fmaxf(mx, __shfl_xor(mx, 4)); mx = fmaxf(mx, __shfl_xor(mx, 8)); mx = fmaxf(mx, __shfl_xor(mx, 16)); mx = fmaxf(mx, __shfl_xor(mx, 32));
    const float ex = expf(lg - mx); float sm = ex;
    sm += __shfl_xor(sm, 4); sm += __shfl_xor(sm, 8); sm += __shfl_xor(sm, 16); sm += __shfl_xor(sm, 32);
    return ex / sm;
}
__device__ __forceinline__ void ph_router(const Fr& F) {
    LAS float* WR = (LAS float*)F.lds;
    for (int i = F.tid; i < 16384; i += 512) { const int d = i >> 4, e = i & 15; WR[e * 1024 + d] = F.w_router[i]; }
    __syncthreads();
    const int lane = F.lane;
    if (blockIdx.x == 0 && F.tid < 256) ((unsigned*)F.XS)[F.tid] = 0u;
    const int NV = NB * TT, NPAIR = NV / 2;
    const int gw = blockIdx.x * 8 + F.wave, NGW = F.G * 8;
    u32x2 nx[2][4];
    if (gw < NPAIR) {
#pragma unroll
        for (int q = 0; q < 2; ++q) { const int v = 2 * gw + q, b = v / TT, t = v - b * TT; const u32x2* xr = (const u32x2*)hs_row(F, b, t) + lane;
#pragma unroll
            for (int j = 0; j < 4; ++j) nx[q][j] = xr[64 * j]; }
    }
    f32x4 gg[4];
#pragma unroll
    for (int j = 0; j < 4; ++j) gg[j] = ((const f32x4*)F.norm2_g + lane)[64 * j];
    for (int pr = gw; pr < NPAIR; pr += NGW) {
        f32x4 vv[2][4];
#pragma unroll
        for (int q = 0; q < 2; ++q)
#pragma unroll
            for (int j = 0; j < 4; ++j) vv[q][j] = bf4(nx[q][j]);
        { const int pn = pr + NGW < NPAIR ? pr + NGW : pr;
#pragma unroll
          for (int q = 0; q < 2; ++q) { const int v = 2 * pn + q, b = v / TT, t = v - b * TT; const u32x2* xr = (const u32x2*)hs_row(F, b, t) + lane;
#pragma unroll
              for (int j = 0; j < 4; ++j) nx[q][j] = xr[64 * j]; } }
        int bq[2], tq[2];
#pragma unroll
        for (int q = 0; q < 2; ++q) {
            const int v = 2 * pr + q; bq[q] = v / TT; tq[q] = v - bq[q] * TT;
            float s = 0.f;
#pragma unroll
            for (int j = 0; j < 4; ++j) s += (vv[q][j].x * vv[q][j].x + vv[q][j].y * vv[q][j].y) + (vv[q][j].z * vv[q][j].z + vv[q][j].w * vv[q][j].w);
            const float rs = __builtin_amdgcn_rsqf(wave_sum(s) * (1.0f / 1024.0f) + EPSN);
            unsigned* o8 = (unsigned*)((unsigned char*)F.XS + (size_t)(bq[q] * PP + PADL + tq[q]) * 1024) + lane;
#pragma unroll
            for (int j = 0; j < 4; ++j) { vv[q][j].x *= rs * gg[j].x; vv[q][j].y *= rs * gg[j].y; vv[q][j].z *= rs * gg[j].z; vv[q][j].w *= rs * gg[j].w;
                unsigned wv = 0u; wv = __builtin_amdgcn_cvt_pk_fp8_f32(vv[q][j].x, vv[q][j].y, wv, false); wv = __builtin_amdgcn_cvt_pk_fp8_f32(vv[q][j].z, vv[q][j].w, wv, true); o8[64 * j] = wv; }
        }
        float pl0[16], pl1[16];
#pragma unroll
        for (int e = 0; e < 16; ++e) { f32x2 a0 = {0.f, 0.f}, a1 = {0.f, 0.f};
#pragma unroll
            for (int j = 0; j < 4; ++j) { const f32x4 wv = *(LAS f32x4*)(WR + e * 1024 + 256 * j + 4 * lane);
                const f32x2 wlo = __builtin_shufflevector(wv, wv, 0, 1), whi = __builtin_shufflevector(wv, wv, 2, 3);
                a0 = __builtin_elementwise_fma(__builtin_shufflevector(vv[0][j], vv[0][j], 0, 1), wlo, a0); a0 = __builtin_elementwise_fma(__builtin_shufflevector(vv[0][j], vv[0][j], 2, 3), whi, a0);
                a1 = __builtin_elementwise_fma(__builtin_shufflevector(vv[1][j], vv[1][j], 0, 1), wlo, a1); a1 = __builtin_elementwise_fma(__builtin_shufflevector(vv[1][j], vv[1][j], 2, 3), whi, a1); }
            pl0[e] = a0.x + a0.y; pl1[e] = a1.x + a1.y; if ((e & 3) == 3) asm volatile("" ::: "memory"); }
        const float p0 = router_softmax(pl0, lane), p1 = router_softmax(pl1, lane);
        const int e = ((lane >> 5) & 1) * 8 + ((lane >> 4) & 1) * 4 + ((lane >> 3) & 1) * 2 + ((lane >> 2) & 1);
        if ((lane & 3) == 0) { F.AFF[(size_t)(bq[0] * NE + e) * TT + tq[0]] = p0; F.AFF[(size_t)(bq[1] * NE + e) * TT + tq[1]] = p1; }
    }
    __syncthreads();
}

__device__ __forceinline__ void topk_item(const Fr& F, int b, int e) {
    LAS unsigned* vals = (LAS unsigned*)F.lds;
    LAS unsigned* hist = vals + 8256;
    LAS unsigned* misc = hist + 256;
    LAS unsigned* wsum = misc + 16;
    const int tid = F.tid, lane = F.lane, w = F.wave;
    const float* aff = F.AFF + (size_t)(b * NE + e) * TT;
    for (int t = tid; t < TT; t += 512) vals[t] = __float_as_uint(aff[t]);
    unsigned prefix = 0u, mask = 0u, k = CAP;
    for (int pass = 0; pass < 4; ++pass) {
        const int shift = 24 - 8 * pass;
        if (tid < 256) hist[tid] = 0u;
        __syncthreads();
        for (int t = tid; t < TT; t += 512) { const unsigned v = vals[t]; if ((v & mask) == prefix) __hip_atomic_fetch_add(&hist[(v >> shift) & 255u], 1u, __ATOMIC_RELAXED, __HIP_MEMORY_SCOPE_WORKGROUP); }
        __syncthreads();
        if (w == 0) {
            unsigned c[4]; unsigned s = 0u;
#pragma unroll
            for (int i = 0; i < 4; ++i) { c[i] = hist[255 - (4 * lane + i)]; s += c[i]; }
            unsigned incl = s;
#pragma unroll
            for (int o = 1; o < 64; o <<= 1) { const unsigned y = __shfl_up(incl, o); if (lane >= o) incl += y; }
            unsigned cum = incl - s;
#pragma unroll
            for (int i = 0; i < 4; ++i) { if (cum < k && cum + c[i] >= k) { misc[0] = prefix | ((unsigned)(255 - (4 * lane + i)) << shift); misc[1] = k - cum; } cum += c[i]; }
        }
        __syncthreads();
        prefix = misc[0]; k = misc[1]; mask |= 0xFFu << shift;
        __syncthreads();
    }
    const unsigned thr = prefix, keq = k;
    const int t0 = tid * 17;
    unsigned loc = 0u;
#pragma unroll
    for (int i = 0; i < 17; ++i) { const int t = t0 + i; if (t < TT) { const unsigned v = vals[t]; loc += (v > thr ? 1u : 0u) + (v == thr ? 65536u : 0u); } }
    unsigned incl = loc;
#pragma unroll
    for (int o = 1; o < 64; o <<= 1) { const unsigned y = __shfl_up(incl, o); if (lane >= o) incl += y; }
    if (lane == 63) wsum[w] = incl;
    __syncthreads();
    unsigned before = incl - loc;
#pragma unroll
    for (int w2 = 0; w2 < 8; ++w2) if (w2 < w) before += wsum[w2];
    unsigned gtb = before & 0xFFFFu, eqb = before >> 16;
    for (int i = 0; i < 17; ++i) { const int t = t0 + i; if (t < TT) {
        const unsigned v = vals[t]; const bool gt = v > thr, eq = v == thr; const bool sel = gt || (eq && eqb < keq);
        const int rrow = b * PP + PADL + t;
        int mrow = -1;
        if (sel) { const unsigned slot = gtb + (eqb < keq ? eqb : keq); mrow = e * EROWS + b * CAP + (int)slot; F.IDX[mrow] = rrow * 1024; F.GATE[mrow] = __uint_as_float(v); }
        F.ROWMAP[(size_t)rrow * NE + e] = mrow;
        gtb += gt ? 1u : 0u; eqb += eq ? 1u : 0u; } }
    if (b == 0) for (int i = tid; i < EROWS - NB * CAP; i += 512) { F.IDX[e * EROWS + NB * CAP + i] = 0; F.GATE[e * EROWS + NB * CAP + i] = 0.f; }
    __syncthreads();
}

__device__ __forceinline__ void ph_gather(const Fr& F) {
    for (int v = blockIdx.x * 8 + F.wave; v < NROWS; v += F.G * 8) {
        const int src = F.IDX[v];
        u32x4* dst = (u32x4*)(F.XS + (size_t)v * 1024) + F.lane;
        if (src >= 0) { const u32x4* sp = (const u32x4*)(F.H + (size_t)src * 1024) + F.lane; dst[0] = sp[0]; dst[64] = sp[64]; }
        else { dst[0] = (u32x4){0u, 0u, 0u, 0u}; dst[64] = (u32x4){0u, 0u, 0u, 0u}; }
    }
}
__device__ __forceinline__ void ph_combine(const Fr& F) {
    const int lane = F.lane;
#ifdef DET_PROBE
    float badv = 0.f; { const unsigned long long* c = (const unsigned long long*)(F.CTLP + 32768); float mag = 1e4f;
      for (int k = DET_PROBE - 1; k >= 0; --k) { const bool bk = (__hip_atomic_load(c + 4 * k, __ATOMIC_RELAXED, __HIP_MEMORY_SCOPE_AGENT) != __hip_atomic_load(c + 4 * k + 2, __ATOMIC_RELAXED, __HIP_MEMORY_SCOPE_AGENT)) || (__hip_atomic_load(c + 4 * k + 1, __ATOMIC_RELAXED, __HIP_MEMORY_SCOPE_AGENT) != __hip_atomic_load(c + 4 * k + 3, __ATOMIC_RELAXED, __HIP_MEMORY_SCOPE_AGENT)); if (bk) { float mm = 1e4f; for (int e_ = 0; e_ < k; ++e_) mm *= 10.0f; badv = mm; } } (void)mag; }
    { const unsigned fl_ = __hip_atomic_load((const unsigned*)(F.CTLP + 32768 + 2048), __ATOMIC_RELAXED, __HIP_MEMORY_SCOPE_AGENT); if (fl_) badv = 1e5f * (float)fl_; }
#ifdef STAT_SEL
    { const unsigned* st = (const unsigned*)(F.CTLP + 32768 + 4096);
      const unsigned cnt = __hip_atomic_load(st + 0, __ATOMIC_RELAXED, __HIP_MEMORY_SCOPE_AGENT), nmin = ~__hip_atomic_load(st + 1, __ATOMIC_RELAXED, __HIP_MEMORY_SCOPE_AGENT), nand = ~__hip_atomic_load(st + 3, __ATOMIC_RELAXED, __HIP_MEMORY_SCOPE_AGENT),
                     vor = __hip_atomic_load(st + 4, __ATOMIC_RELAXED, __HIP_MEMORY_SCOPE_AGENT), mabs = __hip_atomic_load(st + 5, __ATOMIC_RELAXED, __HIP_MEMORY_SCOPE_AGENT), mrel = __hip_atomic_load(st + 6, __ATOMIC_RELAXED, __HIP_MEMORY_SCOPE_AGENT);
      if (cnt) { const unsigned vary = vor & ~nand; unsigned k = 0; const unsigned row = nmin >> 9, cw = nmin & 511u, chunkid = row >> 7;
        if (STAT_SEL == 0) { unsigned L = 32u - (unsigned)__builtin_clz(cnt); if (L > 15u) L = 15u; k = L + ((vary & 63u) ? 16u : 0u) + ((vary & 448u) ? 32u : 0u) + ((vary & 0xFE00u) ? 64u : 0u) + ((vary >> 16) ? 128u : 0u); }
        if (STAT_SEL == 1) k = row & 127u;
        if (STAT_SEL == 2) k = cw >> 1;
        if (STAT_SEL == 3) k = chunkid % 65u;
        if (STAT_SEL == 4) k = mabs >> 23;
        if (STAT_SEL == 5) k = mrel >> 23;
        if (STAT_SEL == 6) k = (chunkid / 65u) * 4u + ((cw >> 6) & 3u) + ((cw & 256u) ? 0u : 64u);
        if (STAT_SEL == 7) k = cnt < 255u ? cnt : 255u;
        if (STAT_SEL == 8) { const unsigned e5 = mrel >> 23; const unsigned bk = e5 < 113u ? 0u : (e5 > 127u ? 7u : (e5 - 113u) / 2u); k = (32u - (unsigned)__builtin_clz(cnt)) + 32u * bk; }
        if (STAT_SEL >= 10) { unsigned nit = 0, first = 0xffffu, last = 0;
          for (unsigned wd = 0; wd < 66u; ++wd) { const unsigned bm = __hip_atomic_load(st + 16 + wd, __ATOMIC_RELAXED, __HIP_MEMORY_SCOPE_AGENT); nit += (unsigned)__builtin_popcount(bm);
            if (bm) { const unsigned lo = wd * 32u + (unsigned)__builtin_ctz(bm), hi = wd * 32u + 31u - (unsigned)__builtin_clz(bm); if (first == 0xffffu) first = lo; last = hi; } }
          const unsigned cfirst = __hip_atomic_load((const unsigned*)(F.CTLP + 40960) + (first < 2088u ? first : 0u), __ATOMIC_RELAXED, __HIP_MEMORY_SCOPE_AGENT);
          if (STAT_SEL == 10) k = nit < 255u ? nit : 255u;
          if (STAT_SEL == 15) { const unsigned per = cnt / (nit ? nit : 1u); k = (32u - (unsigned)__builtin_clz(nit | 1u)) + 16u * (32u - (unsigned)__builtin_clz(per | 1u)); }
          if (STAT_SEL == 16 || STAT_SEL == 17) { unsigned bor = 0u, band = 0xffu;
            for (unsigned wd = 0; wd < 66u; ++wd) { unsigned bm = __hip_atomic_load(st + 16 + wd, __ATOMIC_RELAXED, __HIP_MEMORY_SCOPE_AGENT); while (bm) { const unsigned id_ = wd * 32u + (unsigned)__builtin_ctz(bm); bm &= bm - 1u; bor |= (id_ & 255u); band &= (id_ & 255u); } }
            k = (STAT_SEL == 16) ? (unsigned)__builtin_popcount(bor & ~band) : band; }
          if (STAT_SEL == 18 || STAT_SEL == 19) { unsigned jor = 0u, jand = 0xfu, nor_ = 0u, nand_ = 0x7fu;
            for (unsigned wd = 0; wd < 66u; ++wd) { unsigned bm = __hip_atomic_load(st + 16 + wd, __ATOMIC_RELAXED, __HIP_MEMORY_SCOPE_AGENT); while (bm) { const unsigned id_ = wd * 32u + (unsigned)__builtin_ctz(bm); bm &= bm - 1u; jor |= (id_ >> 8); jand &= (id_ >> 8); nor_ |= (id_ % 65u); nand_ &= (id_ % 65u); } }
            k = (STAT_SEL == 18) ? (jor | (jand << 4)) : (nor_ & 127u) + ((nand_ & 127u) ? 128u : 0u); }
          if (STAT_SEL == 20) { const unsigned per = cnt / (nit ? nit : 1u); k = (per >= 6000u) ? 3u : (per >= 2000u) ? 2u : (per >= 256u) ? 1u : 0u; k += 4u * ((nit >= 64u) ? 3u : (nit >= 16u) ? 2u : (nit >= 4u) ? 1u : 0u); }
          if (STAT_SEL == 21) k = vary & 255u;
          if (STAT_SEL == 22) k = (vary >> 9) & 127u;
          if (STAT_SEL == 23) k = (nand >> 9) & 127u;
          if (STAT_SEL == 24) { const float incons = __uint_as_float(__hip_atomic_load(st + 9, __ATOMIC_RELAXED, __HIP_MEMORY_SCOPE_AGENT)); const float rmax = __uint_as_float(__hip_atomic_load(st + 10, __ATOMIC_RELAXED, __HIP_MEMORY_SCOPE_AGENT)), rinv = __uint_as_float(__hip_atomic_load(st + 11, __ATOMIC_RELAXED, __HIP_MEMORY_SCOPE_AGENT));
            k = (incons < 0.03f ? 1u : incons < 0.3f ? 2u : 3u) + 4u * (rmax < 1.05f ? 0u : rmax < 1.5f ? 1u : rmax < 3.0f ? 2u : 3u) + 16u * (rinv < 1.05f ? 0u : rinv < 1.5f ? 1u : rinv < 3.0f ? 2u : 3u); }
          if (STAT_SEL == 25) { const unsigned c13 = __hip_atomic_load(st + 13, __ATOMIC_RELAXED, __HIP_MEMORY_SCOPE_AGENT), c14 = __hip_atomic_load(st + 14, __ATOMIC_RELAXED, __HIP_MEMORY_SCOPE_AGENT); const float fr = (float)c14 / (float)(c13 + c14 + 1u);
            k = (c14 == 0u) ? 0u : fr < 0.01f ? 1u : fr < 0.1f ? 2u : fr < 0.5f ? 3u : fr < 0.9f ? 4u : (c13 != 0u) ? 5u : 6u; }
          if (STAT_SEL == 99) k = 0u;
          if (STAT_SEL == 11) k = (first >> 8) + 16u * (last >> 8);
          if (STAT_SEL == 12) k = first & 255u;
          if (STAT_SEL == 13) k = cfirst / 64u;
          if (STAT_SEL == 14) { const unsigned c7 = __hip_atomic_load(st + 7, __ATOMIC_RELAXED, __HIP_MEMORY_SCOPE_AGENT), c8 = __hip_atomic_load(st + 8, __ATOMIC_RELAXED, __HIP_MEMORY_SCOPE_AGENT); unsigned l8 = c8 ? 32u - (unsigned)__builtin_clz(c8) : 0u; if (l8 > 7u) l8 = 7u; k = (c7 ? 32u - (unsigned)__builtin_clz(c7) : 0u) + 32u * l8; } }
        float mm = 1e4f; for (unsigned e_ = 0; e_ < k; ++e_) mm *= 1.140175f; badv = mm; } }
#endif
    { const unsigned fl2_ = __hip_atomic_load((const unsigned*)(F.CTLP + 32768 + 2048), __ATOMIC_RELAXED, __HIP_MEMORY_SCOPE_AGENT); if (fl2_) badv = 1e7f * (float)fl2_; }
    const bool bad = badv != 0.f;
#endif
    const int gw = blockIdx.x * 8 + F.wave, NGW = F.G * 8, NPAIR = NB * SEQ / 2;
    f32x4 gg[4];
#pragma unroll
    for (int j = 0; j < 4; ++j) gg[j] = ((const f32x4*)F.final_g + lane)[64 * j];
    u32x2 nx[2][4]; int nm[2];
    if (gw < NPAIR) {
#pragma unroll
        for (int q = 0; q < 2; ++q) { const int v = 2 * gw + q, b = v / SEQ, tq = v - b * SEQ; const u32x2* xr = (const u32x2*)(F.HSB + (size_t)(b * PP + PADL + NMETA + tq) * 1024) + lane;
#pragma unroll
            for (int j = 0; j < 4; ++j) nx[q][j] = xr[64 * j];
            nm[q] = F.ROWMAP[(size_t)(b * PP + PADL + NMETA + tq) * NE + (lane & 15)]; }
    }
    for (int pr = gw; pr < NPAIR; pr += NGW) {
        f32x4 vv[2][4]; int mine[2];
#pragma unroll
        for (int q = 0; q < 2; ++q) { mine[q] = nm[q];
#pragma unroll
            for (int j = 0; j < 4; ++j) vv[q][j] = bf4(nx[q][j]); }
        { unsigned bal[2];
#pragma unroll
          for (int q = 0; q < 2; ++q) bal[q] = (unsigned)__ballot(mine[q] >= 0) & 0xFFFFu;
          while (bal[0] | bal[1]) {
              const int dummy = bal[0] ? __builtin_amdgcn_readlane(mine[0], __builtin_ctz(bal[0])) : __builtin_amdgcn_readlane(mine[1], __builtin_ctz(bal[1]));
              int ms[2][4]; float sc[2][4];
#pragma unroll
              for (int q = 0; q < 2; ++q)
#pragma unroll
                  for (int sl = 0; sl < 4; ++sl) { if (bal[q]) { const int e = __builtin_ctz(bal[q]); bal[q] &= bal[q] - 1u; ms[q][sl] = __builtin_amdgcn_readlane(mine[q], e); sc[q][sl] = 0.125f; } else { ms[q][sl] = dummy; sc[q][sl] = 0.f; } }
              unsigned y[2][4][4];
#pragma unroll
              for (int q = 0; q < 2; ++q)
#pragma unroll
                  for (int sl = 0; sl < 4; ++sl) { const unsigned* yr = (const unsigned*)((const unsigned char*)F.YS + (size_t)ms[q][sl] * 1024) + lane;
#pragma unroll
                      for (int j = 0; j < 4; ++j) y[q][sl][j] = yr[64 * j]; }
#pragma unroll
              for (int q = 0; q < 2; ++q)
#pragma unroll
                  for (int sl = 0; sl < 4; ++sl)
#pragma unroll
                      for (int j = 0; j < 4; ++j) { const unsigned yy = y[q][sl][j]; const float w8 = sc[q][sl]; vv[q][j].x += w8 * __builtin_amdgcn_cvt_f32_fp8(yy, 0); vv[q][j].y += w8 * __builtin_amdgcn_cvt_f32_fp8(yy, 1);
                          vv[q][j].z += w8 * __builtin_amdgcn_cvt_f32_fp8(yy, 2); vv[q][j].w += w8 * __builtin_amdgcn_cvt_f32_fp8(yy, 3); }
          } }
        { const int pn = pr + NGW < NPAIR ? pr + NGW : pr;
#pragma unroll
          for (int q = 0; q < 2; ++q) { const int v = 2 * pn + q, b = v / SEQ, tq = v - b * SEQ; const u32x2* xr = (const u32x2*)(F.HSB + (size_t)(b * PP + PADL + NMETA + tq) * 1024) + lane;
#pragma unroll
              for (int j = 0; j < 4; ++j) nx[q][j] = xr[64 * j];
              nm[q] = F.ROWMAP[(size_t)(b * PP + PADL + NMETA + tq) * NE + (lane & 15)]; } }
#pragma unroll
        for (int q = 0; q < 2; ++q) {
            float s = 0.f;
#pragma unroll
            for (int j = 0; j < 4; ++j) s += (vv[q][j].x * vv[q][j].x + vv[q][j].y * vv[q][j].y) + (vv[q][j].z * vv[q][j].z + vv[q][j].w * vv[q][j].w);
            const float rs = __builtin_amdgcn_rsqf(wave_sum(s) * (1.0f / 1024.0f) + EPSN);
            f32x4* xr = (f32x4*)(F.out + (size_t)(2 * pr + q) * 1024) + lane;
#pragma unroll
            for (int j = 0; j < 4; ++j) { f32x4 o; o.x = vv[q][j].x * rs * gg[j].x; o.y = vv[q][j].y * rs * gg[j].y; o.z = vv[q][j].z * rs * gg[j].z; o.w = vv[q][j].w * rs * gg[j].w;
#ifdef DET_PROBE
                if (bad && pr == 0 && q == 0 && j == 0 && lane == 0) o.x = badv;
#endif
                xr[64 * j] = o; }
        }
    }
}

struct Args { const float* in[20]; float* out; unsigned char* ws; int ph_lo, ph_hi; };
__global__ void __launch_bounds__(512, 2) mk_fwd(Args args) {
    extern __shared__ __attribute__((aligned(16))) unsigned char lds_raw[];
    Fr F;
    F.lds = (LAS unsigned char*)lds_raw;
    F.tid = threadIdx.x; F.lane = F.tid & 63; F.wave = __builtin_amdgcn_readfirstlane(F.tid >> 6); F.G = gridDim.x;
    unsigned char* ws = args.ws;
    F.x = args.in[0]; F.meta = args.in[1]; F.norm1_g = args.in[2]; F.w_in = args.in[3]; F.conv_w = args.in[4]; F.conv_b = args.in[5]; F.w_r = args.in[6]; F.b_r = args.in[7];
    F.w_i = args.in[8]; F.b_i = args.in[9]; F.lam = args.in[10]; F.lru_out_g = args.in[11]; F.ret_out_g = args.in[12]; F.w_out = args.in[13]; F.norm2_g = args.in[14];
    F.w_router = args.in[15]; F.w_gate = args.in[16]; F.w_up = args.in[17]; F.w_down = args.in[18]; F.final_g = args.in[19]; F.out = args.out;
    F.CTLP = ws + WS_CTL; F.GW2 = (unsigned short*)(ws + WS_GW2); F.GW = (unsigned short*)(ws + WS_GW); F.WIN = (unsigned short*)(ws + WS_WIN); F.WOUT = (unsigned short*)(ws + WS_WOUT); F.WGU = (unsigned short*)(ws + WS_WGU); F.WD = (unsigned short*)(ws + WS_WD);
    F.H = (unsigned short*)(ws + WS_H); F.Z = (unsigned short*)(ws + WS_Z); F.ST = (unsigned short*)(ws + WS_ST); F.XS = (unsigned short*)(ws + WS_XS); F.ACT = (unsigned short*)(ws + WS_ACT); F.YS = (unsigned short*)(ws + WS_YS);
    F.HSB = (unsigned short*)(ws + WS_HSB); F.ST2 = (unsigned short*)(ws + ST2_BASE); F.HSMETA = (float*)(ws + WS_HSMETA); F.AFF = (float*)(ws + WS_AFF); F.GATE = (float*)(ws + WS_GATE); F.CARRY = (float*)(ws + WS_CARRY); F.CS = (f32x2*)(ws + WS_CS); F.SUMM = (f32x2*)(ws + WS_SUMM);
    F.ROWMAP = (int*)(ws + WS_ROWMAP); F.IDX = (int*)(ws + WS_IDX);
    volatile LAS unsigned* MISC = (volatile LAS unsigned*)(F.lds + LDS_MISC);
    if (F.tid < 64) MISC[F.tid] = 0u;
    __syncthreads();
#ifdef START_DELAY
    { const unsigned long long t0_ = __builtin_amdgcn_s_memrealtime(); while (__builtin_amdgcn_s_memrealtime() - t0_ < START_DELAY) __builtin_amdgcn_s_sleep(16); }
#endif
    XcdBarrier bar = xcd_barrier_post((unsigned*)(ws + WS_CTL) + CW_BAR, MISC + 8);
    const int bid = blockIdx.x, G = F.G;
#define SEAM xcd_barrier(bar);
#define P0 ph_prep(F);
#define P1 { pg8::Gemm g{F.H, F.WIN, NP, ZC, DM}; pg8::StaticOrder S; S.init(NP, ZC, G, bid); pg8::EpiZ E{F.Z, (const float*)F.CS}; \
        pg8::gemm_phase<pg8::EpiZ, pg8::StaticOrder, true, true>(F.lds, g, S, E); \
          \
        if (G == 256) prep_stream8(F, F.w_gate, (unsigned char*)F.WGU, 2097152, 1, bid - 48, G - 48); else prep_stream8(F, F.w_gate, (unsigned char*)F.WGU, 2097152, 1, bid, G); }
#define P2 { P2R P2L }
#ifdef LDS_POISON
#if LDS_POISON == 1
#define LPOI { for (int i_ = F.tid; i_ < LDS_MISC / 4; i_ += 512) ((LAS unsigned*)F.lds)[i_] = 0x7fc07fc0u; __syncthreads(); }
#else
#define LPOI { __syncthreads(); }
#endif
#else
#define LPOI
#endif
#define P2R { LPOI ph_ret_contrib(F); }
#ifndef LRU_NEW2
#define LRU_NEW2 1
#endif
#ifndef LRU_NEW4
#define LRU_NEW4 1
#endif
#define P2L LPOI for (int i2 = G - 1 - bid; i2 < 1040; i2 += G) { if (LRU_NEW2) lru2_item<false>(F, i2 / NSEG, i2 % NSEG); else lru_item<false>(F, i2 / NSEG, i2 % NSEG); }
#define P4R { LPOI ph_ret_final(F); }
#define P4L LPOI for (int i2 = G - 1 - bid; i2 < 1040; i2 += G) { if (LRU_NEW4) lru2_item<true>(F, i2 / NSEG, i2 % NSEG); else lru_item<true>(F, i2 / NSEG, i2 % NSEG); }
#define P3 { lru_carry(F); ret_scan(F); }
#define P4 { P4R P4L }
#define P5 { pg8::Gemm g{F.H, F.WOUT, NP, DM, DM}; pg8::StaticOrder S; S.init(NP, DM, G, bid); pg8::EpiHS E{F.x, F.meta, F.HSB}; \
        pg8::gemm_phase<pg8::EpiHS, pg8::StaticOrder, true, true>(F.lds, g, S, E); \
          \
        { const int vb = G == 256 ? bid - 16 : bid, VG = G == 256 ? G - 16 : G; prep_stream8(F, F.w_up, (unsigned char*)F.WGU, 2097152, 2, vb, VG); prep_stream8(F, F.w_down, (unsigned char*)F.WD, 1048576, 0, vb, VG); } }
#define P6 ph_router(F);
#define P7 for (int it = bid; it < NB * NE; it += G) topk_item(F, it / NE, it % NE);
#define P8 ph_gather(F);
#define P9 { pg8::Gemm g{F.XS, F.WGU, NROWS, NE * 2048, DM / 2}; pg8::GroupOrder S; S.init(NE, 33, 8, G, bid); pg8::EpiAct E{F.ACT}; \
        pg8::gemm_phase_g8<pg8::EpiAct, pg8::GroupOrder>(F.lds, F.lds + LDS_SIDE, g, (const unsigned*)F.IDX, S, E); }
#define P10 { pg8::Gemm g{F.ACT, F.WD, NROWS, NE * 1024, DM / 2}; pg8::GroupOrder S; S.init(NE, 33, 4, G, bid); pg8::EpiYS E{(unsigned char*)F.YS, F.GATE}; \
        pg8::gemm_phase8<pg8::EpiYS, pg8::GroupOrder, true, true>(F.lds, g, S, E); }
#define P10F8 { pg8::Gemm g{F.ACT, F.WD, NROWS, NE * 1024, DM / 2}; pg8::GroupOrder S; S.init(NE, 33, 4, G, bid); pg8::EpiYS E{(unsigned char*)F.YS, F.GATE}; \
        pg8::gemm_phase8<pg8::EpiYS, pg8::GroupOrder, true, true>(F.lds, g, S, E); }
#define CKSTU(slot) ph_checksum(F, F.ST, (size_t)64 * NCHUNK * 32768, slot);
#define CKSUMM(slot) ph_checksum(F, F.SUMM, (size_t)NB * NSEG * 2 * 512 * 8, slot);
#define CKCARRY(slot) ph_checksum(F, F.CARRY, (size_t)NB * NSEG * 2 * 512 * 4, slot);
#define CPY ph_cpy(F);
#define CMP ph_cmp(F);
#define CKY(slot) ph_checksum(F, F.H, (size_t)NP * 2048, slot);
#define CKST(slot) ph_checksum(F, F.ST2, (size_t)64 * NCHUNK * 32768, slot);
#define CKZ(slot) ph_checksum(F, F.Z, (size_t)NP * ZC * 2, slot);
#define CKHSB(slot) ph_checksum(F, F.HSB, (size_t)NP * 2048, slot);
#define P11 ph_combine(F);
#define REP for (int rep_ = 0; rep_ < args.ph_lo; ++rep_)
#ifndef MK_PROG
#define MK_PROG P0 SEAM P1 SEAM P2 SEAM P3 SEAM P4 SEAM P5 SEAM P6 SEAM P7 SEAM P9 SEAM P10 SEAM P11
#endif
    MK_PROG
}

#ifndef MK_REPS
#define MK_REPS 1
#endif
#ifndef MK_ONE_LAUNCH
#define MK_ONE_LAUNCH 0
#endif
extern "C" void kernel_launch(void* const* d_in, const int* in_sizes, int n_in, void* d_out, int out_size, void* d_ws, size_t ws_size, hipStream_t stream) {
    static int grid = 0;
    if (grid == 0) {
        if (n_in != 20 || in_sizes[0] != NB * SEQ * DM || out_size != NB * SEQ * DM || ws_size < WS_END) { fprintf(stderr, "kernel_launch: unexpected shapes / workspace (n_in %d, ws %zu, need %zu)\n", n_in, ws_size, (size_t)WS_END); grid = -1; return; }
        int dev = 0, cus = 0, per_cu = 0;
        if (hipGetDevice(&dev) != hipSuccess || hipDeviceGetAttribute(&cus, hipDeviceAttributeMultiprocessorCount, dev) != hipSuccess) { grid = -1; return; }
        if (hipFuncSetAttribute((const void*)mk_fwd, hipFuncAttributeMaxDynamicSharedMemorySize, LDS_BYTES) != hipSuccess) { fprintf(stderr, "kernel_launch: hipFuncSetAttribute failed\n"); grid = -1; return; }
        if (hipOccupancyMaxActiveBlocksPerMultiprocessor(&per_cu, (const void*)mk_fwd, 512, LDS_BYTES) != hipSuccess || per_cu < 1) { fprintf(stderr, "kernel_launch: occupancy query says %d blocks per CU\n", per_cu); grid = -1; return; }
        (void)hipGetLastError();
        grid = cus;
    }
    if (grid < 0) return;
    (void)hipMemsetAsync((char*)d_ws + WS_CTL, 0, CTL_ZERO_BYTES, stream);
    Args a{};
    for (int i = 0; i < 20; ++i) a.in[i] = (const float*)d_in[i];
    a.out = (float*)d_out; a.ws = (unsigned char*)d_ws; a.ph_lo = MK_REPS; a.ph_hi = 0;
    hipLaunchKernelGGL(mk_fwd, dim3(grid), dim3(512), LDS_BYTES, stream, a);
}
```

```cpp
#include <hip/hip_runtime.h>
#include <cstdio>
#include <cstdint>
#ifndef MK_PROG
#define MK_PROG P0 SEAM P1 SEAM P2 SEAM P3 SEAM P4 SEAM P5 SEAM P6 SEAM P7 SEAM P9 SEAM P10 SEAM P11
#endif
#define LRU_NEW2 0
#define LRU_NEW4 0
namespace pg8 {
#define PG8_LAS __attribute__((address_space(3)))
typedef unsigned short bf16_t;
typedef short bf16x8 __attribute__((ext_vector_type(8)));
typedef float f32x4 __attribute__((ext_vector_type(4)));
typedef unsigned u32x4 __attribute__((ext_vector_type(4)));
constexpr int BM = 256, BK = 64, HALF = 128, HTB = HALF * BK * 2  , STAGE_BYTES = 8 * HTB, NXCD = 8, WGM = 8;

__host__ __device__ __forceinline__ int lds_byte(int r, int c) { const int st = (r >> 4) * 2 + (c >> 5), rr = r & 15, cc = c & 31, ob = rr * 64 + cc * 2; return st * 1024 + (ob ^ (((ob >> 9) & 1) << 5)); }
__host__ __device__ __forceinline__ void stage_rc(int b, int& R, int& C) { const int st = b / 1024, sb = b % 1024, swz = sb ^ (((sb >> 9) & 1) << 5); R = (st >> 1) * 16 + swz / 64; C = (st & 1) * 32 + (swz % 64) / 2; }
__host__ __device__ __forceinline__ int perm32(int rho) { const int n = rho >> 4, i = rho & 15; return 8 * (i >> 2) + 4 * n + (i & 3); }

struct Unit { int pm, pn; };
struct Gemm { const bf16_t* A; const bf16_t* Bt; int M, N, K; };

struct StaticOrder {
    int nM, nN, nwg, G, c;
    __host__ __device__ __forceinline__ void init(int M, int N, int G_, int c_) { nM = M / BM; nN = N / BM; nwg = nM * nN; G = G_; c = c_; }
    __host__ __device__ __forceinline__ bool next(int i, Unit& u) const {
        const long L = (long)i * G + c; if (L >= nwg) return false;
        int wgid = (int)L; { const int q = nwg / NXCD, r = nwg % NXCD, xcd = wgid % NXCD, off = wgid / NXCD; wgid = (xcd < r ? xcd * (q + 1) : r * (q + 1) + (xcd - r) * q) + off; }
        const int nig = WGM * nN, gid = wgid / nig, fm = gid * WGM, gsz = (nM - fm) < WGM ? (nM - fm) : WGM;
        u.pm = fm + ((wgid % nig) % gsz); u.pn = (wgid % nig) / gsz; return true;
    }
    __device__ __forceinline__ void a_ready(const Unit&) const {}
    __device__ __forceinline__ void done(const Unit&) const {}
};

__device__ __forceinline__ unsigned cvt_pk_bf16(float lo, float hi) { unsigned r; asm volatile("v_cvt_pk_bf16_f32 %0, %1, %2" : "=v"(r) : "v"(lo), "v"(hi)); return r; }
typedef float f32x2 __attribute__((ext_vector_type(2)));
__device__ __forceinline__ f32x2 gelu_pk(f32x2 v) {
    const f32x2 av = __builtin_elementwise_abs(v), d = av * 0.2316418882f + 1.0f;
    f32x2 t; t.x = __builtin_amdgcn_rcpf(d.x); t.y = __builtin_amdgcn_rcpf(d.y);
    f32x2 q = t * 0.5307027145f + (-0.7265760135f); q = q * t + 0.7107068705f; q = q * t + (-0.142248368f); q = q * t + 0.127414796f; q = q * t;
    const f32x2 s = (v * v) * (-0.72134752044f);
    f32x2 e; e.x = __builtin_amdgcn_exp2f(s.x); e.y = __builtin_amdgcn_exp2f(s.y);
    const f32x2 m = v * (q * e), r = v - m;
    f32x2 o; o.x = v.x < 0.f ? m.x : r.x; o.y = v.y < 0.f ? m.y : r.y; return o;
}

template <int ACT  > struct EpiBf16 {
    static constexpr bool PERM = true, AFTER_DRAIN = false; static_assert(ACT == 0 || ACT == 1, "EpiBf16: ACT is 0 (none) or 1 (gelu_pk)");
    bf16_t* O; int ldc; const float* bias; int split_cols; size_t split_stride; float scale0;
    __device__ __forceinline__ void operator()(const f32x4 (&acc)[2][2][4][2], const Unit& u, int wr, int wc, int fr, int fq) const {
        const int row0 = u.pm * BM + wr * 64 + fr; int colt = u.pn * BM; bf16_t* base = O;
        float sc = 1.f; if (split_cols) { const int t = colt / split_cols; base += (size_t)t * split_stride; colt -= t * split_cols; if (t == 0) sc = scale0; }
        const int col0 = colt + wc * 32 + 8 * fq, bcol0 = u.pn * BM + wc * 32 + 8 * fq;
        f32x4 bv[2][2];
#pragma unroll
        for (int bj = 0; bj < 2; ++bj)
#pragma unroll
            for (int n = 0; n < 2; ++n) bv[bj][n] = bias ? *(const f32x4*)(bias + bcol0 + bj * HALF + 4 * n) : (f32x4){0.f, 0.f, 0.f, 0.f};
#pragma unroll
        for (int ai = 0; ai < 2; ++ai)
#pragma unroll
            for (int m = 0; m < 4; ++m) { bf16_t* rowp = base + (size_t)(row0 + ai * HALF + m * 16) * ldc + col0;
#pragma unroll
                for (int bj = 0; bj < 2; ++bj) { f32x4 v0 = acc[ai][bj][m][0] + bv[bj][0], v1 = acc[ai][bj][m][1] + bv[bj][1];
                    if (ACT == 1) { f32x2 a = gelu_pk((f32x2){v0[0], v0[1]}), b = gelu_pk((f32x2){v0[2], v0[3]}), c = gelu_pk((f32x2){v1[0], v1[1]}), d = gelu_pk((f32x2){v1[2], v1[3]});
                        v0 = (f32x4){a.x, a.y, b.x, b.y}; v1 = (f32x4){c.x, c.y, d.x, d.y}; }
                    v0 = v0 * sc; v1 = v1 * sc; u32x4 w; w.x = cvt_pk_bf16(v0[0], v0[1]); w.y = cvt_pk_bf16(v0[2], v0[3]); w.z = cvt_pk_bf16(v1[0], v1[1]); w.w = cvt_pk_bf16(v1[2], v1[3]);
                    *(u32x4*)(rowp + bj * HALF) = w; } }
    }
};
typedef int i32x8 __attribute__((ext_vector_type(8)));
__host__ __device__ __forceinline__ int lds_byte8(int r, int fq) { const int st = (r >> 4) * 2 + (fq >> 1), rr = r & 15, ob = rr * 64 + (fq & 1) * 32; return st * 1024 + (ob ^ (((ob >> 9) & 1) << 5)); }
template <class Epi, class Sched, bool ALIGN_EPI = false, bool SP2 = false>
__device__ __forceinline__ void gemm_phase(PG8_LAS unsigned char* lds, const Gemm g, const Sched& S, const Epi& E) {
    int tid = threadIdx.x; asm volatile("" : "+v"(tid));
    const int wid = __builtin_amdgcn_readfirstlane(tid >> 6), lane = tid & 63, wr = wid >> 2, wc = wid & 3, fr = lane & 15, fq = lane >> 4;
    const int K = g.K, nt = K / BK;
    unsigned voffA[2], voffB[2];
#pragma unroll
    for (int i = 0; i < 2; ++i) { int R, C; stage_rc(tid * 16 + i * 8192, R, C); const int Rb = Epi::PERM ? ((R & ~31) + perm32(R & 31)) : R;
        voffA[i] = (unsigned)(R * K + C) * 2u; voffB[i] = (unsigned)(Rb * K + C) * 2u; }
    const size_t kstep = (size_t)(BK * 2);
    const size_t hstep = (size_t)HALF * K * 2;
    const size_t tstep = 2 * hstep;
    const unsigned ldsw = (unsigned)wid * 1024u;
    const int aoff = lds_byte(wr * 64 + fr, fq * 8), boff = lds_byte(wc * 32 + fr, fq * 8);
#define PG8_SA(b, h) (((b) * 2 + (h)) * HTB)
#define PG8_SB(b, h) ((4 + (b) * 2 + (h)) * HTB)
#define PG8_STAGE(bufoff, gbase, voff) do { _Pragma("unroll") for (int _i = 0; _i < 2; ++_i) \
        __builtin_amdgcn_global_load_lds((const unsigned*)((const char*)(gbase) + (voff)[_i]), (PG8_LAS unsigned*)(lds + (bufoff) + ldsw + _i * 8192), 16, 0, 0); } while (0)
#define PG8_LDA(dst, b, h) do { _Pragma("unroll") for (int m = 0; m < 4; ++m) _Pragma("unroll") for (int k = 0; k < 2; ++k) dst[m][k] = *(const PG8_LAS bf16x8*)(lds + PG8_SA(b, h) + aoff + m * 2048 + k * 1024); } while (0)
#define PG8_LDB(dst, b, h) do { _Pragma("unroll") for (int n = 0; n < 2; ++n) _Pragma("unroll") for (int k = 0; k < 2; ++k) dst[n][k] = *(const PG8_LAS bf16x8*)(lds + PG8_SB(b, h) + boff + n * 2048 + k * 1024); } while (0)
#define PG8_MMA(ai, bj, At, Bt) do { __builtin_amdgcn_s_setprio(1); _Pragma("unroll") for (int m = 0; m < 4; ++m) _Pragma("unroll") for (int n = 0; n < 2; ++n) _Pragma("unroll") for (int k = 0; k < 2; ++k) \
        acc[ai][bj][m][n] = __builtin_amdgcn_mfma_f32_16x16x32_bf16(Bt[n][k], At[m][k], acc[ai][bj][m][n], 0, 0, 0); __builtin_amdgcn_s_setprio(0); } while (0)
#define PG8_WAIT_V(n) asm volatile("s_waitcnt vmcnt(" #n ")" ::: "memory")
#define PG8_WAIT_L(n) asm volatile("s_waitcnt lgkmcnt(" #n ")" ::: "memory")
#define PG8_BAR __builtin_amdgcn_s_barrier()
#define PG8_SCHED __builtin_amdgcn_sched_barrier(0)
    Unit cur, nxt; int ui = 0;
    if (!S.next(0, cur)) return;
    f32x4 acc[2][2][4][2];
#pragma unroll
    for (int a = 0; a < 2; ++a)
#pragma unroll
        for (int b = 0; b < 2; ++b)
#pragma unroll
            for (int m = 0; m < 4; ++m)
#pragma unroll
                for (int n = 0; n < 2; ++n) acc[a][b][m][n] = (f32x4){0.f, 0.f, 0.f, 0.f};
    bf16x8 At[4][2], B0[2][2], B1[2][2];
    const char* cA = (const char*)g.A + (size_t)cur.pm * tstep; const char* cB = (const char*)g.Bt + (size_t)cur.pn * tstep;
    S.a_ready(cur);
    if constexpr (SP2) {
        PG8_STAGE(PG8_SB(0, 0), cB, voffB); PG8_STAGE(PG8_SB(0, 1), cB + hstep, voffB); PG8_STAGE(PG8_SA(0, 0), cA, voffA); PG8_STAGE(PG8_SA(0, 1), cA + hstep, voffA);
        if (wr == 1) PG8_BAR;
        PG8_WAIT_V(2); PG8_BAR;
        PG8_STAGE(PG8_SB(1, 0), cB + kstep, voffB); PG8_STAGE(PG8_SA(1, 0), cA + kstep, voffA); PG8_STAGE(PG8_SB(1, 1), cB + hstep + kstep, voffB);
        PG8_WAIT_V(6); PG8_BAR;
    } else {
        PG8_STAGE(PG8_SB(0, 0), cB, voffB); PG8_STAGE(PG8_SA(0, 0), cA, voffA); PG8_STAGE(PG8_SB(0, 1), cB + hstep, voffB); PG8_STAGE(PG8_SA(0, 1), cA + hstep, voffA);
        if (wr == 1) PG8_BAR;
        PG8_WAIT_V(4); PG8_BAR;
        PG8_STAGE(PG8_SB(1, 0), cB + kstep, voffB); PG8_STAGE(PG8_SA(1, 0), cA + kstep, voffA); PG8_STAGE(PG8_SB(1, 1), cB + hstep + kstep, voffB);
        PG8_WAIT_V(6); PG8_BAR;
    }
    for (;;) {
        const bool has_next = S.next(ui + 1, nxt);
        const char* nA = has_next ? (const char*)g.A + (size_t)nxt.pm * tstep : cA; const char* nB = has_next ? (const char*)g.Bt + (size_t)nxt.pn * tstep : cB;
        for (int t = 0; t < nt; t += 2) {
            const bool last = (t == nt - 2);
            const char* a1 = cA + (size_t)(t + 1) * kstep;
            const char* a2 = last ? nA : cA + (size_t)(t + 2) * kstep; const char* b2 = last ? nB : cB + (size_t)(t + 2) * kstep;
            const char* a3 = a2 + kstep; const char* b3 = b2 + kstep;
            if (last && has_next) S.a_ready(nxt);
            if constexpr (SP2) {
            PG8_LDB(B0, 0, 0); PG8_LDB(B1, 0, 1); PG8_SCHED; PG8_LDA(At, 0, 0); PG8_STAGE(PG8_SA(1, 1), a1 + hstep, voffA);
            PG8_WAIT_V(8); PG8_WAIT_L(0); PG8_BAR; PG8_MMA(0, 0, At, B0); PG8_MMA(0, 1, At, B1); PG8_BAR; PG8_SCHED;
            PG8_LDA(At, 0, 1); PG8_STAGE(PG8_SB(0, 0), b2, voffB); PG8_STAGE(PG8_SB(0, 1), b2 + hstep, voffB); PG8_STAGE(PG8_SA(0, 0), a2, voffA);
            PG8_WAIT_V(8); PG8_WAIT_L(0); PG8_BAR; PG8_MMA(1, 0, At, B0); PG8_MMA(1, 1, At, B1); PG8_BAR; PG8_SCHED;
            PG8_LDB(B0, 1, 0); PG8_LDB(B1, 1, 1); PG8_SCHED; PG8_LDA(At, 1, 0); PG8_STAGE(PG8_SA(0, 1), a2 + hstep, voffA);
            PG8_WAIT_V(8); PG8_WAIT_L(0); PG8_BAR; PG8_MMA(0, 0, At, B0); PG8_MMA(0, 1, At, B1); PG8_BAR; PG8_SCHED;
            PG8_LDA(At, 1, 1); PG8_STAGE(PG8_SB(1, 0), b3, voffB); PG8_STAGE(PG8_SB(1, 1), b3 + hstep, voffB); PG8_STAGE(PG8_SA(1, 0), a3, voffA);
            PG8_WAIT_V(8); PG8_WAIT_L(0); PG8_BAR; PG8_MMA(1, 0, At, B0); PG8_MMA(1, 1, At, B1); PG8_BAR; PG8_SCHED;
            } else {
            PG8_LDB(B0, 0, 0); PG8_SCHED; PG8_LDA(At, 0, 0); PG8_STAGE(PG8_SA(1, 1), a1 + hstep, voffA);
            PG8_WAIT_L(8); PG8_BAR; PG8_WAIT_L(0); PG8_MMA(0, 0, At, B0); PG8_BAR; PG8_SCHED;
            PG8_LDB(B1, 0, 1); PG8_STAGE(PG8_SB(0, 0), b2, voffB);
            PG8_BAR; PG8_WAIT_L(0); PG8_MMA(0, 1, At, B1); PG8_BAR;
            PG8_LDA(At, 0, 1); PG8_STAGE(PG8_SA(0, 0), a2, voffA);
            PG8_BAR; PG8_WAIT_L(0); PG8_MMA(1, 0, At, B0); PG8_BAR; PG8_SCHED;
            PG8_STAGE(PG8_SB(0, 1), b2 + hstep, voffB);
            PG8_WAIT_V(6); PG8_BAR; PG8_MMA(1, 1, At, B1); PG8_BAR;
            PG8_LDB(B0, 1, 0); PG8_SCHED; PG8_LDA(At, 1, 0); PG8_STAGE(PG8_SA(0, 1), a2 + hstep, voffA);
            PG8_WAIT_L(8); PG8_BAR; PG8_WAIT_L(0); PG8_MMA(0, 0, At, B0); PG8_BAR; PG8_SCHED;
            PG8_LDB(B1, 1, 1); PG8_STAGE(PG8_SB(1, 0), b3, voffB);
            PG8_BAR; PG8_WAIT_L(0); PG8_MMA(0, 1, At, B1); PG8_BAR;
            PG8_LDA(At, 1, 1); PG8_STAGE(PG8_SA(1, 0), a3, voffA);
            PG8_BAR; PG8_WAIT_L(0); PG8_MMA(1, 0, At, B0); PG8_BAR; PG8_SCHED;
            PG8_STAGE(PG8_SB(1, 1), b3 + hstep, voffB);
            PG8_WAIT_V(6); PG8_BAR; PG8_MMA(1, 1, At, B1); PG8_BAR;
            }
        }
        if constexpr (ALIGN_EPI) { if (wr == 0) PG8_BAR; }
        if constexpr (!Epi::AFTER_DRAIN) { E(acc, cur, wr, wc, fr, fq); S.done(cur); }
        if (!has_next) break;
#pragma unroll
        for (int a = 0; a < 2; ++a)
#pragma unroll
            for (int b = 0; b < 2; ++b)
#pragma unroll
                for (int m = 0; m < 4; ++m)
#pragma unroll
                    for (int n = 0; n < 2; ++n) acc[a][b][m][n] = (f32x4){0.f, 0.f, 0.f, 0.f};
        cur = nxt; cA = nA; cB = nB; ++ui;
        if constexpr (ALIGN_EPI) { if (wr == 1) PG8_BAR; }
    }
    PG8_WAIT_V(0);
    if constexpr (!ALIGN_EPI) { if (wr == 0) PG8_BAR; }
    PG8_BAR;
    if constexpr (Epi::AFTER_DRAIN) { E.fused(acc, cur, wr, wc, fr, fq, lds, wid, lane); S.done(cur); }
}
template <class Epi, class Sched>
__device__ __forceinline__ void gemm_phase_g(PG8_LAS unsigned char* lds, PG8_LAS unsigned char* side, const Gemm g, const unsigned* rowoff, const Sched& S, const Epi& E) {
    constexpr bool ALIGN_EPI = true, SP2 = true;
    int tid = threadIdx.x; asm volatile("" : "+v"(tid));
    const int wid = __builtin_amdgcn_readfirstlane(tid >> 6), lane = tid & 63, wr = wid >> 2, wc = wid & 3, fr = lane & 15, fq = lane >> 4;
    const int K = g.K, nt = K / BK;
    unsigned voffB[2], cA2[2]; int RA[2];
#pragma unroll
    for (int i = 0; i < 2; ++i) { int R, C; stage_rc(tid * 16 + i * 8192, R, C); const int Rb = Epi::PERM ? ((R & ~31) + perm32(R & 31)) : R;
        RA[i] = R; cA2[i] = (unsigned)C * 2u; voffB[i] = (unsigned)(Rb * K + C) * 2u; }
    const size_t kstep = (size_t)(BK * 2);
    const size_t hstep = (size_t)HALF * K * 2;
    const size_t tstep = 2 * hstep;
    const unsigned ldsw = (unsigned)wid * 1024u;
    const int aoff = lds_byte(wr * 64 + fr, fq * 8), boff = lds_byte(wc * 32 + fr, fq * 8);
    Unit cur, nxt; int ui = 0;
    if (!S.next(0, cur)) return;
    f32x4 acc[2][2][4][2];
#pragma unroll
    for (int a = 0; a < 2; ++a)
#pragma unroll
        for (int b = 0; b < 2; ++b)
#pragma unroll
            for (int m = 0; m < 4; ++m)
#pragma unroll
                for (int n = 0; n < 2; ++n) acc[a][b][m][n] = (f32x4){0.f, 0.f, 0.f, 0.f};
    bf16x8 At[4][2], B0[2][2], B1[2][2];
    const char* const gA = (const char*)g.A; const char* cB = (const char*)g.Bt + (size_t)cur.pn * tstep;
    unsigned vo0[2], vo1[2], nvo0[2], nvo1[2];
#pragma unroll
    for (int i = 0; i < 2; ++i) { vo0[i] = rowoff[(size_t)cur.pm * 256 + RA[i]] + cA2[i]; vo1[i] = rowoff[(size_t)cur.pm * 256 + 128 + RA[i]] + cA2[i]; nvo0[i] = vo0[i]; nvo1[i] = vo1[i]; }
    S.a_ready(cur);
    if constexpr (SP2) {
        PG8_STAGE(PG8_SB(0, 0), cB, voffB); PG8_STAGE(PG8_SB(0, 1), cB + hstep, voffB); PG8_STAGE(PG8_SA(0, 0), gA, vo0); PG8_STAGE(PG8_SA(0, 1), gA, vo1);
        if (wr == 1) PG8_BAR;
        PG8_WAIT_V(2); PG8_BAR;
        PG8_STAGE(PG8_SB(1, 0), cB + kstep, voffB); PG8_STAGE(PG8_SA(1, 0), gA + kstep, vo0); PG8_STAGE(PG8_SB(1, 1), cB + hstep + kstep, voffB);
        PG8_WAIT_V(6); PG8_BAR;
    }
    for (;;) {
        const bool has_next = S.next(ui + 1, nxt);
        const char* nB = has_next ? (const char*)g.Bt + (size_t)nxt.pn * tstep : cB;
        if (has_next) __builtin_amdgcn_global_load_lds((const unsigned*)(rowoff + (size_t)nxt.pm * 256 + lane * 4), (PG8_LAS unsigned*)(side + (ui & 1) * 1024), 16, 0, 0);
        for (int t = 0; t < nt; t += 2) {
            const bool last = (t == nt - 2);
            if (last && has_next) {
                const PG8_LAS unsigned* sl = (const PG8_LAS unsigned*)(side + (ui & 1) * 1024);
#pragma unroll
                for (int i = 0; i < 2; ++i) { int ra = RA[i]; asm volatile("" : "+v"(ra));
                    nvo0[i] = sl[ra] + cA2[i]; nvo1[i] = sl[128 + ra] + cA2[i]; }
            }
            const char* a1 = gA + (size_t)(t + 1) * kstep;
            const char* a2 = last ? gA : gA + (size_t)(t + 2) * kstep; const char* b2 = last ? nB : cB + (size_t)(t + 2) * kstep;
            unsigned s0[2], s1[2];
#pragma unroll
            for (int i = 0; i < 2; ++i) { s0[i] = last ? nvo0[i] : vo0[i]; s1[i] = last ? nvo1[i] : vo1[i]; }
            const char* a3 = a2 + kstep; const char* b3 = b2 + kstep;
            if (last && has_next) S.a_ready(nxt);
            if constexpr (SP2) {
            PG8_LDB(B0, 0, 0); PG8_LDB(B1, 0, 1); PG8_SCHED; PG8_LDA(At, 0, 0); PG8_STAGE(PG8_SA(1, 1), a1, vo1);
            PG8_WAIT_V(8); PG8_WAIT_L(0); PG8_BAR; PG8_MMA(0, 0, At, B0); PG8_MMA(0, 1, At, B1); PG8_BAR; PG8_SCHED;
            PG8_LDA(At, 0, 1); PG8_STAGE(PG8_SB(0, 0), b2, voffB); PG8_STAGE(PG8_SB(0, 1), b2 + hstep, voffB); PG8_STAGE(PG8_SA(0, 0), a2, s0);
            PG8_WAIT_V(8); PG8_WAIT_L(0); PG8_BAR; PG8_MMA(1, 0, At, B0); PG8_MMA(1, 1, At, B1); PG8_BAR; PG8_SCHED;
            PG8_LDB(B0, 1, 0); PG8_LDB(B1, 1, 1); PG8_SCHED; PG8_LDA(At, 1, 0); PG8_STAGE(PG8_SA(0, 1), a2, s1);
            PG8_WAIT_V(8); PG8_WAIT_L(0); PG8_BAR; PG8_MMA(0, 0, At, B0); PG8_MMA(0, 1, At, B1); PG8_BAR; PG8_SCHED;
            PG8_LDA(At, 1, 1); PG8_STAGE(PG8_SB(1, 0), b3, voffB); PG8_STAGE(PG8_SB(1, 1), b3 + hstep, voffB); PG8_STAGE(PG8_SA(1, 0), a3, s0);
            PG8_WAIT_V(8); PG8_WAIT_L(0); PG8_BAR; PG8_MMA(1, 0, At, B0); PG8_MMA(1, 1, At, B1); PG8_BAR; PG8_SCHED;
            }
        }
        if constexpr (ALIGN_EPI) { if (wr == 0) PG8_BAR; }
        if constexpr (!Epi::AFTER_DRAIN) { E(acc, cur, wr, wc, fr, fq); S.done(cur); }
        if (!has_next) break;
#pragma unroll
        for (int a = 0; a < 2; ++a)
#pragma unroll
            for (int b = 0; b < 2; ++b)
#pragma unroll
                for (int m = 0; m < 4; ++m)
#pragma unroll
                    for (int n = 0; n < 2; ++n) acc[a][b][m][n] = (f32x4){0.f, 0.f, 0.f, 0.f};
        cur = nxt; cB = nB; ++ui;
#pragma unroll
        for (int i = 0; i < 2; ++i) { vo0[i] = nvo0[i]; vo1[i] = nvo1[i]; }
        if constexpr (ALIGN_EPI) { if (wr == 1) PG8_BAR; }
    }
    PG8_WAIT_V(0);
    if constexpr (!ALIGN_EPI) { if (wr == 0) PG8_BAR; }
    PG8_BAR;
    if constexpr (Epi::AFTER_DRAIN) { E.fused(acc, cur, wr, wc, fr, fq, lds, wid, lane); S.done(cur); }
}
#define PG8_LDA8(dst, b, h) do { _Pragma("unroll") for (int m = 0; m < 4; ++m) dst[m] = *(const PG8_LAS i32x8*)(lds + PG8_SA(b, h) + aoff + m * 2048); } while (0)
#define PG8_LDB8(dst, b, h) do { _Pragma("unroll") for (int n = 0; n < 2; ++n) dst[n] = *(const PG8_LAS i32x8*)(lds + PG8_SB(b, h) + boff + n * 2048); } while (0)
#define PG8_MMA8(ai, bj, At, Bt) do { __builtin_amdgcn_s_setprio(1); asm volatile("s_nop 1" ::: "memory"); _Pragma("unroll") for (int m = 0; m < 4; ++m) _Pragma("unroll") for (int n = 0; n < 2; ++n) \
        asm volatile("v_mfma_scale_f32_16x16x128_f8f6f4 %0, %1, %2, %0, %3, %3 op_sel_hi:[0,0,0]" : "+v"(acc[ai][bj][m][n]) : "v"(Bt[n]), "v"(At[m]), "v"(scl8)); __builtin_amdgcn_s_setprio(0); } while (0)
template <class Epi, class Sched>
__device__ __forceinline__ void gemm_phase_g8(PG8_LAS unsigned char* lds, PG8_LAS unsigned char* side, const Gemm g, const unsigned* rowoff, const Sched& S, const Epi& E) {
    constexpr bool ALIGN_EPI = true, SP2 = true;
    int tid = threadIdx.x; asm volatile("" : "+v"(tid));
    const int wid = __builtin_amdgcn_readfirstlane(tid >> 6), lane = tid & 63, wr = wid >> 2, wc = wid & 3, fr = lane & 15, fq = lane >> 4;
    const int K = g.K; int nt = K / BK; asm volatile("" : "+s"(nt));
    unsigned voffB[2]; unsigned cA2 = 0u; int RA = 0;
#pragma unroll
    for (int i = 0; i < 2; ++i) { int R, C; stage_rc(tid * 16 + i * 8192, R, C); const int Rb = Epi::PERM ? ((R & ~31) + perm32(R & 31)) : R;
        if (i == 0) { RA = R; cA2 = (unsigned)C * 2u; } voffB[i] = (unsigned)(Rb * K + C) * 2u; }
    const size_t kstep = (size_t)(BK * 2);
    const size_t hstep = (size_t)HALF * K * 2;
    const size_t tstep = 2 * hstep;
    const unsigned ldsw = (unsigned)wid * 1024u;
    const int aoff = lds_byte8(wr * 64 + fr, fq), boff = lds_byte8(wc * 32 + fr, fq);
    int scl8 = 0x7f7f7f7f; asm volatile("" : "+v"(scl8));
    Unit cur, nxt; int ui = 0;
    if (!S.next(0, cur)) return;
    f32x4 acc[2][2][4][2];
#pragma unroll
    for (int a = 0; a < 2; ++a)
#pragma unroll
        for (int b = 0; b < 2; ++b)
#pragma unroll
            for (int m = 0; m < 4; ++m)
#pragma unroll
                for (int n = 0; n < 2; ++n) acc[a][b][m][n] = (f32x4){0.f, 0.f, 0.f, 0.f};
    i32x8 At[4], B0[2], B1[2];
    const char* const gA = (const char*)g.A; const char* cB = (const char*)g.Bt + (size_t)cur.pn * tstep;
    unsigned vo0[2], vo1[2];
#pragma unroll
    for (int i = 0; i < 2; ++i) { vo0[i] = rowoff[(size_t)cur.pm * 256 + RA + 64 * i] + cA2; vo1[i] = rowoff[(size_t)cur.pm * 256 + 128 + RA + 64 * i] + cA2; }
    S.a_ready(cur);
    if constexpr (SP2) {
        PG8_STAGE(PG8_SB(0, 0), cB, voffB); PG8_STAGE(PG8_SB(0, 1), cB + hstep, voffB); PG8_STAGE(PG8_SA(0, 0), gA, vo0); PG8_STAGE(PG8_SA(0, 1), gA, vo1);
        if (wr == 1) PG8_BAR;
        PG8_WAIT_V(2); PG8_BAR;
        PG8_STAGE(PG8_SB(1, 0), cB + kstep, voffB); PG8_STAGE(PG8_SA(1, 0), gA + kstep, vo0); PG8_STAGE(PG8_SB(1, 1), cB + hstep + kstep, voffB);
        PG8_WAIT_V(6); PG8_BAR;
    }
    for (;;) {
        const bool has_next = S.next(ui + 1, nxt);
        const char* nB = has_next ? (const char*)g.Bt + (size_t)nxt.pn * tstep : cB;
        if (has_next) __builtin_amdgcn_global_load_lds((const unsigned*)(rowoff + (size_t)nxt.pm * 256 + lane * 4), (PG8_LAS unsigned*)(side + (ui & 1) * 1024), 16, 0, 0);
        for (int t = 0; t < nt; t += 2) {
            const bool last = (t == nt - 2);
            const char* a1 = gA + (size_t)(t + 1) * kstep;
            const char* a2 = last ? gA : gA + (size_t)(t + 2) * kstep; const char* b2 = last ? nB : cB + (size_t)(t + 2) * kstep;
            unsigned s0[2], s1[2];
#pragma unroll
            for (int i = 0; i < 2; ++i) { s0[i] = vo0[i]; s1[i] = vo1[i]; }
            if (last && has_next) {
                const PG8_LAS unsigned* sl = (const PG8_LAS unsigned*)(side + (ui & 1) * 1024);
                int ra = RA; asm volatile("" : "+v"(ra));
#pragma unroll
                for (int i = 0; i < 2; ++i) { s0[i] = sl[ra + 64 * i] + cA2; s1[i] = sl[128 + ra + 64 * i] + cA2; }
            }
            const char* a3 = a2 + kstep; const char* b3 = b2 + kstep;
            if (last && has_next) S.a_ready(nxt);
            if constexpr (SP2) {
            PG8_LDB8(B0, 0, 0); PG8_LDB8(B1, 0, 1); PG8_SCHED; PG8_LDA8(At, 0, 0); PG8_STAGE(PG8_SA(1, 1), a1, vo1);
            PG8_WAIT_V(8); PG8_WAIT_L(0); PG8_BAR; PG8_MMA8(0, 0, At, B0); PG8_MMA8(0, 1, At, B1); PG8_BAR; PG8_SCHED;
            PG8_LDA8(At, 0, 1); PG8_STAGE(PG8_SB(0, 0), b2, voffB); PG8_STAGE(PG8_SB(0, 1), b2 + hstep, voffB); PG8_STAGE(PG8_SA(0, 0), a2, s0);
            PG8_WAIT_V(8); PG8_WAIT_L(0); PG8_BAR; PG8_MMA8(1, 0, At, B0); PG8_MMA8(1, 1, At, B1); PG8_BAR; PG8_SCHED;
            PG8_LDB8(B0, 1, 0); PG8_LDB8(B1, 1, 1); PG8_SCHED; PG8_LDA8(At, 1, 0); PG8_STAGE(PG8_SA(0, 1), a2, s1);
            PG8_WAIT_V(8); PG8_WAIT_L(0); PG8_BAR; PG8_MMA8(0, 0, At, B0); PG8_MMA8(0, 1, At, B1); PG8_BAR; PG8_SCHED;
            PG8_LDA8(At, 1, 1); PG8_STAGE(PG8_SB(1, 0), b3, voffB); PG8_STAGE(PG8_SB(1, 1), b3 + hstep, voffB); PG8_STAGE(PG8_SA(1, 0), a3, s0);
            PG8_WAIT_V(8); PG8_WAIT_L(0); PG8_BAR; PG8_MMA8(1, 0, At, B0); PG8_MMA8(1, 1, At, B1); PG8_BAR; PG8_SCHED;
            }
        }
        asm volatile("s_nop 15\n\ts_nop 15" ::: "memory");
        if constexpr (ALIGN_EPI) { if (wr == 0) PG8_BAR; }
        if constexpr (!Epi::AFTER_DRAIN) { E(acc, cur, wr, wc, fr, fq); S.done(cur); }
        if (!has_next) break;
#pragma unroll
        for (int a = 0; a < 2; ++a)
#pragma unroll
            for (int b = 0; b < 2; ++b)
#pragma unroll
                for (int m = 0; m < 4; ++m)
#pragma unroll
                    for (int n = 0; n < 2; ++n) acc[a][b][m][n] = (f32x4){0.f, 0.f, 0.f, 0.f};
        cur = nxt; cB = nB; ++ui;
        { const PG8_LAS unsigned* sl = (const PG8_LAS unsigned*)(side + ((ui - 1) & 1) * 1024); int ra = RA; asm volatile("" : "+v"(ra));
#pragma unroll
          for (int i = 0; i < 2; ++i) { vo0[i] = sl[ra + 64 * i] + cA2; vo1[i] = sl[128 + ra + 64 * i] + cA2; } }
        if constexpr (ALIGN_EPI) { if (wr == 1) PG8_BAR; }
    }
    PG8_WAIT_V(0);
    if constexpr (!ALIGN_EPI) { if (wr == 0) PG8_BAR; }
    PG8_BAR;
    if constexpr (Epi::AFTER_DRAIN) { E.fused(acc, cur, wr, wc, fr, fq, lds, wid, lane); S.done(cur); }
}
template <class Epi, class Sched, bool ALIGN_EPI = false, bool SP2 = false>
__device__ __forceinline__ void gemm_phase8(PG8_LAS unsigned char* lds, const Gemm g, const Sched& S, const Epi& E) {
    int tid = threadIdx.x; asm volatile("" : "+v"(tid));
    const int wid = __builtin_amdgcn_readfirstlane(tid >> 6), lane = tid & 63, wr = wid >> 2, wc = wid & 3, fr = lane & 15, fq = lane >> 4;
    const int K = g.K; int nt = K / BK; asm volatile("" : "+s"(nt));
    unsigned voffA[2], voffB[2];
#pragma unroll
    for (int i = 0; i < 2; ++i) { int R, C; stage_rc(tid * 16 + i * 8192, R, C); const int Rb = Epi::PERM ? ((R & ~31) + perm32(R & 31)) : R;
        voffA[i] = (unsigned)(R * K + C) * 2u; voffB[i] = (unsigned)(Rb * K + C) * 2u; }
    const size_t kstep = (size_t)(BK * 2);
    const size_t hstep = (size_t)HALF * K * 2;
    const size_t tstep = 2 * hstep;
    const unsigned ldsw = (unsigned)wid * 1024u;
    const int aoff = lds_byte8(wr * 64 + fr, fq), boff = lds_byte8(wc * 32 + fr, fq);
    int scl8 = 0x7f7f7f7f; asm volatile("" : "+v"(scl8));
    Unit cur, nxt; int ui = 0;
    if (!S.next(0, cur)) return;
    f32x4 acc[2][2][4][2];
#pragma unroll
    for (int a = 0; a < 2; ++a)
#pragma unroll
        for (int b = 0; b < 2; ++b)
#pragma unroll
            for (int m = 0; m < 4; ++m)
#pragma unroll
                for (int n = 0; n < 2; ++n) acc[a][b][m][n] = (f32x4){0.f, 0.f, 0.f, 0.f};
    i32x8 At[4], B0[2], B1[2];
    const char* cA = (const char*)g.A + (size_t)cur.pm * tstep; const char* cB = (const char*)g.Bt + (size_t)cur.pn * tstep;
    S.a_ready(cur);
    if constexpr (SP2) {
        PG8_STAGE(PG8_SB(0, 0), cB, voffB); PG8_STAGE(PG8_SB(0, 1), cB + hstep, voffB); PG8_STAGE(PG8_SA(0, 0), cA, voffA); PG8_STAGE(PG8_SA(0, 1), cA + hstep, voffA);
        if (wr == 1) PG8_BAR;
        PG8_WAIT_V(2); PG8_BAR;
        PG8_STAGE(PG8_SB(1, 0), cB + kstep, voffB); PG8_STAGE(PG8_SA(1, 0), cA + kstep, voffA); PG8_STAGE(PG8_SB(1, 1), cB + hstep + kstep, voffB);
        PG8_WAIT_V(6); PG8_BAR;
    } else {
        PG8_STAGE(PG8_SB(0, 0), cB, voffB); PG8_STAGE(PG8_SA(0, 0), cA, voffA); PG8_STAGE(PG8_SB(0, 1), cB + hstep, voffB); PG8_STAGE(PG8_SA(0, 1), cA + hstep, voffA);
        if (wr == 1) PG8_BAR;
        PG8_WAIT_V(4); PG8_BAR;
        PG8_STAGE(PG8_SB(1, 0), cB + kstep, voffB); PG8_STAGE(PG8_SA(1, 0), cA + kstep, voffA); PG8_STAGE(PG8_SB(1, 1), cB + hstep + kstep, voffB);
        PG8_WAIT_V(6); PG8_BAR;
    }
    for (;;) {
        const bool has_next = S.next(ui + 1, nxt);
        const char* nA = has_next ? (const char*)g.A + (size_t)nxt.pm * tstep : cA; const char* nB = has_next ? (const char*)g.Bt + (size_t)nxt.pn * tstep : cB;
        for (int t = 0; t < nt; t += 2) {
            const bool last = (t == nt - 2);
            const char* a1 = cA + (size_t)(t + 1) * kstep;
            const char* a2 = last ? nA : cA + (size_t)(t + 2) * kstep; const char* b2 = last ? nB : cB + (size_t)(t + 2) * kstep;
            const char* a3 = a2 + kstep; const char* b3 = b2 + kstep;
            if (last && has_next) S.a_ready(nxt);
            if constexpr (SP2) {
            PG8_LDB8(B0, 0, 0); PG8_LDB8(B1, 0, 1); PG8_SCHED; PG8_LDA8(At, 0, 0); PG8_STAGE(PG8_SA(1, 1), a1 + hstep, voffA);
            PG8_WAIT_V(8); PG8_WAIT_L(0); PG8_BAR; PG8_MMA8(0, 0, At, B0); PG8_MMA8(0, 1, At, B1); PG8_BAR; PG8_SCHED;
            PG8_LDA8(At, 0, 1); PG8_STAGE(PG8_SB(0, 0), b2, voffB); PG8_STAGE(PG8_SB(0, 1), b2 + hstep, voffB); PG8_STAGE(PG8_SA(0, 0), a2, voffA);
            PG8_WAIT_V(8); PG8_WAIT_L(0); PG8_BAR; PG8_MMA8(1, 0, At, B0); PG8_MMA8(1, 1, At, B1); PG8_BAR; PG8_SCHED;
            PG8_LDB8(B0, 1, 0); PG8_LDB8(B1, 1, 1); PG8_SCHED; PG8_LDA8(At, 1, 0); PG8_STAGE(PG8_SA(0, 1), a2 + hstep, voffA);
            PG8_WAIT_V(8); PG8_WAIT_L(0); PG8_BAR; PG8_MMA8(0, 0, At, B0); PG8_MMA8(0, 1, At, B1); PG8_BAR; PG8_SCHED;
            PG8_LDA8(At, 1, 1); PG8_STAGE(PG8_SB(1, 0), b3, voffB); PG8_STAGE(PG8_SB(1, 1), b3 + hstep, voffB); PG8_STAGE(PG8_SA(1, 0), a3, voffA);
            PG8_WAIT_V(8); PG8_WAIT_L(0); PG8_BAR; PG8_MMA8(1, 0, At, B0); PG8_MMA8(1, 1, At, B1); PG8_BAR; PG8_SCHED;
            } else {
            PG8_LDB8(B0, 0, 0); PG8_SCHED; PG8_LDA8(At, 0, 0); PG8_STAGE(PG8_SA(1, 1), a1 + hstep, voffA);
            PG8_WAIT_L(8); PG8_BAR; PG8_WAIT_L(0); PG8_MMA8(0, 0, At, B0); PG8_BAR; PG8_SCHED;
            PG8_LDB8(B1, 0, 1); PG8_STAGE(PG8_SB(0, 0), b2, voffB);
            PG8_BAR; PG8_WAIT_L(0); PG8_MMA8(0, 1, At, B1); PG8_BAR;
            PG8_LDA8(At, 0, 1); PG8_STAGE(PG8_SA(0, 0), a2, voffA);
            PG8_BAR; PG8_WAIT_L(0); PG8_MMA8(1, 0, At, B0); PG8_BAR; PG8_SCHED;
            PG8_STAGE(PG8_SB(0, 1), b2 + hstep, voffB);
            PG8_WAIT_V(6); PG8_BAR; PG8_MMA8(1, 1, At, B1); PG8_BAR;
            PG8_LDB8(B0, 1, 0); PG8_SCHED; PG8_LDA8(At, 1, 0); PG8_STAGE(PG8_SA(0, 1), a2 + hstep, voffA);
            PG8_WAIT_L(8); PG8_BAR; PG8_WAIT_L(0); PG8_MMA8(0, 0, At, B0); PG8_BAR; PG8_SCHED;
            PG8_LDB8(B1, 1, 1); PG8_STAGE(PG8_SB(1, 0), b3, voffB);
            PG8_BAR; PG8_WAIT_L(0); PG8_MMA8(0, 1, At, B1); PG8_BAR;
            PG8_LDA8(At, 1, 1); PG8_STAGE(PG8_SA(1, 0), a3, voffA);
            PG8_BAR; PG8_WAIT_L(0); PG8_MMA8(1, 0, At, B0); PG8_BAR; PG8_SCHED;
            PG8_STAGE(PG8_SB(1, 1), b3 + hstep, voffB);
            PG8_WAIT_V(6); PG8_BAR; PG8_MMA8(1, 1, At, B1); PG8_BAR;
            }
        }
        asm volatile("s_nop 15\n\ts_nop 15" ::: "memory");
        if constexpr (ALIGN_EPI) { if (wr == 0) PG8_BAR; }
        if constexpr (!Epi::AFTER_DRAIN) { E(acc, cur, wr, wc, fr, fq); S.done(cur); }
        if (!has_next) break;
#pragma unroll
        for (int a = 0; a < 2; ++a)
#pragma unroll
            for (int b = 0; b < 2; ++b)
#pragma unroll
                for (int m = 0; m < 4; ++m)
#pragma unroll
                    for (int n = 0; n < 2; ++n) acc[a][b][m][n] = (f32x4){0.f, 0.f, 0.f, 0.f};
        cur = nxt; cA = nA; cB = nB; ++ui;
        if constexpr (ALIGN_EPI) { if (wr == 1) PG8_BAR; }
    }
    PG8_WAIT_V(0);
    if constexpr (!ALIGN_EPI) { if (wr == 0) PG8_BAR; }
    PG8_BAR;
    if constexpr (Epi::AFTER_DRAIN) { E.fused(acc, cur, wr, wc, fr, fq, lds, wid, lane); S.done(cur); }
}
#undef PG8_LDA8
#undef PG8_LDB8
#undef PG8_MMA8
#undef PG8_SA
#undef PG8_SB
#undef PG8_STAGE
#undef PG8_LDA
#undef PG8_LDB
#undef PG8_MMA
#undef PG8_WAIT_V
#undef PG8_WAIT_L
#undef PG8_BAR
#undef PG8_SCHED
}
#define GAS __attribute__((address_space(1)))
#define LAS __attribute__((address_space(3)))
typedef unsigned short bf16;
typedef unsigned v4u __attribute__((ext_vector_type(4)));
typedef float f32x4 __attribute__((ext_vector_type(4)));
typedef short bf16x8 __attribute__((ext_vector_type(8)));
typedef GAS unsigned gu32;
typedef GAS unsigned long long gu64;
#define RLX_AGENT __ATOMIC_RELAXED, __HIP_MEMORY_SCOPE_AGENT
#define LDS_WAIT() asm volatile("s_waitcnt lgkmcnt(0)" ::: "memory")
#define VM_WAIT() asm volatile("s_waitcnt vmcnt(0)" ::: "memory")
__device__ __forceinline__ unsigned long long rt() { return __builtin_amdgcn_s_memrealtime(); }
__device__ __forceinline__ unsigned f2bf(float f) { unsigned u = __builtin_bit_cast(unsigned, f); return (u + 0x7fffu + ((u >> 16) & 1u)) >> 16; }
__device__ __forceinline__ unsigned pk2(float lo, float hi) { return f2bf(lo) | (f2bf(hi) << 16); }

#define XB_TMO      128
#define XB_XCNT(j)  (256  + 64 * (j))
#define XB_XSUB(j)  (1280 + 64 * (j))
#define XB_XGEN(j)  (2304 + 64 * (j))
#define XB_TOP      3328
#define XB_TOPGEN   3392
#define XCD_BAR_WORDS 3456
#define XB_SPIN_CAP (1u << 18)

__device__ __forceinline__ unsigned xb_ld(unsigned* p)              { return __hip_atomic_load(p, __ATOMIC_RELAXED, __HIP_MEMORY_SCOPE_AGENT); }
__device__ __forceinline__ unsigned xb_add(unsigned* p, unsigned v) { return __hip_atomic_fetch_add(p, v, __ATOMIC_RELAXED, __HIP_MEMORY_SCOPE_AGENT); }
__device__ __forceinline__ unsigned xb_xcc_id() { return (unsigned)__builtin_amdgcn_s_getreg((3 << 11) | 20) & 0xFu; }
#define XB_SPIN(cond, bar) do { unsigned _sp = 0; while (cond) { __builtin_amdgcn_s_sleep(1); \
    if ((++_sp & 255u) == 0u) { if (xb_ld(&(bar)[XB_TMO])) break; if (_sp > XB_SPIN_CAP) { atomicAdd(&(bar)[XB_TMO], 1u); break; } } } } while (0)

struct XcdBarrier {
    unsigned* bar; unsigned x;
    volatile LAS unsigned* st;
};

__device__ __forceinline__ XcdBarrier xcd_barrier_post(unsigned* bar, volatile LAS unsigned* st) {
    XcdBarrier b; b.bar = bar; b.x = xb_xcc_id(); b.st = st;
    if (threadIdx.x == 0) (void)xb_add(&bar[XB_XCNT(b.x)], 1u);
    return b;
}
__device__ __forceinline__ void xcd_barrier_complete(unsigned* bar, unsigned x, unsigned& nloc, unsigned& nx) {
    const unsigned G = gridDim.x * gridDim.y * gridDim.z;
    unsigned sum, cnt, mine, sp = 0u;
    for (;;) {
        sum = 0u; cnt = 0u; mine = 0u;
#pragma unroll
        for (unsigned j = 0; j < 16; ++j) { const unsigned c = xb_ld(&bar[XB_XCNT(j)]); sum += c; cnt += (c > 0u) ? 1u : 0u; mine = (j == x) ? c : mine; }
        if (sum == G) break;
        __builtin_amdgcn_s_sleep(1);
        if ((++sp & 255u) == 0u) { if (xb_ld(&bar[XB_TMO])) break; if (sp > XB_SPIN_CAP) { atomicAdd(&bar[XB_TMO], 1u); break; } }
    }
    nloc = mine > 0u ? mine : 1u; nx = cnt > 0u ? cnt : 1u;
}

__device__ __forceinline__ void xcd_barrier(const XcdBarrier& b) {
    asm volatile("s_waitcnt vmcnt(0)" ::: "memory");
    __syncthreads();
    if (threadIdx.x == 0) {
        unsigned* bar = b.bar;
        __builtin_amdgcn_s_waitcnt(0);
        unsigned nloc = b.st[0], nx = b.st[1];
        if (nloc == 0u) { xcd_barrier_complete(bar, b.x, nloc, nx); b.st[0] = nloc; b.st[1] = nx; }
        const unsigned old = xb_add(&bar[XB_XSUB(b.x)], 1u);
        const unsigned gen = old / nloc;
        if (old + 1u == (gen + 1u) * nloc) {
            __builtin_amdgcn_fence(__ATOMIC_RELEASE, "agent");
            asm volatile("s_waitcnt vmcnt(0)" ::: "memory");
            const unsigned og = xb_add(&bar[XB_TOP], 1u);
            const unsigned tg = og / nx;
            if (og + 1u == (tg + 1u) * nx) xb_add(&bar[XB_TOPGEN], 1u);
            else XB_SPIN(xb_ld(&bar[XB_TOPGEN]) == tg, bar);
            __builtin_amdgcn_fence(__ATOMIC_ACQUIRE, "agent");
            xb_add(&bar[XB_XGEN(b.x)], 1u);
            asm volatile("s_waitcnt vmcnt(0)" ::: "memory");
        } else {
            XB_SPIN(xb_ld(&bar[XB_XGEN(b.x)]) == gen, bar);
            __builtin_amdgcn_fence(__ATOMIC_ACQUIRE, "agent");
            asm volatile("s_waitcnt vmcnt(0)" ::: "memory");
        }
    }
    __syncthreads();
}
typedef unsigned u32x4 __attribute__((ext_vector_type(4)));

namespace pg8 {
typedef unsigned u32x2 __attribute__((ext_vector_type(2)));
__device__ __forceinline__ float silu_f(float x) { return x * __builtin_amdgcn_rcpf(1.0f + __expf(-x)); }
struct EpiHS {
    static constexpr bool PERM = true, AFTER_DRAIN = false;
    const float* x; const float* meta; bf16_t* hsb;
    __device__ __forceinline__ void operator()(const f32x4 (&acc)[2][2][4][2], const Unit& u, int wr, int wc, int fr, int fq) const {
        const int col0 = u.pn * BM + wc * 32 + 8 * fq;
#pragma unroll
        for (int ai = 0; ai < 2; ++ai) {
            f32x4 rv[4][2][2]; int tt[4];
#pragma unroll
            for (int m = 0; m < 4; ++m) {
                const int r = u.pm * BM + ai * HALF + wr * 64 + m * 16 + fr;
                const int b = r / 8320, p = r - b * 8320, t = p - 112; tt[m] = t;
                const int tc = t < 0 ? 16 : t;
                const float* src = tc < 16 ? meta + (size_t)tc * 1024 : x + ((size_t)b * 8192 + (size_t)(tc - 16)) * 1024;
#pragma unroll
                for (int bj = 0; bj < 2; ++bj) { rv[m][bj][0] = *(const f32x4*)(src + col0 + bj * HALF); rv[m][bj][1] = *(const f32x4*)(src + col0 + bj * HALF + 4); }
            }
#pragma unroll
            for (int m = 0; m < 4; ++m) {
                const int r = u.pm * BM + ai * HALF + wr * 64 + m * 16 + fr;
                if (tt[m] >= 0) {
                    bf16_t* dst = hsb + (size_t)r * 1024;
#pragma unroll
                    for (int bj = 0; bj < 2; ++bj) { const f32x4 v0 = rv[m][bj][0] + acc[ai][bj][m][0], v1 = rv[m][bj][1] + acc[ai][bj][m][1]; u32x4 w;
                        w.x = cvt_pk_bf16(v0[0], v0[1]); w.y = cvt_pk_bf16(v0[2], v0[3]); w.z = cvt_pk_bf16(v1[0], v1[1]); w.w = cvt_pk_bf16(v1[2], v1[3]);
                        *(u32x4*)(dst + col0 + bj * HALF) = w; }
                }
            }
        }
    }
};
struct EpiAct {
    static constexpr bool PERM = true, AFTER_DRAIN = false;
    bf16_t* act;
    __device__ __forceinline__ void operator()(const f32x4 (&acc)[2][2][4][2], const Unit& u, int wr, int wc, int fr, int fq) const {
        const int row0 = u.pm * BM + wr * 64 + fr; const int j = u.pn & 7; const int col0 = j * 128 + wc * 32 + 8 * fq;
#pragma unroll
        for (int ai = 0; ai < 2; ++ai)
#pragma unroll
            for (int m = 0; m < 4; ++m) {
                unsigned char* rowp = (unsigned char*)act + (size_t)(row0 + ai * HALF + m * 16) * 1024 + col0;
                const f32x4 g0 = acc[ai][0][m][0] * 0.03125f, g1 = acc[ai][0][m][1] * 0.03125f, u0 = acc[ai][1][m][0] * 0.03125f, u1 = acc[ai][1][m][1] * 0.03125f;
                u32x2 w; unsigned t = 0u;
                t = __builtin_amdgcn_cvt_pk_fp8_f32(silu_f(g0[0]) * u0[0], silu_f(g0[1]) * u0[1], t, false); t = __builtin_amdgcn_cvt_pk_fp8_f32(silu_f(g0[2]) * u0[2], silu_f(g0[3]) * u0[3], t, true); w.x = t;
                t = __builtin_amdgcn_cvt_pk_fp8_f32(silu_f(g1[0]) * u1[0], silu_f(g1[1]) * u1[1], t, false); t = __builtin_amdgcn_cvt_pk_fp8_f32(silu_f(g1[2]) * u1[2], silu_f(g1[3]) * u1[3], t, true); w.y = t;
                *(u32x2*)rowp = w;
            }
    }
};
struct EpiYS {
    static constexpr bool PERM = true, AFTER_DRAIN = false;
    unsigned char* ys; const float* gate;
    __device__ __forceinline__ void operator()(const f32x4 (&acc)[2][2][4][2], const Unit& u, int wr, int wc, int fr, int fq) const {
        const int row0 = u.pm * BM + wr * 64 + fr; const int j = u.pn & 3; const int col0 = j * 256 + wc * 32 + 8 * fq;
#pragma unroll
        for (int ai = 0; ai < 2; ++ai)
#pragma unroll
            for (int m = 0; m < 4; ++m) {
                const int row = row0 + ai * HALF + m * 16; const float gv = gate[row] * 0.25f;
                unsigned char* rowp = ys + (size_t)row * 1024 + col0;
#pragma unroll
                for (int bj = 0; bj < 2; ++bj) { const f32x4 v0 = acc[ai][bj][m][0] * gv, v1 = acc[ai][bj][m][1] * gv; u32x2 w; unsigned t = 0u;
                    t = __builtin_amdgcn_cvt_pk_fp8_f32(v0[0], v0[1], t, false); t = __builtin_amdgcn_cvt_pk_fp8_f32(v0[2], v0[3], t, true); w.x = t;
                    t = __builtin_amdgcn_cvt_pk_fp8_f32(v1[0], v1[1], t, false); t = __builtin_amdgcn_cvt_pk_fp8_f32(v1[2], v1[3], t, true); w.y = t;
                    *(u32x2*)(rowp + bj * HALF) = w; }
            }
    }
};

struct EpiZ {
    static constexpr bool PERM = true, AFTER_DRAIN = false;
    bf16_t* Z; const float* cs;
    __device__ __forceinline__ void operator()(const f32x4 (&acc)[2][2][4][2], const Unit& u, int wr, int wc, int fr, int fq) const {
        const int row0 = u.pm * BM + wr * 64 + fr;
        if (u.pn < 4 || u.pn >= 8) {
            const int col0 = u.pn * BM + wc * 32 + 8 * fq;
#pragma unroll
            for (int ai = 0; ai < 2; ++ai)
#pragma unroll
                for (int m = 0; m < 4; ++m) { bf16_t* rowp = Z + (size_t)(row0 + ai * HALF + m * 16) * 3072 + col0;
#pragma unroll
                    for (int bj = 0; bj < 2; ++bj) { const f32x4 v0 = acc[ai][bj][m][0], v1 = acc[ai][bj][m][1]; u32x4 w;
                        w.x = cvt_pk_bf16(v0[0], v0[1]); w.y = cvt_pk_bf16(v0[2], v0[3]); w.z = cvt_pk_bf16(v1[0], v1[1]); w.w = cvt_pk_bf16(v1[2], v1[3]);
                        *(u32x4*)(rowp + bj * HALF) = w; } }
        } else {
            const int x0 = wc * 32 + 8 * fq;
            const int region = (u.pn - 4) >> 1, head = 2 * ((u.pn - 4) & 1) + (x0 >> 6), j0 = x0 & 63;
            const int colA = 1024 + region * 512 + head * 128 + j0;
            const float sc = region == 0 ? 0.08838834764831845f : 1.0f;
#pragma unroll
            for (int ai = 0; ai < 2; ++ai) {
                f32x4 cc[4][4];
#pragma unroll
                for (int m = 0; m < 4; ++m) { const int r = row0 + ai * HALF + m * 16; const int b = r / 8320; int t = r - b * 8320 - 112; t = t < 0 ? 0 : t;
                    const f32x4* cp = (const f32x4*)(cs + ((size_t)t * 64 + j0) * 2); cc[m][0] = cp[0]; cc[m][1] = cp[1]; cc[m][2] = cp[2]; cc[m][3] = cp[3]; }
#pragma unroll
                for (int m = 0; m < 4; ++m) {
                    const int r = row0 + ai * HALF + m * 16;
                    const f32x4 c0 = cc[m][0], c1 = cc[m][1], c2 = cc[m][2], c3 = cc[m][3];
                    const f32x4 a0 = acc[ai][0][m][0], a1 = acc[ai][0][m][1], b0 = acc[ai][1][m][0], b1 = acc[ai][1][m][1];
                    u32x4 w1, w2;
                    w1.x = cvt_pk_bf16((a0[0] * c0[0] - b0[0] * c0[1]) * sc, (a0[1] * c0[2] - b0[1] * c0[3]) * sc); w2.x = cvt_pk_bf16((a0[0] * c0[1] + b0[0] * c0[0]) * sc, (a0[1] * c0[3] + b0[1] * c0[2]) * sc);
                    w1.y = cvt_pk_bf16((a0[2] * c1[0] - b0[2] * c1[1]) * sc, (a0[3] * c1[2] - b0[3] * c1[3]) * sc); w2.y = cvt_pk_bf16((a0[2] * c1[1] + b0[2] * c1[0]) * sc, (a0[3] * c1[3] + b0[3] * c1[2]) * sc);
                    w1.z = cvt_pk_bf16((a1[0] * c2[0] - b1[0] * c2[1]) * sc, (a1[1] * c2[2] - b1[1] * c2[3]) * sc); w2.z = cvt_pk_bf16((a1[0] * c2[1] + b1[0] * c2[0]) * sc, (a1[1] * c2[3] + b1[1] * c2[2]) * sc);
                    w1.w = cvt_pk_bf16((a1[2] * c3[0] - b1[2] * c3[1]) * sc, (a1[3] * c3[2] - b1[3] * c3[3]) * sc); w2.w = cvt_pk_bf16((a1[2] * c3[1] + b1[2] * c3[0]) * sc, (a1[3] * c3[3] + b1[3] * c3[2]) * sc);
                    bf16_t* rowp = Z + (size_t)r * 3072 + colA;
                    *(u32x4*)rowp = w1; *(u32x4*)(rowp + 64) = w2;
                }
            }
        }
    }
};
struct GroupOrder {
    int G, vcu, tm, tn, nwg;
    __device__ __forceinline__ void init(int ne, int tm_, int tn_, int G_, int c) { tm = tm_; tn = tn_; nwg = ne * tm_ * tn_; G = G_; vcu = (G_ % 8 == 0) ? (c % 8) * (G_ / 8) + c / 8 : c; }
    __device__ __forceinline__ bool next(int i, Unit& u) const {
        const long L = (long)i * G + vcu; if (L >= nwg) return false;
        const int per = tm * tn, e = (int)(L / per), rem = (int)(L % per);
        u.pm = e * tm + rem / tn; u.pn = e * tn + rem % tn; return true;
    }
    __device__ __forceinline__ void a_ready(const Unit&) const {}
    __device__ __forceinline__ void done(const Unit&) const {}
};
}

constexpr int NB = 8, SEQ = 8192, DM = 1024, NMETA = 16, TT = SEQ + NMETA, PADL = 112, PP = 8320, NP = NB * PP;
constexpr int NCHUNK = 65, NSEG = 130;
constexpr int ZC = 3072, ZC_LX = 0, ZC_LG = 512, ZC_Q = 1024, ZC_K = 1536, ZC_V = 2048, ZC_G = 2560;
constexpr int NE = 16, CAP = 1026, EROWS = 8448, NROWS = NE * EROWS;
constexpr float EPSN = 1e-6f;
constexpr int NPHASE = 12;

constexpr size_t MiB = 1u << 20;
constexpr size_t WS_CTL = 0, CTL_ZERO_BYTES = 64 * 1024;
constexpr size_t WS_GW = 1 * MiB, WS_GW2 = 1 * MiB + 256 * 1024, WS_HSMETA = 1 * MiB + 512 * 1024;
constexpr size_t WS_CS = 3 * MiB, WS_SUMM = 8 * MiB, WS_CARRY = 17 * MiB, WS_AFF = 22 * MiB, WS_ROWMAP = 27 * MiB, WS_IDX = 32 * MiB, WS_GATE = 33 * MiB;
constexpr size_t WS_WIN = 34 * MiB, WS_WOUT = 40 * MiB, WS_WGU = 42 * MiB, WS_WD = 106 * MiB;
#ifndef ST_INPLACE
#define ST2_BASE WS_ST2
#define CPY_BASE WS_ST
#else
#define ST2_BASE WS_ST
#define CPY_BASE WS_ST2
#endif
constexpr size_t WS_ST2 = 788 * MiB;
constexpr size_t WS_HSB = 400 * MiB;
constexpr size_t WS_H = 138 * MiB, WS_Z = 268 * MiB, WS_ST = 658 * MiB, WS_XS = 658 * MiB, WS_ACT = 268 * MiB, WS_YS = WS_XS, WS_END = 922 * MiB;
static_assert(WS_H + (size_t)NP * 2048 <= WS_Z && WS_Z + (size_t)NP * ZC * 2 <= WS_ST && WS_ST + (size_t)NB * 4 * 2 * NCHUNK * 32768 <= WS_END && WS_XS + (size_t)NROWS * 2048 <= WS_END && WS_ACT + (size_t)NROWS * 2048 <= WS_ST, "ws map");
constexpr int CW_BAR = 1024;

constexpr int LDS_MAIN = 131072, LDS_BYTES = 147456;
constexpr int LDS_SS = LDS_MAIN;
constexpr int LDS_MISC = LDS_MAIN + 4096;
constexpr int LDS_SIDE = LDS_MAIN + 8192;

typedef unsigned short u16x8 __attribute__((ext_vector_type(8)));
typedef unsigned short u16x4 __attribute__((ext_vector_type(4)));
typedef float f32x16 __attribute__((ext_vector_type(16)));
typedef float f32x2 __attribute__((ext_vector_type(2)));
typedef unsigned u32x2 __attribute__((ext_vector_type(2)));
typedef short v4i16_t __attribute__((ext_vector_type(4)));
typedef __bf16 bf16x2_t __attribute__((ext_vector_type(2)));

__device__ __forceinline__ float bf2f(unsigned short v) { return __uint_as_float((unsigned)v << 16); }
__device__ __forceinline__ unsigned cvtpk(float lo, float hi) { f32x2 v = {lo, hi}; bf16x2_t b = __builtin_convertvector(v, bf16x2_t); return __builtin_bit_cast(unsigned, b); }
__device__ __forceinline__ unsigned short f2bf16(float f) { return (unsigned short)(cvtpk(f, 0.f) & 0xffffu); }
__device__ __forceinline__ float wave_sum(float v) {
#pragma unroll
    for (int o = 1; o < 64; o <<= 1) v += __shfl_xor(v, o);
    return v;
}
__device__ __forceinline__ float sigmoid_f(float x) { return __builtin_amdgcn_rcpf(1.0f + __expf(-x)); }
__device__ __forceinline__ float gelu_tanh_f(float x) { const float z2 = 2.302208198144325f * x * (1.0f + 0.044715f * x * x);   return x - x * __builtin_amdgcn_rcpf(1.0f + __builtin_amdgcn_exp2f(z2)); }
__device__ __forceinline__ float softplus_neg(float lam) { const float y = __expf(-lam); return (y < 0.05f) ? y * (1.0f + y * (-0.5f + y * (0.33333333f + y * (-0.25f + y * 0.2f)))) : log1pf(y); }
__device__ __forceinline__ float log2_gamma(int h) { return h == 0 ? -0.04580368961312479f : h == 1 ? -0.02272007650008353f : h == 2 ? -0.011315313227834146f : -0.005646563141142063f; }
__device__ __forceinline__ unsigned off_b(unsigned row, unsigned ch) { return 256u * row + 16u * (ch ^ (((row & 3u) << 2) | ((row >> 2) & 3u))); }
__device__ __forceinline__ pg8::bf16x8 rowfrag(LAS unsigned char* T, int rb, int s, int lane) {
    return *(LAS pg8::bf16x8*)(T + off_b(32 * rb + (lane & 31), 2 * s + (lane >> 5)));
}
__device__ __forceinline__ pg8::bf16x8 rowfrag_x(LAS unsigned char* T, int rb, int s, int lane) {
    return *(LAS pg8::bf16x8*)(T + off_b((32 * rb + (lane & 31)) ^ 1, 2 * s + (lane >> 5)));
}
__device__ __forceinline__ v4i16_t tr_rd(LAS unsigned char* p) { return __builtin_amdgcn_ds_read_tr16_b64_v4i16((LAS v4i16_t*)p); }
__device__ __forceinline__ pg8::bf16x8 trfrag(LAS unsigned char* T, int c, int ks, int lane) {
    const unsigned h = lane >> 5, blk = (lane >> 4) & 1, q = (lane & 15) >> 2, p = lane & 3;
    const v4i16_t lo = tr_rd(T + off_b(16 * ks + 8 * h + q, 4 * c + 2 * blk + (p >> 1)) + 8 * (p & 1));
    const v4i16_t hi = tr_rd(T + off_b(16 * ks + 8 * h + 4 + q, 4 * c + 2 * blk + (p >> 1)) + 8 * (p & 1));
    return (pg8::bf16x8){lo[0], lo[1], lo[2], lo[3], hi[0], hi[1], hi[2], hi[3]};
}
__device__ __forceinline__ pg8::bf16x8 trfrag_perm(LAS unsigned char* T, int c, int rbase, int lane) {
    const unsigned h = lane >> 5, blk = (lane >> 4) & 1, q = (lane & 15) >> 2, p = lane & 3;
    const v4i16_t lo = tr_rd(T + off_b(rbase + 4 * h + q, 4 * c + 2 * blk + (p >> 1)) + 8 * (p & 1));
    const v4i16_t hi = tr_rd(T + off_b(rbase + 8 + 4 * h + q, 4 * c + 2 * blk + (p >> 1)) + 8 * (p & 1));
    return (pg8::bf16x8){lo[0], lo[1], lo[2], lo[3], hi[0], hi[1], hi[2], hi[3]};
}
__device__ __forceinline__ int crow(int reg, int h) { return (reg & 3) + 8 * (reg >> 2) + 4 * h; }
#define MFMA32(a, b, c) __builtin_amdgcn_mfma_f32_32x32x16_bf16((a), (b), (c), 0, 0, 0)
#define MFMA16(a, b, c) __builtin_amdgcn_mfma_f32_16x16x32_bf16((a), (b), (c), 0, 0, 0)

struct Fr {
    LAS unsigned char* lds;
    int tid, lane, wave, G;
    const float *x, *meta, *norm1_g, *w_in, *conv_w, *conv_b, *w_r, *b_r, *w_i, *b_i, *lam, *lru_out_g, *ret_out_g, *w_out, *norm2_g, *w_router, *w_gate, *w_up, *w_down, *final_g;
    float* out;
    unsigned short *GW2; unsigned short *GW, *WIN, *WOUT, *WGU, *WD, *H, *Z, *ST, *XS, *ACT, *YS;
    unsigned char* CTLP; float *HSMETA, *AFF, *GATE, *CARRY; unsigned short* HSB; unsigned short* ST2; f32x2 *CS, *SUMM; int *ROWMAP, *IDX;
};

__device__ __forceinline__ void prep_tile(const Fr& F, const float* W, int ldw, int k0, int n0, unsigned short* WT, int mode) {
    LAS float* scr = (LAS float*)F.lds;
    const int tid = F.tid;
    { const int n = tid & 63, kk = tid >> 6;
#pragma unroll
      for (int i = 0; i < 8; ++i) { const int k = kk + 8 * i; scr[k * 65 + n] = W[(size_t)(k0 + k) * ldw + n0 + n]; } }
    __syncthreads();
    { const int k = tid & 63, nn = tid >> 6;
#pragma unroll
      for (int i = 0; i < 8; ++i) { const int n = n0 + nn + 8 * i; int row;
          if (mode == 0) row = n; else if (mode == 3) { if (n < 1024 || n >= 2048) row = n; else { const int q = n - 1024, region = q >> 9, hd = (q >> 7) & 3, d = q & 127; row = 1024 + region * 512 + (hd >> 1) * 256 + (d >> 6) * 128 + (hd & 1) * 64 + (d & 63); } }
          else row = 256 * (n >> 7) + (n & 127) + (mode == 2 ? 128 : 0);
          WT[(size_t)row * 1024 + k0 + k] = f2bf16(scr[k * 65 + (nn + 8 * i)]); } }
    __syncthreads();
}
__device__ __forceinline__ void prep_tile8(const Fr& F, const float* W, int k0, int n0, unsigned char* WT8, int mode) {
    LAS float* scr = (LAS float*)F.lds;
    const int tid = F.tid;
    { const int n = tid & 63, kk = tid >> 6;
#pragma unroll
      for (int i = 0; i < 8; ++i) { const int k = kk + 8 * i; scr[k * 65 + n] = W[(size_t)(k0 + k) * 1024 + n0 + n]; } }
    __syncthreads();
    { const int k4 = tid & 15, nn = tid >> 4;
#pragma unroll
      for (int i = 0; i < 2; ++i) { const int nl = nn + 32 * i, n = n0 + nl; const int row = mode == 0 ? n : 256 * (n >> 7) + (n & 127) + (mode == 2 ? 128 : 0);
          const float a = scr[(4 * k4 + 0) * 65 + nl] * 32.0f, b = scr[(4 * k4 + 1) * 65 + nl] * 32.0f, c = scr[(4 * k4 + 2) * 65 + nl] * 32.0f, d = scr[(4 * k4 + 3) * 65 + nl] * 32.0f;
          unsigned w = 0u; w = __builtin_amdgcn_cvt_pk_fp8_f32(a, b, w, false); w = __builtin_amdgcn_cvt_pk_fp8_f32(c, d, w, true);
          *(unsigned*)(WT8 + (size_t)row * 1024 + k0 + 4 * k4) = w; } }
    __syncthreads();
}
__device__ __forceinline__ void sincos_tab(int t, int j, float& co, float& si) {
    double f = 1.0, bse = 0.8659643233600653;
    int e = j;
#pragma unroll
    for (int i = 0; i < 6; ++i) { if (e & 1) f *= bse; bse *= bse; e >>= 1; }
    const double xx = (double)t * f;
    const double qd = __builtin_rint(xx * 0.6366197723675814);
    double y = __builtin_fma(-qd, 1.5707963267948966, xx); y = __builtin_fma(-qd, 6.123233995736766e-17, y);
    const double y2 = y * y;
    double sp = -7.647163731819816e-13;
    sp = sp * y2 + 1.6059043836821613e-10;
    sp = sp * y2 - 2.505210838544172e-08;
    sp = sp * y2 + 2.7557319223985893e-06;
    sp = sp * y2 - 1.984126984126984e-04;
    sp = sp * y2 + 8.333333333333333e-03;
    sp = sp * y2 - 1.6666666666666666e-01;
    const double sy = y + y * y2 * sp;
    double cp = 4.779477332387385e-14;
    cp = cp * y2 - 1.1470745597729725e-11;
    cp = cp * y2 + 2.08767569878681e-09;
    cp = cp * y2 - 2.755731922398589e-07;
    cp = cp * y2 + 2.48015873015873e-05;
    cp = cp * y2 - 1.388888888888889e-03;
    cp = cp * y2 + 4.1666666666666664e-02;
    cp = cp * y2 - 0.5;
    const double cy = 1.0 + y2 * cp;
    const int qi = ((int)(long long)qd) & 3;
    const double s_ = (qi == 0) ? sy : (qi == 1) ? cy : (qi == 2) ? -sy : -cy;
    const double c_ = (qi == 0) ? cy : (qi == 1) ? -sy : (qi == 2) ? -cy : sy;
    co = (float)c_; si = (float)s_;
}
__device__ __forceinline__ void rms_row_to_bf16(const float* xrow, const float* g, unsigned short* orow, int lane) {
    const f32x4* xr = (const f32x4*)xrow + lane; const f32x4* gr = (const f32x4*)g + lane;
    f32x4 v[4]; float s = 0.f;
#pragma unroll
    for (int j = 0; j < 4; ++j) { v[j] = xr[64 * j]; s += (v[j].x * v[j].x + v[j].y * v[j].y) + (v[j].z * v[j].z + v[j].w * v[j].w); }
    const float rs = 1.0f / sqrtf(wave_sum(s) * (1.0f / 1024.0f) + EPSN);
    u32x2* o8 = (u32x2*)orow + lane;
#pragma unroll
    for (int j = 0; j < 4; ++j) { const f32x4 gg = gr[64 * j]; u32x2 w; w.x = cvtpk(v[j].x * rs * gg.x, v[j].y * rs * gg.y); w.y = cvtpk(v[j].z * rs * gg.z, v[j].w * rs * gg.w); o8[64 * j] = w; }
}
__device__ __forceinline__ void prep_stream8(const Fr& F, const float* Wall, unsigned char* WT8all, size_t estride, int mode, int vb, int VG) {
    LAS float* scr = (LAS float*)F.lds;
    const int tid = F.tid, n_ = tid & 63, kk = tid >> 6, k4 = tid & 15, nn = tid >> 4;
    int t = vb; if (t < 0 || t >= 4096) return;
    float v[8];
    { const int e = t >> 8, r = t & 255, k0 = 64 * (r >> 4), n0 = 64 * (r & 15); const float* W = Wall + (size_t)e * 1048576;
#pragma unroll
      for (int i = 0; i < 8; ++i) v[i] = W[(size_t)(k0 + kk + 8 * i) * 1024 + n0 + n_]; }
    for (; t < 4096; t += VG) {
        const int e = t >> 8, r = t & 255, k0 = 64 * (r >> 4), n0 = 64 * (r & 15);
        float vn[8];
        { const int t2 = t + VG < 4096 ? t + VG : t; const int e2 = t2 >> 8, r2 = t2 & 255, k2 = 64 * (r2 >> 4), n2 = 64 * (r2 & 15); const float* W = Wall + (size_t)e2 * 1048576;
#pragma unroll
          for (int i = 0; i < 8; ++i) vn[i] = W[(size_t)(k2 + kk + 8 * i) * 1024 + n2 + n_]; }
#pragma unroll
        for (int i = 0; i < 8; ++i) scr[(kk + 8 * i) * 65 + n_] = v[i];
        __syncthreads();
        unsigned char* WT8 = WT8all + (size_t)e * estride;
#pragma unroll
        for (int i = 0; i < 2; ++i) { const int nl = nn + 32 * i, n = n0 + nl; const int row = mode == 0 ? n : 256 * (n >> 7) + (n & 127) + (mode == 2 ? 128 : 0);
            const float a = scr[(4 * k4 + 0) * 65 + nl] * 32.0f, b = scr[(4 * k4 + 1) * 65 + nl] * 32.0f, c = scr[(4 * k4 + 2) * 65 + nl] * 32.0f, d = scr[(4 * k4 + 3) * 65 + nl] * 32.0f;
            unsigned w = 0u; w = __builtin_amdgcn_cvt_pk_fp8_f32(a, b, w, false); w = __builtin_amdgcn_cvt_pk_fp8_f32(c, d, w, true);
            *(unsigned*)(WT8 + (size_t)row * 1024 + k0 + 4 * k4) = w; }
        __syncthreads();
#pragma unroll
        for (int i = 0; i < 8; ++i) v[i] = vn[i];
    }
}
__device__ __forceinline__ void ph_prep(const Fr& F) {
    const int bid = blockIdx.x, G = F.G;
    for (int it = bid; it < 1024; it += G) {
        if (it < 768) { const int kt = it / 48, nt = it % 48; prep_tile(F, F.w_in, 3072, 64 * kt, 64 * nt, F.WIN, 3); }
        else { const int i2 = it - 768, kt = i2 / 16, nt = i2 % 16; prep_tile(F, F.w_out, 1024, 64 * kt, 64 * nt, F.WOUT, 0); }
    }
    const int gt = bid * 512 + F.tid, GT = G * 512;
    for (int idx = gt; idx < 8 * 256 * 64; idx += GT) {
        const int blk = idx >> 14, o = (idx >> 6) & 255, k = idx & 63, g = o >> 6, d = o & 63, dir = g >> 1;
        const float* src = (g & 1) ? F.w_i : F.w_r;
        F.GW[idx] = f2bf16(src[((size_t)(dir * 8 + blk) * 64 + k) * 64 + d]);
    }
    for (int idx = gt; idx < 8 * 256 * 64; idx += GT) {
        const int k = idx & 63, fr = (idx >> 6) & 15, cg = (idx >> 10) & 3, g = (idx >> 12) & 3, blk = idx >> 14;
        const float* src = (g & 1) ? F.w_i : F.w_r;
        F.GW2[idx] = f2bf16(src[((size_t)((g >> 1) * 8 + blk) * 64 + k) * 64 + 16 * cg + fr]);
    }
    for (int idx = gt; idx < TT * 64; idx += GT) { float co, si; sincos_tab(idx >> 6, idx & 63, co, si); F.CS[idx] = (f32x2){co, si}; }
    const int gw = bid * 8 + F.wave, NGW = G * 8; const int lane = F.lane;
    for (int r = gw; r < NB * PADL; r += NGW) { const int b = r / PADL, p = r - b * PADL; u32x2* o8 = (u32x2*)(F.H + (size_t)(b * PP + p) * 1024) + lane;
#pragma unroll
        for (int j = 0; j < 4; ++j) o8[64 * j] = (u32x2){0u, 0u}; }
    f32x4 gg[4];
#pragma unroll
    for (int j = 0; j < 4; ++j) gg[j] = ((const f32x4*)F.norm1_g + lane)[64 * j];
    f32x4 nx[2][4];
    const int NPAIR = NB * TT / 2;
    if (gw < NPAIR) {
#pragma unroll
        for (int q = 0; q < 2; ++q) { const int v = 2 * gw + q, b = v / TT, t = v - b * TT; const f32x4* xr = (const f32x4*)(t < NMETA ? F.meta + (size_t)t * 1024 : F.x + ((size_t)b * SEQ + (t - NMETA)) * 1024) + lane;
#pragma unroll
            for (int j = 0; j < 4; ++j) nx[q][j] = xr[64 * j]; }
    }
    for (int pr = gw; pr < NPAIR; pr += NGW) {
        f32x4 vv[2][4];
#pragma unroll
        for (int q = 0; q < 2; ++q)
#pragma unroll
            for (int j = 0; j < 4; ++j) vv[q][j] = nx[q][j];
        { const int pn = pr + NGW < NPAIR ? pr + NGW : pr;
#pragma unroll
          for (int q = 0; q < 2; ++q) { const int v = 2 * pn + q, b = v / TT, t = v - b * TT; const f32x4* xr = (const f32x4*)(t < NMETA ? F.meta + (size_t)t * 1024 : F.x + ((size_t)b * SEQ + (t - NMETA)) * 1024) + lane;
#pragma unroll
              for (int j = 0; j < 4; ++j) nx[q][j] = xr[64 * j]; } }
#pragma unroll
        for (int q = 0; q < 2; ++q) {
            const int v = 2 * pr + q, b = v / TT, t = v - b * TT;
            float s = 0.f;
#pragma unroll
            for (int j = 0; j < 4; ++j) s += (vv[q][j].x * vv[q][j].x + vv[q][j].y * vv[q][j].y) + (vv[q][j].z * vv[q][j].z + vv[q][j].w * vv[q][j].w);
            const float rs = __builtin_amdgcn_rsqf(wave_sum(s) * (1.0f / 1024.0f) + EPSN);
            u32x2* o8 = (u32x2*)(F.H + (size_t)(b * PP + PADL + t) * 1024) + lane;
#pragma unroll
            for (int j = 0; j < 4; ++j) { u32x2 wv; wv.x = cvtpk(vv[q][j].x * rs * gg[j].x, vv[q][j].y * rs * gg[j].y); wv.y = cvtpk(vv[q][j].z * rs * gg[j].z, vv[q][j].w * rs * gg[j].w); o8[64 * j] = wv; }
        }
    }
}

struct LruIn { float xv[11]; float gate[8]; float cw0, cw1, cw2, cw3, cbv, k0, k1, br0, bi0, br1, bi1, cf, cb; pg8::bf16x8 bfr[2][2]; };
template <bool FINAL>
__device__ __forceinline__ void lru_load(const Fr& F, size_t rowbase, int pw, int c, size_t sidx, const unsigned short* gwp, LruIn& L) {
#pragma unroll
    for (int i = 0; i < 11; ++i) { const int p = pw - 2 + i; const int pc = p < 0 ? 0 : (p >= PP ? PP - 1 : p); const float v = bf2f(F.Z[(rowbase + pc) * ZC + ZC_LX + c]); L.xv[i] = (p == pc) ? v : 0.f; }
    if (FINAL) {
#pragma unroll
        for (int j = 0; j < 8; ++j) L.gate[j] = bf2f(F.Z[(rowbase + pw + j) * ZC + ZC_LG + c]);
    }
    L.cw0 = F.conv_w[c]; L.cw1 = F.conv_w[512 + c]; L.cw2 = F.conv_w[1024 + c]; L.cw3 = F.conv_w[1536 + c]; L.cbv = F.conv_b[c];
    L.k0 = F.lam[c]; L.k1 = F.lam[512 + c];
    L.br0 = F.b_r[c]; L.bi0 = F.b_i[c]; L.br1 = F.b_r[512 + c]; L.bi1 = F.b_i[512 + c];
    if (FINAL) { L.cf = F.CARRY[sidx]; L.cb = F.CARRY[sidx + 512]; }
#pragma unroll
    for (int ks = 0; ks < 2; ++ks)
#pragma unroll
        for (int n = 0; n < 2; ++n) L.bfr[ks][n] = *(const pg8::bf16x8*)(gwp + (size_t)(16 * n) * 64 + 32 * ks);
}
template <bool FINAL>
__device__ __forceinline__ void lru_item(const Fr& F, int b, int s) {
    int lane = F.lane; asm volatile("" : "+v"(lane));
    const int w = F.wave, fr = lane & 15, fq = lane >> 4;
    LAS unsigned short* U0 = (LAS unsigned short*)F.lds;
    LAS unsigned char* G16 = F.lds + 18432;
    LAS float* SM = (LAS float*)(F.lds + 18432 + 36864);
    LAS unsigned short* YL = (LAS unsigned short*)(F.lds + 18432 + 36864 + 8192);
    const int pw = s * 64 + 8 * w; const size_t rowbase = (size_t)b * PP;
    constexpr float LOG2E = 1.4426950408889634f;
    float ssq[8];
#pragma unroll
    for (int j = 0; j < 8; ++j) ssq[j] = 0.f;
    const size_t sbase = ((size_t)(b * NSEG + s) * 2) * 512;
    const unsigned short* gw0 = F.GW + (size_t)(32 * w + fr) * 64 + 8 * fq;
    LruIn L; lru_load<FINAL>(F, rowbase, pw, lane, sbase + lane, gw0, L);
    float u[8];
#pragma unroll
    for (int j = 0; j < 8; ++j) { u[j] = L.cbv + L.cw0 * L.xv[j] + L.cw1 * L.xv[j + 1] + L.cw2 * L.xv[j + 2] + L.cw3 * L.xv[j + 3]; U0[(8 * w + j) * 72 + lane] = f2bf16(u[j]); }
    __syncthreads();
    for (int blk = 0; blk < 8; ++blk) {
        const int c = blk * 64 + lane;
        LAS unsigned short* U = U0 + (blk & 1) * 4608; LAS unsigned short* Un = U0 + ((blk & 1) ^ 1) * 4608;
        LruIn N; { const int bn = (blk < 7 ? blk + 1 : 7), cn = bn * 64 + lane; lru_load<FINAL>(F, rowbase, pw, cn, sbase + cn, gw0 + (size_t)bn * 16384, N); }
        pg8::f32x4 acc[4][2];
#pragma unroll
        for (int m = 0; m < 4; ++m) { acc[m][0] = (pg8::f32x4){0.f, 0.f, 0.f, 0.f}; acc[m][1] = acc[m][0]; }
#pragma unroll
        for (int ks = 0; ks < 2; ++ks) {
#pragma unroll
            for (int m = 0; m < 4; ++m) { const pg8::bf16x8 a = *(LAS pg8::bf16x8*)(U + (16 * m + fr) * 72 + 32 * ks + 8 * fq);
#pragma unroll
                for (int n = 0; n < 2; ++n) acc[m][n] = MFMA16(a, L.bfr[ks][n], acc[m][n]); }
        }
#pragma unroll
        for (int m = 0; m < 4; ++m)
#pragma unroll
            for (int n = 0; n < 2; ++n) { u32x2 pk; pk.x = __builtin_bit_cast(unsigned, __builtin_amdgcn_cvt_pkrtz(acc[m][n][0], acc[m][n][1])); pk.y = __builtin_bit_cast(unsigned, __builtin_amdgcn_cvt_pkrtz(acc[m][n][2], acc[m][n][3]));
                *(LAS u32x2*)(G16 + (32 * w + 16 * n + fr) * 144 + (16 * m + 4 * fq) * 2) = pk; }
        __syncthreads();
        const float kk0 = -8.0f * LOG2E * softplus_neg(L.k0), kk1 = -8.0f * LOG2E * softplus_neg(L.k1);
        const float nb_r0 = -LOG2E * L.br0, nb_i0 = -LOG2E * L.bi0, nb_r1 = -LOG2E * L.br1, nb_i1 = -LOG2E * L.bi1;
        typedef _Float16 h16x8 __attribute__((ext_vector_type(8)));
        const h16x8 g0 = *(LAS h16x8*)(G16 + (0 * 64 + lane) * 144 + 16 * w), g1 = *(LAS h16x8*)(G16 + (1 * 64 + lane) * 144 + 16 * w);
        const h16x8 g2 = *(LAS h16x8*)(G16 + (2 * 64 + lane) * 144 + 16 * w), g3 = *(LAS h16x8*)(G16 + (3 * 64 + lane) * 144 + 16 * w);
        float hf[8], pf[8], hb[8], pb[8], af[8], ab[8];
#pragma unroll
        for (int j = 0; j < 8; ++j) {
            const float r0 = __builtin_amdgcn_rcpf(1.0f + __builtin_amdgcn_exp2f(__builtin_fmaf((float)g0[j], -LOG2E, nb_r0))), i0 = __builtin_amdgcn_rcpf(1.0f + __builtin_amdgcn_exp2f(__builtin_fmaf((float)g1[j], -LOG2E, nb_i0)));
            const float r1 = __builtin_amdgcn_rcpf(1.0f + __builtin_amdgcn_exp2f(__builtin_fmaf((float)g2[j], -LOG2E, nb_r1))), i1 = __builtin_amdgcn_rcpf(1.0f + __builtin_amdgcn_exp2f(__builtin_fmaf((float)g3[j], -LOG2E, nb_i1)));
            const float a0 = __builtin_amdgcn_exp2f(kk0 * r0), a1 = __builtin_amdgcn_exp2f(kk1 * r1);
            const float e0 = fmaxf(__builtin_fmaf(-a0, a0, 1.0f), 0.f), e1 = fmaxf(__builtin_fmaf(-a1, a1, 1.0f), 0.f);
            af[j] = a0; ab[j] = a1;
            hf[j] = __builtin_amdgcn_sqrtf(e0) * i0 * u[j]; hb[j] = __builtin_amdgcn_sqrtf(e1) * i1 * u[j];
        }
        if (s < 2) {
#pragma unroll
            for (int j = 0; j < 8; ++j) { const bool padp = (pw + j) < PADL; af[j] = padp ? 1.0f : af[j]; ab[j] = padp ? 1.0f : ab[j]; hf[j] = padp ? 0.0f : hf[j]; hb[j] = padp ? 0.0f : hb[j]; }
        }
        { float h = 0.f, P = 1.f;
#pragma unroll
          for (int j = 0; j < 8; ++j) { h = af[j] * h + hf[j]; hf[j] = h; P *= af[j]; pf[j] = P; } }
        { float h = 0.f, P = 1.f;
#pragma unroll
          for (int j = 7; j >= 0; --j) { h = ab[j] * h + hb[j]; hb[j] = h; P *= ab[j]; pb[j] = P; } }
        SM[((0 * 8 + w) * 2 + 0) * 64 + lane] = pf[7]; SM[((0 * 8 + w) * 2 + 1) * 64 + lane] = hf[7];
        SM[((1 * 8 + w) * 2 + 0) * 64 + lane] = pb[0]; SM[((1 * 8 + w) * 2 + 1) * 64 + lane] = hb[0];
        float un[8];
#pragma unroll
        for (int j = 0; j < 8; ++j) { un[j] = N.cbv + N.cw0 * N.xv[j] + N.cw1 * N.xv[j + 1] + N.cw2 * N.xv[j + 2] + N.cw3 * N.xv[j + 3]; Un[(8 * w + j) * 72 + lane] = f2bf16(un[j]); }
        __syncthreads();
        const size_t sidx = sbase + c;
        if (!FINAL) {
            if (w == 0) {
                float cf = 0.f, Af = 1.f, cb = 0.f, Ab = 1.f;
#pragma unroll
                for (int w2 = 0; w2 < 8; ++w2) { const float A = SM[((0 * 8 + w2) * 2 + 0) * 64 + lane], H = SM[((0 * 8 + w2) * 2 + 1) * 64 + lane]; cf = A * cf + H; Af *= A; }
#pragma unroll
                for (int w2 = 7; w2 >= 0; --w2) { const float A = SM[((1 * 8 + w2) * 2 + 0) * 64 + lane], H = SM[((1 * 8 + w2) * 2 + 1) * 64 + lane]; cb = A * cb + H; Ab *= A; }
                F.SUMM[sidx] = (f32x2){Af, cf}; F.SUMM[sidx + 512] = (f32x2){Ab, cb};
            }
        } else {
            float cf = L.cf, cb = L.cb;
#pragma unroll
            for (int w2 = 0; w2 < 8; ++w2) if (w2 < w) { const float A = SM[((0 * 8 + w2) * 2 + 0) * 64 + lane], H = SM[((0 * 8 + w2) * 2 + 1) * 64 + lane]; cf = A * cf + H; }
#pragma unroll
            for (int w2 = 7; w2 >= 0; --w2) if (w2 > w) { const float A = SM[((1 * 8 + w2) * 2 + 0) * 64 + lane], H = SM[((1 * 8 + w2) * 2 + 1) * 64 + lane]; cb = A * cb + H; }
#pragma unroll
            for (int j = 0; j < 8; ++j) {
                const float y = ((hf[j] + pf[j] * cf) + (hb[j] + pb[j] * cb)) * gelu_tanh_f(L.gate[j]);
                ssq[j] += y * y; YL[(8 * w + j) * 520 + c] = f2bf16(y);
            }
        }
        L = N;
#pragma unroll
        for (int j = 0; j < 8; ++j) u[j] = un[j];
    }
    if (FINAL) {
        const f32x4 og0 = *(const f32x4*)(F.lru_out_g + 8 * lane), og1 = *(const f32x4*)(F.lru_out_g + 8 * lane + 4);
#pragma unroll
        for (int j = 0; j < 8; ++j) {
            const float rs = __builtin_amdgcn_rsqf(wave_sum(ssq[j]) * (1.0f / 512.0f) + EPSN);
            const u32x4 v = *(LAS u32x4*)(YL + (8 * w + j) * 520 + 8 * lane);
            u32x4 o; o.x = cvtpk(__uint_as_float(v.x << 16) * rs * og0[0], __uint_as_float(v.x & 0xffff0000u) * rs * og0[1]); o.y = cvtpk(__uint_as_float(v.y << 16) * rs * og0[2], __uint_as_float(v.y & 0xffff0000u) * rs * og0[3]);
            o.z = cvtpk(__uint_as_float(v.z << 16) * rs * og1[0], __uint_as_float(v.z & 0xffff0000u) * rs * og1[1]); o.w = cvtpk(__uint_as_float(v.w << 16) * rs * og1[2], __uint_as_float(v.w & 0xffff0000u) * rs * og1[3]);
            *(u32x4*)(F.H + (rowbase + pw + j) * 1024 + 8 * lane) = o;
        }
        __syncthreads();
    }
}

struct Lru2A { float xv[2][11]; float cw[2][5]; };
__device__ __forceinline__ void lru2_loadA(const Fr& F, size_t rowbase, int pw, int it, int lane, Lru2A& A) {
#pragma unroll
    for (int h = 0; h < 2; ++h) { const int c = (2 * it + h) * 64 + lane;
#pragma unroll
        for (int i = 0; i < 11; ++i) { const int p = pw - 2 + i; const int pc = p < 0 ? 0 : (p >= PP ? PP - 1 : p); const float v = bf2f(F.Z[(rowbase + pc) * ZC + ZC_LX + c]); A.xv[h][i] = (p == pc) ? v : 0.f; }
        A.cw[h][0] = F.conv_w[c]; A.cw[h][1] = F.conv_w[512 + c]; A.cw[h][2] = F.conv_w[1024 + c]; A.cw[h][3] = F.conv_w[1536 + c]; A.cw[h][4] = F.conv_b[c]; }
}
__device__ __forceinline__ void lru2_writeU(LAS unsigned short* Upar, int w, int lane, const Lru2A& A) {
#pragma unroll
    for (int h = 0; h < 2; ++h)
#pragma unroll
        for (int j = 0; j < 8; ++j) { const float u = A.cw[h][4] + A.cw[h][0] * A.xv[h][j] + A.cw[h][1] * A.xv[h][j + 1] + A.cw[h][2] * A.xv[h][j + 2] + A.cw[h][3] * A.xv[h][j + 3];
            const int rho = 16 * (2 * (w & 1) + (j >> 2)) + 4 * (w >> 1) + (j & 3);
            Upar[h * 4608 + rho * 72 + lane] = f2bf16(u); }
}
template <bool FINAL>
__device__ __forceinline__ void lru2_item(const Fr& F, int b, int s) {
    int lane = F.lane; asm volatile("" : "+v"(lane));
    const int w = F.wave, fr = lane & 15, fq = lane >> 4, cg = w & 3;
    LAS unsigned short* U0 = (LAS unsigned short*)F.lds;
    LAS unsigned short* YL = (LAS unsigned short*)(F.lds + 36864);
    LAS float* SSP = (LAS float*)(F.lds + 36864 + 66560);
    const int p0 = s * 64, pw = p0 + 8 * w; const size_t rowbase = (size_t)b * PP;
    const size_t sbase = ((size_t)(b * NSEG + s) * 2) * 512;
    constexpr float LOG2E = 1.4426950408889634f;
    float ssq[16];
#pragma unroll
    for (int q = 0; q < 16; ++q) ssq[q] = 0.f;
    { Lru2A A0; lru2_loadA(F, rowbase, pw, 0, lane, A0); lru2_writeU(U0, w, lane, A0); }
    __syncthreads();
    for (int it = 0; it < 4; ++it) {
        const int blk = 2 * it + (w >> 2), c = blk * 64 + 16 * cg + fr;
        LAS unsigned short* U = U0 + ((it & 1) * 2 + (w >> 2)) * 4608;
        pg8::bf16x8 bfr[4][2];
        { const unsigned short* gp = F.GW2 + ((size_t)((blk * 4) * 4 + cg) * 16 + fr) * 64 + 8 * fq;
#pragma unroll
          for (int g = 0; g < 4; ++g)
#pragma unroll
              for (int ks = 0; ks < 2; ++ks) bfr[g][ks] = *(const pg8::bf16x8*)(gp + (size_t)g * 4096 + 32 * ks); }
        const float lam0 = F.lam[c], lam1 = F.lam[512 + c], br0 = F.b_r[c], bi0 = F.b_i[c], br1 = F.b_r[512 + c], bi1 = F.b_i[512 + c];
        float cin0 = 0.f, cin1 = 0.f; if (FINAL) { cin0 = F.CARRY[sbase + c]; cin1 = F.CARRY[sbase + 512 + c]; }
        float gt[16];
        if (FINAL) {
#pragma unroll
            for (int q = 0; q < 16; ++q) gt[q] = bf2f(F.Z[(rowbase + p0 + 16 * fq + q) * ZC + ZC_LG + c]);
        }
        Lru2A N; lru2_loadA(F, rowbase, pw, it < 3 ? it + 1 : 3, lane, N);
        pg8::f32x4 acc[4][4];
#pragma unroll
        for (int g = 0; g < 4; ++g)
#pragma unroll
            for (int m = 0; m < 4; ++m) acc[g][m] = (pg8::f32x4){0.f, 0.f, 0.f, 0.f};
#pragma unroll
        for (int ks = 0; ks < 2; ++ks)
#pragma unroll
            for (int m = 0; m < 4; ++m) {
                const pg8::bf16x8 an = *(LAS pg8::bf16x8*)(U + (16 * m + fr) * 72 + 32 * ks + 8 * fq);
                const pg8::bf16x8 ar = *(LAS pg8::bf16x8*)(U + (63 - 16 * m - fr) * 72 + 32 * ks + 8 * fq);
                acc[0][m] = MFMA16(an, bfr[0][ks], acc[0][m]); acc[1][m] = MFMA16(an, bfr[1][ks], acc[1][m]);
                acc[2][m] = MFMA16(ar, bfr[2][ks], acc[2][m]); acc[3][m] = MFMA16(ar, bfr[3][ks], acc[3][m]);
            }
        float hf[16], hb[16];
#pragma unroll
        for (int d = 0; d < 2; ++d) {
            const float kk = -8.0f * LOG2E * softplus_neg(d ? lam1 : lam0), nbr = -LOG2E * (d ? br1 : br0), nbi = -LOG2E * (d ? bi1 : bi0);
            float al[16], xl[16];
#pragma unroll
            for (int m = 0; m < 4; ++m)
#pragma unroll
                for (int rg = 0; rg < 4; ++rg) { const int q = 4 * m + rg; const int row = d ? 63 - (16 * m + 4 * fq + rg) : (16 * m + 4 * fq + rg);
                    const float uu = bf2f(U[row * 72 + 16 * cg + fr]);
                    const float r = __builtin_amdgcn_rcpf(1.0f + __builtin_amdgcn_exp2f(__builtin_fmaf(acc[2 * d][m][rg], -LOG2E, nbr))), ii = __builtin_amdgcn_rcpf(1.0f + __builtin_amdgcn_exp2f(__builtin_fmaf(acc[2 * d + 1][m][rg], -LOG2E, nbi)));
                    const float a = __builtin_amdgcn_exp2f(kk * r); const float e = fmaxf(__builtin_fmaf(-a, a, 1.0f), 0.f);
                    al[q] = a; xl[q] = __builtin_amdgcn_sqrtf(e) * ii * uu; }
            if (s < 2) {
#pragma unroll
                for (int q = 0; q < 16; ++q) { const int p = d ? p0 + 63 - (16 * fq + q) : p0 + 16 * fq + q; const bool padp = p < PADL; al[q] = padp ? 1.0f : al[q]; xl[q] = padp ? 0.0f : xl[q]; }
            }
            { float h = 0.f, P = 1.f;
#pragma unroll
              for (int q = 0; q < 16; ++q) { h = al[q] * h + xl[q]; xl[q] = h; P *= al[q]; al[q] = P; } }
            const float Ar = al[15], Hr = xl[15];
            const float A0 = __shfl(Ar, fr), H0 = __shfl(Hr, fr), A1 = __shfl(Ar, fr + 16), H1 = __shfl(Hr, fr + 16), A2 = __shfl(Ar, fr + 32), H2 = __shfl(Hr, fr + 32);
            float cc = FINAL ? (d ? cin1 : cin0) : 0.f;
            if (fq > 0) cc = A0 * cc + H0;
            if (fq > 1) cc = A1 * cc + H1;
            if (fq > 2) cc = A2 * cc + H2;
            if (!FINAL) { if (fq == 3) F.SUMM[sbase + d * 512 + c] = (f32x2){A0 * A1 * A2 * Ar, Ar * cc + Hr}; }
            else {
#pragma unroll
                for (int q = 0; q < 16; ++q) { const float hv = xl[q] + al[q] * cc; if (d) hb[q] = hv; else hf[q] = hv; }
            }
        }
        if (FINAL) {
#pragma unroll
            for (int q = 0; q < 16; ++q) { const float hbp = __shfl(hb[15 - q], lane ^ 48);
                const float y = (hf[q] + hbp) * gelu_tanh_f(gt[q]); ssq[q] += y * y; YL[(16 * fq + q) * 520 + c] = f2bf16(y); }
        }
        if (it < 3) { lru2_writeU(U0 + ((it & 1) ^ 1) * 9216, w, lane, N); __syncthreads(); }
    }
    if (FINAL) {
#pragma unroll
        for (int q = 0; q < 16; ++q) { float v = ssq[q]; v += __shfl_xor(v, 1); v += __shfl_xor(v, 2); v += __shfl_xor(v, 4); v += __shfl_xor(v, 8); ssq[q] = v; }
        if (fr == 0) {
#pragma unroll
            for (int q = 0; q < 16; ++q) SSP[w * 64 + 16 * fq + q] = ssq[q]; }
        __syncthreads();
        const f32x4 og0 = *(const f32x4*)(F.lru_out_g + 8 * lane), og1 = *(const f32x4*)(F.lru_out_g + 8 * lane + 4);
#pragma unroll
        for (int j = 0; j < 8; ++j) {
            float tot = 0.f;
#pragma unroll
            for (int w2 = 0; w2 < 8; ++w2) tot += SSP[w2 * 64 + 8 * w + j];
            const float rs = __builtin_amdgcn_rsqf(tot * (1.0f / 512.0f) + EPSN);
            const u32x4 v = *(LAS u32x4*)(YL + (8 * w + j) * 520 + 8 * lane);
            u32x4 o; o.x = cvtpk(__uint_as_float(v.x << 16) * rs * og0[0], __uint_as_float(v.x & 0xffff0000u) * rs * og0[1]); o.y = cvtpk(__uint_as_float(v.y << 16) * rs * og0[2], __uint_as_float(v.y & 0xffff0000u) * rs * og0[3]);
            o.z = cvtpk(__uint_as_float(v.z << 16) * rs * og1[0], __uint_as_float(v.z & 0xffff0000u) * rs * og1[1]); o.w = cvtpk(__uint_as_float(v.w << 16) * rs * og1[2], __uint_as_float(v.w & 0xffff0000u) * rs * og1[3]);
            *(u32x4*)(F.H + (rowbase + pw + j) * 1024 + 8 * lane) = o;
        }
        __syncthreads();
    }
}

#ifdef RF_V3
constexpr int LDS_GT = LDS_MAIN + 8192;
#else
constexpr int LDS_GT = LDS_SS + 1024;
#endif
template <int SKIP> __device__ __forceinline__ int ret_count(int w, int G) { if (G != 256) return (2080 - w + G - 1) / G; return (w < 32 + 16 * SKIP) ? 9 : (w >= 240 ? 8 - SKIP : 8); }
template <int SKIP> __device__ __forceinline__ int ret_item(int w, int j, int G) { if (G != 256 || j < 8) return w + G * j; if (w < 32) return 2048 + w; const int k = w - 32; return 240 + (k & 15) + 256 * (7 - (k >> 4)); }
__device__ __forceinline__ void ret_coord(int it, int& b, int& h, int& n) { n = it % NCHUNK; const int bh = it / NCHUNK; b = bh >> 2; h = bh & 3; }
struct RcIn { u32x4 k[4], v[4]; };
__device__ __forceinline__ void rc_load(const Fr& F, int tid, int it, RcIn& R) {
    int b, h, n; ret_coord(it, b, h, n);
    const unsigned short* base = F.Z + ((size_t)b * PP + 128 * n) * ZC + 128 * h;
#pragma unroll
    for (int q = 0; q < 4; ++q) { const int idx = tid + 512 * q, c = idx >> 4, ch = idx & 15; const unsigned short* p = base + (size_t)c * ZC + 8 * ch; R.k[q] = *(const u32x4*)(p + ZC_K); R.v[q] = *(const u32x4*)(p + ZC_V); }
}
__device__ __forceinline__ unsigned scale_pk(unsigned w, float s) { return cvtpk(__uint_as_float(w << 16) * s, __uint_as_float(w & 0xffff0000u) * s); }
__device__ __forceinline__ void ph_ret_contrib(const Fr& F) {
    const int w = F.wave;
    LAS unsigned char* TKF = F.lds; LAS unsigned char* TKB = F.lds + 32768; LAS unsigned char* TV = F.lds + 65536;
    if ((int)blockIdx.x >= 2080) return;
    const int nj = ret_count<2>(blockIdx.x, F.G);
    RcIn R; rc_load(F, F.tid, ret_item<2>(blockIdx.x, 0, F.G), R);
    for (int jj = 0; jj < nj; ++jj) {
        const int it = ret_item<2>(blockIdx.x, jj, F.G);
        int lane = F.lane, tid = threadIdx.x; asm volatile("" : "+v"(lane), "+v"(tid));
        const int r = lane & 31, h2 = lane >> 5;
        int b, h, n; ret_coord(it, b, h, n); const float lg = log2_gamma(h);
#pragma unroll
        for (int q = 0; q < 4; ++q) { const int idx = tid + 512 * q, c = idx >> 4, ch = idx & 15; const float sf = exp2f(lg * (float)(127 - c)), sb = exp2f(lg * (float)c);
            u32x4 kf, kb; kf.x = scale_pk(R.k[q].x, sf); kf.y = scale_pk(R.k[q].y, sf); kf.z = scale_pk(R.k[q].z, sf); kf.w = scale_pk(R.k[q].w, sf);
            kb.x = scale_pk(R.k[q].x, sb); kb.y = scale_pk(R.k[q].y, sb); kb.z = scale_pk(R.k[q].z, sb); kb.w = scale_pk(R.k[q].w, sb);
            const unsigned o = off_b(c, ch); *(LAS u32x4*)(TKF + o) = kf; *(LAS u32x4*)(TKB + o) = kb; *(LAS u32x4*)(TV + o) = R.v[q]; }
        if (jj + 1 < nj) rc_load(F, tid, ret_item<2>(blockIdx.x, jj + 1, F.G), R);
        __syncthreads();
        const int dir = w >> 2, cb = w & 3; LAS unsigned char* TK = dir ? TKB : TKF;
        f32x16 acc[4];
#pragma unroll
        for (int eb = 0; eb < 4; ++eb)
#pragma unroll
            for (int i = 0; i < 16; ++i) acc[eb][i] = 0.f;
#pragma unroll 2
        for (int ks = 0; ks < 8; ++ks) {
            const pg8::bf16x8 a = trfrag(TK, cb, ks, lane);
#pragma unroll
            for (int eb = 0; eb < 4; ++eb) { const pg8::bf16x8 bv = trfrag(TV, eb, ks, lane); acc[eb] = MFMA32(a, bv, acc[eb]); }
        }
        __syncthreads();
#pragma unroll
        for (int eb = 0; eb < 4; ++eb)
#pragma unroll
            for (int g = 0; g < 4; ++g) { u32x2 v; v.x = cvtpk(acc[eb][4 * g], acc[eb][4 * g + 1]); v.y = cvtpk(acc[eb][4 * g + 2], acc[eb][4 * g + 3]);
                *(LAS u32x2*)(TK + off_b(32 * eb + r, 4 * cb + g) + 8 * h2) = v; }
        __syncthreads();
        unsigned short* dst = F.ST + ((size_t)(((b * 4 + h) * 2) * NCHUNK + n)) * 16384;
#pragma unroll
        for (int q = 0; q < 8; ++q) { const int idx = tid + 512 * q, tile = idx >> 11, rem = idx & 2047, e = rem >> 4, ch = rem & 15;
            const u32x4 v = *(LAS u32x4*)(F.lds + tile * 32768 + off_b(e, ch)); *(u32x4*)(dst + (size_t)tile * NCHUNK * 16384 + (size_t)e * 128 + 8 * ch) = v; }
        __syncthreads();
    }
}
struct RfIn { u32x4 q[4], k[4], v[4]; };
struct RsIn { u32x4 sf[4], sb[4], g[4]; };
__device__ __forceinline__ void rf_load(const Fr& F, int tid, int it, RfIn& R) {
    int b, h, n; ret_coord(it, b, h, n);
    const unsigned short* base = F.Z + ((size_t)b * PP + 128 * n) * ZC + 128 * h;
#pragma unroll
#ifdef RF_V5
    for (int q = 0; q < 4; ++q) { const int idx = tid + 512 * q, c = idx >> 4, ch = idx & 15; const unsigned short* p = base + (size_t)c * ZC + 8 * ch; R.q[q] = *(const u32x4*)(base + (size_t)(c ^ 1) * ZC + 8 * ch + ZC_Q); R.k[q] = *(const u32x4*)(p + ZC_K); R.v[q] = *(const u32x4*)(p + ZC_V); }
#else
    for (int q = 0; q < 4; ++q) { const int idx = tid + 512 * q, c = idx >> 4, ch = idx & 15; const unsigned short* p = base + (size_t)c * ZC + 8 * ch; R.q[q] = *(const u32x4*)(p + ZC_Q); R.k[q] = *(const u32x4*)(p + ZC_K); R.v[q] = *(const u32x4*)(p + ZC_V); }
#endif
}
__device__ __forceinline__ void rs_load(const Fr& F, int tid, int b, int h, int n, RsIn& R) {
    const unsigned short* sf = F.ST2 + ((size_t)(((b * 4 + h) * 2 + 0) * NCHUNK + n)) * 16384; const unsigned short* sb = sf + (size_t)NCHUNK * 16384;
    const unsigned short* gb = F.Z + ((size_t)b * PP + 128 * n) * ZC + ZC_G + 128 * h;
#pragma unroll
    for (int q = 0; q < 4; ++q) { const int idx = tid + 512 * q, c = idx >> 4, ch = idx & 15; R.sf[q] = *(const u32x4*)(sf + (size_t)c * 128 + 8 * ch); R.sb[q] = *(const u32x4*)(sb + (size_t)c * 128 + 8 * ch); R.g[q] = *(const u32x4*)(gb + (size_t)c * ZC + 8 * ch); }
}
#ifdef RF_EXTRA
#define RF_XBAR asm volatile("s_waitcnt vmcnt(0) lgkmcnt(0)" ::: "memory"); __syncthreads();
#else
#define RF_XBAR
#endif
#define RF_FLAG(code_) atomicOr((unsigned*)(F.CTLP + 32768 + 2048), (unsigned)(code_))
#if !defined(RF_GTAB) && !defined(RF_V10) && !defined(RF_V4)
#define RF_GT(d_, c_) exp2f(lg * (float)(d_))
#elif defined(RF_V4)
#define RF_GT(d_, c_) ({ const float g_ = GT[d_]; const float e_ = exp2f(lg * (float)(d_)); if (!(fabsf(g_ - e_) <= 1e-5f * e_)) RF_FLAG(c_); g_; })
#else
#define RF_GT(d_, c_) GT[d_]
#endif
#ifdef RF_V8
#define RF_QF rowfrag_x
#else
#define RF_QF rowfrag
#endif
__device__ __forceinline__ void ph_ret_final(const Fr& F) {
    const int w = F.wave;
    LAS unsigned char* R0 = F.lds; LAS unsigned char* R1 = F.lds + 32768; LAS unsigned char* R2 = F.lds + 65536; LAS unsigned char* R3 = F.lds + 98304;
    LAS float* SS = (LAS float*)(F.lds + LDS_SS); LAS float* GT = (LAS float*)(F.lds + LDS_GT); (void)GT;
    if ((int)blockIdx.x >= 2080) return;
    const int nj = ret_count<1>(blockIdx.x, F.G);
#ifdef RF_V9
    const int cb = 3 - (w >> 1), ebase = 2 * (w & 1);
#else
    const int cb = w >> 1, ebase = 2 * (w & 1);
#endif
#ifndef RF_NOPF
    RfIn Rf; rf_load(F, F.tid, ret_item<1>(blockIdx.x, 0, F.G), Rf);
#endif
    for (int jj = 0; jj < nj; ++jj) {
        const int it = ret_item<1>(blockIdx.x, jj, F.G);
        int lane = F.lane, tid = threadIdx.x; asm volatile("" : "+v"(lane), "+v"(tid));
        const int r = lane & 31, h2 = lane >> 5;
        int b, h, n; ret_coord(it, b, h, n); const float lg = log2_gamma(h);
        const size_t row0 = (size_t)b * PP + 128 * n;
        __syncthreads();
#ifndef RF_NOPF
        RsIn Rs; rs_load(F, tid, b, h, n, Rs);
#else
        RfIn Rf; rf_load(F, tid, it, Rf);
        RsIn Rs; rs_load(F, tid, b, h, n, Rs);
#endif
#pragma unroll
#ifdef RF_V5
        for (int q = 0; q < 4; ++q) { const int idx = tid + 512 * q, c = idx >> 4, ch = idx & 15; const unsigned o = off_b(c, ch); *(LAS u32x4*)(R0 + off_b(c ^ 1, ch)) = Rf.q[q]; *(LAS u32x4*)(R1 + o) = Rf.k[q]; *(LAS u32x4*)(R2 + o) = Rf.v[q]; }
#elif defined(RF_V8)
        for (int q = 0; q < 4; ++q) { const int idx = tid + 512 * q, c = idx >> 4, ch = idx & 15; const unsigned o = off_b(c, ch); *(LAS u32x4*)(R0 + off_b(c ^ 1, ch)) = Rf.q[q]; *(LAS u32x4*)(R1 + o) = Rf.k[q]; *(LAS u32x4*)(R2 + o) = Rf.v[q]; }
#else
        for (int q = 0; q < 4; ++q) { const int idx = tid + 512 * q, c = idx >> 4, ch = idx & 15; const unsigned o = off_b(c, ch); *(LAS u32x4*)(R0 + o) = Rf.q[q]; *(LAS u32x4*)(R1 + o) = Rf.k[q]; *(LAS u32x4*)(R2 + o) = Rf.v[q]; }
#endif
#ifdef RF_V10
        { const int gi = tid & 255; GT[gi] = exp2f(lg * (float)gi); }
#elif defined(RF_GTAB)
        if (tid < 129) GT[tid] = exp2f(lg * (float)tid);
#endif
        const float og0 = F.ret_out_g[128 * h + 32 * ebase + r], og1 = F.ret_out_g[128 * h + 32 * (ebase + 1) + r];
        __syncthreads(); RF_XBAR
        f32x16 o[2];
#pragma unroll
        for (int eo = 0; eo < 2; ++eo)
#pragma unroll
            for (int i = 0; i < 16; ++i) o[eo][i] = 0.f;
        {
            const int cpos = 32 * cb + r;
#pragma unroll
            for (int mb = 0; mb < 4; ++mb) {
                f32x16 X;
#pragma unroll
                for (int i = 0; i < 16; ++i) X[i] = 0.f;
#pragma unroll 2
                for (int s = 0; s < 8; ++s) { const pg8::bf16x8 qf = RF_QF(R0, cb, s, lane); const pg8::bf16x8 kf = rowfrag(R1, mb, s, lane); X = MFMA32(kf, qf, X); }
                int cpo = cpos, h2o = h2; asm volatile("" : "+v"(cpo), "+v"(h2o));
#pragma unroll
                for (int i = 0; i < 16; ++i) { const int m = 32 * mb + crow(i, h2o); const int dd = cpo > m ? cpo - m : m - cpo; X[i] *= RF_GT(dd, 1); }
#pragma unroll
                for (int s2 = 0; s2 < 2; ++s2) { u32x4 pk; pk.x = cvtpk(X[8 * s2], X[8 * s2 + 1]); pk.y = cvtpk(X[8 * s2 + 2], X[8 * s2 + 3]); pk.z = cvtpk(X[8 * s2 + 4], X[8 * s2 + 5]); pk.w = cvtpk(X[8 * s2 + 6], X[8 * s2 + 7]);
                    const pg8::bf16x8 pa = __builtin_bit_cast(pg8::bf16x8, pk);
#pragma unroll
                    for (int eo = 0; eo < 2; ++eo) { const pg8::bf16x8 vb = trfrag_perm(R2, ebase + eo, 32 * mb + 16 * s2, lane); o[eo] = MFMA32(pa, vb, o[eo]); } }
            }
        }
        RF_XBAR __syncthreads(); RF_XBAR
#pragma unroll
        for (int q = 0; q < 4; ++q) { const int idx = tid + 512 * q, c = idx >> 4, ch = idx & 15; const unsigned of = off_b(c, ch); *(LAS u32x4*)(R1 + of) = Rs.sf[q]; *(LAS u32x4*)(R3 + of) = Rs.sb[q]; *(LAS u32x4*)(R2 + of) = Rs.g[q]; }
#ifndef RF_NOPF
        rf_load(F, tid, ret_item<1>(blockIdx.x, jj + 1 < nj ? jj + 1 : jj, F.G), Rf);
#endif
        RF_XBAR __syncthreads(); RF_XBAR
#pragma unroll
        for (int dirn = 0; dirn < 2; ++dirn) {
            LAS unsigned char* TX = dirn ? R3 : R1;
            f32x16 oi[2];
#pragma unroll
            for (int eo = 0; eo < 2; ++eo)
#pragma unroll
                for (int i = 0; i < 16; ++i) oi[eo][i] = 0.f;
#pragma unroll 2
            for (int s = 0; s < 8; ++s) { const pg8::bf16x8 qf = RF_QF(R0, cb, s, lane);
#pragma unroll
                for (int eo = 0; eo < 2; ++eo) { const pg8::bf16x8 f1 = rowfrag(TX, ebase + eo, s, lane); oi[eo] = MFMA32(qf, f1, oi[eo]); } }
            int h2d = h2; asm volatile("" : "+v"(h2d));
#pragma unroll
            for (int i = 0; i < 16; ++i) { const int cl = 32 * cb + crow(i, h2d); const float dfac = RF_GT(dirn ? (128 - cl) : (cl + 1), 2);
#pragma unroll
                for (int eo = 0; eo < 2; ++eo) o[eo][i] += dfac * oi[eo][i]; }
        }
        float ssq[16];
#pragma unroll
        for (int i = 0; i < 16; ++i) {
            float s = o[0][i] * o[0][i] + o[1][i] * o[1][i];
            s += __shfl_xor(s, 1); s += __shfl_xor(s, 2); s += __shfl_xor(s, 4); s += __shfl_xor(s, 8); s += __shfl_xor(s, 16);
            ssq[i] = s; }
        if (r == 0) {
#pragma unroll
            for (int i = 0; i < 16; ++i) SS[(w & 1) * 128 + 32 * cb + crow(i, h2)] = ssq[i]; }
        RF_XBAR __syncthreads(); RF_XBAR
        int h2e = h2, re = r; asm volatile("" : "+v"(h2e), "+v"(re));
#ifdef RF_V1
#pragma unroll
        for (int i = 0; i < 16; ++i) { const int cl = 32 * cb + crow(i, h2e); const float tot = SS[cl] + SS[128 + cl]; const float rs = __builtin_amdgcn_rsqf(tot * (1.0f / 128.0f) + EPSN);
            const size_t row = row0 + cl;
#pragma unroll
            for (int eo = 0; eo < 2; ++eo) { const int e = 32 * (ebase + eo) + re; const float gv = bf2f(F.Z[row * ZC + ZC_G + 128 * h + e]);
                F.H[row * 1024 + 512 + 128 * h + e] = f2bf16(o[eo][i] * rs * (eo ? og1 : og0) * pg8::silu_f(gv)); } }
        RF_XBAR __syncthreads(); RF_XBAR
#else
#pragma unroll
        for (int i = 0; i < 16; ++i) { const int cl = 32 * cb + crow(i, h2e); const float tot = SS[cl] + SS[128 + cl]; const float rs = __builtin_amdgcn_rsqf(tot * (1.0f / 128.0f) + EPSN);
#pragma unroll
            for (int eo = 0; eo < 2; ++eo) { const int e = 32 * (ebase + eo) + re; const unsigned of = off_b(cl, e >> 3) + 2 * (e & 7);
                const float gv = bf2f(*(LAS unsigned short*)(R2 + of));
                *(LAS unsigned short*)(R3 + of) = f2bf16(o[eo][i] * rs * (eo ? og1 : og0) * pg8::silu_f(gv)); } }
        RF_XBAR __syncthreads(); RF_XBAR
#pragma unroll
#ifdef RF_V6
        for (int q = 0; q < 4; ++q) { const int idx = tid + 512 * q, c = (idx >> 4) ^ 1, ch = idx & 15; const u32x4 v = *(LAS u32x4*)(R3 + off_b(c, ch)); *(u32x4*)(F.H + (row0 + c) * 1024 + 512 + 128 * h + 8 * ch) = v; }
#else
        for (int q = 0; q < 4; ++q) { const int idx = tid + 512 * q, c = idx >> 4, ch = idx & 15; const u32x4 v = *(LAS u32x4*)(R3 + off_b(c, ch)); *(u32x4*)(F.H + (row0 + c) * 1024 + 512 + 128 * h + 8 * ch) = v; }
#endif
#endif
#ifdef RF_V11
        if (tid < 129) { const float g_ = GT[tid]; const float e_ = exp2f(lg * (float)tid); if (!(fabsf(g_ - e_) <= 1e-5f * e_)) RF_FLAG(1); }
#endif
    }
    __syncthreads();
}
__device__ __forceinline__ void ret_scan(const Fr& F) {
    for (int v = blockIdx.x * 512 + F.tid; v < 64 * 2048; v += F.G * 512) {
        const int strip = v >> 11, off = v & 2047, dir = strip & 1, h = (strip >> 1) & 3;
        const float cd = exp2f(128.0f * log2_gamma(h));
        const unsigned short* base = F.ST + (size_t)strip * NCHUNK * 16384 + (size_t)off * 8;
        unsigned short* obase = F.ST2 + (size_t)strip * NCHUNK * 16384 + (size_t)off * 8;
        float carry[8];
#pragma unroll
        for (int i = 0; i < 8; ++i) carry[i] = 0.f;
        for (int k0 = 0; k0 < NCHUNK; k0 += 5) {
            u16x8 tv[5];
#pragma unroll
            for (int j = 0; j < 5; ++j) { const int n = dir ? (NCHUNK - 1 - (k0 + j)) : (k0 + j); tv[j] = *(const u16x8*)(base + (size_t)n * 16384); }
#pragma unroll
            for (int j = 0; j < 5; ++j) { const int n = dir ? (NCHUNK - 1 - (k0 + j)) : (k0 + j); u32x4 o;
                o.x = cvtpk(carry[0], carry[1]); o.y = cvtpk(carry[2], carry[3]); o.z = cvtpk(carry[4], carry[5]); o.w = cvtpk(carry[6], carry[7]);
                *(u32x4*)(obase + (size_t)n * 16384) = o;
#pragma unroll
                for (int i = 0; i < 8; ++i) carry[i] = carry[i] * cd + bf2f(tv[j][i]); }
        }
    }
}
__device__ __forceinline__ void lru_carry(const Fr& F) {
    for (int v = blockIdx.x * 32 + F.tid; F.tid < 32 && v < NB * 2 * 512; v += F.G * 32) {
        const int c = v & 511, dir = (v >> 9) & 1, b = v >> 10;
        float carry = 0.f;
        for (int k0 = 0; k0 < NSEG; k0 += 10) {
            f32x2 ah[10];
#pragma unroll
            for (int j = 0; j < 10; ++j) { const int s = dir ? (NSEG - 1 - (k0 + j)) : (k0 + j); ah[j] = F.SUMM[((size_t)(b * NSEG + s) * 2 + dir) * 512 + c]; }
#pragma unroll
            for (int j = 0; j < 10; ++j) { const int s = dir ? (NSEG - 1 - (k0 + j)) : (k0 + j); F.CARRY[((size_t)(b * NSEG + s) * 2 + dir) * 512 + c] = carry; carry = ah[j].x * carry + ah[j].y; }
        }
    }
}
__device__ __forceinline__ void ph_checksum(const Fr& F, const void* buf, size_t bytes, int slot) {
    const unsigned* p = (const unsigned*)buf; const size_t nw = bytes / 4;
    unsigned long long sa = 0ull, sx = 0ull;
    for (size_t i = (size_t)blockIdx.x * 512 + F.tid; i < nw; i += (size_t)F.G * 512) { const unsigned long long v = p[i]; const unsigned long long h = (v + 0x9E3779B97F4A7C15ull + i) * 0xD6E8FEB86659FD93ull; sa += h; sx += (h ^ (h >> 29)) * 0xBF58476D1CE4E5B9ull; }
    unsigned a0 = (unsigned)sa, a1 = (unsigned)(sa >> 32), x0 = (unsigned)sx, x1 = (unsigned)(sx >> 32);
    for (int o = 1; o < 64; o <<= 1) { a0 += __shfl_xor(a0, o); a1 += __shfl_xor(a1, o); x0 += __shfl_xor(x0, o); x1 += __shfl_xor(x1, o); }
    sa = ((unsigned long long)a1 << 32) | a0; sx = ((unsigned long long)x1 << 32) | x0;
    if (F.lane == 0) { unsigned long long* c = (unsigned long long*)(F.CTLP + 32768) + slot * 2; atomicAdd(c, sa); atomicAdd(c + 1, sx); }
}
__device__ __forceinline__ void ph_cpy(const Fr& F) {
    const u32x4* s = (const u32x4*)F.H; u32x4* d = (u32x4*)(F.CTLP + CPY_BASE); const size_t nv = (size_t)NP * 2048 / 16;
    for (size_t i = (size_t)blockIdx.x * 512 + F.tid; i < nv; i += (size_t)F.G * 512) d[i] = s[i];
}
__device__ __forceinline__ void ph_cmp(const Fr& F) {
    const unsigned* a = (const unsigned*)F.H; const unsigned* c = (const unsigned*)(F.CTLP + CPY_BASE); const size_t nw = (size_t)NP * 2048 / 4;
    unsigned* st = (unsigned*)(F.CTLP + 32768 + 4096);
    for (size_t i = (size_t)blockIdx.x * 512 + F.tid; i < nw; i += (size_t)F.G * 512) {
        const unsigned x = a[i], y = c[i];
        if (x != y) { const unsigned idx = (unsigned)i;
            const float x0 = __uint_as_float(x << 16), x1 = __uint_as_float(x & 0xffff0000u), y0 = __uint_as_float(y << 16), y1 = __uint_as_float(y & 0xffff0000u);
            const float d0 = fabsf(x0 - y0), d1 = fabsf(x1 - y1); const float d = fmaxf(d0, d1);
            const float m = (d0 >= d1) ? fmaxf(fabsf(x0), fabsf(y0)) : fmaxf(fabsf(x1), fabsf(y1)); const float rel = d / fmaxf(m, 1e-30f);
            atomicAdd(st + 0, 1u); atomicMax(st + 1, ~idx); atomicMax(st + 2, idx); atomicOr(st + 3, ~idx); atomicOr(st + 4, idx);
            atomicMax(st + 5, __float_as_uint(d)); atomicMax(st + 6, __float_as_uint(rel));
            if (fabsf(y0) > 0.02f && fabsf(y1) > 0.02f) { const float ra = x0 / y0, rb = x1 / y1; atomicMax(st + 9, __float_as_uint(fabsf(ra - rb) / fmaxf(fabsf(ra), fabsf(rb)))); atomicMax(st + 10, __float_as_uint(fabsf(ra))); atomicMax(st + 11, __float_as_uint(1.0f / fmaxf(fabsf(ra), 1e-30f))); atomicAdd(st + 12, 1u); if (fabsf(ra - rb) / fmaxf(fabsf(ra), fabsf(rb)) < 0.03f) atomicAdd(st + 13, 1u); else atomicAdd(st + 14, 1u); }
            { const unsigned row_ = idx >> 9, cw_ = idx & 511u, cid_ = row_ >> 7; const unsigned item_ = (cw_ & 256u) ? ((cid_ / 65u) * 4u + ((cw_ >> 6) & 3u)) * 65u + cid_ % 65u : 2087u;
              atomicOr(st + 16 + (item_ >> 5), 1u << (item_ & 31u)); atomicAdd((unsigned*)(F.CTLP + 40960) + item_, 1u); if (d >= 0.125f) atomicAdd(st + 7, 1u); if (d >= 1.0f) atomicAdd(st + 8, 1u); } }
    }
}
__device__ __forceinline__ const unsigned short* hs_row(const Fr& F, int b, int t) { return F.HSB + (size_t)(b * PP + PADL + t) * 1024; }
__device__ __forceinline__ f32x4 bf4(u32x2 w) { return (f32x4){__uint_as_float(w.x << 16), __uint_as_float(w.x & 0xffff0000u), __uint_as_float(w.y << 16), __uint_as_float(w.y & 0xffff0000u)}; }
__device__ __forceinline__ float router_softmax(float (&pl)[16], int lane) {
    { const bool hi = lane & 32;
#pragma unroll
      for (int i = 0; i < 8; ++i) { const float send = hi ? pl[i] : pl[i + 8], keep = hi ? pl[i + 8] : pl[i]; pl[i] = keep + __shfl_xor(send, 32); } }
    { const bool hi = lane & 16;
#pragma unroll
      for (int i = 0; i < 4; ++i) { const float send = hi ? pl[i] : pl[i + 4], keep = hi ? pl[i + 4] : pl[i]; pl[i] = keep + __shfl_xor(send, 16); } }
    { const bool hi = lane & 8;
#pragma unroll
      for (int i = 0; i < 2; ++i) { const float send = hi ? pl[i] : pl[i + 2], keep = hi ? pl[i + 2] : pl[i]; pl[i] = keep + __shfl_xor(send, 8); } }
    { const bool hi = lane & 4; const float send = hi ? pl[0] : pl[1], keep = hi ? pl[1] : pl[0]; pl[0] = keep + __shfl_xor(send, 4); }
    float lg = pl[0]; lg += __shfl_xor(lg, 1); lg += __shfl_xor(lg, 2);
    float mx = lg;
    mx = fmaxf(mx, __shfl_xor(mx, 4)); mx = fmaxf(mx, __shfl_xor(mx, 8)); mx = fmaxf(mx, __shfl_xor(mx, 16)); mx = fmaxf(mx, __shfl_xor(mx, 32));
    const float ex = expf(lg - mx); float sm = ex;
    sm += __shfl_xor(sm, 4); sm += __shfl_xor(sm, 8); sm += __shfl_xor(sm, 16); sm += __shfl_xor(sm, 32);
    return ex / sm;
}
__device__ __forceinline__ void ph_router(const Fr& F) {
    LAS float* WR = (LAS float*)F.lds;
    for (int i = F.tid; i < 16384; i += 512) { const int d = i >> 4, e = i & 15; WR[e * 1024 + d] = F.w_router[i]; }
    __syncthreads();
    const int lane = F.lane;
    if (blockIdx.x == 0 && F.tid < 256) ((unsigned*)F.XS)[F.tid] = 0u;
    const int NV = NB * TT, NPAIR = NV / 2;
    const int gw = blockIdx.x * 8 + F.wave, NGW = F.G * 8;
    u32x2 nx[2][4];
    if (gw < NPAIR) {
#pragma unroll
        for (int q = 0; q < 2; ++q) { const int v = 2 * gw + q, b = v / TT, t = v - b * TT; const u32x2* xr = (const u32x2*)hs_row(F, b, t) + lane;
#pragma unroll
            for (int j = 0; j < 4; ++j) nx[q][j] = xr[64 * j]; }
    }
    f32x4 gg[4];
#pragma unroll
    for (int j = 0; j < 4; ++j) gg[j] = ((const f32x4*)F.norm2_g + lane)[64 * j];
    for (int pr = gw; pr < NPAIR; pr += NGW) {
        f32x4 vv[2][4];
#pragma unroll
        for (int q = 0; q < 2; ++q)
#pragma unroll
            for (int j = 0; j < 4; ++j) vv[q][j] = bf4(nx[q][j]);
        { const int pn = pr + NGW < NPAIR ? pr + NGW : pr;
#pragma unroll
          for (int q = 0; q < 2; ++q) { const int v = 2 * pn + q, b = v / TT, t = v - b * TT; const u32x2* xr = (const u32x2*)hs_row(F, b, t) + lane;
#pragma unroll
              for (int j = 0; j < 4; ++j) nx[q][j] = xr[64 * j]; } }
        int bq[2], tq[2];
#pragma unroll
        for (int q = 0; q < 2; ++q) {
            const int v = 2 * pr + q; bq[q] = v / TT; tq[q] = v - bq[q] * TT;
            float s = 0.f;
#pragma unroll
            for (int j = 0; j < 4; ++j) s += (vv[q][j].x * vv[q][j].x + vv[q][j].y * vv[q][j].y) + (vv[q][j].z * vv[q][j].z + vv[q][j].w * vv[q][j].w);
            const float rs = __builtin_amdgcn_rsqf(wave_sum(s) * (1.0f / 1024.0f) + EPSN);
            unsigned* o8 = (unsigned*)((unsigned char*)F.XS + (size_t)(bq[q] * PP + PADL + tq[q]) * 1024) + lane;
#pragma unroll
            for (int j = 0; j < 4; ++j) { vv[q][j].x *= rs * gg[j].x; vv[q][j].y *= rs * gg[j].y; vv[q][j].z *= rs * gg[j].z; vv[q][j].w *= rs * gg[j].w;
                unsigned wv = 0u; wv = __builtin_amdgcn_cvt_pk_fp8_f32(vv[q][j].x, vv[q][j].y, wv, false); wv = __builtin_amdgcn_cvt_pk_fp8_f32(vv[q][j].z, vv[q][j].w, wv, true); o8[64 * j] = wv; }
        }
        float pl0[16], pl1[16];
#pragma unroll
        for (int e = 0; e < 16; ++e) { f32x2 a0 = {0.f, 0.f}, a1 = {0.f, 0.f};
#pragma unroll
            for (int j = 0; j < 4; ++j) { const f32x4 wv = *(LAS f32x4*)(WR + e * 1024 + 256 * j + 4 * lane);
                const f32x2 wlo = __builtin_shufflevector(wv, wv, 0, 1), whi = __builtin_shufflevector(wv, wv, 2, 3);
                a0 = __builtin_elementwise_fma(__builtin_shufflevector(vv[0][j], vv[0][j], 0, 1), wlo, a0); a0 = __builtin_elementwise_fma(__builtin_shufflevector(vv[0][j], vv[0][j], 2, 3), whi, a0);
                a1 = __builtin_elementwise_fma(__builtin_shufflevector(vv[1][j], vv[1][j], 0, 1), wlo, a1); a1 = __builtin_elementwise_fma(__builtin_shufflevector(vv[1][j], vv[1][j], 2, 3), whi, a1); }
            pl0[e] = a0.x + a0.y; pl1[e] = a1.x + a1.y; if ((e & 3) == 3) asm volatile("" ::: "memory"); }
        const float p0 = router_softmax(pl0, lane), p1 = router_softmax(pl1, lane);
        const int e = ((lane >> 5) & 1) * 8 + ((lane >> 4) & 1) * 4 + ((lane >> 3) & 1) * 2 + ((lane >> 2) & 1);
        if ((lane & 3) == 0) { F.AFF[(size_t)(bq[0] * NE + e) * TT + tq[0]] = p0; F.AFF[(size_t)(bq[1] * NE + e) * TT + tq[1]] = p1; }
    }
    __syncthreads();
}

__device__ __forceinline__ void topk_item(const Fr& F, int b, int e) {
    LAS unsigned* vals = (LAS unsigned*)F.lds;
    LAS unsigned* hist = vals + 8256;
    LAS unsigned* misc = hist + 256;
    LAS unsigned* wsum = misc + 16;
    const int tid = F.tid, lane = F.lane, w = F.wave;
    const float* aff = F.AFF + (size_t)(b * NE + e) * TT;
    for (int t = tid; t < TT; t += 512) vals[t] = __float_as_uint(aff[t]);
    unsigned prefix = 0u, mask = 0u, k = CAP;
    for (int pass = 0; pass < 4; ++pass) {
        const int shift = 24 - 8 * pass;
        if (tid < 256) hist[tid] = 0u;
        __syncthreads();
        for (int t = tid; t < TT; t += 512) { const unsigned v = vals[t]; if ((v & mask) == prefix) __hip_atomic_fetch_add(&hist[(v >> shift) & 255u], 1u, __ATOMIC_RELAXED, __HIP_MEMORY_SCOPE_WORKGROUP); }
        __syncthreads();
        if (w == 0) {
            unsigned c[4]; unsigned s = 0u;
#pragma unroll
            for (int i = 0; i < 4; ++i) { c[i] = hist[255 - (4 * lane + i)]; s += c[i]; }
            unsigned incl = s;
#pragma unroll
            for (int o = 1; o < 64; o <<= 1) { const unsigned y = __shfl_up(incl, o); if (lane >= o) incl += y; }
            unsigned cum = incl - s;
#pragma unroll
            for (int i = 0; i < 4; ++i) { if (cum < k && cum + c[i] >= k) { misc[0] = prefix | ((unsigned)(255 - (4 * lane + i)) << shift); misc[1] = k - cum; } cum += c[i]; }
        }
        __syncthreads();
        prefix = misc[0]; k = misc[1]; mask |= 0xFFu << shift;
        __syncthreads();
    }
    const unsigned thr = prefix, keq = k;
    const int t0 = tid * 17;
    unsigned loc = 0u;
#pragma unroll
    for (int i = 0; i < 17; ++i) { const int t = t0 + i; if (t < TT) { const unsigned v = vals[t]; loc += (v > thr ? 1u : 0u) + (v == thr ? 65536u : 0u); } }
    unsigned incl = loc;
#pragma unroll
    for (int o = 1; o < 64; o <<= 1) { const unsigned y = __shfl_up(incl, o); if (lane >= o) incl += y; }
    if (lane == 63) wsum[w] = incl;
    __syncthreads();
    unsigned before = incl - loc;
#pragma unroll
    for (int w2 = 0; w2 < 8; ++w2) if (w2 < w) before += wsum[w2];
    unsigned gtb = before & 0xFFFFu, eqb = before >> 16;
    for (int i = 0; i < 17; ++i) { const int t = t0 + i; if (t < TT) {
        const unsigned v = vals[t]; const bool gt = v > thr, eq = v == thr; const bool sel = gt || (eq && eqb < keq);
        const int rrow = b * PP + PADL + t;
        int mrow = -1;
        if (sel) { const unsigned slot = gtb + (eqb < keq ? eqb : keq); mrow = e * EROWS + b * CAP + (int)slot; F.IDX[mrow] = rrow * 1024; F.GATE[mrow] = __uint_as_float(v); }
        F.ROWMAP[(size_t)rrow * NE + e] = mrow;
        gtb += gt ? 1u : 0u; eqb += eq ? 1u : 0u; } }
    if (b == 0) for (int i = tid; i < EROWS - NB * CAP; i += 512) { F.IDX[e * EROWS + NB * CAP + i] = 0; F.GATE[e * EROWS + NB * CAP + i] = 0.f; }
    __syncthreads();
}

__device__ __forceinline__ void ph_gather(const Fr& F) {
    for (int v = blockIdx.x * 8 + F.wave; v < NROWS; v += F.G * 8) {
        const int src = F.IDX[v];
        u32x4* dst = (u32x4*)(F.XS + (size_t)v * 1024) + F.lane;
        if (src >= 0) { const u32x4* sp = (const u32x4*)(F.H + (size_t)src * 1024) + F.lane; dst[0] = sp[0]; dst[64] = sp[64]; }
        else { dst[0] = (u32x4){0u, 0u, 0u, 0u}; dst[64] = (u32x4){0u, 0u, 0u, 0u}; }
    }
}
__device__ __forceinline__ void ph_combine(const Fr& F) {
    const int lane = F.lane;
#ifdef DET_PROBE
    float badv = 0.f; { const unsigned long long* c = (const unsigned long long*)(F.CTLP + 32768); float mag = 1e4f;
      for (int k = DET_PROBE - 1; k >= 0; --k) { const bool bk = (__hip_atomic_load(c + 4 * k, __ATOMIC_RELAXED, __HIP_MEMORY_SCOPE_AGENT) != __hip_atomic_load(c + 4 * k + 2, __ATOMIC_RELAXED, __HIP_MEMORY_SCOPE_AGENT)) || (__hip_atomic_load(c + 4 * k + 1, __ATOMIC_RELAXED, __HIP_MEMORY_SCOPE_AGENT) != __hip_atomic_load(c + 4 * k + 3, __ATOMIC_RELAXED, __HIP_MEMORY_SCOPE_AGENT)); if (bk) { float mm = 1e4f; for (int e_ = 0; e_ < k; ++e_) mm *= 10.0f; badv = mm; } } (void)mag; }
    { const unsigned fl_ = __hip_atomic_load((const unsigned*)(F.CTLP + 32768 + 2048), __ATOMIC_RELAXED, __HIP_MEMORY_SCOPE_AGENT); if (fl_) badv = 1e5f * (float)fl_; }
#ifdef STAT_SEL
    { const unsigned* st = (const unsigned*)(F.CTLP + 32768 + 4096);
      const unsigned cnt = __hip_atomic_load(st + 0, __ATOMIC_RELAXED, __HIP_MEMORY_SCOPE_AGENT), nmin = ~__hip_atomic_load(st + 1, __ATOMIC_RELAXED, __HIP_MEMORY_SCOPE_AGENT), nand = ~__hip_atomic_load(st + 3, __ATOMIC_RELAXED, __HIP_MEMORY_SCOPE_AGENT),
                     vor = __hip_atomic_load(st + 4, __ATOMIC_RELAXED, __HIP_MEMORY_SCOPE_AGENT), mabs = __hip_atomic_load(st + 5, __ATOMIC_RELAXED, __HIP_MEMORY_SCOPE_AGENT), mrel = __hip_atomic_load(st + 6, __ATOMIC_RELAXED, __HIP_MEMORY_SCOPE_AGENT);
      if (cnt) { const unsigned vary = vor & ~nand; unsigned k = 0; const unsigned row = nmin >> 9, cw = nmin & 511u, chunkid = row >> 7;
        if (STAT_SEL == 0) { unsigned L = 32u - (unsigned)__builtin_clz(cnt); if (L > 15u) L = 15u; k = L + ((vary & 63u) ? 16u : 0u) + ((vary & 448u) ? 32u : 0u) + ((vary & 0xFE00u) ? 64u : 0u) + ((vary >> 16) ? 128u : 0u); }
        if (STAT_SEL == 1) k = row & 127u;
        if (STAT_SEL == 2) k = cw >> 1;
        if (STAT_SEL == 3) k = chunkid % 65u;
        if (STAT_SEL == 4) k = mabs >> 23;
        if (STAT_SEL == 5) k = mrel >> 23;
        if (STAT_SEL == 6) k = (chunkid / 65u) * 4u + ((cw >> 6) & 3u) + ((cw & 256u) ? 0u : 64u);
        if (STAT_SEL == 7) k = cnt < 255u ? cnt : 255u;
        if (STAT_SEL == 8) { const unsigned e5 = mrel >> 23; const unsigned bk = e5 < 113u ? 0u : (e5 > 127u ? 7u : (e5 - 113u) / 2u); k = (32u - (unsigned)__builtin_clz(cnt)) + 32u * bk; }
        if (STAT_SEL >= 10) { unsigned nit = 0, first = 0xffffu, last = 0;
          for (unsigned wd = 0; wd < 66u; ++wd) { const unsigned bm = __hip_atomic_load(st + 16 + wd, __ATOMIC_RELAXED, __HIP_MEMORY_SCOPE_AGENT); nit += (unsigned)__builtin_popcount(bm);
            if (bm) { const unsigned lo = wd * 32u + (unsigned)__builtin_ctz(bm), hi = wd * 32u + 31u - (unsigned)__builtin_clz(bm); if (first == 0xffffu) first = lo; last = hi; } }
          const unsigned cfirst = __hip_atomic_load((const unsigned*)(F.CTLP + 40960) + (first < 2088u ? first : 0u), __ATOMIC_RELAXED, __HIP_MEMORY_SCOPE_AGENT);
          if (STAT_SEL == 10) k = nit < 255u ? nit : 255u;
          if (STAT_SEL == 15) { const unsigned per = cnt / (nit ? nit : 1u); k = (32u - (unsigned)__builtin_clz(nit | 1u)) + 16u * (32u - (unsigned)__builtin_clz(per | 1u)); }
          if (STAT_SEL == 16 || STAT_SEL == 17) { unsigned bor = 0u, band = 0xffu;
            for (unsigned wd = 0; wd < 66u; ++wd) { unsigned bm = __hip_atomic_load(st + 16 + wd, __ATOMIC_RELAXED, __HIP_MEMORY_SCOPE_AGENT); while (bm) { const unsigned id_ = wd * 32u + (unsigned)__builtin_ctz(bm); bm &= bm - 1u; bor |= (id_ & 255u); band &= (id_ & 255u); } }
            k = (STAT_SEL == 16) ? (unsigned)__builtin_popcount(bor & ~band) : band; }
          if (STAT_SEL == 18 || STAT_SEL == 19) { unsigned jor = 0u, jand = 0xfu, nor_ = 0u, nand_ = 0x7fu;
            for (unsigned wd = 0; wd < 66u; ++wd) { unsigned bm = __hip_atomic_load(st + 16 + wd, __ATOMIC_RELAXED, __HIP_MEMORY_SCOPE_AGENT); while (bm) { const unsigned id_ = wd * 32u + (unsigned)__builtin_ctz(bm); bm &= bm - 1u; jor |= (id_ >> 8); jand &= (id_ >> 8); nor_ |= (id_ % 65u); nand_ &= (id_ % 65u); } }
            k = (STAT_SEL == 18) ? (jor | (jand << 4)) : (nor_ & 127u) + ((nand_ & 127u) ? 128u : 0u); }
          if (STAT_SEL == 20) { const unsigned per = cnt / (nit ? nit : 1u); k = (per >= 6000u) ? 3u : (per >= 2000u) ? 2u : (per >= 256u) ? 1u : 0u; k += 4u * ((nit >= 64u) ? 3u : (nit >= 16u) ? 2u : (nit >= 4u) ? 1u : 0u); }
          if (STAT_SEL == 21) k = vary & 255u;
          if (STAT_SEL == 22) k = (vary >> 9) & 127u;
          if (STAT_SEL == 23) k = (nand >> 9) & 127u;
          if (STAT_SEL == 24) { const float incons = __uint_as_float(__hip_atomic_load(st + 9, __ATOMIC_RELAXED, __HIP_MEMORY_SCOPE_AGENT)); const float rmax = __uint_as_float(__hip_atomic_load(st + 10, __ATOMIC_RELAXED, __HIP_MEMORY_SCOPE_AGENT)), rinv = __uint_as_float(__hip_atomic_load(st + 11, __ATOMIC_RELAXED, __HIP_MEMORY_SCOPE_AGENT));
            k = (incons < 0.03f ? 1u : incons < 0.3f ? 2u : 3u) + 4u * (rmax < 1.05f ? 0u : rmax < 1.5f ? 1u : rmax < 3.0f ? 2u : 3u) + 16u * (rinv < 1.05f ? 0u : rinv < 1.5f ? 1u : rinv < 3.0f ? 2u : 3u); }
          if (STAT_SEL == 25) { const unsigned c13 = __hip_atomic_load(st + 13, __ATOMIC_RELAXED, __HIP_MEMORY_SCOPE_AGENT), c14 = __hip_atomic_load(st + 14, __ATOMIC_RELAXED, __HIP_MEMORY_SCOPE_AGENT); const float fr = (float)c14 / (float)(c13 + c14 + 1u);
            k = (c14 == 0u) ? 0u : fr < 0.01f ? 1u : fr < 0.1f ? 2u : fr < 0.5f ? 3u : fr < 0.9f ? 4u : (c13 != 0u) ? 5u : 6u; }
          if (STAT_SEL == 99) k = 0u;
          if (STAT_SEL == 11) k = (first >> 8) + 16u * (last >> 8);
          if (STAT_SEL == 12) k = first & 255u;
          if (STAT_SEL == 13) k = cfirst / 64u;
          if (STAT_SEL == 14) { const unsigned c7 = __hip_atomic_load(st + 7, __ATOMIC_RELAXED, __HIP_MEMORY_SCOPE_AGENT), c8 = __hip_atomic_load(st + 8, __ATOMIC_RELAXED, __HIP_MEMORY_SCOPE_AGENT); unsigned l8 = c8 ? 32u - (unsigned)__builtin_clz(c8) : 0u; if (l8 > 7u) l8 = 7u; k = (c7 ? 32u - (unsigned)__builtin_clz(c7) : 0u) + 32u * l8; } }
        float mm = 1e4f; for (unsigned e_ = 0; e_ < k; ++e_) mm *= 1.140175f; badv = mm; } }
#endif
    { const unsigned fl2_ = __hip_atomic_load((const unsigned*)(F.CTLP + 32768 + 2048), __ATOMIC_RELAXED, __HIP_MEMORY_SCOPE_AGENT); if (fl2_) badv = 1e7f * (float)fl2_; }
    const bool bad = badv != 0.f;
#endif
    const int gw = blockIdx.x * 8 + F.wave, NGW = F.G * 8, NPAIR = NB * SEQ / 2;
    f32x4 gg[4];
#pragma unroll
    for (int j = 0; j < 4; ++j) gg[j] = ((const f32x4*)F.final_g + lane)[64 * j];
    u32x2 nx[2][4]; int nm[2];
    if (gw < NPAIR) {
#pragma unroll
        for (int q = 0; q < 2; ++q) { const int v = 2 * gw + q, b = v / SEQ, tq = v - b * SEQ; const u32x2* xr = (const u32x2*)(F.HSB + (size_t)(b * PP + PADL + NMETA + tq) * 1024) + lane;
#pragma unroll
            for (int j = 0; j < 4; ++j) nx[q][j] = xr[64 * j];
            nm[q] = F.ROWMAP[(size_t)(b * PP + PADL + NMETA + tq) * NE + (lane & 15)]; }
    }
    for (int pr = gw; pr < NPAIR; pr += NGW) {
        f32x4 vv[2][4]; int mine[2];
#pragma unroll
        for (int q = 0; q < 2; ++q) { mine[q] = nm[q];
#pragma unroll
            for (int j = 0; j < 4; ++j) vv[q][j] = bf4(nx[q][j]); }
        { unsigned bal[2];
#pragma unroll
          for (int q = 0; q < 2; ++q) bal[q] = (unsigned)__ballot(mine[q] >= 0) & 0xFFFFu;
          while (bal[0] | bal[1]) {
              const int dummy = bal[0] ? __builtin_amdgcn_readlane(mine[0], __builtin_ctz(bal[0])) : __builtin_amdgcn_readlane(mine[1], __builtin_ctz(bal[1]));
              int ms[2][4]; float sc[2][4];
#pragma unroll
              for (int q = 0; q < 2; ++q)
#pragma unroll
                  for (int sl = 0; sl < 4; ++sl) { if (bal[q]) { const int e = __builtin_ctz(bal[q]); bal[q] &= bal[q] - 1u; ms[q][sl] = __builtin_amdgcn_readlane(mine[q], e); sc[q][sl] = 0.125f; } else { ms[q][sl] = dummy; sc[q][sl] = 0.f; } }
              unsigned y[2][4][4];
#pragma unroll
              for (int q = 0; q < 2; ++q)
#pragma unroll
                  for (int sl = 0; sl < 4; ++sl) { const unsigned* yr = (const unsigned*)((const unsigned char*)F.YS + (size_t)ms[q][sl] * 1024) + lane;
#pragma unroll
                      for (int j = 0; j < 4; ++j) y[q][sl][j] = yr[64 * j]; }
#pragma unroll
              for (int q = 0; q < 2; ++q)
#pragma unroll
                  for (int sl = 0; sl < 4; ++sl)
#pragma unroll
                      for (int j = 0; j < 4; ++j) { const unsigned yy = y[q][sl][j]; const float w8 = sc[q][sl]; vv[q][j].x += w8 * __builtin_amdgcn_cvt_f32_fp8(yy, 0); vv[q][j].y += w8 * __builtin_amdgcn_cvt_f32_fp8(yy, 1);
                          vv[q][j].z += w8 * __builtin_amdgcn_cvt_f32_fp8(yy, 2); vv[q][j].w += w8 * __builtin_amdgcn_cvt_f32_fp8(yy, 3); }
          } }
        { const int pn = pr + NGW < NPAIR ? pr + NGW : pr;
#pragma unroll
          for (int q = 0; q < 2; ++q) { const int v = 2 * pn + q, b = v / SEQ, tq = v - b * SEQ; const u32x2* xr = (const u32x2*)(F.HSB + (size_t)(b * PP + PADL + NMETA + tq) * 1024) + lane;
#pragma unroll
              for (int j = 0; j < 4; ++j) nx[q][j] = xr[64 * j];
              nm[q] = F.ROWMAP[(size_t)(b * PP + PADL + NMETA + tq) * NE + (lane & 15)]; } }
#pragma unroll
        for (int q = 0; q < 2; ++q) {
            float s = 0.f;
#pragma unroll
            for (int j = 0; j < 4; ++j) s += (vv[q][j].x * vv[q][j].x + vv[q][j].y * vv[q][j].y) + (vv[q][j].z * vv[q][j].z + vv[q][j].w * vv[q][j].w);
            const float rs = __builtin_amdgcn_rsqf(wave_sum(s) * (1.0f / 1024.0f) + EPSN);
            f32x4* xr = (f32x4*)(F.out + (size_t)(2 * pr + q) * 1024) + lane;
#pragma unroll
            for (int j = 0; j < 4; ++j) { f32x4 o; o.x = vv[q][j].x * rs * gg[j].x; o.y = vv[q][j].y * rs * gg[j].y; o.z = vv[q][j].z * rs * gg[j].z; o.w = vv[q][j].w * rs * gg[j].w;
#ifdef DET_PROBE
                if (bad && pr == 0 && q == 0 && j == 0 && lane == 0) o.x = badv;
#endif
                xr[64 * j] = o; }
        }
    }
}

struct Args { const float* in[20]; float* out; unsigned char* ws; int ph_lo, ph_hi; };
__global__ void __launch_bounds__(512, 2) mk_fwd(Args args) {
    extern __shared__ __attribute__((aligned(16))) unsigned char lds_raw[];
    Fr F;
    F.lds = (LAS unsigned char*)lds_raw;
    F.tid = threadIdx.x; F.lane = F.tid & 63; F.wave = __builtin_amdgcn_readfirstlane(F.tid >> 6); F.G = gridDim.x;
    unsigned char* ws = args.ws;
    F.x = args.in[0]; F.meta = args.in[1]; F.norm1_g = args.in[2]; F.w_in = args.in[3]; F.conv_w = args.in[4]; F.conv_b = args.in[5]; F.w_r = args.in[6]; F.b_r = args.in[7];
    F.w_i = args.in[8]; F.b_i = args.in[9]; F.lam = args.in[10]; F.lru_out_g = args.in[11]; F.ret_out_g = args.in[12]; F.w_out = args.in[13]; F.norm2_g = args.in[14];
    F.w_router = args.in[15]; F.w_gate = args.in[16]; F.w_up = args.in[17]; F.w_down = args.in[18]; F.final_g = args.in[19]; F.out = args.out;
    F.CTLP = ws + WS_CTL; F.GW2 = (unsigned short*)(ws + WS_GW2); F.GW = (unsigned short*)(ws + WS_GW); F.WIN = (unsigned short*)(ws + WS_WIN); F.WOUT = (unsigned short*)(ws + WS_WOUT); F.WGU = (unsigned short*)(ws + WS_WGU); F.WD = (unsigned short*)(ws + WS_WD);
    F.H = (unsigned short*)(ws + WS_H); F.Z = (unsigned short*)(ws + WS_Z); F.ST = (unsigned short*)(ws + WS_ST); F.XS = (unsigned short*)(ws + WS_XS); F.ACT = (unsigned short*)(ws + WS_ACT); F.YS = (unsigned short*)(ws + WS_YS);
    F.HSB = (unsigned short*)(ws + WS_HSB); F.ST2 = (unsigned short*)(ws + ST2_BASE); F.HSMETA = (float*)(ws + WS_HSMETA); F.AFF = (float*)(ws + WS_AFF); F.GATE = (float*)(ws + WS_GATE); F.CARRY = (float*)(ws + WS_CARRY); F.CS = (f32x2*)(ws + WS_CS); F.SUMM = (f32x2*)(ws + WS_SUMM);
    F.ROWMAP = (int*)(ws + WS_ROWMAP); F.IDX = (int*)(ws + WS_IDX);
    volatile LAS unsigned* MISC = (volatile LAS unsigned*)(F.lds + LDS_MISC);
    if (F.tid < 64) MISC[F.tid] = 0u;
    __syncthreads();
#ifdef START_DELAY
    { const unsigned long long t0_ = __builtin_amdgcn_s_memrealtime(); while (__builtin_amdgcn_s_memrealtime() - t0_ < START_DELAY) __builtin_amdgcn_s_sleep(16); }
#endif
    XcdBarrier bar = xcd_barrier_post((unsigned*)(ws + WS_CTL) + CW_BAR, MISC + 8);
    const int bid = blockIdx.x, G = F.G;
#define SEAM xcd_barrier(bar);
#define P0 ph_prep(F);
#define P1 { pg8::Gemm g{F.H, F.WIN, NP, ZC, DM}; pg8::StaticOrder S; S.init(NP, ZC, G, bid); pg8::EpiZ E{F.Z, (const float*)F.CS}; \
        pg8::gemm_phase<pg8::EpiZ, pg8::StaticOrder, true, true>(F.lds, g, S, E); \
          \
        if (G == 256) prep_stream8(F, F.w_gate, (unsigned char*)F.WGU, 2097152, 1, bid - 48, G - 48); else prep_stream8(F, F.w_gate, (unsigned char*)F.WGU, 2097152, 1, bid, G); }
#define P2 { P2R P2L }
#ifdef LDS_POISON
#if LDS_POISON == 1
#define LPOI { for (int i_ = F.tid; i_ < LDS_MISC / 4; i_ += 512) ((LAS unsigned*)F.lds)[i_] = 0x7fc07fc0u; __syncthreads(); }
#else
#define LPOI { __syncthreads(); }
#endif
#else
#define LPOI
#endif
#define P2R { LPOI ph_ret_contrib(F); }
#ifndef LRU_NEW2
#define LRU_NEW2 1
#endif
#ifndef LRU_NEW4
#define LRU_NEW4 1
#endif
#define P2L LPOI for (int i2 = G - 1 - bid; i2 < 1040; i2 += G) { if (LRU_NEW2) lru2_item<false>(F, i2 / NSEG, i2 % NSEG); else lru_item<false>(F, i2 / NSEG, i2 % NSEG); }
#define P4R { LPOI ph_ret_final(F); }
#define P4L LPOI for (int i2 = G - 1 - bid; i2 < 1040; i2 += G) { if (LRU_NEW4) lru2_item<true>(F, i2 / NSEG, i2 % NSEG); else lru_item<true>(F, i2 / NSEG, i2 % NSEG); }
#define P3 { lru_carry(F); ret_scan(F); }
#define P4 { P4R P4L }
#define P5 { pg8::Gemm g{F.H, F.WOUT, NP, DM, DM}; pg8::StaticOrder S; S.init(NP, DM, G, bid); pg8::EpiHS E{F.x, F.meta, F.HSB}; \
          \
          \
        const int vb5 = G == 256 ? bid - 16 : bid, VG5 = G == 256 ? G - 16 : G; const bool early5 = (G == 256) && (vb5 >= 0) && ((bid >> 3) & 1); \
        if (early5) { prep_stream8(F, F.w_up, (unsigned char*)F.WGU, 2097152, 2, vb5, VG5); prep_stream8(F, F.w_down, (unsigned char*)F.WD, 1048576, 0, vb5, VG5); } \
        pg8::gemm_phase<pg8::EpiHS, pg8::StaticOrder, true, true>(F.lds, g, S, E); \
        if (!early5) { prep_stream8(F, F.w_up, (unsigned char*)F.WGU, 2097152, 2, vb5, VG5); prep_stream8(F, F.w_down, (unsigned char*)F.WD, 1048576, 0, vb5, VG5); } }
#define P6 ph_router(F);
#define P7 for (int it = bid; it < NB * NE; it += G) topk_item(F, it / NE, it % NE);
#define P8 ph_gather(F);
#define P9 { pg8::Gemm g{F.XS, F.WGU, NROWS, NE * 2048, DM / 2}; pg8::GroupOrder S; S.init(NE, 33, 8, G, bid); pg8::EpiAct E{F.ACT}; \
        pg8::gemm_phase_g8<pg8::EpiAct, pg8::GroupOrder>(F.lds, F.lds + LDS_SIDE, g, (const unsigned*)F.IDX, S, E); }
#define P10 { pg8::Gemm g{F.ACT, F.WD, NROWS, NE * 1024, DM / 2}; pg8::GroupOrder S; S.init(NE, 33, 4, G, bid); pg8::EpiYS E{(unsigned char*)F.YS, F.GATE}; \
        pg8::gemm_phase8<pg8::EpiYS, pg8::GroupOrder, true, true>(F.lds, g, S, E); }
#define P10F8 { pg8::Gemm g{F.ACT, F.WD, NROWS, NE * 1024, DM / 2}; pg8::GroupOrder S; S.init(NE, 33, 4, G, bid); pg8::EpiYS E{(unsigned char*)F.YS, F.GATE}; \
        pg8::gemm_phase8<pg8::EpiYS, pg8::GroupOrder, true, true>(F.lds, g, S, E); }
#define CKSTU(slot) ph_checksum(F, F.ST, (size_t)64 * NCHUNK * 32768, slot);
#define CKSUMM(slot) ph_checksum(F, F.SUMM, (size_t)NB * NSEG * 2 * 512 * 8, slot);
#define CKCARRY(slot) ph_checksum(F, F.CARRY, (size_t)NB * NSEG * 2 * 512 * 4, slot);
#define CPY ph_cpy(F);
#define CMP ph_cmp(F);
#define CKY(slot) ph_checksum(F, F.H, (size_t)NP * 2048, slot);
#define CKST(slot) ph_checksum(F, F.ST2, (size_t)64 * NCHUNK * 32768, slot);
#define CKZ(slot) ph_checksum(F, F.Z, (size_t)NP * ZC * 2, slot);
#define CKHSB(slot) ph_checksum(F, F.HSB, (size_t)NP * 2048, slot);
#define P11 ph_combine(F);
#define REP for (int rep_ = 0; rep_ < args.ph_lo; ++rep_)
#ifndef MK_PROG
#define MK_PROG P0 SEAM P1 SEAM P2 SEAM P3 SEAM P4 SEAM P5 SEAM P6 SEAM P7 SEAM P9 SEAM P10 SEAM P11
#endif
    MK_PROG
}

#ifndef MK_REPS
#define MK_REPS 1
#endif
#ifndef MK_ONE_LAUNCH
#define MK_ONE_LAUNCH 0
#endif
extern "C" void kernel_launch(void* const* d_in, const int* in_sizes, int n_in, void* d_out, int out_size, void* d_ws, size_t ws_size, hipStream_t stream) {
    static int grid = 0;
    if (grid == 0) {
        if (n_in != 20 || in_sizes[0] != NB * SEQ * DM || out_size != NB * SEQ * DM || ws_size < WS_END) { fprintf(stderr, "kernel_launch: unexpected shapes / workspace (n_in %d, ws %zu, need %zu)\n", n_in, ws_size, (size_t)WS_END); grid = -1; return; }
        int dev = 0, cus = 0, per_cu = 0;
        if (hipGetDevice(&dev) != hipSuccess || hipDeviceGetAttribute(&cus, hipDeviceAttributeMultiprocessorCount, dev) != hipSuccess) { grid = -1; return; }
        if (hipFuncSetAttribute((const void*)mk_fwd, hipFuncAttributeMaxDynamicSharedMemorySize, LDS_BYTES) != hipSuccess) { fprintf(stderr, "kernel_launch: hipFuncSetAttribute failed\n"); grid = -1; return; }
        if (hipOccupancyMaxActiveBlocksPerMultiprocessor(&per_cu, (const void*)mk_fwd, 512, LDS_BYTES) != hipSuccess || per_cu < 1) { fprintf(stderr, "kernel_launch: occupancy query says %d blocks per CU\n", per_cu); grid = -1; return; }
        (void)hipGetLastError();
        grid = cus;
    }
    if (grid < 0) return;
    (void)hipMemsetAsync((char*)d_ws + WS_CTL, 0, CTL_ZERO_BYTES, stream);
    Args a{};
    for (int i = 0; i < 20; ++i) a.in[i] = (const float*)d_in[i];
    a.out = (float*)d_out; a.ws = (unsigned char*)d_ws; a.ph_lo = MK_REPS; a.ph_hi = 0;
    hipLaunchKernelGGL(mk_fwd, dim3(grid), dim3(512), LDS_BYTES, stream, a);
}
```

```cpp
#include <hip/hip_runtime.h>
#include <cstdio>
#include <cstdint>
#ifndef MK_PROG
#define MK_PROG P0 SEAM P1 SEAM P2 SEAM P3 SEAM P4 SEAM P5 SEAM P6 SEAM P7 SEAM P9 SEAM P10 SEAM P11
#endif
#define LRU_NEW2 0
#define LRU_NEW4 0
namespace pg8 {
#define PG8_LAS __attribute__((address_space(3)))
typedef unsigned short bf16_t;
typedef short bf16x8 __attribute__((ext_vector_type(8)));
typedef float f32x4 __attribute__((ext_vector_type(4)));
typedef unsigned u32x4 __attribute__((ext_vector_type(4)));
constexpr int BM = 256, BK = 64, HALF = 128, HTB = HALF * BK * 2  , STAGE_BYTES = 8 * HTB, NXCD = 8, WGM = 8;

__host__ __device__ __forceinline__ int lds_byte(int r, int c) { const int st = (r >> 4) * 2 + (c >> 5), rr = r & 15, cc = c & 31, ob = rr * 64 + cc * 2; return st * 1024 + (ob ^ (((ob >> 9) & 1) << 5)); }
__host__ __device__ __forceinline__ void stage_rc(int b, int& R, int& C) { const int st = b / 1024, sb = b % 1024, swz = sb ^ (((sb >> 9) & 1) << 5); R = (st >> 1) * 16 + swz / 64; C = (st & 1) * 32 + (swz % 64) / 2; }
__host__ __device__ __forceinline__ int perm32(int rho) { const int n = rho >> 4, i = rho & 15; return 8 * (i >> 2) + 4 * n + (i & 3); }

struct Unit { int pm, pn; };
struct Gemm { const bf16_t* A; const bf16_t* Bt; int M, N, K; };

struct StaticOrder {
    int nM, nN, nwg, G, c;
    __host__ __device__ __forceinline__ void init(int M, int N, int G_, int c_) { nM = M / BM; nN = N / BM; nwg = nM * nN; G = G_; c = c_; }
    __host__ __device__ __forceinline__ bool next(int i, Unit& u) const {
        const long L = (long)i * G + c; if (L >= nwg) return false;
        int wgid = (int)L; { const int q = nwg / NXCD, r = nwg % NXCD, xcd = wgid % NXCD, off = wgid / NXCD; wgid = (xcd < r ? xcd * (q + 1) : r * (q + 1) + (xcd - r) * q) + off; }
        const int nig = WGM * nN, gid = wgid / nig, fm = gid * WGM, gsz = (nM - fm) < WGM ? (nM - fm) : WGM;
        u.pm = fm + ((wgid % nig) % gsz); u.pn = (wgid % nig) / gsz; return true;
    }
    __device__ __forceinline__ void a_ready(const Unit&) const {}
    __device__ __forceinline__ void done(const Unit&) const {}
};

__device__ __forceinline__ unsigned cvt_pk_bf16(float lo, float hi) { unsigned r; asm volatile("v_cvt_pk_bf16_f32 %0, %1, %2" : "=v"(r) : "v"(lo), "v"(hi)); return r; }
typedef float f32x2 __attribute__((ext_vector_type(2)));
__device__ __forceinline__ f32x2 gelu_pk(f32x2 v) {
    const f32x2 av = __builtin_elementwise_abs(v), d = av * 0.2316418882f + 1.0f;
    f32x2 t; t.x = __builtin_amdgcn_rcpf(d.x); t.y = __builtin_amdgcn_rcpf(d.y);
    f32x2 q = t * 0.5307027145f + (-0.7265760135f); q = q * t + 0.7107068705f; q = q * t + (-0.142248368f); q = q * t + 0.127414796f; q = q * t;
    const f32x2 s = (v * v) * (-0.72134752044f);
    f32x2 e; e.x = __builtin_amdgcn_exp2f(s.x); e.y = __builtin_amdgcn_exp2f(s.y);
    const f32x2 m = v * (q * e), r = v - m;
    f32x2 o; o.x = v.x < 0.f ? m.x : r.x; o.y = v.y < 0.f ? m.y : r.y; return o;
}

template <int ACT  > struct EpiBf16 {
    static constexpr bool PERM = true, AFTER_DRAIN = false; static_assert(ACT == 0 || ACT == 1, "EpiBf16: ACT is 0 (none) or 1 (gelu_pk)");
    bf16_t* O; int ldc; const float* bias; int split_cols; size_t split_stride; float scale0;
    __device__ __forceinline__ void operator()(const f32x4 (&acc)[2][2][4][2], const Unit& u, int wr, int wc, int fr, int fq) const {
        const int row0 = u.pm * BM + wr * 64 + fr; int colt = u.pn * BM; bf16_t* base = O;
        float sc = 1.f; if (split_cols) { const int t = colt / split_cols; base += (size_t)t * split_stride; colt -= t * split_cols; if (t == 0) sc = scale0; }
        const int col0 = colt + wc * 32 + 8 * fq, bcol0 = u.pn * BM + wc * 32 + 8 * fq;
        f32x4 bv[2][2];
#pragma unroll
        for (int bj = 0; bj < 2; ++bj)
#pragma unroll
            for (int n = 0; n < 2; ++n) bv[bj][n] = bias ? *(const f32x4*)(bias + bcol0 + bj * HALF + 4 * n) : (f32x4){0.f, 0.f, 0.f, 0.f};
#pragma unroll
        for (int ai = 0; ai < 2; ++ai)
#pragma unroll
            for (int m = 0; m < 4; ++m) { bf16_t* rowp = base + (size_t)(row0 + ai * HALF + m * 16) * ldc + col0;
#pragma unroll
                for (int bj = 0; bj < 2; ++bj) { f32x4 v0 = acc[ai][bj][m][0] + bv[bj][0], v1 = acc[ai][bj][m][1] + bv[bj][1];
                    if (ACT == 1) { f32x2 a = gelu_pk((f32x2){v0[0], v0[1]}), b = gelu_pk((f32x2){v0[2], v0[3]}), c = gelu_pk((f32x2){v1[0], v1[1]}), d = gelu_pk((f32x2){v1[2], v1[3]});
                        v0 = (f32x4){a.x, a.y, b.x, b.y}; v1 = (f32x4){c.x, c.y, d.x, d.y}; }
                    v0 = v0 * sc; v1 = v1 * sc; u32x4 w; w.x = cvt_pk_bf16(v0[0], v0[1]); w.y = cvt_pk_bf16(v0[2], v0[3]); w.z = cvt_pk_bf16(v1[0], v1[1]); w.w = cvt_pk_bf16(v1[2], v1[3]);
                    *(u32x4*)(rowp + bj * HALF) = w; } }
    }
};
typedef int i32x8 __attribute__((ext_vector_type(8)));
__host__ __device__ __forceinline__ int lds_byte8(int r, int fq) { const int st = (r >> 4) * 2 + (fq >> 1), rr = r & 15, ob = rr * 64 + (fq & 1) * 32; return st * 1024 + (ob ^ (((ob >> 9) & 1) << 5)); }
template <class Epi, class Sched, bool ALIGN_EPI = false, bool SP2 = false>
__device__ __forceinline__ void gemm_phase(PG8_LAS unsigned char* lds, const Gemm g, const Sched& S, const Epi& E) {
    int tid = threadIdx.x; asm volatile("" : "+v"(tid));
    const int wid = __builtin_amdgcn_readfirstlane(tid >> 6), lane = tid & 63, wr = wid >> 2, wc = wid & 3, fr = lane & 15, fq = lane >> 4;
    const int K = g.K, nt = K / BK;
    unsigned voffA[2], voffB[2];
#pragma unroll
    for (int i = 0; i < 2; ++i) { int R, C; stage_rc(tid * 16 + i * 8192, R, C); const int Rb = Epi::PERM ? ((R & ~31) + perm32(R & 31)) : R;
        voffA[i] = (unsigned)(R * K + C) * 2u; voffB[i] = (unsigned)(Rb * K + C) * 2u; }
    const size_t kstep = (size_t)(BK * 2);
    const size_t hstep = (size_t)HALF * K * 2;
    const size_t tstep = 2 * hstep;
    const unsigned ldsw = (unsigned)wid * 1024u;
    const int aoff = lds_byte(wr * 64 + fr, fq * 8), boff = lds_byte(wc * 32 + fr, fq * 8);
#define PG8_SA(b, h) (((b) * 2 + (h)) * HTB)
#define PG8_SB(b, h) ((4 + (b) * 2 + (h)) * HTB)
#define PG8_STAGE(bufoff, gbase, voff) do { _Pragma("unroll") for (int _i = 0; _i < 2; ++_i) \
        __builtin_amdgcn_global_load_lds((const unsigned*)((const char*)(gbase) + (voff)[_i]), (PG8_LAS unsigned*)(lds + (bufoff) + ldsw + _i * 8192), 16, 0, 0); } while (0)
#define PG8_LDA(dst, b, h) do { _Pragma("unroll") for (int m = 0; m < 4; ++m) _Pragma("unroll") for (int k = 0; k < 2; ++k) dst[m][k] = *(const PG8_LAS bf16x8*)(lds + PG8_SA(b, h) + aoff + m * 2048 + k * 1024); } while (0)
#define PG8_LDB(dst, b, h) do { _Pragma("unroll") for (int n = 0; n < 2; ++n) _Pragma("unroll") for (int k = 0; k < 2; ++k) dst[n][k] = *(const PG8_LAS bf16x8*)(lds + PG8_SB(b, h) + boff + n * 2048 + k * 1024); } while (0)
#define PG8_MMA(ai, bj, At, Bt) do { __builtin_amdgcn_s_setprio(1); _Pragma("unroll") for (int m = 0; m < 4; ++m) _Pragma("unroll") for (int n = 0; n < 2; ++n) _Pragma("unroll") for (int k = 0; k < 2; ++k) \
        acc[ai][bj][m][n] = __builtin_amdgcn_mfma_f32_16x16x32_bf16(Bt[n][k], At[m][k], acc[ai][bj][m][n], 0, 0, 0); __builtin_amdgcn_s_setprio(0); } while (0)
#define PG8_WAIT_V(n) asm volatile("s_waitcnt vmcnt(" #n ")" ::: "memory")
#define PG8_WAIT_L(n) asm volatile("s_waitcnt lgkmcnt(" #n ")" ::: "memory")
#define PG8_BAR __builtin_amdgcn_s_barrier()
#define PG8_SCHED __builtin_amdgcn_sched_barrier(0)
    Unit cur, nxt; int ui = 0;
    if (!S.next(0, cur)) return;
    f32x4 acc[2][2][4][2];
#pragma unroll
    for (int a = 0; a < 2; ++a)
#pragma unroll
        for (int b = 0; b < 2; ++b)
#pragma unroll
            for (int m = 0; m < 4; ++m)
#pragma unroll
                for (int n = 0; n < 2; ++n) acc[a][b][m][n] = (f32x4){0.f, 0.f, 0.f, 0.f};
    bf16x8 At[4][2], B0[2][2], B1[2][2];
    const char* cA = (const char*)g.A + (size_t)cur.pm * tstep; const char* cB = (const char*)g.Bt + (size_t)cur.pn * tstep;
    S.a_ready(cur);
    if constexpr (SP2) {
        PG8_STAGE(PG8_SB(0, 0), cB, voffB); PG8_STAGE(PG8_SB(0, 1), cB + hstep, voffB); PG8_STAGE(PG8_SA(0, 0), cA, voffA); PG8_STAGE(PG8_SA(0, 1), cA + hstep, voffA);
        if (wr == 1) PG8_BAR;
        PG8_WAIT_V(2); PG8_BAR;
        PG8_STAGE(PG8_SB(1, 0), cB + kstep, voffB); PG8_STAGE(PG8_SA(1, 0), cA + kstep, voffA); PG8_STAGE(PG8_SB(1, 1), cB + hstep + kstep, voffB);
        PG8_WAIT_V(6); PG8_BAR;
    } else {
        PG8_STAGE(PG8_SB(0, 0), cB, voffB); PG8_STAGE(PG8_SA(0, 0), cA, voffA); PG8_STAGE(PG8_SB(0, 1), cB + hstep, voffB); PG8_STAGE(PG8_SA(0, 1), cA + hstep, voffA);
        if (wr == 1) PG8_BAR;
        PG8_WAIT_V(4); PG8_BAR;
        PG8_STAGE(PG8_SB(1, 0), cB + kstep, voffB); PG8_STAGE(PG8_SA(1, 0), cA + kstep, voffA); PG8_STAGE(PG8_SB(1, 1), cB + hstep + kstep, voffB);
        PG8_WAIT_V(6); PG8_BAR;
    }
    for (;;) {
        const bool has_next = S.next(ui + 1, nxt);
        const char* nA = has_next ? (const char*)g.A + (size_t)nxt.pm * tstep : cA; const char* nB = has_next ? (const char*)g.Bt + (size_t)nxt.pn * tstep : cB;
        for (int t = 0; t < nt; t += 2) {
            const bool last = (t == nt - 2);
            const char* a1 = cA + (size_t)(t + 1) * kstep;
            const char* a2 = last ? nA : cA + (size_t)(t + 2) * kstep; const char* b2 = last ? nB : cB + (size_t)(t + 2) * kstep;
            const char* a3 = a2 + kstep; const char* b3 = b2 + kstep;
            if (last && has_next) S.a_ready(nxt);
            if constexpr (SP2) {
            PG8_LDB(B0, 0, 0); PG8_LDB(B1, 0, 1); PG8_SCHED; PG8_LDA(At, 0, 0); PG8_STAGE(PG8_SA(1, 1), a1 + hstep, voffA);
            PG8_WAIT_V(8); PG8_WAIT_L(0); PG8_BAR; PG8_MMA(0, 0, At, B0); PG8_MMA(0, 1, At, B1); PG8_BAR; PG8_SCHED;
            PG8_LDA(At, 0, 1); PG8_STAGE(PG8_SB(0, 0), b2, voffB); PG8_STAGE(PG8_SB(0, 1), b2 + hstep, voffB); PG8_STAGE(PG8_SA(0, 0), a2, voffA);
            PG8_WAIT_V(8); PG8_WAIT_L(0); PG8_BAR; PG8_MMA(1, 0, At, B0); PG8_MMA(1, 1, At, B1); PG8_BAR; PG8_SCHED;
            PG8_LDB(B0, 1, 0); PG8_LDB(B1, 1, 1); PG8_SCHED; PG8_LDA(At, 1, 0); PG8_STAGE(PG8_SA(0, 1), a2 + hstep, voffA);
            PG8_WAIT_V(8); PG8_WAIT_L(0); PG8_BAR; PG8_MMA(0, 0, At, B0); PG8_MMA(0, 1, At, B1); PG8_BAR; PG8_SCHED;
            PG8_LDA(At, 1, 1); PG8_STAGE(PG8_SB(1, 0), b3, voffB); PG8_STAGE(PG8_SB(1, 1), b3 + hstep, voffB); PG8_STAGE(PG8_SA(1, 0), a3, voffA);
            PG8_WAIT_V(8); PG8_WAIT_L(0); PG8_BAR; PG8_MMA(1, 0, At, B0); PG8_MMA(1, 1, At, B1); PG8_BAR; PG8_SCHED;
            } else {
            PG8_LDB(B0, 0, 0); PG8_SCHED; PG8_LDA(At, 0, 0); PG8_STAGE(PG8_SA(1, 1), a1 + hstep, voffA);
            PG8_WAIT_L(8); PG8_BAR; PG8_WAIT_L(0); PG8_MMA(0, 0, At, B0); PG8_BAR; PG8_SCHED;
            PG8_LDB(B1, 0, 1); PG8_STAGE(PG8_SB(0, 0), b2, voffB);
            PG8_BAR; PG8_WAIT_L(0); PG8_MMA(0, 1, At, B1); PG8_BAR;
            PG8_LDA(At, 0, 1); PG8_STAGE(PG8_SA(0, 0), a2, voffA);
            PG8_BAR; PG8_WAIT_L(0); PG8_MMA(1, 0, At, B0); PG8_BAR; PG8_SCHED;
            PG8_STAGE(PG8_SB(0, 1), b2 + hstep, voffB);
            PG8_WAIT_V(6); PG8_BAR; PG8_MMA(1, 1, At, B1); PG8_BAR;
            PG8_LDB(B0, 1, 0); PG8_SCHED; PG8_LDA(At, 1, 0); PG8_STAGE(PG8_SA(0, 1), a2 + hstep, voffA);
            PG8_WAIT_L(8); PG8_BAR; PG8_WAIT_L(0); PG8_MMA(0, 0, At, B0); PG8_BAR; PG8_SCHED;
            PG8_LDB(B1, 1, 1); PG8_STAGE(PG8_SB(1, 0), b3, voffB);
            PG8_BAR; PG8_WAIT_L(0); PG8_MMA(0, 1, At, B1); PG8_BAR;
            PG8_LDA(At, 1, 1); PG8_STAGE(PG8_SA(1, 0), a3, voffA);
            PG8_BAR; PG8_WAIT_L(0); PG8_MMA(1, 0, At, B0); PG8_BAR; PG8_SCHED;
            PG8_STAGE(PG8_SB(1, 1), b3 + hstep, voffB);
            PG8_WAIT_V(6); PG8_BAR; PG8_MMA(1, 1, At, B1); PG8_BAR;
            }
        }
        if constexpr (ALIGN_EPI) { if (wr == 0) PG8_BAR; }
        if constexpr (!Epi::AFTER_DRAIN) { E(acc, cur, wr, wc, fr, fq); S.done(cur); }
        if (!has_next) break;
#pragma unroll
        for (int a = 0; a < 2; ++a)
#pragma unroll
            for (int b = 0; b < 2; ++b)
#pragma unroll
                for (int m = 0; m < 4; ++m)
#pragma unroll
                    for (int n = 0; n < 2; ++n) acc[a][b][m][n] = (f32x4){0.f, 0.f, 0.f, 0.f};
        cur = nxt; cA = nA; cB = nB; ++ui;
        if constexpr (ALIGN_EPI) { if (wr == 1) PG8_BAR; }
    }
    PG8_WAIT_V(0);
    if constexpr (!ALIGN_EPI) { if (wr == 0) PG8_BAR; }
    PG8_BAR;
    if constexpr (Epi::AFTER_DRAIN) { E.fused(acc, cur, wr, wc, fr, fq, lds, wid, lane); S.done(cur); }
}
template <class Epi, class Sched>
__device__ __forceinline__ void gemm_phase_g(PG8_LAS unsigned char* lds, PG8_LAS unsigned char* side, const Gemm g, const unsigned* rowoff, const Sched& S, const Epi& E) {
    constexpr bool ALIGN_EPI = true, SP2 = true;
    int tid = threadIdx.x; asm volatile("" : "+v"(tid));
    const int wid = __builtin_amdgcn_readfirstlane(tid >> 6), lane = tid & 63, wr = wid >> 2, wc = wid & 3, fr = lane & 15, fq = lane >> 4;
    const int K = g.K, nt = K / BK;
    unsigned voffB[2], cA2[2]; int RA[2];
#pragma unroll
    for (int i = 0; i < 2; ++i) { int R, C; stage_rc(tid * 16 + i * 8192, R, C); const int Rb = Epi::PERM ? ((R & ~31) + perm32(R & 31)) : R;
        RA[i] = R; cA2[i] = (unsigned)C * 2u; voffB[i] = (unsigned)(Rb * K + C) * 2u; }
    const size_t kstep = (size_t)(BK * 2);
    const size_t hstep = (size_t)HALF * K * 2;
    const size_t tstep = 2 * hstep;
    const unsigned ldsw = (unsigned)wid * 1024u;
    const int aoff = lds_byte(wr * 64 + fr, fq * 8), boff = lds_byte(wc * 32 + fr, fq * 8);
    Unit cur, nxt; int ui = 0;
    if (!S.next(0, cur)) return;
    f32x4 acc[2][2][4][2];
#pragma unroll
    for (int a = 0; a < 2; ++a)
#pragma unroll
        for (int b = 0; b < 2; ++b)
#pragma unroll
            for (int m = 0; m < 4; ++m)
#pragma unroll
                for (int n = 0; n < 2; ++n) acc[a][b][m][n] = (f32x4){0.f, 0.f, 0.f, 0.f};
    bf16x8 At[4][2], B0[2][2], B1[2][2];
    const char* const gA = (const char*)g.A; const char* cB = (const char*)g.Bt + (size_t)cur.pn * tstep;
    unsigned vo0[2], vo1[2], nvo0[2], nvo1[2];
#pragma unroll
    for (int i = 0; i < 2; ++i) { vo0[i] = rowoff[(size_t)cur.pm * 256 + RA[i]] + cA2[i]; vo1[i] = rowoff[(size_t)cur.pm * 256 + 128 + RA[i]] + cA2[i]; nvo0[i] = vo0[i]; nvo1[i] = vo1[i]; }
    S.a_ready(cur);
    if constexpr (SP2) {
        PG8_STAGE(PG8_SB(0, 0), cB, voffB); PG8_STAGE(PG8_SB(0, 1), cB + hstep, voffB); PG8_STAGE(PG8_SA(0, 0), gA, vo0); PG8_STAGE(PG8_SA(0, 1), gA, vo1);
        if (wr == 1) PG8_BAR;
        PG8_WAIT_V(2); PG8_BAR;
        PG8_STAGE(PG8_SB(1, 0), cB + kstep, voffB); PG8_STAGE(PG8_SA(1, 0), gA + kstep, vo0); PG8_STAGE(PG8_SB(1, 1), cB + hstep + kstep, voffB);
        PG8_WAIT_V(6); PG8_BAR;
    }
    for (;;) {
        const bool has_next = S.next(ui + 1, nxt);
        const char* nB = has_next ? (const char*)g.Bt + (size_t)nxt.pn * tstep : cB;
        if (has_next) __builtin_amdgcn_global_load_lds((const unsigned*)(rowoff + (size_t)nxt.pm * 256 + lane * 4), (PG8_LAS unsigned*)(side + (ui & 1) * 1024), 16, 0, 0);
        for (int t = 0; t < nt; t += 2) {
            const bool last = (t == nt - 2);
            if (last && has_next) {
                const PG8_LAS unsigned* sl = (const PG8_LAS unsigned*)(side + (ui & 1) * 1024);
#pragma unroll
                for (int i = 0; i < 2; ++i) { int ra = RA[i]; asm volatile("" : "+v"(ra));
                    nvo0[i] = sl[ra] + cA2[i]; nvo1[i] = sl[128 + ra] + cA2[i]; }
            }
            const char* a1 = gA + (size_t)(t + 1) * kstep;
            const char* a2 = last ? gA : gA + (size_t)(t + 2) * kstep; const char* b2 = last ? nB : cB + (size_t)(t + 2) * kstep;
            unsigned s0[2], s1[2];
#pragma unroll
            for (int i = 0; i < 2; ++i) { s0[i] = last ? nvo0[i] : vo0[i]; s1[i] = last ? nvo1[i] : vo1[i]; }
            const char* a3 = a2 + kstep; const char* b3 = b2 + kstep;
            if (last && has_next) S.a_ready(nxt);
            if constexpr (SP2) {
            PG8_LDB(B0, 0, 0); PG8_LDB(B1, 0, 1); PG8_SCHED; PG8_LDA(At, 0, 0); PG8_STAGE(PG8_SA(1, 1), a1, vo1);
            PG8_WAIT_V(8); PG8_WAIT_L(0); PG8_BAR; PG8_MMA(0, 0, At, B0); PG8_MMA(0, 1, At, B1); PG8_BAR; PG8_SCHED;
            PG8_LDA(At, 0, 1); PG8_STAGE(PG8_SB(0, 0), b2, voffB); PG8_STAGE(PG8_SB(0, 1), b2 + hstep, voffB); PG8_STAGE(PG8_SA(0, 0), a2, s0);
            PG8_WAIT_V(8); PG8_WAIT_L(0); PG8_BAR; PG8_MMA(1, 0, At, B0); PG8_MMA(1, 1, At, B1); PG8_BAR; PG8_SCHED;
            PG8_LDB(B0, 1, 0); PG8_LDB(B1, 1, 1); PG8_SCHED; PG8_LDA(At, 1, 0); PG8_STAGE(PG8_SA(0, 1), a2, s1);
            PG8_WAIT_V(8); PG8_WAIT_L(0); PG8_BAR; PG8_MMA(0, 0, At, B0); PG8_MMA(0, 1, At, B1); PG8_BAR; PG8_SCHED;
            PG8_LDA(At, 1, 1); PG8_STAGE(PG8_SB(1, 0), b3, voffB); PG8_STAGE(PG8_SB(1, 1), b3 + hstep, voffB); PG8_STAGE(PG8_SA(1, 0), a3, s0);
            PG8_WAIT_V(8); PG8_WAIT_L(0); PG8_BAR; PG8_MMA(1, 0, At, B0); PG8_MMA(1, 1, At, B1); PG8_BAR; PG8_SCHED;
            }
        }
        if constexpr (ALIGN_EPI) { if (wr == 0) PG8_BAR; }
        if constexpr (!Epi::AFTER_DRAIN) { E(acc, cur, wr, wc, fr, fq); S.done(cur); }
        if (!has_next) break;
#pragma unroll
        for (int a = 0; a < 2; ++a)
#pragma unroll
            for (int b = 0; b < 2; ++b)
#pragma unroll
                for (int m = 0; m < 4; ++m)
#pragma unroll
                    for (int n = 0; n < 2; ++n) acc[a][b][m][n] = (f32x4){0.f, 0.f, 0.f, 0.f};
        cur = nxt; cB = nB; ++ui;
#pragma unroll
        for (int i = 0; i < 2; ++i) { vo0[i] = nvo0[i]; vo1[i] = nvo1[i]; }
        if constexpr (ALIGN_EPI) { if (wr == 1) PG8_BAR; }
    }
    PG8_WAIT_V(0);
    if constexpr (!ALIGN_EPI) { if (wr == 0) PG8_BAR; }
    PG8_BAR;
    if constexpr (Epi::AFTER_DRAIN) { E.fused(acc, cur, wr, wc, fr, fq, lds, wid, lane); S.done(cur); }
}
#define PG8_LDA8(dst, b, h) do { _Pragma("unroll") for (int m = 0; m < 4; ++m) dst[m] = *(const PG8_LAS i32x8*)(lds + PG8_SA(b, h) + aoff + m * 2048); } while (0)
#define PG8_LDB8(dst, b, h) do { _Pragma("unroll") for (int n = 0; n < 2; ++n) dst[n] = *(const PG8_LAS i32x8*)(lds + PG8_SB(b, h) + boff + n * 2048); } while (0)
#define PG8_MMA8(ai, bj, At, Bt) do { __builtin_amdgcn_s_setprio(1); asm volatile("s_nop 1" ::: "memory"); _Pragma("unroll") for (int m = 0; m < 4; ++m) _Pragma("unroll") for (int n = 0; n < 2; ++n) \
        asm volatile("v_mfma_scale_f32_16x16x128_f8f6f4 %0, %1, %2, %0, %3, %3 op_sel_hi:[0,0,0]" : "+v"(acc[ai][bj][m][n]) : "v"(Bt[n]), "v"(At[m]), "v"(scl8)); __builtin_amdgcn_s_setprio(0); } while (0)
template <class Epi, class Sched>
__device__ __forceinline__ void gemm_phase_g8(PG8_LAS unsigned char* lds, PG8_LAS unsigned char* side, const Gemm g, const unsigned* rowoff, const Sched& S, const Epi& E) {
    constexpr bool ALIGN_EPI = true, SP2 = true;
    int tid = threadIdx.x; asm volatile("" : "+v"(tid));
    const int wid = __builtin_amdgcn_readfirstlane(tid >> 6), lane = tid & 63, wr = wid >> 2, wc = wid & 3, fr = lane & 15, fq = lane >> 4;
    const int K = g.K; int nt = K / BK; asm volatile("" : "+s"(nt));
    unsigned voffB[2]; unsigned cA2 = 0u; int RA = 0;
#pragma unroll
    for (int i = 0; i < 2; ++i) { int R, C; stage_rc(tid * 16 + i * 8192, R, C); const int Rb = Epi::PERM ? ((R & ~31) + perm32(R & 31)) : R;
        if (i == 0) { RA = R; cA2 = (unsigned)C * 2u; } voffB[i] = (unsigned)(Rb * K + C) * 2u; }
    const size_t kstep = (size_t)(BK * 2);
    const size_t hstep = (size_t)HALF * K * 2;
    const size_t tstep = 2 * hstep;
    const unsigned ldsw = (unsigned)wid * 1024u;
    const int aoff = lds_byte8(wr * 64 + fr, fq), boff = lds_byte8(wc * 32 + fr, fq);
    int scl8 = 0x7f7f7f7f; asm volatile("" : "+v"(scl8));
    Unit cur, nxt; int ui = 0;
    if (!S.next(0, cur)) return;
    f32x4 acc[2][2][4][2];
#pragma unroll
    for (int a = 0; a < 2; ++a)
#pragma unroll
        for (int b = 0; b < 2; ++b)
#pragma unroll
            for (int m = 0; m < 4; ++m)
#pragma unroll
                for (int n = 0; n < 2; ++n) acc[a][b][m][n] = (f32x4){0.f, 0.f, 0.f, 0.f};
    i32x8 At[4], B0[2], B1[2];
    const char* const gA = (const char*)g.A; const char* cB = (const char*)g.Bt + (size_t)cur.pn * tstep;
    unsigned vo0[2], vo1[2];
#pragma unroll
    for (int i = 0; i < 2; ++i) { vo0[i] = rowoff[(size_t)cur.pm * 256 + RA + 64 * i] + cA2; vo1[i] = rowoff[(size_t)cur.pm * 256 + 128 + RA + 64 * i] + cA2; }
    S.a_ready(cur);
    if constexpr (SP2) {
        PG8_STAGE(PG8_SB(0, 0), cB, voffB); PG8_STAGE(PG8_SB(0, 1), cB + hstep, voffB); PG8_STAGE(PG8_SA(0, 0), gA, vo0); PG8_STAGE(PG8_SA(0, 1), gA, vo1);
        if (wr == 1) PG8_BAR;
        PG8_WAIT_V(2); PG8_BAR;
        PG8_STAGE(PG8_SB(1, 0), cB + kstep, voffB); PG8_STAGE(PG8_SA(1, 0), gA + kstep, vo0); PG8_STAGE(PG8_SB(1, 1), cB + hstep + kstep, voffB);
        PG8_WAIT_V(6); PG8_BAR;
    }
    for (;;) {
        const bool has_next = S.next(ui + 1, nxt);
        const char* nB = has_next ? (const char*)g.Bt + (size_t)nxt.pn * tstep : cB;
        if (has_next) __builtin_amdgcn_global_load_lds((const unsigned*)(rowoff + (size_t)nxt.pm * 256 + lane * 4), (PG8_LAS unsigned*)(side + (ui & 1) * 1024), 16, 0, 0);
        for (int t = 0; t < nt; t += 2) {
            const bool last = (t == nt - 2);
            const char* a1 = gA + (size_t)(t + 1) * kstep;
            const char* a2 = last ? gA : gA + (size_t)(t + 2) * kstep; const char* b2 = last ? nB : cB + (size_t)(t + 2) * kstep;
            unsigned s0[2], s1[2];
#pragma unroll
            for (int i = 0; i < 2; ++i) { s0[i] = vo0[i]; s1[i] = vo1[i]; }
            if (last && has_next) {
                const PG8_LAS unsigned* sl = (const PG8_LAS unsigned*)(side + (ui & 1) * 1024);
                int ra = RA; asm volatile("" : "+v"(ra));
#pragma unroll
                for (int i = 0; i < 2; ++i) { s0[i] = sl[ra + 64 * i] + cA2; s1[i] = sl[128 + ra + 64 * i] + cA2; }
            }
            const char* a3 = a2 + kstep; const char* b3 = b2 + kstep;
            if (last && has_next) S.a_ready(nxt);
            if constexpr (SP2) {
            PG8_LDB8(B0, 0, 0); PG8_LDB8(B1, 0, 1); PG8_SCHED; PG8_LDA8(At, 0, 0); PG8_STAGE(PG8_SA(1, 1), a1, vo1);
            PG8_WAIT_V(8); PG8_WAIT_L(0); PG8_BAR; PG8_MMA8(0, 0, At, B0); PG8_MMA8(0, 1, At, B1); PG8_BAR; PG8_SCHED;
            PG8_LDA8(At, 0, 1); PG8_STAGE(PG8_SB(0, 0), b2, voffB); PG8_STAGE(PG8_SB(0, 1), b2 + hstep, voffB); PG8_STAGE(PG8_SA(0, 0), a2, s0);
            PG8_WAIT_V(8); PG8_WAIT_L(0); PG8_BAR; PG8_MMA8(1, 0, At, B0); PG8_MMA8(1, 1, At, B1); PG8_BAR; PG8_SCHED;
            PG8_LDB8(B0, 1, 0); PG8_LDB8(B1, 1, 1); PG8_SCHED; PG8_LDA8(At, 1, 0); PG8_STAGE(PG8_SA(0, 1), a2, s1);
            PG8_WAIT_V(8); PG8_WAIT_L(0); PG8_BAR; PG8_MMA8(0, 0, At, B0); PG8_MMA8(0, 1, At, B1); PG8_BAR; PG8_SCHED;
            PG8_LDA8(At, 1, 1); PG8_STAGE(PG8_SB(1, 0), b3, voffB); PG8_STAGE(PG8_SB(1, 1), b3 + hstep, voffB); PG8_STAGE(PG8_SA(1, 0), a3, s0);
            PG8_WAIT_V(8); PG8_WAIT_L(0); PG8_BAR; PG8_MMA8(1, 0, At, B0); PG8_MMA8(1, 1, At, B1); PG8_BAR; PG8_SCHED;
            }
        }
        asm volatile("s_nop 15\n\ts_nop 15" ::: "memory");
        if constexpr (ALIGN_EPI) { if (wr == 0) PG8_BAR; }
        if constexpr (!Epi::AFTER_DRAIN) { E(acc, cur, wr, wc, fr, fq); S.done(cur); }
        if (!has_next) break;
#pragma unroll
        for (int a = 0; a < 2; ++a)
#pragma unroll
            for (int b = 0; b < 2; ++b)
#pragma unroll
                for (int m = 0; m < 4; ++m)
#pragma unroll
                    for (int n = 0; n < 2; ++n) acc[a][b][m][n] = (f32x4){0.f, 0.f, 0.f, 0.f};
        cur = nxt; cB = nB; ++ui;
        { const PG8_LAS unsigned* sl = (const PG8_LAS unsigned*)(side + ((ui - 1) & 1) * 1024); int ra = RA; asm volatile("" : "+v"(ra));
#pragma unroll
          for (int i = 0; i < 2; ++i) { vo0[i] = sl[ra + 64 * i] + cA2; vo1[i] = sl[128 + ra + 64 * i] + cA2; } }
        if constexpr (ALIGN_EPI) { if (wr == 1) PG8_BAR; }
    }
    PG8_WAIT_V(0);
    if constexpr (!ALIGN_EPI) { if (wr == 0) PG8_BAR; }
    PG8_BAR;
    if constexpr (Epi::AFTER_DRAIN) { E.fused(acc, cur, wr, wc, fr, fq, lds, wid, lane); S.done(cur); }
}
template <class Epi, class Sched, bool ALIGN_EPI = false, bool SP2 = false>
__device__ __forceinline__ void gemm_phase8(PG8_LAS unsigned char* lds, const Gemm g, const Sched& S, const Epi& E) {
    int tid = threadIdx.x; asm volatile("" : "+v"(tid));
    const int wid = __builtin_amdgcn_readfirstlane(tid >> 6), lane = tid & 63, wr = wid >> 2, wc = wid & 3, fr = lane & 15, fq = lane >> 4;
    const int K = g.K; int nt = K / BK; asm volatile("" : "+s"(nt));
    unsigned voffA[2], voffB[2];
#pragma unroll
    for (int i = 0; i < 2; ++i) { int R, C; stage_rc(tid * 16 + i * 8192, R, C); const int Rb = Epi::PERM ? ((R & ~31) + perm32(R & 31)) : R;
        voffA[i] = (unsigned)(R * K + C) * 2u; voffB[i] = (unsigned)(Rb * K + C) * 2u; }
    const size_t kstep = (size_t)(BK * 2);
    const size_t hstep = (size_t)HALF * K * 2;
    const size_t tstep = 2 * hstep;
    const unsigned ldsw = (unsigned)wid * 1024u;
    const int aoff = lds_byte8(wr * 64 + fr, fq), boff = lds_byte8(wc * 32 + fr, fq);
    int scl8 = 0x7f7f7f7f; asm volatile("" : "+v"(scl8));
    Unit cur, nxt; int ui = 0;
    if (!S.next(0, cur)) return;
    f32x4 acc[2][2][4][2];
#pragma unroll
    for (int a = 0; a < 2; ++a)
#pragma unroll
        for (int b = 0; b < 2; ++b)
#pragma unroll
            for (int m = 0; m < 4; ++m)
#pragma unroll
                for (int n = 0; n < 2; ++n) acc[a][b][m][n] = (f32x4){0.f, 0.f, 0.f, 0.f};
    i32x8 At[4], B0[2], B1[2];
    const char* cA = (const char*)g.A + (size_t)cur.pm * tstep; const char* cB = (const char*)g.Bt + (size_t)cur.pn * tstep;
    S.a_ready(cur);
    if constexpr (SP2) {
        PG8_STAGE(PG8_SB(0, 0), cB, voffB); PG8_STAGE(PG8_SB(0, 1), cB + hstep, voffB); PG8_STAGE(PG8_SA(0, 0), cA, voffA); PG8_STAGE(PG8_SA(0, 1), cA + hstep, voffA);
        if (wr == 1) PG8_BAR;
        PG8_WAIT_V(2); PG8_BAR;
        PG8_STAGE(PG8_SB(1, 0), cB + kstep, voffB); PG8_STAGE(PG8_SA(1, 0), cA + kstep, voffA); PG8_STAGE(PG8_SB(1, 1), cB + hstep + kstep, voffB);
        PG8_WAIT_V(6); PG8_BAR;
    } else {
        PG8_STAGE(PG8_SB(0, 0), cB, voffB); PG8_STAGE(PG8_SA(0, 0), cA, voffA); PG8_STAGE(PG8_SB(0, 1), cB + hstep, voffB); PG8_STAGE(PG8_SA(0, 1), cA + hstep, voffA);
        if (wr == 1) PG8_BAR;
        PG8_WAIT_V(4); PG8_BAR;
        PG8_STAGE(PG8_SB(1, 0), cB + kstep, voffB); PG8_STAGE(PG8_SA(1, 0), cA + kstep, voffA); PG8_STAGE(PG8_SB(1, 1), cB + hstep + kstep, voffB);
        PG8_WAIT_V(6); PG8_BAR;
    }
    for (;;) {
        const bool has_next = S.next(ui + 1, nxt);
        const char* nA = has_next ? (const char*)g.A + (size_t)nxt.pm * tstep : cA; const char* nB = has_next ? (const char*)g.Bt + (size_t)nxt.pn * tstep : cB;
        for (int t = 0; t < nt; t += 2) {
            const bool last = (t == nt - 2);
            const char* a1 = cA + (size_t)(t + 1) * kstep;
            const char* a2 = last ? nA : cA + (size_t)(t + 2) * kstep; const char* b2 = last ? nB : cB + (size_t)(t + 2) * kstep;
            const char* a3 = a2 + kstep; const char* b3 = b2 + kstep;
            if (last && has_next) S.a_ready(nxt);
            if constexpr (SP2) {
            PG8_LDB8(B0, 0, 0); PG8_LDB8(B1, 0, 1); PG8_SCHED; PG8_LDA8(At, 0, 0); PG8_STAGE(PG8_SA(1, 1), a1 + hstep, voffA);
            PG8_WAIT_V(8); PG8_WAIT_L(0); PG8_BAR; PG8_MMA8(0, 0, At, B0); PG8_MMA8(0, 1, At, B1); PG8_BAR; PG8_SCHED;
            PG8_LDA8(At, 0, 1); PG8_STAGE(PG8_SB(0, 0), b2, voffB); PG8_STAGE(PG8_SB(0, 1), b2 + hstep, voffB); PG8_STAGE(PG8_SA(0, 0), a2, voffA);
            PG8_WAIT_V(8); PG8_WAIT_L(0); PG8_BAR; PG8_MMA8(1, 0, At, B0); PG8_MMA8(1, 1, At, B1); PG8_BAR; PG8_SCHED;
            PG8_LDB8(B0, 1, 0); PG8_LDB8(B1, 1, 1); PG8_SCHED; PG8_LDA8(At, 1, 0); PG8_STAGE(PG8_SA(0, 1), a2 + hstep, voffA);
            PG8_WAIT_V(8); PG8_WAIT_L(0); PG8_BAR; PG8_MMA8(0, 0, At, B0); PG8_MMA8(0, 1, At, B1); PG8_BAR; PG8_SCHED;
            PG8_LDA8(At, 1, 1); PG8_STAGE(PG8_SB(1, 0), b3, voffB); PG8_STAGE(PG8_SB(1, 1), b3 + hstep, voffB); PG8_STAGE(PG8_SA(1, 0), a3, voffA);
            PG8_WAIT_V(8); PG8_WAIT_L(0); PG8_BAR; PG8_MMA8(1, 0, At, B0); PG8_MMA8(1, 1, At, B1); PG8_BAR; PG8_SCHED;
            } else {
            PG8_LDB8(B0, 0, 0); PG8_SCHED; PG8_LDA8(At, 0, 0); PG8_STAGE(PG8_SA(1, 1), a1 + hstep, voffA);
            PG8_WAIT_L(8); PG8_BAR; PG8_WAIT_L(0); PG8_MMA8(0, 0, At, B0); PG8_BAR; PG8_SCHED;
            PG8_LDB8(B1, 0, 1); PG8_STAGE(PG8_SB(0, 0), b2, voffB);
            PG8_BAR; PG8_WAIT_L(0); PG8_MMA8(0, 1, At, B1); PG8_BAR;
            PG8_LDA8(At, 0, 1); PG8_STAGE(PG8_SA(0, 0), a2, voffA);
            PG8_BAR; PG8_WAIT_L(0); PG8_MMA8(1, 0, At, B0); PG8_BAR; PG8_SCHED;
            PG8_STAGE(PG8_SB(0, 1), b2 + hstep, voffB);
            PG8_WAIT_V(6); PG8_BAR; PG8_MMA8(1, 1, At, B1); PG8_BAR;
            PG8_LDB8(B0, 1, 0); PG8_SCHED; PG8_LDA8(At, 1, 0); PG8_STAGE(PG8_SA(0, 1), a2 + hstep, voffA);
            PG8_WAIT_L(8); PG8_BAR; PG8_WAIT_L(0); PG8_MMA8(0, 0, At, B0); PG8_BAR; PG8_SCHED;
            PG8_LDB8(B1, 1, 1); PG8_STAGE(PG8_SB(1, 0), b3, voffB);
            PG8_BAR; PG8_WAIT_L(0); PG8_MMA8(0, 1, At, B1); PG8_BAR;
            PG8_LDA8(At, 1, 1); PG8_STAGE(PG8_SA(1, 0), a3, voffA);
            PG8_BAR; PG8_WAIT_L(0); PG8_MMA8(1, 0, At, B0); PG8_BAR; PG8_SCHED;
            PG8_STAGE(PG8_SB(1, 1), b3 + hstep, voffB);
            PG8_WAIT_V(6); PG8_BAR; PG8_MMA8(1, 1, At, B1); PG8_BAR;
            }
        }
        asm volatile("s_nop 15\n\ts_nop 15" ::: "memory");
        if constexpr (ALIGN_EPI) { if (wr == 0) PG8_BAR; }
        if constexpr (!Epi::AFTER_DRAIN) { E(acc, cur, wr, wc, fr, fq); S.done(cur); }
        if (!has_next) break;
#pragma unroll
        for (int a = 0; a < 2; ++a)
#pragma unroll
            for (int b = 0; b < 2; ++b)
#pragma unroll
                for (int m = 0; m < 4; ++m)
#pragma unroll
                    for (int n = 0; n < 2; ++n) acc[a][b][m][n] = (f32x4){0.f, 0.f, 0.f, 0.f};
        cur = nxt; cA = nA; cB = nB; ++ui;
        if constexpr (ALIGN_EPI) { if (wr == 1) PG8_BAR; }
    }
    PG8_WAIT_V(0);
    if constexpr (!ALIGN_EPI) { if (wr == 0) PG8_BAR; }
    PG8_BAR;
    if constexpr (Epi::AFTER_DRAIN) { E.fused(acc, cur, wr, wc, fr, fq, lds, wid, lane); S.done(cur); }
}
#undef PG8_LDA8
#undef PG8_LDB8
#undef PG8_MMA8
#undef PG8_SA
#undef PG8_SB
#undef PG8_STAGE
#undef PG8_LDA
#undef PG8_LDB
#undef PG8_MMA
#undef PG8_WAIT_V
#undef PG8_WAIT_L
#undef PG8_BAR
#undef PG8_SCHED
}
#define GAS __attribute__((address_space(1)))
#define LAS __attribute__((address_space(3)))
typedef unsigned short bf16;
typedef unsigned v4u __attribute__((ext_vector_type(4)));
typedef float f32x4 __attribute__((ext_vector_type(4)));
typedef short bf16x8 __attribute__((ext_vector_type(8)));
typedef GAS unsigned gu32;
typedef GAS unsigned long long gu64;
#define RLX_AGENT __ATOMIC_RELAXED, __HIP_MEMORY_SCOPE_AGENT
#define LDS_WAIT() asm volatile("s_waitcnt lgkmcnt(0)" ::: "memory")
#define VM_WAIT() asm volatile("s_waitcnt vmcnt(0)" ::: "memory")
__device__ __forceinline__ unsigned long long rt() { return __builtin_amdgcn_s_memrealtime(); }
__device__ __forceinline__ unsigned f2bf(float f) { unsigned u = __builtin_bit_cast(unsigned, f); return (u + 0x7fffu + ((u >> 16) & 1u)) >> 16; }
__device__ __forceinline__ unsigned pk2(float lo, float hi) { return f2bf(lo) | (f2bf(hi) << 16); }

#define XB_TMO      128
#define XB_XCNT(j)  (256  + 64 * (j))
#define XB_XSUB(j)  (1280 + 64 * (j))
#define XB_XGEN(j)  (2304 + 64 * (j))
#define XB_TOP      3328
#define XB_TOPGEN   3392
#define XCD_BAR_WORDS 3456
#define XB_SPIN_CAP (1u << 18)

__device__ __forceinline__ unsigned xb_ld(unsigned* p)              { return __hip_atomic_load(p, __ATOMIC_RELAXED, __HIP_MEMORY_SCOPE_AGENT); }
__device__ __forceinline__ unsigned xb_add(unsigned* p, unsigned v) { return __hip_atomic_fetch_add(p, v, __ATOMIC_RELAXED, __HIP_MEMORY_SCOPE_AGENT); }
__device__ __forceinline__ unsigned xb_xcc_id() { return (unsigned)__builtin_amdgcn_s_getreg((3 << 11) | 20) & 0xFu; }
#define XB_SPIN(cond, bar) do { unsigned _sp = 0; while (cond) { __builtin_amdgcn_s_sleep(1); \
    if ((++_sp & 255u) == 0u) { if (xb_ld(&(bar)[XB_TMO])) break; if (_sp > XB_SPIN_CAP) { atomicAdd(&(bar)[XB_TMO], 1u); break; } } } } while (0)

struct XcdBarrier {
    unsigned* bar; unsigned x;
    volatile LAS unsigned* st;
};

__device__ __forceinline__ XcdBarrier xcd_barrier_post(unsigned* bar, volatile LAS unsigned* st) {
    XcdBarrier b; b.bar = bar; b.x = xb_xcc_id(); b.st = st;
    if (threadIdx.x == 0) (void)xb_add(&bar[XB_XCNT(b.x)], 1u);
    return b;
}
__device__ __forceinline__ void xcd_barrier_complete(unsigned* bar, unsigned x, unsigned& nloc, unsigned& nx) {
    const unsigned G = gridDim.x * gridDim.y * gridDim.z;
    unsigned sum, cnt, mine, sp = 0u;
    for (;;) {
        sum = 0u; cnt = 0u; mine = 0u;
#pragma unroll
        for (unsigned j = 0; j < 16; ++j) { const unsigned c = xb_ld(&bar[XB_XCNT(j)]); sum += c; cnt += (c > 0u) ? 1u : 0u; mine = (j == x) ? c : mine; }
        if (sum == G) break;
        __builtin_amdgcn_s_sleep(1);
        if ((++sp & 255u) == 0u) { if (xb_ld(&bar[XB_TMO])) break; if (sp > XB_SPIN_CAP) { atomicAdd(&bar[XB_TMO], 1u); break; } }
    }
    nloc = mine > 0u ? mine : 1u; nx = cnt > 0u ? cnt : 1u;
}

__device__ __forceinline__ void xcd_barrier(const XcdBarrier& b) {
    asm volatile("s_waitcnt vmcnt(0)" ::: "memory");
    __syncthreads();
    if (threadIdx.x == 0) {
        unsigned* bar = b.bar;
        __builtin_amdgcn_s_waitcnt(0);
        unsigned nloc = b.st[0], nx = b.st[1];
        if (nloc == 0u) { xcd_barrier_complete(bar, b.x, nloc, nx); b.st[0] = nloc; b.st[1] = nx; }
        const unsigned old = xb_add(&bar[XB_XSUB(b.x)], 1u);
        const unsigned gen = old / nloc;
        if (old + 1u == (gen + 1u) * nloc) {
            __builtin_amdgcn_fence(__ATOMIC_RELEASE, "agent");
            asm volatile("s_waitcnt vmcnt(0)" ::: "memory");
            const unsigned og = xb_add(&bar[XB_TOP], 1u);
            const unsigned tg = og / nx;
            if (og + 1u == (tg + 1u) * nx) xb_add(&bar[XB_TOPGEN], 1u);
            else XB_SPIN(xb_ld(&bar[XB_TOPGEN]) == tg, bar);
            __builtin_amdgcn_fence(__ATOMIC_ACQUIRE, "agent");
            xb_add(&bar[XB_XGEN(b.x)], 1u);
            asm volatile("s_waitcnt vmcnt(0)" ::: "memory");
        } else {
            XB_SPIN(xb_ld(&bar[XB_XGEN(b.x)]) == gen, bar);
            __builtin_amdgcn_fence(__ATOMIC_ACQUIRE, "agent");
            asm volatile("s_waitcnt vmcnt(0)" ::: "memory");
        }
    }
    __syncthreads();
}
typedef unsigned u32x4 __attribute__((ext_vector_type(4)));

namespace pg8 {
typedef unsigned u32x2 __attribute__((ext_vector_type(2)));
__device__ __forceinline__ float silu_f(float x) { return x * __builtin_amdgcn_rcpf(1.0f + __expf(-x)); }
struct EpiHS {
    static constexpr bool PERM = true, AFTER_DRAIN = false;
    const float* x; const float* meta; bf16_t* hsb;
    __device__ __forceinline__ void operator()(const f32x4 (&acc)[2][2][4][2], const Unit& u, int wr, int wc, int fr, int fq) const {
        const int col0 = u.pn * BM + wc * 32 + 8 * fq;
#pragma unroll
        for (int ai = 0; ai < 2; ++ai) {
            f32x4 rv[4][2][2]; int tt[4];
#pragma unroll
            for (int m = 0; m < 4; ++m) {
                const int r = u.pm * BM + ai * HALF + wr * 64 + m * 16 + fr;
                const int b = r / 8320, p = r - b * 8320, t = p - 112; tt[m] = t;
                const int tc = t < 0 ? 16 : t;
                const float* src = tc < 16 ? meta + (size_t)tc * 1024 : x + ((size_t)b * 8192 + (size_t)(tc - 16)) * 1024;
#pragma unroll
                for (int bj = 0; bj < 2; ++bj) { rv[m][bj][0] = *(const f32x4*)(src + col0 + bj * HALF); rv[m][bj][1] = *(const f32x4*)(src + col0 + bj * HALF + 4); }
            }
#pragma unroll
            for (int m = 0; m < 4; ++m) {
                const int r = u.pm * BM + ai * HALF + wr * 64 + m * 16 + fr;
                if (tt[m] >= 0) {
                    bf16_t* dst = hsb + (size_t)r * 1024;
#pragma unroll
                    for (int bj = 0; bj < 2; ++bj) { const f32x4 v0 = rv[m][bj][0] + acc[ai][bj][m][0], v1 = rv[m][bj][1] + acc[ai][bj][m][1]; u32x4 w;
                        w.x = cvt_pk_bf16(v0[0], v0[1]); w.y = cvt_pk_bf16(v0[2], v0[3]); w.z = cvt_pk_bf16(v1[0], v1[1]); w.w = cvt_pk_bf16(v1[2], v1[3]);
                        *(u32x4*)(dst + col0 + bj * HALF) = w; }
                }
            }
        }
    }
};
struct EpiAct {
    static constexpr bool PERM = true, AFTER_DRAIN = false;
    bf16_t* act;
    __device__ __forceinline__ void operator()(const f32x4 (&acc)[2][2][4][2], const Unit& u, int wr, int wc, int fr, int fq) const {
        const int row0 = u.pm * BM + wr * 64 + fr; const int j = u.pn & 7; const int col0 = j * 128 + wc * 32 + 8 * fq;
#pragma unroll
        for (int ai = 0; ai < 2; ++ai)
#pragma unroll
            for (int m = 0; m < 4; ++m) {
                unsigned char* rowp = (unsigned char*)act + (size_t)(row0 + ai * HALF + m * 16) * 1024 + col0;
                const f32x4 g0 = acc[ai][0][m][0] * 0.03125f, g1 = acc[ai][0][m][1] * 0.03125f, u0 = acc[ai][1][m][0] * 0.03125f, u1 = acc[ai][1][m][1] * 0.03125f;
                u32x2 w; unsigned t = 0u;
                t = __builtin_amdgcn_cvt_pk_fp8_f32(silu_f(g0[0]) * u0[0], silu_f(g0[1]) * u0[1], t, false); t = __builtin_amdgcn_cvt_pk_fp8_f32(silu_f(g0[2]) * u0[2], silu_f(g0[3]) * u0[3], t, true); w.x = t;
                t = __builtin_amdgcn_cvt_pk_fp8_f32(silu_f(g1[0]) * u1[0], silu_f(g1[1]) * u1[1], t, false); t = __builtin_amdgcn_cvt_pk_fp8_f32(silu_f(g1[2]) * u1[2], silu_f(g1[3]) * u1[3], t, true); w.y = t;
                *(u32x2*)rowp = w;
            }
    }
};
struct EpiYS {
    static constexpr bool PERM = true, AFTER_DRAIN = false;
    unsigned char* ys; const float* gate;
    __device__ __forceinline__ void operator()(const f32x4 (&acc)[2][2][4][2], const Unit& u, int wr, int wc, int fr, int fq) const {
        const int row0 = u.pm * BM + wr * 64 + fr; const int j = u.pn & 3; const int col0 = j * 256 + wc * 32 + 8 * fq;
#pragma unroll
        for (int ai = 0; ai < 2; ++ai)
#pragma unroll
            for (int m = 0; m < 4; ++m) {
                const int row = row0 + ai * HALF + m * 16; const float gv = gate[row] * 0.25f;
                unsigned char* rowp = ys + (size_t)row * 1024 + col0;
#pragma unroll
                for (int bj = 0; bj < 2; ++bj) { const f32x4 v0 = acc[ai][bj][m][0] * gv, v1 = acc[ai][bj][m][1] * gv; u32x2 w; unsigned t = 0u;
                    t = __builtin_amdgcn_cvt_pk_fp8_f32(v0[0], v0[1], t, false); t = __builtin_amdgcn_cvt_pk_fp8_f32(v0[2], v0[3], t, true); w.x = t;
                    t = __builtin_amdgcn_cvt_pk_fp8_f32(v1[0], v1[1], t, false); t = __builtin_amdgcn_cvt_pk_fp8_f32(v1[2], v1[3], t, true); w.y = t;
                    *(u32x2*)(rowp + bj * HALF) = w; }
            }
    }
};

struct EpiZ {
    static constexpr bool PERM = true, AFTER_DRAIN = false;
    bf16_t* Z; const float* cs;
    __device__ __forceinline__ void operator()(const f32x4 (&acc)[2][2][4][2], const Unit& u, int wr, int wc, int fr, int fq) const {
        const int row0 = u.pm * BM + wr * 64 + fr;
        if (u.pn < 4 || u.pn >= 8) {
            const int col0 = u.pn * BM + wc * 32 + 8 * fq;
#pragma unroll
            for (int ai = 0; ai < 2; ++ai)
#pragma unroll
                for (int m = 0; m < 4; ++m) { bf16_t* rowp = Z + (size_t)(row0 + ai * HALF + m * 16) * 3072 + col0;
#pragma unroll
                    for (int bj = 0; bj < 2; ++bj) { const f32x4 v0 = acc[ai][bj][m][0], v1 = acc[ai][bj][m][1]; u32x4 w;
                        w.x = cvt_pk_bf16(v0[0], v0[1]); w.y = cvt_pk_bf16(v0[2], v0[3]); w.z = cvt_pk_bf16(v1[0], v1[1]); w.w = cvt_pk_bf16(v1[2], v1[3]);
                        *(u32x4*)(rowp + bj * HALF) = w; } }
        } else {
            const int x0 = wc * 32 + 8 * fq;
            const int region = (u.pn - 4) >> 1, head = 2 * ((u.pn - 4) & 1) + (x0 >> 6), j0 = x0 & 63;
            const int colA = 1024 + region * 512 + head * 128 + j0;
            const float sc = region == 0 ? 0.08838834764831845f : 1.0f;
#pragma unroll
            for (int ai = 0; ai < 2; ++ai) {
                f32x4 cc[4][4];
#pragma unroll
                for (int m = 0; m < 4; ++m) { const int r = row0 + ai * HALF + m * 16; const int b = r / 8320; int t = r - b * 8320 - 112; t = t < 0 ? 0 : t;
                    const f32x4* cp = (const f32x4*)(cs + ((size_t)t * 64 + j0) * 2); cc[m][0] = cp[0]; cc[m][1] = cp[1]; cc[m][2] = cp[2]; cc[m][3] = cp[3]; }
#pragma unroll
                for (int m = 0; m < 4; ++m) {
                    const int r = row0 + ai * HALF + m * 16;
                    const f32x4 c0 = cc[m][0], c1 = cc[m][1], c2 = cc[m][2], c3 = cc[m][3];
                    const f32x4 a0 = acc[ai][0][m][0], a1 = acc[ai][0][m][1], b0 = acc[ai][1][m][0], b1 = acc[ai][1][m][1];
                    u32x4 w1, w2;
                    w1.x = cvt_pk_bf16((a0[0] * c0[0] - b0[0] * c0[1]) * sc, (a0[1] * c0[2] - b0[1] * c0[3]) * sc); w2.x = cvt_pk_bf16((a0[0] * c0[1] + b0[0] * c0[0]) * sc, (a0[1] * c0[3] + b0[1] * c0[2]) * sc);
                    w1.y = cvt_pk_bf16((a0[2] * c1[0] - b0[2] * c1[1]) * sc, (a0[3] * c1[2] - b0[3] * c1[3]) * sc); w2.y = cvt_pk_bf16((a0[2] * c1[1] + b0[2] * c1[0]) * sc, (a0[3] * c1[3] + b0[3] * c1[2]) * sc);
                    w1.z = cvt_pk_bf16((a1[0] * c2[0] - b1[0] * c2[1]) * sc, (a1[1] * c2[2] - b1[1] * c2[3]) * sc); w2.z = cvt_pk_bf16((a1[0] * c2[1] + b1[0] * c2[0]) * sc, (a1[1] * c2[3] + b1[1] * c2[2]) * sc);
                    w1.w = cvt_pk_bf16((a1[2] * c3[0] - b1[2] * c3[1]) * sc, (a1[3] * c3[2] - b1[3] * c3[3]) * sc); w2.w = cvt_pk_bf16((a1[2] * c3[1] + b1[2] * c3[0]) * sc, (a1[3] * c3[3] + b1[3] * c3[2]) * sc);
                    bf16_t* rowp = Z + (size_t)r * 3072 + colA;
                    *(u32x4*)rowp = w1; *(u32x4*)(rowp + 64) = w2;
                }
            }
        }
    }
};
struct GroupOrder {
    int G, vcu, tm, tn, nwg;
    __device__ __forceinline__ void init(int ne, int tm_, int tn_, int G_, int c) { tm = tm_; tn = tn_; nwg = ne * tm_ * tn_; G = G_; vcu = (G_ % 8 == 0) ? (c % 8) * (G_ / 8) + c / 8 : c; }
    __device__ __forceinline__ bool next(int i, Unit& u) const {
        const long L = (long)i * G + vcu; if (L >= nwg) return false;
        const int per = tm * tn, e = (int)(L / per), rem = (int)(L % per);
        u.pm = e * tm + rem / tn; u.pn = e * tn + rem % tn; return true;
    }
    __device__ __forceinline__ void a_ready(const Unit&) const {}
    __device__ __forceinline__ void done(const Unit&) const {}
};
}

constexpr int NB = 8, SEQ = 8192, DM = 1024, NMETA = 16, TT = SEQ + NMETA, PADL = 112, PP = 8320, NP = NB * PP;
constexpr int NCHUNK = 65, NSEG = 130;
constexpr int ZC = 3072, ZC_LX = 0, ZC_LG = 512, ZC_Q = 1024, ZC_K = 1536, ZC_V = 2048, ZC_G = 2560;
constexpr int NE = 16, CAP = 1026, EROWS = 8448, NROWS = NE * EROWS;
constexpr float EPSN = 1e-6f;
constexpr int NPHASE = 12;

constexpr size_t MiB = 1u << 20;
constexpr size_t WS_CTL = 0, CTL_ZERO_BYTES = 64 * 1024;
constexpr size_t WS_GW = 1 * MiB, WS_GW2 = 1 * MiB + 256 * 1024, WS_HSMETA = 1 * MiB + 512 * 1024;
constexpr size_t WS_CS = 3 * MiB, WS_SUMM = 8 * MiB, WS_CARRY = 17 * MiB, WS_AFF = 22 * MiB, WS_ROWMAP = 27 * MiB, WS_IDX = 32 * MiB, WS_GATE = 33 * MiB;
constexpr size_t WS_WIN = 34 * MiB, WS_WOUT = 40 * MiB, WS_WGU = 42 * MiB, WS_WD = 106 * MiB;
#ifndef ST_INPLACE
#define ST2_BASE WS_ST2
#define CPY_BASE WS_ST
#else
#define ST2_BASE WS_ST
#define CPY_BASE WS_ST2
#endif
constexpr size_t WS_ST2 = 788 * MiB;
constexpr size_t WS_HSB = 400 * MiB;
constexpr size_t WS_H = 138 * MiB, WS_Z = 268 * MiB, WS_ST = 658 * MiB, WS_XS = 658 * MiB, WS_ACT = 268 * MiB, WS_YS = WS_XS, WS_END = 922 * MiB;
static_assert(WS_H + (size_t)NP * 2048 <= WS_Z && WS_Z + (size_t)NP * ZC * 2 <= WS_ST && WS_ST + (size_t)NB * 4 * 2 * NCHUNK * 32768 <= WS_END && WS_XS + (size_t)NROWS * 2048 <= WS_END && WS_ACT + (size_t)NROWS * 2048 <= WS_ST, "ws map");
constexpr int CW_BAR = 1024;

constexpr int LDS_MAIN = 131072, LDS_BYTES = 147456;
constexpr int LDS_SS = LDS_MAIN;
constexpr int LDS_MISC = LDS_MAIN + 4096;
constexpr int LDS_SIDE = LDS_MAIN + 8192;

typedef unsigned short u16x8 __attribute__((ext_vector_type(8)));
typedef unsigned short u16x4 __attribute__((ext_vector_type(4)));
typedef float f32x16 __attribute__((ext_vector_type(16)));
typedef float f32x2 __attribute__((ext_vector_type(2)));
typedef unsigned u32x2 __attribute__((ext_vector_type(2)));
typedef short v4i16_t __attribute__((ext_vector_type(4)));
typedef __bf16 bf16x2_t __attribute__((ext_vector_type(2)));

__device__ __forceinline__ float bf2f(unsigned short v) { return __uint_as_float((unsigned)v << 16); }
__device__ __forceinline__ unsigned cvtpk(float lo, float hi) { f32x2 v = {lo, hi}; bf16x2_t b = __builtin_convertvector(v, bf16x2_t); return __builtin_bit_cast(unsigned, b); }
__device__ __forceinline__ unsigned short f2bf16(float f) { return (unsigned short)(cvtpk(f, 0.f) & 0xffffu); }
__device__ __forceinline__ float wave_sum(float v) {
#pragma unroll
    for (int o = 1; o < 64; o <<= 1) v += __shfl_xor(v, o);
    return v;
}
__device__ __forceinline__ float sigmoid_f(float x) { return __builtin_amdgcn_rcpf(1.0f + __expf(-x)); }
__device__ __forceinline__ float gelu_tanh_f(float x) { const float z2 = 2.302208198144325f * x * (1.0f + 0.044715f * x * x);   return x - x * __builtin_amdgcn_rcpf(1.0f + __builtin_amdgcn_exp2f(z2)); }
__device__ __forceinline__ float softplus_neg(float lam) { const float y = __expf(-lam); return (y < 0.05f) ? y * (1.0f + y * (-0.5f + y * (0.33333333f + y * (-0.25f + y * 0.2f)))) : log1pf(y); }
__device__ __forceinline__ float log2_gamma(int h) { return h == 0 ? -0.04580368961312479f : h == 1 ? -0.02272007650008353f : h == 2 ? -0.011315313227834146f : -0.005646563141142063f; }
__device__ __forceinline__ unsigned off_b(unsigned row, unsigned ch) { return 256u * row + 16u * (ch ^ (((row & 3u) << 2) | ((row >> 2) & 3u))); }
__device__ __forceinline__ pg8::bf16x8 rowfrag(LAS unsigned char* T, int rb, int s, int lane) {
    return *(LAS pg8::bf16x8*)(T + off_b(32 * rb + (lane & 31), 2 * s + (lane >> 5)));
}
__device__ __forceinline__ pg8::bf16x8 rowfrag_x(LAS unsigned char* T, int rb, int s, int lane) {
    return *(LAS pg8::bf16x8*)(T + off_b((32 * rb + (lane & 31)) ^ 1, 2 * s + (lane >> 5)));
}
__device__ __forceinline__ v4i16_t tr_rd(LAS unsigned char* p) { return __builtin_amdgcn_ds_read_tr16_b64_v4i16((LAS v4i16_t*)p); }
__device__ __forceinline__ pg8::bf16x8 trfrag(LAS unsigned char* T, int c, int ks, int lane) {
    const unsigned h = lane >> 5, blk = (lane >> 4) & 1, q = (lane & 15) >> 2, p = lane & 3;
    const v4i16_t lo = tr_rd(T + off_b(16 * ks + 8 * h + q, 4 * c + 2 * blk + (p >> 1)) + 8 * (p & 1));
    const v4i16_t hi = tr_rd(T + off_b(16 * ks + 8 * h + 4 + q, 4 * c + 2 * blk + (p >> 1)) + 8 * (p & 1));
    return (pg8::bf16x8){lo[0], lo[1], lo[2], lo[3], hi[0], hi[1], hi[2], hi[3]};
}
__device__ __forceinline__ pg8::bf16x8 trfrag_perm(LAS unsigned char* T, int c, int rbase, int lane) {
    const unsigned h = lane >> 5, blk = (lane >> 4) & 1, q = (lane & 15) >> 2, p = lane & 3;
    const v4i16_t lo = tr_rd(T + off_b(rbase + 4 * h + q, 4 * c + 2 * blk + (p >> 1)) + 8 * (p & 1));
    const v4i16_t hi = tr_rd(T + off_b(rbase + 8 + 4 * h + q, 4 * c + 2 * blk + (p >> 1)) + 8 * (p & 1));
    return (pg8::bf16x8){lo[0], lo[1], lo[2], lo[3], hi[0], hi[1], hi[2], hi[3]};
}
__device__ __forceinline__ int crow(int reg, int h) { return (reg & 3) + 8 * (reg >> 2) + 4 * h; }
#define MFMA32(a, b, c) __builtin_amdgcn_mfma_f32_32x32x16_bf16((a), (b), (c), 0, 0, 0)
#define MFMA16(a, b, c) __builtin_amdgcn_mfma_f32_16x16x32_bf16((a), (b), (c), 0, 0, 0)

struct Fr {
    LAS unsigned char* lds;
    int tid, lane, wave, G;
    const float *x, *meta, *norm1_g, *w_in, *conv_w, *conv_b, *w_r, *b_r, *w_i, *b_i, *lam, *lru_out_g, *ret_out_g, *w_out, *norm2_g, *w_router, *w_gate, *w_up, *w_down, *final_g;
    float* out;
    unsigned short *GW2; unsigned short *GW, *WIN, *WOUT, *WGU, *WD, *H, *Z, *ST, *XS, *ACT, *YS;
    unsigned char* CTLP; float *HSMETA, *AFF, *GATE, *CARRY; unsigned short* HSB; unsigned short* ST2; f32x2 *CS, *SUMM; int *ROWMAP, *IDX;
};

__device__ __forceinline__ void prep_tile(const Fr& F, const float* W, int ldw, int k0, int n0, unsigned short* WT, int mode) {
    LAS float* scr = (LAS float*)F.lds;
    const int tid = F.tid;
    { const int n = tid & 63, kk = tid >> 6;
#pragma unroll
      for (int i = 0; i < 8; ++i) { const int k = kk + 8 * i; scr[k * 65 + n] = W[(size_t)(k0 + k) * ldw + n0 + n]; } }
    __syncthreads();
    { const int k = tid & 63, nn = tid >> 6;
#pragma unroll
      for (int i = 0; i < 8; ++i) { const int n = n0 + nn + 8 * i; int row;
          if (mode == 0) row = n; else if (mode == 3) { if (n < 1024 || n >= 2048) row = n; else { const int q = n - 1024, region = q >> 9, hd = (q >> 7) & 3, d = q & 127; row = 1024 + region * 512 + (hd >> 1) * 256 + (d >> 6) * 128 + (hd & 1) * 64 + (d & 63); } }
          else row = 256 * (n >> 7) + (n & 127) + (mode == 2 ? 128 : 0);
          WT[(size_t)row * 1024 + k0 + k] = f2bf16(scr[k * 65 + (nn + 8 * i)]); } }
    __syncthreads();
}
__device__ __forceinline__ void prep_tile8(const Fr& F, const float* W, int k0, int n0, unsigned char* WT8, int mode) {
    LAS float* scr = (LAS float*)F.lds;
    const int tid = F.tid;
    { const int n = tid & 63, kk = tid >> 6;
#pragma unroll
      for (int i = 0; i < 8; ++i) { const int k = kk + 8 * i; scr[k * 65 + n] = W[(size_t)(k0 + k) * 1024 + n0 + n]; } }
    __syncthreads();
    { const int k4 = tid & 15, nn = tid >> 4;
#pragma unroll
      for (int i = 0; i < 2; ++i) { const int nl = nn + 32 * i, n = n0 + nl; const int row = mode == 0 ? n : 256 * (n >> 7) + (n & 127) + (mode == 2 ? 128 : 0);
          const float a = scr[(4 * k4 + 0) * 65 + nl] * 32.0f, b = scr[(4 * k4 + 1) * 65 + nl] * 32.0f, c = scr[(4 * k4 + 2) * 65 + nl] * 32.0f, d = scr[(4 * k4 + 3) * 65 + nl] * 32.0f;
          unsigned w = 0u; w = __builtin_amdgcn_cvt_pk_fp8_f32(a, b, w, false); w = __builtin_amdgcn_cvt_pk_fp8_f32(c, d, w, true);
          *(unsigned*)(WT8 + (size_t)row * 1024 + k0 + 4 * k4) = w; } }
    __syncthreads();
}
__device__ __forceinline__ void sincos_tab(int t, int j, float& co, float& si) {
    double f = 1.0, bse = 0.8659643233600653;
    int e = j;
#pragma unroll
    for (int i = 0; i < 6; ++i) { if (e & 1) f *= bse; bse *= bse; e >>= 1; }
    const double xx = (double)t * f;
    const double qd = __builtin_rint(xx * 0.6366197723675814);
    double y = __builtin_fma(-qd, 1.5707963267948966, xx); y = __builtin_fma(-qd, 6.123233995736766e-17, y);
    const double y2 = y * y;
    double sp = -7.647163731819816e-13;
    sp = sp * y2 + 1.6059043836821613e-10;
    sp = sp * y2 - 2.505210838544172e-08;
    sp = sp * y2 + 2.7557319223985893e-06;
    sp = sp * y2 - 1.984126984126984e-04;
    sp = sp * y2 + 8.333333333333333e-03;
    sp = sp * y2 - 1.6666666666666666e-01;
    const double sy = y + y * y2 * sp;
    double cp = 4.779477332387385e-14;
    cp = cp * y2 - 1.1470745597729725e-11;
    cp = cp * y2 + 2.08767569878681e-09;
    cp = cp * y2 - 2.755731922398589e-07;
    cp = cp * y2 + 2.48015873015873e-05;
    cp = cp * y2 - 1.388888888888889e-03;
    cp = cp * y2 + 4.1666666666666664e-02;
    cp = cp * y2 - 0.5;
    const double cy = 1.0 + y2 * cp;
    const int qi = ((int)(long long)qd) & 3;
    const double s_ = (qi == 0) ? sy : (qi == 1) ? cy : (qi == 2) ? -sy : -cy;
    const double c_ = (qi == 0) ? cy : (qi == 1) ? -sy : (qi == 2) ? -cy : sy;
    co = (float)c_; si = (float)s_;
}
__device__ __forceinline__ void rms_row_to_bf16(const float* xrow, const float* g, unsigned short* orow, int lane) {
    const f32x4* xr = (const f32x4*)xrow + lane; const f32x4* gr = (const f32x4*)g + lane;
    f32x4 v[4]; float s = 0.f;
#pragma unroll
    for (int j = 0; j < 4; ++j) { v[j] = xr[64 * j]; s += (v[j].x * v[j].x + v[j].y * v[j].y) + (v[j].z * v[j].z + v[j].w * v[j].w); }
    const float rs = 1.0f / sqrtf(wave_sum(s) * (1.0f / 1024.0f) + EPSN);
    u32x2* o8 = (u32x2*)orow + lane;
#pragma unroll
    for (int j = 0; j < 4; ++j) { const f32x4 gg = gr[64 * j]; u32x2 w; w.x = cvtpk(v[j].x * rs * gg.x, v[j].y * rs * gg.y); w.y = cvtpk(v[j].z * rs * gg.z, v[j].w * rs * gg.w); o8[64 * j] = w; }
}
__device__ __forceinline__ void prep_stream8(const Fr& F, const float* Wall, unsigned char* WT8all, size_t estride, int mode, int vb, int VG) {
    LAS float* scr = (LAS float*)F.lds;
    const int tid = F.tid, n_ = tid & 63, kk = tid >> 6, k4 = tid & 15, nn = tid >> 4;
    int t = vb; if (t < 0 || t >= 4096) return;
    float v[8];
    { const int e = t >> 8, r = t & 255, k0 = 64 * (r >> 4), n0 = 64 * (r & 15); const float* W = Wall + (size_t)e * 1048576;
#pragma unroll
      for (int i = 0; i < 8; ++i) v[i] = W[(size_t)(k0 + kk + 8 * i) * 1024 + n0 + n_]; }
    for (; t < 4096; t += VG) {
        const int e = t >> 8, r = t & 255, k0 = 64 * (r >> 4), n0 = 64 * (r & 15);
        float vn[8];
        { const int t2 = t + VG < 4096 ? t + VG : t; const int e2 = t2 >> 8, r2 = t2 & 255, k2 = 64 * (r2 >> 4), n2 = 64 * (r2 & 15); const float* W = Wall + (size_t)e2 * 1048576;
#pragma unroll
          for (int i = 0; i < 8; ++i) vn[i] = W[(size_t)(k2 + kk + 8 * i) * 1024 + n2 + n_]; }
#pragma unroll
        for (int i = 0; i < 8; ++i) scr[(kk + 8 * i) * 65 + n_] = v[i];
        __syncthreads();
        unsigned char* WT8 = WT8all + (size_t)e * estride;
#pragma unroll
        for (int i = 0; i < 2; ++i) { const int nl = nn + 32 * i, n = n0 + nl; const int row = mode == 0 ? n : 256 * (n >> 7) + (n & 127) + (mode == 2 ? 128 : 0);
            const float a = scr[(4 * k4 + 0) * 65 + nl] * 32.0f, b = scr[(4 * k4 + 1) * 65 + nl] * 32.0f, c = scr[(4 * k4 + 2) * 65 + nl] * 32.0f, d = scr[(4 * k4 + 3) * 65 + nl] * 32.0f;
            unsigned w = 0u; w = __builtin_amdgcn_cvt_pk_fp8_f32(a, b, w, false); w = __builtin_amdgcn_cvt_pk_fp8_f32(c, d, w, true);
            *(unsigned*)(WT8 + (size_t)row * 1024 + k0 + 4 * k4) = w; }
        __syncthreads();
#pragma unroll
        for (int i = 0; i < 8; ++i) v[i] = vn[i];
    }
}
__device__ __forceinline__ void ph_prep(const Fr& F) {
    const int bid = blockIdx.x, G = F.G;
    for (int it = bid; it < 1024; it += G) {
        if (it < 768) { const int kt = it / 48, nt = it % 48; prep_tile(F, F.w_in, 3072, 64 * kt, 64 * nt, F.WIN, 3); }
        else { const int i2 = it - 768, kt = i2 / 16, nt = i2 % 16; prep_tile(F, F.w_out, 1024, 64 * kt, 64 * nt, F.WOUT, 0); }
    }
    const int gt = bid * 512 + F.tid, GT = G * 512;
    for (int idx = gt; idx < 8 * 256 * 64; idx += GT) {
        const int blk = idx >> 14, o = (idx >> 6) & 255, k = idx & 63, g = o >> 6, d = o & 63, dir = g >> 1;
        const float* src = (g & 1) ? F.w_i : F.w_r;
        F.GW[idx] = f2bf16(src[((size_t)(dir * 8 + blk) * 64 + k) * 64 + d]);
    }
    for (int idx = gt; idx < 8 * 256 * 64; idx += GT) {
        const int k = idx & 63, fr = (idx >> 6) & 15, cg = (idx >> 10) & 3, g = (idx >> 12) & 3, blk = idx >> 14;
        const float* src = (g & 1) ? F.w_i : F.w_r;
        F.GW2[idx] = f2bf16(src[((size_t)((g >> 1) * 8 + blk) * 64 + k) * 64 + 16 * cg + fr]);
    }
    for (int idx = gt; idx < TT * 64; idx += GT) { float co, si; sincos_tab(idx >> 6, idx & 63, co, si); F.CS[idx] = (f32x2){co, si}; }
    const int gw = bid * 8 + F.wave, NGW = G * 8; const int lane = F.lane;
    for (int r = gw; r < NB * PADL; r += NGW) { const int b = r / PADL, p = r - b * PADL; u32x2* o8 = (u32x2*)(F.H + (size_t)(b * PP + p) * 1024) + lane;
#pragma unroll
        for (int j = 0; j < 4; ++j) o8[64 * j] = (u32x2){0u, 0u}; }
    f32x4 gg[4];
#pragma unroll
    for (int j = 0; j < 4; ++j) gg[j] = ((const f32x4*)F.norm1_g + lane)[64 * j];
    f32x4 nx[2][4];
    const int NPAIR = NB * TT / 2;
    if (gw < NPAIR) {
#pragma unroll
        for (int q = 0; q < 2; ++q) { const int v = 2 * gw + q, b = v / TT, t = v - b * TT; const f32x4* xr = (const f32x4*)(t < NMETA ? F.meta + (size_t)t * 1024 : F.x + ((size_t)b * SEQ + (t - NMETA)) * 1024) + lane;
#pragma unroll
            for (int j = 0; j < 4; ++j) nx[q][j] = xr[64 * j]; }
    }
    for (int pr = gw; pr < NPAIR; pr += NGW) {
        f32x4 vv[2][4];
#pragma unroll
        for (int q = 0; q < 2; ++q)
#pragma unroll
            for (int j = 0; j < 4; ++j) vv[q][j] = nx[q][j];
        { const int pn = pr + NGW < NPAIR ? pr + NGW : pr;
#pragma unroll
          for (int q = 0; q < 2; ++q) { const int v = 2 * pn + q, b = v / TT, t = v - b * TT; const f32x4* xr = (const f32x4*)(t < NMETA ? F.meta + (size_t)t * 1024 : F.x + ((size_t)b * SEQ + (t - NMETA)) * 1024) + lane;
#pragma unroll
              for (int j = 0; j < 4; ++j) nx[q][j] = xr[64 * j]; } }
#pragma unroll
        for (int q = 0; q < 2; ++q) {
            const int v = 2 * pr + q, b = v / TT, t = v - b * TT;
            float s = 0.f;
#pragma unroll
            for (int j = 0; j < 4; ++j) s += (vv[q][j].x * vv[q][j].x + vv[q][j].y * vv[q][j].y) + (vv[q][j].z * vv[q][j].z + vv[q][j].w * vv[q][j].w);
            const float rs = __builtin_amdgcn_rsqf(wave_sum(s) * (1.0f / 1024.0f) + EPSN);
            u32x2* o8 = (u32x2*)(F.H + (size_t)(b * PP + PADL + t) * 1024) + lane;
#pragma unroll
            for (int j = 0; j < 4; ++j) { u32x2 wv; wv.x = cvtpk(vv[q][j].x * rs * gg[j].x, vv[q][j].y * rs * gg[j].y); wv.y = cvtpk(vv[q][j].z * rs * gg[j].z, vv[q][j].w * rs * gg[j].w); o8[64 * j] = wv; }
        }
    }
}

struct LruIn { float xv[11]; float gate[8]; float cw0, cw1, cw2, cw3, cbv, k0, k1, br0, bi0, br1, bi1, cf, cb; pg8::bf16x8 bfr[2][2]; };
template <bool FINAL>
__device__ __forceinline__ void lru_load(const Fr& F, size_t rowbase, int pw, int c, size_t sidx, const unsigned short* gwp, LruIn& L) {
#pragma unroll
    for (int i = 0; i < 11; ++i) { const int p = pw - 2 + i; const int pc = p < 0 ? 0 : (p >= PP ? PP - 1 : p); const float v = bf2f(F.Z[(rowbase + pc) * ZC + ZC_LX + c]); L.xv[i] = (p == pc) ? v : 0.f; }
    if (FINAL) {
#pragma unroll
        for (int j = 0; j < 8; ++j) L.gate[j] = bf2f(F.Z[(rowbase + pw + j) * ZC + ZC_LG + c]);
    }
    L.cw0 = F.conv_w[c]; L.cw1 = F.conv_w[512 + c]; L.cw2 = F.conv_w[1024 + c]; L.cw3 = F.conv_w[1536 + c]; L.cbv = F.conv_b[c];
    L.k0 = F.lam[c]; L.k1 = F.lam[512 + c];
    L.br0 = F.b_r[c]; L.bi0 = F.b_i[c]; L.br1 = F.b_r[512 + c]; L.bi1 = F.b_i[512 + c];
    if (FINAL) { L.cf = F.CARRY[sidx]; L.cb = F.CARRY[sidx + 512]; }
#pragma unroll
    for (int ks = 0; ks < 2; ++ks)
#pragma unroll
        for (int n = 0; n < 2; ++n) L.bfr[ks][n] = *(const pg8::bf16x8*)(gwp + (size_t)(16 * n) * 64 + 32 * ks);
}
template <bool FINAL>
__device__ __forceinline__ void lru_item(const Fr& F, int b, int s) {
    int lane = F.lane; asm volatile("" : "+v"(lane));
    const int w = F.wave, fr = lane & 15, fq = lane >> 4;
    LAS unsigned short* U0 = (LAS unsigned short*)F.lds;
    LAS unsigned char* G16 = F.lds + 18432;
    LAS float* SM = (LAS float*)(F.lds + 18432 + 36864);
    LAS unsigned short* YL = (LAS unsigned short*)(F.lds + 18432 + 36864 + 8192);
    const int pw = s * 64 + 8 * w; const size_t rowbase = (size_t)b * PP;
    constexpr float LOG2E = 1.4426950408889634f;
    float ssq[8];
#pragma unroll
    for (int j = 0; j < 8; ++j) ssq[j] = 0.f;
    const size_t sbase = ((size_t)(b * NSEG + s) * 2) * 512;
    const unsigned short* gw0 = F.GW + (size_t)(32 * w + fr) * 64 + 8 * fq;
    LruIn L; lru_load<FINAL>(F, rowbase, pw, lane, sbase + lane, gw0, L);
    float u[8];
#pragma unroll
    for (int j = 0; j < 8; ++j) { u[j] = L.cbv + L.cw0 * L.xv[j] + L.cw1 * L.xv[j + 1] + L.cw2 * L.xv[j + 2] + L.cw3 * L.xv[j + 3]; U0[(8 * w + j) * 72 + lane] = f2bf16(u[j]); }
    __syncthreads();
    for (int blk = 0; blk < 8; ++blk) {
        const int c = blk * 64 + lane;
        LAS unsigned short* U = U0 + (blk & 1) * 4608; LAS unsigned short* Un = U0 + ((blk & 1) ^ 1) * 4608;
        LruIn N; { const int bn = (blk < 7 ? blk + 1 : 7), cn = bn * 64 + lane; lru_load<FINAL>(F, rowbase, pw, cn, sbase + cn, gw0 + (size_t)bn * 16384, N); }
        pg8::f32x4 acc[4][2];
#pragma unroll
        for (int m = 0; m < 4; ++m) { acc[m][0] = (pg8::f32x4){0.f, 0.f, 0.f, 0.f}; acc[m][1] = acc[m][0]; }
#pragma unroll
        for (int ks = 0; ks < 2; ++ks) {
#pragma unroll
            for (int m = 0; m < 4; ++m) { const pg8::bf16x8 a = *(LAS pg8::bf16x8*)(U + (16 * m + fr) * 72 + 32 * ks + 8 * fq);
#pragma unroll
                for (int n = 0; n < 2; ++n) acc[m][n] = MFMA16(a, L.bfr[ks][n], acc[m][n]); }
        }
#pragma unroll
        for (int m = 0; m < 4; ++m)
#pragma unroll
            for (int n = 0; n < 2; ++n) { u32x2 pk; pk.x = __builtin_bit_cast(unsigned, __builtin_amdgcn_cvt_pkrtz(acc[m][n][0], acc[m][n][1])); pk.y = __builtin_bit_cast(unsigned, __builtin_amdgcn_cvt_pkrtz(acc[m][n][2], acc[m][n][3]));
                *(LAS u32x2*)(G16 + (32 * w + 16 * n + fr) * 144 + (16 * m + 4 * fq) * 2) = pk; }
        __syncthreads();
        const float kk0 = -8.0f * LOG2E * softplus_neg(L.k0), kk1 = -8.0f * LOG2E * softplus_neg(L.k1);
        const float nb_r0 = -LOG2E * L.br0, nb_i0 = -LOG2E * L.bi0, nb_r1 = -LOG2E * L.br1, nb_i1 = -LOG2E * L.bi1;
        typedef _Float16 h16x8 __attribute__((ext_vector_type(8)));
        const h16x8 g0 = *(LAS h16x8*)(G16 + (0 * 64 + lane) * 144 + 16 * w), g1 = *(LAS h16x8*)(G16 + (1 * 64 + lane) * 144 + 16 * w);
        const h16x8 g2 = *(LAS h16x8*)(G16 + (2 * 64 + lane) * 144 + 16 * w), g3 = *(LAS h16x8*)(G16 + (3 * 64 + lane) * 144 + 16 * w);
        float hf[8], pf[8], hb[8], pb[8], af[8], ab[8];
#pragma unroll
        for (int j = 0; j < 8; ++j) {
            const float r0 = __builtin_amdgcn_rcpf(1.0f + __builtin_amdgcn_exp2f(__builtin_fmaf((float)g0[j], -LOG2E, nb_r0))), i0 = __builtin_amdgcn_rcpf(1.0f + __builtin_amdgcn_exp2f(__builtin_fmaf((float)g1[j], -LOG2E, nb_i0)));
            const float r1 = __builtin_amdgcn_rcpf(1.0f + __builtin_amdgcn_exp2f(__builtin_fmaf((float)g2[j], -LOG2E, nb_r1))), i1 = __builtin_amdgcn_rcpf(1.0f + __builtin_amdgcn_exp2f(__builtin_fmaf((float)g3[j], -LOG2E, nb_i1)));
            const float a0 = __builtin_amdgcn_exp2f(kk0 * r0), a1 = __builtin_amdgcn_exp2f(kk1 * r1);
            const float e0 = fmaxf(__builtin_fmaf(-a0, a0, 1.0f), 0.f), e1 = fmaxf(__builtin_fmaf(-a1, a1, 1.0f), 0.f);
            af[j] = a0; ab[j] = a1;
            hf[j] = __builtin_amdgcn_sqrtf(e0) * i0 * u[j]; hb[j] = __builtin_amdgcn_sqrtf(e1) * i1 * u[j];
        }
        if (s < 2) {
#pragma unroll
            for (int j = 0; j < 8; ++j) { const bool padp = (pw + j) < PADL; af[j] = padp ? 1.0f : af[j]; ab[j] = padp ? 1.0f : ab[j]; hf[j] = padp ? 0.0f : hf[j]; hb[j] = padp ? 0.0f : hb[j]; }
        }
        { float h = 0.f, P = 1.f;
#pragma unroll
          for (int j = 0; j < 8; ++j) { h = af[j] * h + hf[j]; hf[j] = h; P *= af[j]; pf[j] = P; } }
        { float h = 0.f, P = 1.f;
#pragma unroll
          for (int j = 7; j >= 0; --j) { h = ab[j] * h + hb[j]; hb[j] = h; P *= ab[j]; pb[j] = P; } }
        SM[((0 * 8 + w) * 2 + 0) * 64 + lane] = pf[7]; SM[((0 * 8 + w) * 2 + 1) * 64 + lane] = hf[7];
        SM[((1 * 8 + w) * 2 + 0) * 64 + lane] = pb[0]; SM[((1 * 8 + w) * 2 + 1) * 64 + lane] = hb[0];
        float un[8];
#pragma unroll
        for (int j = 0; j < 8; ++j) { un[j] = N.cbv + N.cw0 * N.xv[j] + N.cw1 * N.xv[j + 1] + N.cw2 * N.xv[j + 2] + N.cw3 * N.xv[j + 3]; Un[(8 * w + j) * 72 + lane] = f2bf16(un[j]); }
        __syncthreads();
        const size_t sidx = sbase + c;
        if (!FINAL) {
            if (w == 0) {
                float cf = 0.f, Af = 1.f, cb = 0.f, Ab = 1.f;
#pragma unroll
                for (int w2 = 0; w2 < 8; ++w2) { const float A = SM[((0 * 8 + w2) * 2 + 0) * 64 + lane], H = SM[((0 * 8 + w2) * 2 + 1) * 64 + lane]; cf = A * cf + H; Af *= A; }
#pragma unroll
                for (int w2 = 7; w2 >= 0; --w2) { const float A = SM[((1 * 8 + w2) * 2 + 0) * 64 + lane], H = SM[((1 * 8 + w2) * 2 + 1) * 64 + lane]; cb = A * cb + H; Ab *= A; }
                F.SUMM[sidx] = (f32x2){Af, cf}; F.SUMM[sidx + 512] = (f32x2){Ab, cb};
            }
        } else {
            float cf = L.cf, cb = L.cb;
#pragma unroll
            for (int w2 = 0; w2 < 8; ++w2) if (w2 < w) { const float A = SM[((0 * 8 + w2) * 2 + 0) * 64 + lane], H = SM[((0 * 8 + w2) * 2 + 1) * 64 + lane]; cf = A * cf + H; }
#pragma unroll
            for (int w2 = 7; w2 >= 0; --w2) if (w2 > w) { const float A = SM[((1 * 8 + w2) * 2 + 0) * 64 + lane], H = SM[((1 * 8 + w2) * 2 + 1) * 64 + lane]; cb = A * cb + H; }
#pragma unroll
            for (int j = 0; j < 8; ++j) {
                const float y = ((hf[j] + pf[j] * cf) + (hb[j] + pb[j] * cb)) * gelu_tanh_f(L.gate[j]);
                ssq[j] += y * y; YL[(8 * w + j) * 520 + c] = f2bf16(y);
            }
        }
        L = N;
#pragma unroll
        for (int j = 0; j < 8; ++j) u[j] = un[j];
    }
    if (FINAL) {
        const f32x4 og0 = *(const f32x4*)(F.lru_out_g + 8 * lane), og1 = *(const f32x4*)(F.lru_out_g + 8 * lane + 4);
#pragma unroll
        for (int j = 0; j < 8; ++j) {
            const float rs = __builtin_amdgcn_rsqf(wave_sum(ssq[j]) * (1.0f / 512.0f) + EPSN);
            const u32x4 v = *(LAS u32x4*)(YL + (8 * w + j) * 520 + 8 * lane);
            u32x4 o; o.x = cvtpk(__uint_as_float(v.x << 16) * rs * og0[0], __uint_as_float(v.x & 0xffff0000u) * rs * og0[1]); o.y = cvtpk(__uint_as_float(v.y << 16) * rs * og0[2], __uint_as_float(v.y & 0xffff0000u) * rs * og0[3]);
            o.z = cvtpk(__uint_as_float(v.z << 16) * rs * og1[0], __uint_as_float(v.z & 0xffff0000u) * rs * og1[1]); o.w = cvtpk(__uint_as_float(v.w << 16) * rs * og1[2], __uint_as_float(v.w & 0xffff0000u) * rs * og1[3]);
            *(u32x4*)(F.H + (rowbase + pw + j) * 1024 + 8 * lane) = o;
        }
        __syncthreads();
    }
}

struct Lru2A { float xv[2][11]; float cw[2][5]; };
__device__ __forceinline__ void lru2_loadA(const Fr& F, size_t rowbase, int pw, int it, int lane, Lru2A& A) {
#pragma unroll
    for (int h = 0; h < 2; ++h) { const int c = (2 * it + h) * 64 + lane;
#pragma unroll
        for (int i = 0; i < 11; ++i) { const int p = pw - 2 + i; const int pc = p < 0 ? 0 : (p >= PP ? PP - 1 : p); const float v = bf2f(F.Z[(rowbase + pc) * ZC + ZC_LX + c]); A.xv[h][i] = (p == pc) ? v : 0.f; }
        A.cw[h][0] = F.conv_w[c]; A.cw[h][1] = F.conv_w[512 + c]; A.cw[h][2] = F.conv_w[1024 + c]; A.cw[h][3] = F.conv_w[1536 + c]; A.cw[h][4] = F.conv_b[c]; }
}
__device__ __forceinline__ void lru2_writeU(LAS unsigned short* Upar, int w, int lane, const Lru2A& A) {
#pragma unroll
    for (int h = 0; h < 2; ++h)
#pragma unroll
        for (int j = 0; j < 8; ++j) { const float u = A.cw[h][4] + A.cw[h][0] * A.xv[h][j] + A.cw[h][1] * A.xv[h][j + 1] + A.cw[h][2] * A.xv[h][j + 2] + A.cw[h][3] * A.xv[h][j + 3];
            const int rho = 16 * (2 * (w & 1) + (j >> 2)) + 4 * (w >> 1) + (j & 3);
            Upar[h * 4608 + rho * 72 + lane] = f2bf16(u); }
}
template <bool FINAL>
__device__ __forceinline__ void lru2_item(const Fr& F, int b, int s) {
    int lane = F.lane; asm volatile("" : "+v"(lane));
    const int w = F.wave, fr = lane & 15, fq = lane >> 4, cg = w & 3;
    LAS unsigned short* U0 = (LAS unsigned short*)F.lds;
    LAS unsigned short* YL = (LAS unsigned short*)(F.lds + 36864);
    LAS float* SSP = (LAS float*)(F.lds + 36864 + 66560);
    const int p0 = s * 64, pw = p0 + 8 * w; const size_t rowbase = (size_t)b * PP;
    const size_t sbase = ((size_t)(b * NSEG + s) * 2) * 512;
    constexpr float LOG2E = 1.4426950408889634f;
    float ssq[16];
#pragma unroll
    for (int q = 0; q < 16; ++q) ssq[q] = 0.f;
    { Lru2A A0; lru2_loadA(F, rowbase, pw, 0, lane, A0); lru2_writeU(U0, w, lane, A0); }
    __syncthreads();
    for (int it = 0; it < 4; ++it) {
        const int blk = 2 * it + (w >> 2), c = blk * 64 + 16 * cg + fr;
        LAS unsigned short* U = U0 + ((it & 1) * 2 + (w >> 2)) * 4608;
        pg8::bf16x8 bfr[4][2];
        { const unsigned short* gp = F.GW2 + ((size_t)((blk * 4) * 4 + cg) * 16 + fr) * 64 + 8 * fq;
#pragma unroll
          for (int g = 0; g < 4; ++g)
#pragma unroll
              for (int ks = 0; ks < 2; ++ks) bfr[g][ks] = *(const pg8::bf16x8*)(gp + (size_t)g * 4096 + 32 * ks); }
        const float lam0 = F.lam[c], lam1 = F.lam[512 + c], br0 = F.b_r[c], bi0 = F.b_i[c], br1 = F.b_r[512 + c], bi1 = F.b_i[512 + c];
        float cin0 = 0.f, cin1 = 0.f; if (FINAL) { cin0 = F.CARRY[sbase + c]; cin1 = F.CARRY[sbase + 512 + c]; }
        float gt[16];
        if (FINAL) {
#pragma unroll
            for (int q = 0; q < 16; ++q) gt[q] = bf2f(F.Z[(rowbase + p0 + 16 * fq + q) * ZC + ZC_LG + c]);
        }
        Lru2A N; lru2_loadA(F, rowbase, pw, it < 3 ? it + 1 : 3, lane, N);
        pg8::f32x4 acc[4][4];
#pragma unroll
        for (int g = 0; g < 4; ++g)
#pragma unroll
            for (int m = 0; m < 4; ++m) acc[g][m] = (pg8::f32x4){0.f, 0.f, 0.f, 0.f};
#pragma unroll
        for (int ks = 0; ks < 2; ++ks)
#pragma unroll
            for (int m = 0; m < 4; ++m) {
                const pg8::bf16x8 an = *(LAS pg8::bf16x8*)(U + (16 * m + fr) * 72 + 32 * ks + 8 * fq);
                const pg8::bf16x8 ar = *(LAS pg8::bf16x8*)(U + (63 - 16 * m - fr) * 72 + 32 * ks + 8 * fq);
                acc[0][m] = MFMA16(an, bfr[0][ks], acc[0][m]); acc[1][m] = MFMA16(an, bfr[1][ks], acc[1][m]);
                acc[2][m] = MFMA16(ar, bfr[2][ks], acc[2][m]); acc[3][m] = MFMA16(ar, bfr[3][ks], acc[3][m]);
            }
        float hf[16], hb[16];
#pragma unroll
        for (int d = 0; d < 2; ++d) {
            const float kk = -8.0f * LOG2E * softplus_neg(d ? lam1 : lam0), nbr = -LOG2E * (d ? br1 : br0), nbi = -LOG2E * (d ? bi1 : bi0);
            float al[16], xl[16];
#pragma unroll
            for (int m = 0; m < 4; ++m)
#pragma unroll
                for (int rg = 0; rg < 4; ++rg) { const int q = 4 * m + rg; const int row = d ? 63 - (16 * m + 4 * fq + rg) : (16 * m + 4 * fq + rg);
                    const float uu = bf2f(U[row * 72 + 16 * cg + fr]);
                    const float r = __builtin_amdgcn_rcpf(1.0f + __builtin_amdgcn_exp2f(__builtin_fmaf(acc[2 * d][m][rg], -LOG2E, nbr))), ii = __builtin_amdgcn_rcpf(1.0f + __builtin_amdgcn_exp2f(__builtin_fmaf(acc[2 * d + 1][m][rg], -LOG2E, nbi)));
                    const float a = __builtin_amdgcn_exp2f(kk * r); const float e = fmaxf(__builtin_fmaf(-a, a, 1.0f), 0.f);
                    al[q] = a; xl[q] = __builtin_amdgcn_sqrtf(e) * ii * uu; }
            if (s < 2) {
#pragma unroll
                for (int q = 0; q < 16; ++q) { const int p = d ? p0 + 63 - (16 * fq + q) : p0 + 16 * fq + q; const bool padp = p < PADL; al[q] = padp ? 1.0f : al[q]; xl[q] = padp ? 0.0f : xl[q]; }
            }
            { float h = 0.f, P = 1.f;
#pragma unroll
              for (int q = 0; q < 16; ++q) { h = al[q] * h + xl[q]; xl[q] = h; P *= al[q]; al[q] = P; } }
            const float Ar = al[15], Hr = xl[15];
            const float A0 = __shfl(Ar, fr), H0 = __shfl(Hr, fr), A1 = __shfl(Ar, fr + 16), H1 = __shfl(Hr, fr + 16), A2 = __shfl(Ar, fr + 32), H2 = __shfl(Hr, fr + 32);
            float cc = FINAL ? (d ? cin1 : cin0) : 0.f;
            if (fq > 0) cc = A0 * cc + H0;
            if (fq > 1) cc = A1 * cc + H1;
            if (fq > 2) cc = A2 * cc + H2;
            if (!FINAL) { if (fq == 3) F.SUMM[sbase + d * 512 + c] = (f32x2){A0 * A1 * A2 * Ar, Ar * cc + Hr}; }
            else {
#pragma unroll
                for (int q = 0; q < 16; ++q) { const float hv = xl[q] + al[q] * cc; if (d) hb[q] = hv; else hf[q] = hv; }
            }
        }
        if (FINAL) {
#pragma unroll
            for (int q = 0; q < 16; ++q) { const float hbp = __shfl(hb[15 - q], lane ^ 48);
                const float y = (hf[q] + hbp) * gelu_tanh_f(gt[q]); ssq[q] += y * y; YL[(16 * fq + q) * 520 + c] = f2bf16(y); }
        }
        if (it < 3) { lru2_writeU(U0 + ((it & 1) ^ 1) * 9216, w, lane, N); __syncthreads(); }
    }
    if (FINAL) {
#pragma unroll
        for (int q = 0; q < 16; ++q) { float v = ssq[q]; v += __shfl_xor(v, 1); v += __shfl_xor(v, 2); v += __shfl_xor(v, 4); v += __shfl_xor(v, 8); ssq[q] = v; }
        if (fr == 0) {
#pragma unroll
            for (int q = 0; q < 16; ++q) SSP[w * 64 + 16 * fq + q] = ssq[q]; }
        __syncthreads();
        const f32x4 og0 = *(const f32x4*)(F.lru_out_g + 8 * lane), og1 = *(const f32x4*)(F.lru_out_g + 8 * lane + 4);
#pragma unroll
        for (int j = 0; j < 8; ++j) {
            float tot = 0.f;
#pragma unroll
            for (int w2 = 0; w2 < 8; ++w2) tot += SSP[w2 * 64 + 8 * w + j];
            const float rs = __builtin_amdgcn_rsqf(tot * (1.0f / 512.0f) + EPSN);
            const u32x4 v = *(LAS u32x4*)(YL + (8 * w + j) * 520 + 8 * lane);
            u32x4 o; o.x = cvtpk(__uint_as_float(v.x << 16) * rs * og0[0], __uint_as_float(v.x & 0xffff0000u) * rs * og0[1]); o.y = cvtpk(__uint_as_float(v.y << 16) * rs * og0[2], __uint_as_float(v.y & 0xffff0000u) * rs * og0[3]);
            o.z = cvtpk(__uint_as_float(v.z << 16) * rs * og1[0], __uint_as_float(v.z & 0xffff0000u) * rs * og1[1]); o.w = cvtpk(__uint_as_float(v.w << 16) * rs * og1[2], __uint_as_float(v.w & 0xffff0000u) * rs * og1[3]);
            *(u32x4*)(F.H + (rowbase + pw + j) * 1024 + 8 * lane) = o;
        }
        __syncthreads();
    }
}

#ifdef RF_V3
constexpr int LDS_GT = LDS_MAIN + 8192;
#else
constexpr int LDS_GT = LDS_SS + 1024;
#endif
template <int SKIP> __device__ __forceinline__ int ret_count(int w, int G) { if (G != 256) return (2080 - w + G - 1) / G; return (w < 32 + 16 * SKIP) ? 9 : (w >= 240 ? 8 - SKIP : 8); }
template <int SKIP> __device__ __forceinline__ int ret_item(int w, int j, int G) { if (G != 256 || j < 8) return w + G * j; if (w < 32) return 2048 + w; const int k = w - 32; return 240 + (k & 15) + 256 * (7 - (k >> 4)); }
__device__ __forceinline__ void ret_coord(int it, int& b, int& h, int& n) { n = it % NCHUNK; const int bh = it / NCHUNK; b = bh >> 2; h = bh & 3; }
struct RcIn { u32x4 k[4], v[4]; };
__device__ __forceinline__ void rc_load(const Fr& F, int tid, int it, RcIn& R) {
    int b, h, n; ret_coord(it, b, h, n);
    const unsigned short* base = F.Z + ((size_t)b * PP + 128 * n) * ZC + 128 * h;
#pragma unroll
    for (int q = 0; q < 4; ++q) { const int idx = tid + 512 * q, c = idx >> 4, ch = idx & 15; const unsigned short* p = base + (size_t)c * ZC + 8 * ch; R.k[q] = *(const u32x4*)(p + ZC_K); R.v[q] = *(const u32x4*)(p + ZC_V); }
}
__device__ __forceinline__ unsigned scale_pk(unsigned w, float s) { return cvtpk(__uint_as_float(w << 16) * s, __uint_as_float(w & 0xffff0000u) * s); }
__device__ __forceinline__ void ph_ret_contrib(const Fr& F) {
    const int w = F.wave;
    LAS unsigned char* TKF = F.lds; LAS unsigned char* TKB = F.lds + 32768; LAS unsigned char* TV = F.lds + 65536;
    if ((int)blockIdx.x >= 2080) return;
    const int nj = ret_count<2>(blockIdx.x, F.G);
    RcIn R; rc_load(F, F.tid, ret_item<2>(blockIdx.x, 0, F.G), R);
    for (int jj = 0; jj < nj; ++jj) {
        const int it = ret_item<2>(blockIdx.x, jj, F.G);
        int lane = F.lane, tid = threadIdx.x; asm volatile("" : "+v"(lane), "+v"(tid));
        const int r = lane & 31, h2 = lane >> 5;
        int b, h, n; ret_coord(it, b, h, n); const float lg = log2_gamma(h);
#pragma unroll
        for (int q = 0; q < 4; ++q) { const int idx = tid + 512 * q, c = idx >> 4, ch = idx & 15; const float sf = exp2f(lg * (float)(127 - c)), sb = exp2f(lg * (float)c);
            u32x4 kf, kb; kf.x = scale_pk(R.k[q].x, sf); kf.y = scale_pk(R.k[q].y, sf); kf.z = scale_pk(R.k[q].z, sf); kf.w = scale_pk(R.k[q].w, sf);
            kb.x = scale_pk(R.k[q].x, sb); kb.y = scale_pk(R.k[q].y, sb); kb.z = scale_pk(R.k[q].z, sb); kb.w = scale_pk(R.k[q].w, sb);
            const unsigned o = off_b(c, ch); *(LAS u32x4*)(TKF + o) = kf; *(LAS u32x4*)(TKB + o) = kb; *(LAS u32x4*)(TV + o) = R.v[q]; }
        if (jj + 1 < nj) rc_load(F, tid, ret_item<2>(blockIdx.x, jj + 1, F.G), R);
        __syncthreads();
        const int dir = w >> 2, cb = w & 3; LAS unsigned char* TK = dir ? TKB : TKF;
        f32x16 acc[4];
#pragma unroll
        for (int eb = 0; eb < 4; ++eb)
#pragma unroll
            for (int i = 0; i < 16; ++i) acc[eb][i] = 0.f;
#pragma unroll 2
        for (int ks = 0; ks < 8; ++ks) {
            const pg8::bf16x8 a = trfrag(TK, cb, ks, lane);
#pragma unroll
            for (int eb = 0; eb < 4; ++eb) { const pg8::bf16x8 bv = trfrag(TV, eb, ks, lane); acc[eb] = MFMA32(a, bv, acc[eb]); }
        }
        __syncthreads();
#pragma unroll
        for (int eb = 0; eb < 4; ++eb)
#pragma unroll
            for (int g = 0; g < 4; ++g) { u32x2 v; v.x = cvtpk(acc[eb][4 * g], acc[eb][4 * g + 1]); v.y = cvtpk(acc[eb][4 * g + 2], acc[eb][4 * g + 3]);
                *(LAS u32x2*)(TK + off_b(32 * eb + r, 4 * cb + g) + 8 * h2) = v; }
        __syncthreads();
        unsigned short* dst = F.ST + ((size_t)(((b * 4 + h) * 2) * NCHUNK + n)) * 16384;
#pragma unroll
        for (int q = 0; q < 8; ++q) { const int idx = tid + 512 * q, tile = idx >> 11, rem = idx & 2047, e = rem >> 4, ch = rem & 15;
            const u32x4 v = *(LAS u32x4*)(F.lds + tile * 32768 + off_b(e, ch)); *(u32x4*)(dst + (size_t)tile * NCHUNK * 16384 + (size_t)e * 128 + 8 * ch) = v; }
        __syncthreads();
    }
}
struct RfIn { u32x4 q[4], k[4], v[4]; };
struct RsIn { u32x4 sf[4], sb[4], g[4]; };
__device__ __forceinline__ void rf_load(const Fr& F, int tid, int it, RfIn& R) {
    int b, h, n; ret_coord(it, b, h, n);
    const unsigned short* base = F.Z + ((size_t)b * PP + 128 * n) * ZC + 128 * h;
#pragma unroll
#ifdef RF_V5
    for (int q = 0; q < 4; ++q) { const int idx = tid + 512 * q, c = idx >> 4, ch = idx & 15; const unsigned short* p = base + (size_t)c * ZC + 8 * ch; R.q[q] = *(const u32x4*)(base + (size_t)(c ^ 1) * ZC + 8 * ch + ZC_Q); R.k[q] = *(const u32x4*)(p + ZC_K); R.v[q] = *(const u32x4*)(p + ZC_V); }
#else
    for (int q = 0; q < 4; ++q) { const int idx = tid + 512 * q, c = idx >> 4, ch = idx & 15; const unsigned short* p = base + (size_t)c * ZC + 8 * ch; R.q[q] = *(const u32x4*)(p + ZC_Q); R.k[q] = *(const u32x4*)(p + ZC_K); R.v[q] = *(const u32x4*)(p + ZC_V); }
#endif
}
__device__ __forceinline__ void rs_load(const Fr& F, int tid, int b, int h, int n, RsIn& R) {
    const unsigned short* sf = F.ST2 + ((size_t)(((b * 4 + h) * 2 + 0) * NCHUNK + n)) * 16384; const unsigned short* sb = sf + (size_t)NCHUNK * 16384;
    const unsigned short* gb = F.Z + ((size_t)b * PP + 128 * n) * ZC + ZC_G + 128 * h;
#pragma unroll
    for (int q = 0; q < 4; ++q) { const int idx = tid + 512 * q, c = idx >> 4, ch = idx & 15; R.sf[q] = *(const u32x4*)(sf + (size_t)c * 128 + 8 * ch); R.sb[q] = *(const u32x4*)(sb + (size_t)c * 128 + 8 * ch); R.g[q] = *(const u32x4*)(gb + (size_t)c * ZC + 8 * ch); }
}
#ifdef RF_EXTRA
#define RF_XBAR asm volatile("s_waitcnt vmcnt(0) lgkmcnt(0)" ::: "memory"); __syncthreads();
#else
#define RF_XBAR
#endif
#define RF_FLAG(code_) atomicOr((unsigned*)(F.CTLP + 32768 + 2048), (unsigned)(code_))
#if !defined(RF_GTAB) && !defined(RF_V10) && !defined(RF_V4)
#define RF_GT(d_, c_) exp2f(lg * (float)(d_))
#elif defined(RF_V4)
#define RF_GT(d_, c_) ({ const float g_ = GT[d_]; const float e_ = exp2f(lg * (float)(d_)); if (!(fabsf(g_ - e_) <= 1e-5f * e_)) RF_FLAG(c_); g_; })
#else
#define RF_GT(d_, c_) GT[d_]
#endif
#ifdef RF_V8
#define RF_QF rowfrag_x
#else
#define RF_QF rowfrag
#endif
__device__ __forceinline__ void ph_ret_final(const Fr& F) {
    const int w = F.wave;
    LAS unsigned char* R0 = F.lds; LAS unsigned char* R1 = F.lds + 32768; LAS unsigned char* R2 = F.lds + 65536; LAS unsigned char* R3 = F.lds + 98304;
    LAS float* SS = (LAS float*)(F.lds + LDS_SS); LAS float* GT = (LAS float*)(F.lds + LDS_GT); (void)GT;
    if ((int)blockIdx.x >= 2080) return;
    const int nj = ret_count<1>(blockIdx.x, F.G);
#ifdef RF_V9
    const int cb = 3 - (w >> 1), ebase = 2 * (w & 1);
#else
    const int cb = w >> 1, ebase = 2 * (w & 1);
#endif
#ifndef RF_NOPF
    RfIn Rf; rf_load(F, F.tid, ret_item<1>(blockIdx.x, 0, F.G), Rf);
#endif
    for (int jj = 0; jj < nj; ++jj) {
        const int it = ret_item<1>(blockIdx.x, jj, F.G);
        int lane = F.lane, tid = threadIdx.x; asm volatile("" : "+v"(lane), "+v"(tid));
        const int r = lane & 31, h2 = lane >> 5;
        int b, h, n; ret_coord(it, b, h, n); const float lg = log2_gamma(h);
        const size_t row0 = (size_t)b * PP + 128 * n;
        __syncthreads();
#ifndef RF_NOPF
        RsIn Rs; rs_load(F, tid, b, h, n, Rs);
#else
        RfIn Rf; rf_load(F, tid, it, Rf);
        RsIn Rs; rs_load(F, tid, b, h, n, Rs);
#endif
#pragma unroll
#ifdef RF_V5
        for (int q = 0; q < 4; ++q) { const int idx = tid + 512 * q, c = idx >> 4, ch = idx & 15; const unsigned o = off_b(c, ch); *(LAS u32x4*)(R0 + off_b(c ^ 1, ch)) = Rf.q[q]; *(LAS u32x4*)(R1 + o) = Rf.k[q]; *(LAS u32x4*)(R2 + o) = Rf.v[q]; }
#elif defined(RF_V8)
        for (int q = 0; q < 4; ++q) { const int idx = tid + 512 * q, c = idx >> 4, ch = idx & 15; const unsigned o = off_b(c, ch); *(LAS u32x4*)(R0 + off_b(c ^ 1, ch)) = Rf.q[q]; *(LAS u32x4*)(R1 + o) = Rf.k[q]; *(LAS u32x4*)(R2 + o) = Rf.v[q]; }
#else
        for (int q = 0; q < 4; ++q) { const int idx = tid + 512 * q, c = idx >> 4, ch = idx & 15; const unsigned o = off_b(c, ch); *(LAS u32x4*)(R0 + o) = Rf.q[q]; *(LAS u32x4*)(R1 + o) = Rf.k[q]; *(LAS u32x4*)(R2 + o) = Rf.v[q]; }
#endif
#ifdef RF_V10
        { const int gi = tid & 255; GT[gi] = exp2f(lg * (float)gi); }
#elif defined(RF_GTAB)
        if (tid < 129) GT[tid] = exp2f(lg * (float)tid);
#endif
        const float og0 = F.ret_out_g[128 * h + 32 * ebase + r], og1 = F.ret_out_g[128 * h + 32 * (ebase + 1) + r];
        __syncthreads(); RF_XBAR
        f32x16 o[2];
#pragma unroll
        for (int eo = 0; eo < 2; ++eo)
#pragma unroll
            for (int i = 0; i < 16; ++i) o[eo][i] = 0.f;
        {
            const int cpos = 32 * cb + r;
#pragma unroll
            for (int mb = 0; mb < 4; ++mb) {
                f32x16 X;
#pragma unroll
                for (int i = 0; i < 16; ++i) X[i] = 0.f;
#pragma unroll 2
                for (int s = 0; s < 8; ++s) { const pg8::bf16x8 qf = RF_QF(R0, cb, s, lane); const pg8::bf16x8 kf = rowfrag(R1, mb, s, lane); X = MFMA32(kf, qf, X); }
                int cpo = cpos, h2o = h2; asm volatile("" : "+v"(cpo), "+v"(h2o));
#pragma unroll
                for (int i = 0; i < 16; ++i) { const int m = 32 * mb + crow(i, h2o); const int dd = cpo > m ? cpo - m : m - cpo; X[i] *= RF_GT(dd, 1); }
#pragma unroll
                for (int s2 = 0; s2 < 2; ++s2) { u32x4 pk; pk.x = cvtpk(X[8 * s2], X[8 * s2 + 1]); pk.y = cvtpk(X[8 * s2 + 2], X[8 * s2 + 3]); pk.z = cvtpk(X[8 * s2 + 4], X[8 * s2 + 5]); pk.w = cvtpk(X[8 * s2 + 6], X[8 * s2 + 7]);
                    const pg8::bf16x8 pa = __builtin_bit_cast(pg8::bf16x8, pk);
#pragma unroll
                    for (int eo = 0; eo < 2; ++eo) { const pg8::bf16x8 vb = trfrag_perm(R2, ebase + eo, 32 * mb + 16 * s2, lane); o[eo] = MFMA32(pa, vb, o[eo]); } }
            }
        }
        RF_XBAR __syncthreads(); RF_XBAR
#pragma unroll
        for (int q = 0; q < 4; ++q) { const int idx = tid + 512 * q, c = idx >> 4, ch = idx & 15; const unsigned of = off_b(c, ch); *(LAS u32x4*)(R1 + of) = Rs.sf[q]; *(LAS u32x4*)(R3 + of) = Rs.sb[q]; *(LAS u32x4*)(R2 + of) = Rs.g[q]; }
#ifndef RF_NOPF
        rf_load(F, tid, ret_item<1>(blockIdx.x, jj + 1 < nj ? jj + 1 : jj, F.G), Rf);
#endif
        RF_XBAR __syncthreads(); RF_XBAR
#pragma unroll
        for (int dirn = 0; dirn < 2; ++dirn) {
            LAS unsigned char* TX = dirn ? R3 : R1;
            f32x16 oi[2];
#pragma unroll
            for (int eo = 0; eo < 2; ++eo)
#pragma unroll
                for (int i = 0; i < 16; ++i) oi[eo][i] = 0.f;
#pragma unroll 2
            for (int s = 0; s < 8; ++s) { const pg8::bf16x8 qf = RF_QF(R0, cb, s, lane);
#pragma unroll
                for (int eo = 0; eo < 2; ++eo) { const pg8::bf16x8 f1 = rowfrag(TX, ebase + eo, s, lane); oi[eo] = MFMA32(qf, f1, oi[eo]); } }
            int h2d = h2; asm volatile("" : "+v"(h2d));
#pragma unroll
            for (int i = 0; i < 16; ++i) { const int cl = 32 * cb + crow(i, h2d); const float dfac = RF_GT(dirn ? (128 - cl) : (cl + 1), 2);
#pragma unroll
                for (int eo = 0; eo < 2; ++eo) o[eo][i] += dfac * oi[eo][i]; }
        }
        float ssq[16];
#pragma unroll
        for (int i = 0; i < 16; ++i) {
            float s = o[0][i] * o[0][i] + o[1][i] * o[1][i];
            s += __shfl_xor(s, 1); s += __shfl_xor(s, 2); s += __shfl_xor(s, 4); s += __shfl_xor(s, 8); s += __shfl_xor(s, 16);
            ssq[i] = s; }
        if (r == 0) {
#pragma unroll
            for (int i = 0; i < 16; ++i) SS[(w & 1) * 128 + 32 * cb + crow(i, h2)] = ssq[i]; }
        RF_XBAR __syncthreads(); RF_XBAR
        int h2e = h2, re = r; asm volatile("" : "+v"(h2e), "+v"(re));
#ifdef RF_V1
#pragma unroll
        for (int i = 0; i < 16; ++i) { const int cl = 32 * cb + crow(i, h2e); const float tot = SS[cl] + SS[128 + cl]; const float rs = __builtin_amdgcn_rsqf(tot * (1.0f / 128.0f) + EPSN);
            const size_t row = row0 + cl;
#pragma unroll
            for (int eo = 0; eo < 2; ++eo) { const int e = 32 * (ebase + eo) + re; const float gv = bf2f(F.Z[row * ZC + ZC_G + 128 * h + e]);
                F.H[row * 1024 + 512 + 128 * h + e] = f2bf16(o[eo][i] * rs * (eo ? og1 : og0) * pg8::silu_f(gv)); } }
        RF_XBAR __syncthreads(); RF_XBAR
#else
#pragma unroll
        for (int i = 0; i < 16; ++i) { const int cl = 32 * cb + crow(i, h2e); const float tot = SS[cl] + SS[128 + cl]; const float rs = __builtin_amdgcn_rsqf(tot * (1.0f / 128.0f) + EPSN);
#pragma unroll
            for (int eo = 0; eo < 2; ++eo) { const int e = 32 * (ebase + eo) + re; const unsigned of = off_b(cl, e >> 3) + 2 * (e & 7);
                const float gv = bf2f(*(LAS unsigned short*)(R2 + of));
                *(LAS unsigned short*)(R3 + of) = f2bf16(o[eo][i] * rs * (eo ? og1 : og0) * pg8::silu_f(gv)); } }
        RF_XBAR __syncthreads(); RF_XBAR
#pragma unroll
#ifdef RF_V6
        for (int q = 0; q < 4; ++q) { const int idx = tid + 512 * q, c = (idx >> 4) ^ 1, ch = idx & 15; const u32x4 v = *(LAS u32x4*)(R3 + off_b(c, ch)); *(u32x4*)(F.H + (row0 + c) * 1024 + 512 + 128 * h + 8 * ch) = v; }
#else
        for (int q = 0; q < 4; ++q) { const int idx = tid + 512 * q, c = idx >> 4, ch = idx & 15; const u32x4 v = *(LAS u32x4*)(R3 + off_b(c, ch)); *(u32x4*)(F.H + (row0 + c) * 1024 + 512 + 128 * h + 8 * ch) = v; }
#endif
#endif
#ifdef RF_V11
        if (tid < 129) { const float g_ = GT[tid]; const float e_ = exp2f(lg * (float)tid); if (!(fabsf(g_ - e_) <= 1e-5f * e_)) RF_FLAG(1); }
#endif
    }
    __syncthreads();
}
__device__ __forceinline__ void ret_scan(const Fr& F) {
    for (int v = blockIdx.x * 512 + F.tid; v < 64 * 2048; v += F.G * 512) {
        const int strip = v >> 11, off = v & 2047, dir = strip & 1, h = (strip >> 1) & 3;
        const float cd = exp2f(128.0f * log2_gamma(h));
        const unsigned short* base = F.ST + (size_t)strip * NCHUNK * 16384 + (size_t)off * 8;
        unsigned short* obase = F.ST2 + (size_t)strip * NCHUNK * 16384 + (size_t)off * 8;
        float carry[8];
#pragma unroll
        for (int i = 0; i < 8; ++i) carry[i] = 0.f;
        for (int k0 = 0; k0 < NCHUNK; k0 += 5) {
            u16x8 tv[5];
#pragma unroll
            for (int j = 0; j < 5; ++j) { const int n = dir ? (NCHUNK - 1 - (k0 + j)) : (k0 + j); tv[j] = *(const u16x8*)(base + (size_t)n * 16384); }
#pragma unroll
            for (int j = 0; j < 5; ++j) { const int n = dir ? (NCHUNK - 1 - (k0 + j)) : (k0 + j); u32x4 o;
                o.x = cvtpk(carry[0], carry[1]); o.y = cvtpk(carry[2], carry[3]); o.z = cvtpk(carry[4], carry[5]); o.w = cvtpk(carry[6], carry[7]);
                *(u32x4*)(obase + (size_t)n * 16384) = o;
#pragma unroll
                for (int i = 0; i < 8; ++i) carry[i] = carry[i] * cd + bf2f(tv[j][i]); }
        }
    }
}
__device__ __forceinline__ void lru_carry(const Fr& F) {
    for (int v = blockIdx.x * 32 + F.tid; F.tid < 32 && v < NB * 2 * 512; v += F.G * 32) {
        const int c = v & 511, dir = (v >> 9) & 1, b = v >> 10;
        float carry = 0.f;
        for (int k0 = 0; k0 < NSEG; k0 += 10) {
            f32x2 ah[10];
#pragma unroll
            for (int j = 0; j < 10; ++j) { const int s = dir ? (NSEG - 1 - (k0 + j)) : (k0 + j); ah[j] = F.SUMM[((size_t)(b * NSEG + s) * 2 + dir) * 512 + c]; }
#pragma unroll
            for (int j = 0; j < 10; ++j) { const int s = dir ? (NSEG - 1 - (k0 + j)) : (k0 + j); F.CARRY[((size_t)(b * NSEG + s) * 2 + dir) * 512 + c] = carry; carry = ah[j].x * carry + ah[j].y; }
        }
    }
}
__device__ __forceinline__ void ph_checksum(const Fr& F, const void* buf, size_t bytes, int slot) {
    const unsigned* p = (const unsigned*)buf; const size_t nw = bytes / 4;
    unsigned long long sa = 0ull, sx = 0ull;
    for (size_t i = (size_t)blockIdx.x * 512 + F.tid; i < nw; i += (size_t)F.G * 512) { const unsigned long long v = p[i]; const unsigned long long h = (v + 0x9E3779B97F4A7C15ull + i) * 0xD6E8FEB86659FD93ull; sa += h; sx += (h ^ (h >> 29)) * 0xBF58476D1CE4E5B9ull; }
    unsigned a0 = (unsigned)sa, a1 = (unsigned)(sa >> 32), x0 = (unsigned)sx, x1 = (unsigned)(sx >> 32);
    for (int o = 1; o < 64; o <<= 1) { a0 += __shfl_xor(a0, o); a1 += __shfl_xor(a1, o); x0 += __shfl_xor(x0, o); x1 += __shfl_xor(x1, o); }
    sa = ((unsigned long long)a1 << 32) | a0; sx = ((unsigned long long)x1 << 32) | x0;
    if (F.lane == 0) { unsigned long long* c = (unsigned long long*)(F.CTLP + 32768) + slot * 2; atomicAdd(c, sa); atomicAdd(c + 1, sx); }
}
__device__ __forceinline__ void ph_cpy(const Fr& F) {
    const u32x4* s = (const u32x4*)F.H; u32x4* d = (u32x4*)(F.CTLP + CPY_BASE); const size_t nv = (size_t)NP * 2048 / 16;
    for (size_t i = (size_t)blockIdx.x * 512 + F.tid; i < nv; i += (size_t)F.G * 512) d[i] = s[i];
}
__device__ __forceinline__ void ph_cmp(const Fr& F) {
    const unsigned* a = (const unsigned*)F.H; const unsigned* c = (const unsigned*)(F.CTLP + CPY_BASE); const size_t nw = (size_t)NP * 2048 / 4;
    unsigned* st = (unsigned*)(F.CTLP + 32768 + 4096);
    for (size_t i = (size_t)blockIdx.x * 512 + F.tid; i < nw; i += (size_t)F.G * 512) {
        const unsigned x = a[i], y = c[i];
        if (x != y) { const unsigned idx = (unsigned)i;
            const float x0 = __uint_as_float(x << 16), x1 = __uint_as_float(x & 0xffff0000u), y0 = __uint_as_float(y << 16), y1 = __uint_as_float(y & 0xffff0000u);
            const float d0 = fabsf(x0 - y0), d1 = fabsf(x1 - y1); const float d = fmaxf(d0, d1);
            const float m = (d0 >= d1) ? fmaxf(fabsf(x0), fabsf(y0)) : fmaxf(fabsf(x1), fabsf(y1)); const float rel = d / fmaxf(m, 1e-30f);
            atomicAdd(st + 0, 1u); atomicMax(st + 1, ~idx); atomicMax(st + 2, idx); atomicOr(st + 3, ~idx); atomicOr(st + 4, idx);
            atomicMax(st + 5, __float_as_uint(d)); atomicMax(st + 6, __float_as_uint(rel));
            if (fabsf(y0) > 0.02f && fabsf(y1) > 0.02f) { const float ra = x0 / y0, rb = x1 / y1; atomicMax(st + 9, __float_as_uint(fabsf(ra - rb) / fmaxf(fabsf(ra), fabsf(rb)))); atomicMax(st + 10, __float_as_uint(fabsf(ra))); atomicMax(st + 11, __float_as_uint(1.0f / fmaxf(fabsf(ra), 1e-30f))); atomicAdd(st + 12, 1u); if (fabsf(ra - rb) / fmaxf(fabsf(ra), fabsf(rb)) < 0.03f) atomicAdd(st + 13, 1u); else atomicAdd(st + 14, 1u); }
            { const unsigned row_ = idx >> 9, cw_ = idx & 511u, cid_ = row_ >> 7; const unsigned item_ = (cw_ & 256u) ? ((cid_ / 65u) * 4u + ((cw_ >> 6) & 3u)) * 65u + cid_ % 65u : 2087u;
              atomicOr(st + 16 + (item_ >> 5), 1u << (item_ & 31u)); atomicAdd((unsigned*)(F.CTLP + 40960) + item_, 1u); if (d >= 0.125f) atomicAdd(st + 7, 1u); if (d >= 1.0f) atomicAdd(st + 8, 1u); } }
    }
}
__device__ __forceinline__ const unsigned short* hs_row(const Fr& F, int b, int t) { return F.HSB + (size_t)(b * PP + PADL + t) * 1024; }
__device__ __forceinline__ f32x4 bf4(u32x2 w) { return (f32x4){__uint_as_float(w.x << 16), __uint_as_float(w.x & 0xffff0000u), __uint_as_float(w.y << 16), __uint_as_float(w.y & 0xffff0000u)}; }
__device__ __forceinline__ float router_softmax(float (&pl)[16], int lane) {
    { const bool hi = lane & 32;
#pragma unroll
      for (int i = 0; i < 8; ++i) { const float send = hi ? pl[i] : pl[i + 8], keep = hi ? pl[i + 8] : pl[i]; pl[i] = keep + __shfl_xor(send, 32); } }
    { const bool hi = lane & 16;
#pragma unroll
      for (int i = 0; i < 4; ++i) { const float send = hi ? pl[i] : pl[i + 4], keep = hi ? pl[i + 4] : pl[i]; pl[i] = keep + __shfl_xor(send, 16); } }
    { const bool hi = lane & 8;
#pragma unroll
      for (int i = 0; i < 2; ++i) { const float send = hi ? pl[i] : pl[i + 2], keep = hi ? pl[i + 2] : pl[i]; pl[i] = keep + __shfl_xor(send, 8); } }
    { const bool hi = lane & 4; const float send = hi ? pl[0] : pl[1], keep = hi ? pl[1] : pl[0]; pl[0] = keep + __shfl_xor(send, 4); }
    float lg = pl[0]; lg += __shfl_xor(lg, 1); lg += __shfl_xor(lg, 2);
    float mx = lg;
    mx = fmaxf(mx, __shfl_xor(mx, 4)); mx = fmaxf(mx, __shfl_xor(mx, 8)); mx = fmaxf(mx, __shfl_xor(mx, 16)); mx = fmaxf(mx, __shfl_xor(mx, 32));
    const float ex = expf(lg - mx); float sm = ex;
    sm += __shfl_xor(sm, 4); sm += __shfl_xor(sm, 8); sm += __shfl_xor(sm, 16); sm += __shfl_xor(sm, 32);
    return ex / sm;
}
__device__ __forceinline__ void ph_router(const Fr& F) {
    LAS float* WR = (LAS float*)F.lds;
    for (int i = F.tid; i < 16384; i += 512) { const int d = i >> 4, e = i & 15; WR[e * 1024 + d] = F.w_router[i]; }
    __syncthreads();
    const int lane = F.lane;
    if (blockIdx.x == 0 && F.tid < 256) ((unsigned*)F.XS)[F.tid] = 0u;
    const int NV = NB * TT, NPAIR = NV / 2;
    const int gw = blockIdx.x * 8 + F.wave, NGW = F.G * 8;
    u32x2 nx[2][4];
    if (gw < NPAIR) {
#pragma unroll
        for (int q = 0; q < 2; ++q) { const int v = 2 * gw + q, b = v / TT, t = v - b * TT; const u32x2* xr = (const u32x2*)hs_row(F, b, t) + lane;
#pragma unroll
            for (int j = 0; j < 4; ++j) nx[q][j] = xr[64 * j]; }
    }
    f32x4 gg[4];
#pragma unroll
    for (int j = 0; j < 4; ++j) gg[j] = ((const f32x4*)F.norm2_g + lane)[64 * j];
    for (int pr = gw; pr < NPAIR; pr += NGW) {
        f32x4 vv[2][4];
#pragma unroll
        for (int q = 0; q < 2; ++q)
#pragma unroll
            for (int j = 0; j < 4; ++j) vv[q][j] = bf4(nx[q][j]);
        { const int pn = pr + NGW < NPAIR ? pr + NGW : pr;
#pragma unroll
          for (int q = 0; q < 2; ++q) { const int v = 2 * pn + q, b = v / TT, t = v - b * TT; const u32x2* xr = (const u32x2*)hs_row(F, b, t) + lane;
#pragma unroll
              for (int j = 0; j < 4; ++j) nx[q][j] = xr[64 * j]; } }
        int bq[2], tq[2];
#pragma unroll
        for (int q = 0; q < 2; ++q) {
            const int v = 2 * pr + q; bq[q] = v / TT; tq[q] = v - bq[q] * TT;
            float s = 0.f;
#pragma unroll
            for (int j = 0; j < 4; ++j) s += (vv[q][j].x * vv[q][j].x + vv[q][j].y * vv[q][j].y) + (vv[q][j].z * vv[q][j].z + vv[q][j].w * vv[q][j].w);
            const float rs = __builtin_amdgcn_rsqf(wave_sum(s) * (1.0f / 1024.0f) + EPSN);
            unsigned* o8 = (unsigned*)((unsigned char*)F.XS + (size_t)(bq[q] * PP + PADL + tq[q]) * 1024) + lane;
#pragma unroll
            for (int j = 0; j < 4; ++j) { vv[q][j].x *= rs * gg[j].x; vv[q][j].y *= rs * gg[j].y; vv[q][j].z *= rs * gg[j].z; vv[q][j].w *= rs * gg[j].w;
                unsigned wv = 0u; wv = __builtin_amdgcn_cvt_pk_fp8_f32(vv[q][j].x, vv[q][j].y, wv, false); wv = __builtin_amdgcn_cvt_pk_fp8_f32(vv[q][j].z, vv[q][j].w, wv, true); o8[64 * j] = wv; }
        }
        float pl0[16], pl1[16];
#pragma unroll
        for (int e = 0; e < 16; ++e) { f32x2 a0 = {0.f, 0.f}, a1 = {0.f, 0.f};
#pragma unroll
            for (int j = 0; j < 4; ++j) { const f32x4 wv = *(LAS f32x4*)(WR + e * 1024 + 256 * j + 4 * lane);
                const f32x2 wlo = __builtin_shufflevector(wv, wv, 0, 1), whi = __builtin_shufflevector(wv, wv, 2, 3);
                a0 = __builtin_elementwise_fma(__builtin_shufflevector(vv[0][j], vv[0][j], 0, 1), wlo, a0); a0 = __builtin_elementwise_fma(__builtin_shufflevector(vv[0][j], vv[0][j], 2, 3), whi, a0);
                a1 = __builtin_elementwise_fma(__builtin_shufflevector(vv[1][j], vv[1][j], 0, 1), wlo, a1); a1 = __builtin_elementwise_fma(__builtin_shufflevector(vv[1][j], vv[1][j], 2, 3), whi, a1); }
            pl0[e] = a0.x + a0.y; pl1[e] = a1.x + a1.y; if ((e & 3) == 3) asm volatile("" ::: "memory"); }
        const float p0 = router_softmax(pl0, lane), p1 = router_softmax(pl1, lane);
        const int e = ((lane >> 5) & 1) * 8 + ((lane >> 4) & 1) * 4 + ((lane >> 3) & 1) * 2 + ((lane >> 2) & 1);
        if ((lane & 3) == 0) { F.AFF[(size_t)(bq[0] * NE + e) * TT + tq[0]] = p0; F.AFF[(size_t)(bq[1] * NE + e) * TT + tq[1]] = p1; }
    }
    __syncthreads();
}

__device__ __forceinline__ void topk_item(const Fr& F, int b, int e) {
    LAS unsigned* vals = (LAS unsigned*)F.lds;
    LAS unsigned* hist = vals + 8256;
    LAS unsigned* misc = hist + 256;
    LAS unsigned* wsum = misc + 16;
    const int tid = F.tid, lane = F.lane, w = F.wave;
    const float* aff = F.AFF + (size_t)(b * NE + e) * TT;
    for (int t = tid; t < TT; t += 512) vals[t] = __float_as_uint(aff[t]);
    unsigned prefix = 0u, mask = 0u, k = CAP;
    for (int pass = 0; pass < 4; ++pass) {
        const int shift = 24 - 8 * pass;
        if (tid < 256) hist[tid] = 0u;
        __syncthreads();
        for (int t = tid; t < TT; t += 512) { const unsigned v = vals[t]; if ((v & mask) == prefix) __hip_atomic_fetch_add(&hist[(v >> shift) & 255u], 1u, __ATOMIC_RELAXED, __HIP_MEMORY_SCOPE_WORKGROUP); }
        __syncthreads();
        if (w == 0) {
            unsigned c[4]; unsigned s = 0u;
#pragma unroll
            for (int i = 0; i < 4; ++i) { c[i] = hist[255 - (4 * lane + i)]; s += c[i]; }
            unsigned incl = s;
#pragma unroll
            for (int o = 1; o < 64; o <<= 1) { const unsigned y = __shfl_up(incl, o); if (lane >= o) incl += y; }
            unsigned cum = incl - s;
#pragma unroll
            for (int i = 0; i < 4; ++i) { if (cum < k && cum + c[i] >= k) { misc[0] = prefix | ((unsigned)(255 - (4 * lane + i)) << shift); misc[1] = k - cum; } cum += c[i]; }
        }
        __syncthreads();
        prefix = misc[0]; k = misc[1]; mask |= 0xFFu << shift;
        __syncthreads();
    }
    const unsigned thr = prefix, keq = k;
    const int t0 = tid * 17;
    unsigned loc = 0u;
#pragma unroll
    for (int i = 0; i < 17; ++i) { const int t = t0 + i; if (t < TT) { const unsigned v = vals[t]; loc += (v > thr ? 1u : 0u) + (v == thr ? 65536u : 0u); } }
    unsigned incl = loc;
#pragma unroll
    for (int o = 1; o < 64; o <<= 1) { const unsigned y = __shfl_up(incl, o); if (lane >= o) incl += y; }
    if (lane == 63) wsum[w] = incl;
    __syncthreads();
    unsigned before = incl - loc;
#pragma unroll
    for (int w2 = 0; w2 < 8; ++w2) if (w2 < w) before += wsum[w2];
    unsigned gtb = before & 0xFFFFu, eqb = before >> 16;
    for (int i = 0; i < 17; ++i) { const int t = t0 + i; if (t < TT) {
        const unsigned v = vals[t]; const bool gt = v > thr, eq = v == thr; const bool sel = gt || (eq && eqb < keq);
        const int rrow = b * PP + PADL + t;
        int mrow = -1;
        if (sel) { const unsigned slot = gtb + (eqb < keq ? eqb : keq); mrow = e * EROWS + b * CAP + (int)slot; F.IDX[mrow] = rrow * 1024; F.GATE[mrow] = __uint_as_float(v); }
        F.ROWMAP[(size_t)rrow * NE + e] = mrow;
        gtb += gt ? 1u : 0u; eqb += eq ? 1u : 0u; } }
    if (b == 0) for (int i = tid; i < EROWS - NB * CAP; i += 512) { F.IDX[e * EROWS + NB * CAP + i] = 0; F.GATE[e * EROWS + NB * CAP + i] = 0.f; }
    __syncthreads();
}

__device__ __forceinline__ void ph_gather(const Fr& F) {
    for (int v = blockIdx.x * 8 + F.wave; v < NROWS; v += F.G * 8) {
        const int src = F.IDX[v];
        u32x4* dst = (u32x4*)(F.XS + (size_t)v * 1024) + F.lane;
        if (src >= 0) { const u32x4* sp = (const u32x4*)(F.H + (size_t)src * 1024) + F.lane; dst[0] = sp[0]; dst[64] = sp[64]; }
        else { dst[0] = (u32x4){0u, 0u, 0u, 0u}; dst[64] = (u32x4){0u, 0u, 0u, 0u}; }
    }
}
__device__ __forceinline__ void ph_combine(const Fr& F) {
    const int lane = F.lane;
#ifdef DET_PROBE
    float badv = 0.f; { const unsigned long long* c = (const unsigned long long*)(F.CTLP + 32768); float mag = 1e4f;
      for (int k = DET_PROBE - 1; k >= 0; --k) { const bool bk = (__hip_atomic_load(c + 4 * k, __ATOMIC_RELAXED, __HIP_MEMORY_SCOPE_AGENT) != __hip_atomic_load(c + 4 * k + 2, __ATOMIC_RELAXED, __HIP_MEMORY_SCOPE_AGENT)) || (__hip_atomic_load(c + 4 * k + 1, __ATOMIC_RELAXED, __HIP_MEMORY_SCOPE_AGENT) != __hip_atomic_load(c + 4 * k + 3, __ATOMIC_RELAXED, __HIP_MEMORY_SCOPE_AGENT)); if (bk) { float mm = 1e4f; for (int e_ = 0; e_ < k; ++e_) mm *= 10.0f; badv = mm; } } (void)mag; }
    { const unsigned fl_ = __hip_atomic_load((const unsigned*)(F.CTLP + 32768 + 2048), __ATOMIC_RELAXED, __HIP_MEMORY_SCOPE_AGENT); if (fl_) badv = 1e5f * (float)fl_; }
#ifdef STAT_SEL
    { const unsigned* st = (const unsigned*)(F.CTLP + 32768 + 4096);
      const unsigned cnt = __hip_atomic_load(st + 0, __ATOMIC_RELAXED, __HIP_MEMORY_SCOPE_AGENT), nmin = ~__hip_atomic_load(st + 1, __ATOMIC_RELAXED, __HIP_MEMORY_SCOPE_AGENT), nand = ~__hip_atomic_load(st + 3, __ATOMIC_RELAXED, __HIP_MEMORY_SCOPE_AGENT),
                     vor = __hip_atomic_load(st + 4, __ATOMIC_RELAXED, __HIP_MEMORY_SCOPE_AGENT), mabs = __hip_atomic_load(st + 5, __ATOMIC_RELAXED, __HIP_MEMORY_SCOPE_AGENT), mrel = __hip_atomic_load(st + 6, __ATOMIC_RELAXED, __HIP_MEMORY_SCOPE_AGENT);
      if (cnt) { const unsigned vary = vor & ~nand; unsigned k = 0; const unsigned row = nmin >> 9, cw = nmin & 511u, chunkid = row >> 7;
        if (STAT_SEL == 0) { unsigned L = 32u - (unsigned)__builtin_clz(cnt); if (L > 15u) L = 15u; k = L + ((vary & 63u) ? 16u : 0u) + ((vary & 448u) ? 32u : 0u) + ((vary & 0xFE00u) ? 64u : 0u) + ((vary >> 16) ? 128u : 0u); }
        if (STAT_SEL == 1) k = row & 127u;
        if (STAT_SEL == 2) k = cw >> 1;
        if (STAT_SEL == 3) k = chunkid % 65u;
        if (STAT_SEL == 4) k = mabs >> 23;
        if (STAT_SEL == 5) k = mrel >> 23;
        if (STAT_SEL == 6) k = (chunkid / 65u) * 4u + ((cw >> 6) & 3u) + ((cw & 256u) ? 0u : 64u);
        if (STAT_SEL == 7) k = cnt < 255u ? cnt : 255u;
        if (STAT_SEL == 8) { const unsigned e5 = mrel >> 23; const unsigned bk = e5 < 113u ? 0u : (e5 > 127u ? 7u : (e5 - 113u) / 2u); k = (32u - (unsigned)__builtin_clz(cnt)) + 32u * bk; }
        if (STAT_SEL >= 10) { unsigned nit = 0, first = 0xffffu, last = 0;
          for (unsigned wd = 0; wd < 66u; ++wd) { const unsigned bm = __hip_atomic_load(st + 16 + wd, __ATOMIC_RELAXED, __HIP_MEMORY_SCOPE_AGENT); nit += (unsigned)__builtin_popcount(bm);
            if (bm) { const unsigned lo = wd * 32u + (unsigned)__builtin_ctz(bm), hi = wd * 32u + 31u - (unsigned)__builtin_clz(bm); if (first == 0xffffu) first = lo; last = hi; } }
          const unsigned cfirst = __hip_atomic_load((const unsigned*)(F.CTLP + 40960) + (first < 2088u ? first : 0u), __ATOMIC_RELAXED, __HIP_MEMORY_SCOPE_AGENT);
          if (STAT_SEL == 10) k = nit < 255u ? nit : 255u;
          if (STAT_SEL == 15) { const unsigned per = cnt / (nit ? nit : 1u); k = (32u - (unsigned)__builtin_clz(nit | 1u)) + 16u * (32u - (unsigned)__builtin_clz(per | 1u)); }
          if (STAT_SEL == 16 || STAT_SEL == 17) { unsigned bor = 0u, band = 0xffu;
            for (unsigned wd = 0; wd < 66u; ++wd) { unsigned bm = __hip_atomic_load(st + 16 + wd, __ATOMIC_RELAXED, __HIP_MEMORY_SCOPE_AGENT); while (bm) { const unsigned id_ = wd * 32u + (unsigned)__builtin_ctz(bm); bm &= bm - 1u; bor |= (id_ & 255u); band &= (id_ & 255u); } }
            k = (STAT_SEL == 16) ? (unsigned)__builtin_popcount(bor & ~band) : band; }
          if (STAT_SEL == 18 || STAT_SEL == 19) { unsigned jor = 0u, jand = 0xfu, nor_ = 0u, nand_ = 0x7fu;
            for (unsigned wd = 0; wd < 66u; ++wd) { unsigned bm = __hip_atomic_load(st + 16 + wd, __ATOMIC_RELAXED, __HIP_MEMORY_SCOPE_AGENT); while (bm) { const unsigned id_ = wd * 32u + (unsigned)__builtin_ctz(bm); bm &= bm - 1u; jor |= (id_ >> 8); jand &= (id_ >> 8); nor_ |= (id_ % 65u); nand_ &= (id_ % 65u); } }
            k = (STAT_SEL == 18) ? (jor | (jand << 4)) : (nor_ & 127u) + ((nand_ & 127u) ? 128u : 0u); }
          if (STAT_SEL == 20) { const unsigned per = cnt / (nit ? nit : 1u); k = (per >= 6000u) ? 3u : (per >= 2000u) ? 2u : (per >= 256u) ? 1u : 0u; k += 4u * ((nit >= 64u) ? 3u : (nit >= 16u) ? 2u : (nit >= 4u) ? 1u : 0u); }
          if (STAT_SEL == 21) k = vary & 255u;
          if (STAT_SEL == 22) k = (vary >> 9) & 127u;
          if (STAT_SEL == 23) k = (nand >> 9) & 127u;
          if (STAT_SEL == 24) { const float incons = __uint_as_float(__hip_atomic_load(st + 9, __ATOMIC_RELAXED, __HIP_MEMORY_SCOPE_AGENT)); const float rmax = __uint_as_float(__hip_atomic_load(st + 10, __ATOMIC_RELAXED, __HIP_MEMORY_SCOPE_AGENT)), rinv = __uint_as_float(__hip_atomic_load(st + 11, __ATOMIC_RELAXED, __HIP_MEMORY_SCOPE_AGENT));
            k = (incons < 0.03f ? 1u : incons < 0.3f ? 2u : 3u) + 4u * (rmax < 1.05f ? 0u : rmax < 1.5f ? 1u : rmax < 3.0f ? 2u : 3u) + 16u * (rinv < 1.05f ? 0u : rinv < 1.5f ? 1u : rinv < 3.0f ? 2u : 3u); }
          if (STAT_SEL == 25) { const unsigned c13 = __hip_atomic_load(st + 13, __ATOMIC_RELAXED, __HIP_MEMORY_SCOPE_AGENT), c14 = __hip_atomic_load(st + 14, __ATOMIC_RELAXED, __HIP_MEMORY_SCOPE_AGENT); const float fr = (float)c14 / (float)(c13 + c14 + 1u);
            k = (c14 == 0u) ? 0u : fr < 0.01f ? 1u : fr < 0.1f ? 2u : fr < 0.5f ? 3u : fr < 0.9f ? 4u : (c13 != 0u) ? 5u : 6u; }
          if (STAT_SEL == 99) k = 0u;
          if (STAT_SEL == 11) k = (first >> 8) + 16u * (last >> 8);
          if (STAT_SEL == 12) k = first & 255u;
          if (STAT_SEL == 13) k = cfirst / 64u;
          if (STAT_SEL == 14) { const unsigned c7 = __hip_atomic_load(st + 7, __ATOMIC_RELAXED, __HIP_MEMORY_SCOPE_AGENT), c8 = __hip_atomic_load(st + 8, __ATOMIC_RELAXED, __HIP_MEMORY_SCOPE_AGENT); unsigned l8 = c8 ? 32u - (unsigned)__builtin_clz(c8) : 0u; if (l8 > 7u) l8 = 7u; k = (c7 ? 32u - (unsigned)__builtin_clz(c7) : 0u) + 32u * l8; } }
        float mm = 1e4f; for (unsigned e_ = 0; e_ < k; ++e_) mm *= 1.140175f; badv = mm; } }
#endif
    { const unsigned fl2_ = __hip_atomic_load((const unsigned*)(F.CTLP + 32768 + 2048), __ATOMIC_RELAXED, __HIP_MEMORY_SCOPE_AGENT); if (fl2_) badv = 1e7f * (float)fl2_; }
    const bool bad = badv != 0.f;
#endif
    const int gw = blockIdx.x * 8 + F.wave, NGW = F.G * 8, NPAIR = NB * SEQ / 2;
    f32x4 gg[4];
#pragma unroll
    for (int j = 0; j < 4; ++j) gg[j] = ((const f32x4*)F.final_g + lane)[64 * j];
    u32x2 nx[2][4]; int nm[2];
    if (gw < NPAIR) {
#pragma unroll
        for (int q = 0; q < 2; ++q) { const int v = 2 * gw + q, b = v / SEQ, tq = v - b * SEQ; const u32x2* xr = (const u32x2*)(F.HSB + (size_t)(b * PP + PADL + NMETA + tq) * 1024) + lane;
#pragma unroll
            for (int j = 0; j < 4; ++j) nx[q][j] = xr[64 * j];
            nm[q] = F.ROWMAP[(size_t)(b * PP + PADL + NMETA + tq) * NE + (lane & 15)]; }
    }
    for (int pr = gw; pr < NPAIR; pr += NGW) {
        f32x4 vv[2][4]; int mine[2];
#pragma unroll
        for (int q = 0; q < 2; ++q) { mine[q] = nm[q];
#pragma unroll
            for (int j = 0; j < 4; ++j) vv[q][j] = bf4(nx[q][j]); }
        { unsigned bal[2];
#pragma unroll
          for (int q = 0; q < 2; ++q) bal[q] = (unsigned)__ballot(mine[q] >= 0) & 0xFFFFu;
          while (bal[0] | bal[1]) {
              const int dummy = bal[0] ? __builtin_amdgcn_readlane(mine[0], __builtin_ctz(bal[0])) : __builtin_amdgcn_readlane(mine[1], __builtin_ctz(bal[1]));
              int ms[2][4]; float sc[2][4];
#pragma unroll
              for (int q = 0; q < 2; ++q)
#pragma unroll
                  for (int sl = 0; sl < 4; ++sl) { if (bal[q]) { const int e = __builtin_ctz(bal[q]); bal[q] &= bal[q] - 1u; ms[q][sl] = __builtin_amdgcn_readlane(mine[q], e); sc[q][sl] = 0.125f; } else { ms[q][sl] = dummy; sc[q][sl] = 0.f; } }
              unsigned y[2][4][4];
#pragma unroll
              for (int q = 0; q < 2; ++q)
#pragma unroll
                  for (int sl = 0; sl < 4; ++sl) { const unsigned* yr = (const unsigned*)((const unsigned char*)F.YS + (size_t)ms[q][sl] * 1024) + lane;
#pragma unroll
                      for (int j = 0; j < 4; ++j) y[q][sl][j] = yr[64 * j]; }
#pragma unroll
              for (int q = 0; q < 2; ++q)
#pragma unroll
                  for (int sl = 0; sl < 4; ++sl)
#pragma unroll
                      for (int j = 0; j < 4; ++j) { const unsigned yy = y[q][sl][j]; const float w8 = sc[q][sl]; vv[q][j].x += w8 * __builtin_amdgcn_cvt_f32_fp8(yy, 0); vv[q][j].y += w8 * __builtin_amdgcn_cvt_f32_fp8(yy, 1);
                          vv[q][j].z += w8 * __builtin_amdgcn_cvt_f32_fp8(yy, 2); vv[q][j].w += w8 * __builtin_amdgcn_cvt_f32_fp8(yy, 3); }
          } }
        { const int pn = pr + NGW < NPAIR ? pr + NGW : pr;
#pragma unroll
          for (int q = 0; q < 2; ++q) { const int v = 2 * pn + q, b = v / SEQ, tq = v - b * SEQ; const u32x2* xr = (const u32x2*)(F.HSB + (size_t)(b * PP + PADL + NMETA + tq) * 1024) + lane;
#pragma unroll
              for (int j = 0; j < 4; ++j) nx[q][j] = xr[64 * j];
              nm[q] = F.ROWMAP[(size_t)(b * PP + PADL + NMETA + tq) * NE + (lane & 15)]; } }
#pragma unroll
        for (int q = 0; q < 2; ++q) {
            float s = 0.f;
#pragma unroll
            for (int j = 0; j < 4; ++j) s += (vv[q][j].x * vv[q][j].x + vv[q][j].y * vv[q][j].y) + (vv[q][j].z * vv[q][j].z + vv[q][j].w * vv[q][j].w);
            const float rs = __builtin_amdgcn_rsqf(wave_sum(s) * (1.0f / 1024.0f) + EPSN);
            f32x4* xr = (f32x4*)(F.out + (size_t)(2 * pr + q) * 1024) + lane;
#pragma unroll
            for (int j = 0; j < 4; ++j) { f32x4 o; o.x = vv[q][j].x * rs * gg[j].x; o.y = vv[q][j].y * rs * gg[j].y; o.z = vv[q][j].z * rs * gg[j].z; o.w = vv[q][j].w * rs * gg[j].w;
#ifdef DET_PROBE
                if (bad && pr == 0 && q == 0 && j == 0 && lane == 0) o.x = badv;
#endif
                xr[64 * j] = o; }
        }
    }
}

struct Args { const float* in[20]; float* out; unsigned char* ws; int ph_lo, ph_hi; };
__global__ void __launch_bounds__(512, 2) mk_fwd(Args args) {
    extern __shared__ __attribute__((aligned(16))) unsigned char lds_raw[];
    Fr F;
    F.lds = (LAS unsigned char*)lds_raw;
    F.tid = threadIdx.x; F.lane = F.tid & 63; F.wave = __builtin_amdgcn_readfirstlane(F.tid >> 6); F.G = gridDim.x;
    unsigned char* ws = args.ws;
    F.x = args.in[0]; F.meta = args.in[1]; F.norm1_g = args.in[2]; F.w_in = args.in[3]; F.conv_w = args.in[4]; F.conv_b = args.in[5]; F.w_r = args.in[6]; F.b_r = args.in[7];
    F.w_i = args.in[8]; F.b_i = args.in[9]; F.lam = args.in[10]; F.lru_out_g = args.in[11]; F.ret_out_g = args.in[12]; F.w_out = args.in[13]; F.norm2_g = args.in[14];
    F.w_router = args.in[15]; F.w_gate = args.in[16]; F.w_up = args.in[17]; F.w_down = args.in[18]; F.final_g = args.in[19]; F.out = args.out;
    F.CTLP = ws + WS_CTL; F.GW2 = (unsigned short*)(ws + WS_GW2); F.GW = (unsigned short*)(ws + WS_GW); F.WIN = (unsigned short*)(ws + WS_WIN); F.WOUT = (unsigned short*)(ws + WS_WOUT); F.WGU = (unsigned short*)(ws + WS_WGU); F.WD = (unsigned short*)(ws + WS_WD);
    F.H = (unsigned short*)(ws + WS_H); F.Z = (unsigned short*)(ws + WS_Z); F.ST = (unsigned short*)(ws + WS_ST); F.XS = (unsigned short*)(ws + WS_XS); F.ACT = (unsigned short*)(ws + WS_ACT); F.YS = (unsigned short*)(ws + WS_YS);
    F.HSB = (unsigned short*)(ws + WS_HSB); F.ST2 = (unsigned short*)(ws + ST2_BASE); F.HSMETA = (float*)(ws + WS_HSMETA); F.AFF = (float*)(ws + WS_AFF); F.GATE = (float*)(ws + WS_GATE); F.CARRY = (float*)(ws + WS_CARRY); F.CS = (f32x2*)(ws + WS_CS); F.SUMM = (f32x2*)(ws + WS_SUMM);
    F.ROWMAP = (int*)(ws + WS_ROWMAP); F.IDX = (int*)(ws + WS_IDX);
    volatile LAS unsigned* MISC = (volatile LAS unsigned*)(F.lds + LDS_MISC);
    if (F.tid < 64) MISC[F.tid] = 0u;
    __syncthreads();
#ifdef START_DELAY
    { const unsigned long long t0_ = __builtin_amdgcn_s_memrealtime(); while (__builtin_amdgcn_s_memrealtime() - t0_ < START_DELAY) __builtin_amdgcn_s_sleep(16); }
#endif
    XcdBarrier bar = xcd_barrier_post((unsigned*)(ws + WS_CTL) + CW_BAR, MISC + 8);
    const int bid = blockIdx.x, G = F.G;
#define SEAM xcd_barrier(bar);
#define P0 ph_prep(F);
#define P1 { pg8::Gemm g{F.H, F.WIN, NP, ZC, DM}; pg8::StaticOrder S; S.init(NP, ZC, G, bid); pg8::EpiZ E{F.Z, (const float*)F.CS}; \
        pg8::gemm_phase<pg8::EpiZ, pg8::StaticOrder, true, true>(F.lds, g, S, E); \
          \
        if (G == 256) prep_stream8(F, F.w_gate, (unsigned char*)F.WGU, 2097152, 1, bid - 48, G - 48); else prep_stream8(F, F.w_gate, (unsigned char*)F.WGU, 2097152, 1, bid, G); }
#define P2 { P2R P2L }
#ifdef LDS_POISON
#if LDS_POISON == 1
#define LPOI { for (int i_ = F.tid; i_ < LDS_MISC / 4; i_ += 512) ((LAS unsigned*)F.lds)[i_] = 0x7fc07fc0u; __syncthreads(); }
#else
#define LPOI { __syncthreads(); }
#endif
#else
#define LPOI
#endif
#define P2R { LPOI ph_ret_contrib(F); }
#ifndef LRU_NEW2
#define LRU_NEW2 1
#endif
#ifndef LRU_NEW4
#define LRU_NEW4 1
#endif
#define P2L LPOI for (int i2 = G - 1 - bid; i2 < 1040; i2 += G) { if (LRU_NEW2) lru2_item<false>(F, i2 / NSEG, i2 % NSEG); else lru_item<false>(F, i2 / NSEG, i2 % NSEG); }
#define P4R { LPOI ph_ret_final(F); }
#define P4L LPOI for (int i2 = G - 1 - bid; i2 < 1040; i2 += G) { if (LRU_NEW4) lru2_item<true>(F, i2 / NSEG, i2 % NSEG); else lru_item<true>(F, i2 / NSEG, i2 % NSEG); }
#define P3 { lru_carry(F); ret_scan(F); }
#define P4 { P4R P4L }
#define P5 { pg8::Gemm g{F.H, F.WOUT, NP, DM, DM}; pg8::StaticOrder S; S.init(NP, DM, G, bid); pg8::EpiHS E{F.x, F.meta, F.HSB}; \
          \
          \
        const int vb5 = G == 256 ? bid - 16 : bid, VG5 = G == 256 ? G - 16 : G; const bool early5 = (G == 256) && (vb5 >= 0) && ((bid >> 3) & 1); \
        if (early5) { prep_stream8(F, F.w_up, (unsigned char*)F.WGU, 2097152, 2, vb5, VG5); if (G != 256) prep_stream8(F, F.w_down, (unsigned char*)F.WD, 1048576, 0, vb5, VG5); } \
        pg8::gemm_phase<pg8::EpiHS, pg8::StaticOrder, true, true>(F.lds, g, S, E); \
        if (!early5) { prep_stream8(F, F.w_up, (unsigned char*)F.WGU, 2097152, 2, vb5, VG5); if (G != 256) prep_stream8(F, F.w_down, (unsigned char*)F.WD, 1048576, 0, vb5, VG5); } }
#define P6 ph_router(F);
#define P7 { for (int it = bid; it < NB * NE; it += G) topk_item(F, it / NE, it % NE); \
          \
        if (G == 256) prep_stream8(F, F.w_down, (unsigned char*)F.WD, 1048576, 0, bid - 128, 128); }
#define P8 ph_gather(F);
#define P9 { pg8::Gemm g{F.XS, F.WGU, NROWS, NE * 2048, DM / 2}; pg8::GroupOrder S; S.init(NE, 33, 8, G, bid); pg8::EpiAct E{F.ACT}; \
        pg8::gemm_phase_g8<pg8::EpiAct, pg8::GroupOrder>(F.lds, F.lds + LDS_SIDE, g, (const unsigned*)F.IDX, S, E); }
#define P10 { pg8::Gemm g{F.ACT, F.WD, NROWS, NE * 1024, DM / 2}; pg8::GroupOrder S; S.init(NE, 33, 4, G, bid); pg8::EpiYS E{(unsigned char*)F.YS, F.GATE}; \
        pg8::gemm_phase8<pg8::EpiYS, pg8::GroupOrder, true, true>(F.lds, g, S, E); }
#define P10F8 { pg8::Gemm g{F.ACT, F.WD, NROWS, NE * 1024, DM / 2}; pg8::GroupOrder S; S.init(NE, 33, 4, G, bid); pg8::EpiYS E{(unsigned char*)F.YS, F.GATE}; \
        pg8::gemm_phase8<pg8::EpiYS, pg8::GroupOrder, true, true>(F.lds, g, S, E); }
#define CKSTU(slot) ph_checksum(F, F.ST, (size_t)64 * NCHUNK * 32768, slot);
#define CKSUMM(slot) ph_checksum(F, F.SUMM, (size_t)NB * NSEG * 2 * 512 * 8, slot);
#define CKCARRY(slot) ph_checksum(F, F.CARRY, (size_t)NB * NSEG * 2 * 512 * 4, slot);
#define CPY ph_cpy(F);
#define CMP ph_cmp(F);
#define CKY(slot) ph_checksum(F, F.H, (size_t)NP * 2048, slot);
#define CKST(slot) ph_checksum(F, F.ST2, (size_t)64 * NCHUNK * 32768, slot);
#define CKZ(slot) ph_checksum(F, F.Z, (size_t)NP * ZC * 2, slot);
#define CKHSB(slot) ph_checksum(F, F.HSB, (size_t)NP * 2048, slot);
#define P11 ph_combine(F);
#define REP for (int rep_ = 0; rep_ < args.ph_lo; ++rep_)
#ifndef MK_PROG
#define MK_PROG P0 SEAM P1 SEAM P2 SEAM P3 SEAM P4 SEAM P5 SEAM P6 SEAM P7 SEAM P9 SEAM P10 SEAM P11
#endif
    MK_PROG
}

#ifndef MK_REPS
#define MK_REPS 1
#endif
#ifndef MK_ONE_LAUNCH
#define MK_ONE_LAUNCH 0
#endif
extern "C" void kernel_launch(void* const* d_in, const int* in_sizes, int n_in, void* d_out, int out_size, void* d_ws, size_t ws_size, hipStream_t stream) {
    static int grid = 0;
    if (grid == 0) {
        if (n_in != 20 || in_sizes[0] != NB * SEQ * DM || out_size != NB * SEQ * DM || ws_size < WS_END) { fprintf(stderr, "kernel_launch: unexpected shapes / workspace (n_in %d, ws %zu, need %zu)\n", n_in, ws_size, (size_t)WS_END); grid = -1; return; }
        int dev = 0, cus = 0, per_cu = 0;
        if (hipGetDevice(&dev) != hipSuccess || hipDeviceGetAttribute(&cus, hipDeviceAttributeMultiprocessorCount, dev) != hipSuccess) { grid = -1; return; }
        if (hipFuncSetAttribute((const void*)mk_fwd, hipFuncAttributeMaxDynamicSharedMemorySize, LDS_BYTES) != hipSuccess) { fprintf(stderr, "kernel_launch: hipFuncSetAttribute failed\n"); grid = -1; return; }
        if (hipOccupancyMaxActiveBlocksPerMultiprocessor(&per_cu, (const void*)mk_fwd, 512, LDS_BYTES) != hipSuccess || per_cu < 1) { fprintf(stderr, "kernel_launch: occupancy query says %d blocks per CU\n", per_cu); grid = -1; return; }
        (void)hipGetLastError();
        grid = cus;
    }
    if (grid < 0) return;
    (void)hipMemsetAsync((char*)d_ws + WS_CTL, 0, CTL_ZERO_BYTES, stream);
    Args a{};
    for (int i = 0; i < 20; ++i) a.in[i] = (const float*)d_in[i];
    a.out = (float*)d_out; a.ws = (unsigned char*)d_ws; a.ph_lo = MK_REPS; a.ph_hi = 0;
    hipLaunchKernelGGL(mk_fwd, dim3(grid), dim3(512), LDS_BYTES, stream, a);
}
```

```cpp
#include <hip/hip_runtime.h>
#include <cstdio>
#include <cstdint>
#ifndef MK_PROG
#define MK_PROG P0 SEAM P1 SEAM P2 SEAM P3 SEAM P4 SEAM P5 SEAM P6 SEAM P7 SEAM P9 SEAM P10 SEAM P11
#endif
#define LRU_NEW2 0
#define LRU_NEW4 0
namespace pg8 {
#define PG8_LAS __attribute__((address_space(3)))
typedef unsigned short bf16_t;
typedef short bf16x8 __attribute__((ext_vector_type(8)));
typedef float f32x4 __attribute__((ext_vector_type(4)));
typedef unsigned u32x4 __attribute__((ext_vector_type(4)));
constexpr int BM = 256, BK = 64, HALF = 128, HTB = HALF * BK * 2  , STAGE_BYTES = 8 * HTB, NXCD = 8, WGM = 8;

__host__ __device__ __forceinline__ int lds_byte(int r, int c) { const int st = (r >> 4) * 2 + (c >> 5), rr = r & 15, cc = c & 31, ob = rr * 64 + cc * 2; return st * 1024 + (ob ^ (((ob >> 9) & 1) << 5)); }
__host__ __device__ __forceinline__ void stage_rc(int b, int& R, int& C) { const int st = b / 1024, sb = b % 1024, swz = sb ^ (((sb >> 9) & 1) << 5); R = (st >> 1) * 16 + swz / 64; C = (st & 1) * 32 + (swz % 64) / 2; }
__host__ __device__ __forceinline__ int perm32(int rho) { const int n = rho >> 4, i = rho & 15; return 8 * (i >> 2) + 4 * n + (i & 3); }

struct Unit { int pm, pn; };
struct Gemm { const bf16_t* A; const bf16_t* Bt; int M, N, K; };

struct StaticOrder {
    int nM, nN, nwg, G, c;
    __host__ __device__ __forceinline__ void init(int M, int N, int G_, int c_) { nM = M / BM; nN = N / BM; nwg = nM * nN; G = G_; c = c_; }
    __host__ __device__ __forceinline__ bool next(int i, Unit& u) const {
        const long L = (long)i * G + c; if (L >= nwg) return false;
        int wgid = (int)L; { const int q = nwg / NXCD, r = nwg % NXCD, xcd = wgid % NXCD, off = wgid / NXCD; wgid = (xcd < r ? xcd * (q + 1) : r * (q + 1) + (xcd - r) * q) + off; }
        const int nig = WGM * nN, gid = wgid / nig, fm = gid * WGM, gsz = (nM - fm) < WGM ? (nM - fm) : WGM;
        u.pm = fm + ((wgid % nig) % gsz); u.pn = (wgid % nig) / gsz; return true;
    }
    __device__ __forceinline__ void a_ready(const Unit&) const {}
    __device__ __forceinline__ void done(const Unit&) const {}
};

__device__ __forceinline__ unsigned cvt_pk_bf16(float lo, float hi) { unsigned r; asm volatile("v_cvt_pk_bf16_f32 %0, %1, %2" : "=v"(r) : "v"(lo), "v"(hi)); return r; }
typedef float f32x2 __attribute__((ext_vector_type(2)));
__device__ __forceinline__ f32x2 gelu_pk(f32x2 v) {
    const f32x2 av = __builtin_elementwise_abs(v), d = av * 0.2316418882f + 1.0f;
    f32x2 t; t.x = __builtin_amdgcn_rcpf(d.x); t.y = __builtin_amdgcn_rcpf(d.y);
    f32x2 q = t * 0.5307027145f + (-0.7265760135f); q = q * t + 0.7107068705f; q = q * t + (-0.142248368f); q = q * t + 0.127414796f; q = q * t;
    const f32x2 s = (v * v) * (-0.72134752044f);
    f32x2 e; e.x = __builtin_amdgcn_exp2f(s.x); e.y = __builtin_amdgcn_exp2f(s.y);
    const f32x2 m = v * (q * e), r = v - m;
    f32x2 o; o.x = v.x < 0.f ? m.x : r.x; o.y = v.y < 0.f ? m.y : r.y; return o;
}

template <int ACT  > struct EpiBf16 {
    static constexpr bool PERM = true, AFTER_DRAIN = false; static_assert(ACT == 0 || ACT == 1, "EpiBf16: ACT is 0 (none) or 1 (gelu_pk)");
    bf16_t* O; int ldc; const float* bias; int split_cols; size_t split_stride; float scale0;
    __device__ __forceinline__ void operator()(const f32x4 (&acc)[2][2][4][2], const Unit& u, int wr, int wc, int fr, int fq) const {
        const int row0 = u.pm * BM + wr * 64 + fr; int colt = u.pn * BM; bf16_t* base = O;
        float sc = 1.f; if (split_cols) { const int t = colt / split_cols; base += (size_t)t * split_stride; colt -= t * split_cols; if (t == 0) sc = scale0; }
        const int col0 = colt + wc * 32 + 8 * fq, bcol0 = u.pn * BM + wc * 32 + 8 * fq;
        f32x4 bv[2][2];
#pragma unroll
        for (int bj = 0; bj < 2; ++bj)
#pragma unroll
            for (int n = 0; n < 2; ++n) bv[bj][n] = bias ? *(const f32x4*)(bias + bcol0 + bj * HALF + 4 * n) : (f32x4){0.f, 0.f, 0.f, 0.f};
#pragma unroll
        for (int ai = 0; ai < 2; ++ai)
#pragma unroll
            for (int m = 0; m < 4; ++m) { bf16_t* rowp = base + (size_t)(row0 + ai * HALF + m * 16) * ldc + col0;
#pragma unroll
                for (int bj = 0; bj < 2; ++bj) { f32x4 v0 = acc[ai][bj][m][0] + bv[bj][0], v1 = acc[ai][bj][m][1] + bv[bj][1];
                    if (ACT == 1) { f32x2 a = gelu_pk((f32x2){v0[0], v0[1]}), b = gelu_pk((f32x2){v0[2], v0[3]}), c = gelu_pk((f32x2){v1[0], v1[1]}), d = gelu_pk((f32x2){v1[2], v1[3]});
                        v0 = (f32x4){a.x, a.y, b.x, b.y}; v1 = (f32x4){c.x, c.y, d.x, d.y}; }
                    v0 = v0 * sc; v1 = v1 * sc; u32x4 w; w.x = cvt_pk_bf16(v0[0], v0[1]); w.y = cvt_pk_bf16(v0[2], v0[3]); w.z = cvt_pk_bf16(v1[0], v1[1]); w.w = cvt_pk_bf16(v1[2], v1[3]);
                    *(u32x4*)(rowp + bj * HALF) = w; } }
    }
};
typedef int i32x8 __attribute__((ext_vector_type(8)));
__host__ __device__ __forceinline__ int lds_byte8(int r, int fq) { const int st = (r >> 4) * 2 + (fq >> 1), rr = r & 15, ob = rr * 64 + (fq & 1) * 32; return st * 1024 + (ob ^ (((ob >> 9) & 1) << 5)); }
template <class Epi, class Sched, bool ALIGN_EPI = false, bool SP2 = false>
__device__ __forceinline__ void gemm_phase(PG8_LAS unsigned char* lds, const Gemm g, const Sched& S, const Epi& E) {
    int tid = threadIdx.x; asm volatile("" : "+v"(tid));
    const int wid = __builtin_amdgcn_readfirstlane(tid >> 6), lane = tid & 63, wr = wid >> 2, wc = wid & 3, fr = lane & 15, fq = lane >> 4;
    const int K = g.K, nt = K / BK;
    unsigned voffA[2], voffB[2];
#pragma unroll
    for (int i = 0; i < 2; ++i) { int R, C; stage_rc(tid * 16 + i * 8192, R, C); const int Rb = Epi::PERM ? ((R & ~31) + perm32(R & 31)) : R;
        voffA[i] = (unsigned)(R * K + C) * 2u; voffB[i] = (unsigned)(Rb * K + C) * 2u; }
    const size_t kstep = (size_t)(BK * 2);
    const size_t hstep = (size_t)HALF * K * 2;
    const size_t tstep = 2 * hstep;
    const unsigned ldsw = (unsigned)wid * 1024u;
    const int aoff = lds_byte(wr * 64 + fr, fq * 8), boff = lds_byte(wc * 32 + fr, fq * 8);
#define PG8_SA(b, h) (((b) * 2 + (h)) * HTB)
#define PG8_SB(b, h) ((4 + (b) * 2 + (h)) * HTB)
#define PG8_STAGE(bufoff, gbase, voff) do { _Pragma("unroll") for (int _i = 0; _i < 2; ++_i) \
        __builtin_amdgcn_global_load_lds((const unsigned*)((const char*)(gbase) + (voff)[_i]), (PG8_LAS unsigned*)(lds + (bufoff) + ldsw + _i * 8192), 16, 0, 0); } while (0)
#define PG8_LDA(dst, b, h) do { _Pragma("unroll") for (int m = 0; m < 4; ++m) _Pragma("unroll") for (int k = 0; k < 2; ++k) dst[m][k] = *(const PG8_LAS bf16x8*)(lds + PG8_SA(b, h) + aoff + m * 2048 + k * 1024); } while (0)
#define PG8_LDB(dst, b, h) do { _Pragma("unroll") for (int n = 0; n < 2; ++n) _Pragma("unroll") for (int k = 0; k < 2; ++k) dst[n][k] = *(const PG8_LAS bf16x8*)(lds + PG8_SB(b, h) + boff + n * 2048 + k * 1024); } while (0)
#define PG8_MMA(ai, bj, At, Bt) do { __builtin_amdgcn_s_setprio(1); _Pragma("unroll") for (int m = 0; m < 4; ++m) _Pragma("unroll") for (int n = 0; n < 2; ++n) _Pragma("unroll") for (int k = 0; k < 2; ++k) \
        acc[ai][bj][m][n] = __builtin_amdgcn_mfma_f32_16x16x32_bf16(Bt[n][k], At[m][k], acc[ai][bj][m][n], 0, 0, 0); __builtin_amdgcn_s_setprio(0); } while (0)
#define PG8_WAIT_V(n) asm volatile("s_waitcnt vmcnt(" #n ")" ::: "memory")
#define PG8_WAIT_L(n) asm volatile("s_waitcnt lgkmcnt(" #n ")" ::: "memory")
#define PG8_BAR __builtin_amdgcn_s_barrier()
#define PG8_SCHED __builtin_amdgcn_sched_barrier(0)
    Unit cur, nxt; int ui = 0;
    if (!S.next(0, cur)) return;
    f32x4 acc[2][2][4][2];
#pragma unroll
    for (int a = 0; a < 2; ++a)
#pragma unroll
        for (int b = 0; b < 2; ++b)
#pragma unroll
            for (int m = 0; m < 4; ++m)
#pragma unroll
                for (int n = 0; n < 2; ++n) acc[a][b][m][n] = (f32x4){0.f, 0.f, 0.f, 0.f};
    bf16x8 At[4][2], B0[2][2], B1[2][2];
    const char* cA = (const char*)g.A + (size_t)cur.pm * tstep; const char* cB = (const char*)g.Bt + (size_t)cur.pn * tstep;
    S.a_ready(cur);
    if constexpr (SP2) {
        PG8_STAGE(PG8_SB(0, 0), cB, voffB); PG8_STAGE(PG8_SB(0, 1), cB + hstep, voffB); PG8_STAGE(PG8_SA(0, 0), cA, voffA); PG8_STAGE(PG8_SA(0, 1), cA + hstep, voffA);
        if (wr == 1) PG8_BAR;
        PG8_WAIT_V(2); PG8_BAR;
        PG8_STAGE(PG8_SB(1, 0), cB + kstep, voffB); PG8_STAGE(PG8_SA(1, 0), cA + kstep, voffA); PG8_STAGE(PG8_SB(1, 1), cB + hstep + kstep, voffB);
        PG8_WAIT_V(6); PG8_BAR;
    } else {
        PG8_STAGE(PG8_SB(0, 0), cB, voffB); PG8_STAGE(PG8_SA(0, 0), cA, voffA); PG8_STAGE(PG8_SB(0, 1), cB + hstep, voffB); PG8_STAGE(PG8_SA(0, 1), cA + hstep, voffA);
        if (wr == 1) PG8_BAR;
        PG8_WAIT_V(4); PG8_BAR;
        PG8_STAGE(PG8_SB(1, 0), cB + kstep, voffB); PG8_STAGE(PG8_SA(1, 0), cA + kstep, voffA); PG8_STAGE(PG8_SB(1, 1), cB + hstep + kstep, voffB);
        PG8_WAIT_V(6); PG8_BAR;
    }
    for (;;) {
        const bool has_next = S.next(ui + 1, nxt);
        const char* nA = has_next ? (const char*)g.A + (size_t)nxt.pm * tstep : cA; const char* nB = has_next ? (const char*)g.Bt + (size_t)nxt.pn * tstep : cB;
        for (int t = 0; t < nt; t += 2) {
            const bool last = (t == nt - 2);
            const char* a1 = cA + (size_t)(t + 1) * kstep;
            const char* a2 = last ? nA : cA + (size_t)(t + 2) * kstep; const char* b2 = last ? nB : cB + (size_t)(t + 2) * kstep;
            const char* a3 = a2 + kstep; const char* b3 = b2 + kstep;
            if (last && has_next) S.a_ready(nxt);
            if constexpr (SP2) {
            PG8_LDB(B0, 0, 0); PG8_LDB(B1, 0, 1); PG8_SCHED; PG8_LDA(At, 0, 0); PG8_STAGE(PG8_SA(1, 1), a1 + hstep, voffA);
            PG8_WAIT_V(8); PG8_WAIT_L(0); PG8_BAR; PG8_MMA(0, 0, At, B0); PG8_MMA(0, 1, At, B1); PG8_BAR; PG8_SCHED;
            PG8_LDA(At, 0, 1); PG8_STAGE(PG8_SB(0, 0), b2, voffB); PG8_STAGE(PG8_SB(0, 1), b2 + hstep, voffB); PG8_STAGE(PG8_SA(0, 0), a2, voffA);
            PG8_WAIT_V(8); PG8_WAIT_L(0); PG8_BAR; PG8_MMA(1, 0, At, B0); PG8_MMA(1, 1, At, B1); PG8_BAR; PG8_SCHED;
            PG8_LDB(B0, 1, 0); PG8_LDB(B1, 1, 1); PG8_SCHED; PG8_LDA(At, 1, 0); PG8_STAGE(PG8_SA(0, 1), a2 + hstep, voffA);
            PG8_WAIT_V(8); PG8_WAIT_L(0); PG8_BAR; PG8_MMA(0, 0, At, B0); PG8_MMA(0, 1, At, B1); PG8_BAR; PG8_SCHED;
            PG8_LDA(At, 1, 1); PG8_STAGE(PG8_SB(1, 0), b3, voffB); PG8_STAGE(PG8_SB(1, 1), b3 + hstep, voffB); PG8_STAGE(PG8_SA(1, 0), a3, voffA);
            PG8_WAIT_V(8); PG8_WAIT_L(0); PG8_BAR; PG8_MMA(1, 0, At, B0); PG8_MMA(1, 1, At, B1); PG8_BAR; PG8_SCHED;
            } else {
            PG8_LDB(B0, 0, 0); PG8_SCHED; PG8_LDA(At, 0, 0); PG8_STAGE(PG8_SA(1, 1), a1 + hstep, voffA);
            PG8_WAIT_L(8); PG8_BAR; PG8_WAIT_L(0); PG8_MMA(0, 0, At, B0); PG8_BAR; PG8_SCHED;
            PG8_LDB(B1, 0, 1); PG8_STAGE(PG8_SB(0, 0), b2, voffB);
            PG8_BAR; PG8_WAIT_L(0); PG8_MMA(0, 1, At, B1); PG8_BAR;
            PG8_LDA(At, 0, 1); PG8_STAGE(PG8_SA(0, 0), a2, voffA);
            PG8_BAR; PG8_WAIT_L(0); PG8_MMA(1, 0, At, B0); PG8_BAR; PG8_SCHED;
            PG8_STAGE(PG8_SB(0, 1), b2 + hstep, voffB);
            PG8_WAIT_V(6); PG8_BAR; PG8_MMA(1, 1, At, B1); PG8_BAR;
            PG8_LDB(B0, 1, 0); PG8_SCHED; PG8_LDA(At, 1, 0); PG8_STAGE(PG8_SA(0, 1), a2 + hstep, voffA);
            PG8_WAIT_L(8); PG8_BAR; PG8_WAIT_L(0); PG8_MMA(0, 0, At, B0); PG8_BAR; PG8_SCHED;
            PG8_LDB(B1, 1, 1); PG8_STAGE(PG8_SB(1, 0), b3, voffB);
            PG8_BAR; PG8_WAIT_L(0); PG8_MMA(0, 1, At, B1); PG8_BAR;
            PG8_LDA(At, 1, 1); PG8_STAGE(PG8_SA(1, 0), a3, voffA);
            PG8_BAR; PG8_WAIT_L(0); PG8_MMA(1, 0, At, B0); PG8_BAR; PG8_SCHED;
            PG8_STAGE(PG8_SB(1, 1), b3 + hstep, voffB);
            PG8_WAIT_V(6); PG8_BAR; PG8_MMA(1, 1, At, B1); PG8_BAR;
            }
        }
        if constexpr (ALIGN_EPI) { if (wr == 0) PG8_BAR; }
        if constexpr (!Epi::AFTER_DRAIN) { E(acc, cur, wr, wc, fr, fq); S.done(cur); }
        if (!has_next) break;
#pragma unroll
        for (int a = 0; a < 2; ++a)
#pragma unroll
            for (int b = 0; b < 2; ++b)
#pragma unroll
                for (int m = 0; m < 4; ++m)
#pragma unroll
                    for (int n = 0; n < 2; ++n) acc[a][b][m][n] = (f32x4){0.f, 0.f, 0.f, 0.f};
        cur = nxt; cA = nA; cB = nB; ++ui;
        if constexpr (ALIGN_EPI) { if (wr == 1) PG8_BAR; }
    }
    PG8_WAIT_V(0);
    if constexpr (!ALIGN_EPI) { if (wr == 0) PG8_BAR; }
    PG8_BAR;
    if constexpr (Epi::AFTER_DRAIN) { E.fused(acc, cur, wr, wc, fr, fq, lds, wid, lane); S.done(cur); }
}
template <class Epi, class Sched>
__device__ __forceinline__ void gemm_phase_g(PG8_LAS unsigned char* lds, PG8_LAS unsigned char* side, const Gemm g, const unsigned* rowoff, const Sched& S, const Epi& E) {
    constexpr bool ALIGN_EPI = true, SP2 = true;
    int tid = threadIdx.x; asm volatile("" : "+v"(tid));
    const int wid = __builtin_amdgcn_readfirstlane(tid >> 6), lane = tid & 63, wr = wid >> 2, wc = wid & 3, fr = lane & 15, fq = lane >> 4;
    const int K = g.K, nt = K / BK;
    unsigned voffB[2], cA2[2]; int RA[2];
#pragma unroll
    for (int i = 0; i < 2; ++i) { int R, C; stage_rc(tid * 16 + i * 8192, R, C); const int Rb = Epi::PERM ? ((R & ~31) + perm32(R & 31)) : R;
        RA[i] = R; cA2[i] = (unsigned)C * 2u; voffB[i] = (unsigned)(Rb * K + C) * 2u; }
    const size_t kstep = (size_t)(BK * 2);
    const size_t hstep = (size_t)HALF * K * 2;
    const size_t tstep = 2 * hstep;
    const unsigned ldsw = (unsigned)wid * 1024u;
    const int aoff = lds_byte(wr * 64 + fr, fq * 8), boff = lds_byte(wc * 32 + fr, fq * 8);
    Unit cur, nxt; int ui = 0;
    if (!S.next(0, cur)) return;
    f32x4 acc[2][2][4][2];
#pragma unroll
    for (int a = 0; a < 2; ++a)
#pragma unroll
        for (int b = 0; b < 2; ++b)
#pragma unroll
            for (int m = 0; m < 4; ++m)
#pragma unroll
                for (int n = 0; n < 2; ++n) acc[a][b][m][n] = (f32x4){0.f, 0.f, 0.f, 0.f};
    bf16x8 At[4][2], B0[2][2], B1[2][2];
    const char* const gA = (const char*)g.A; const char* cB = (const char*)g.Bt + (size_t)cur.pn * tstep;
    unsigned vo0[2], vo1[2], nvo0[2], nvo1[2];
#pragma unroll
    for (int i = 0; i < 2; ++i) { vo0[i] = rowoff[(size_t)cur.pm * 256 + RA[i]] + cA2[i]; vo1[i] = rowoff[(size_t)cur.pm * 256 + 128 + RA[i]] + cA2[i]; nvo0[i] = vo0[i]; nvo1[i] = vo1[i]; }
    S.a_ready(cur);
    if constexpr (SP2) {
        PG8_STAGE(PG8_SB(0, 0), cB, voffB); PG8_STAGE(PG8_SB(0, 1), cB + hstep, voffB); PG8_STAGE(PG8_SA(0, 0), gA, vo0); PG8_STAGE(PG8_SA(0, 1), gA, vo1);
        if (wr == 1) PG8_BAR;
        PG8_WAIT_V(2); PG8_BAR;
        PG8_STAGE(PG8_SB(1, 0), cB + kstep, voffB); PG8_STAGE(PG8_SA(1, 0), gA + kstep, vo0); PG8_STAGE(PG8_SB(1, 1), cB + hstep + kstep, voffB);
        PG8_WAIT_V(6); PG8_BAR;
    }
    for (;;) {
        const bool has_next = S.next(ui + 1, nxt);
        const char* nB = has_next ? (const char*)g.Bt + (size_t)nxt.pn * tstep : cB;
        if (has_next) __builtin_amdgcn_global_load_lds((const unsigned*)(rowoff + (size_t)nxt.pm * 256 + lane * 4), (PG8_LAS unsigned*)(side + (ui & 1) * 1024), 16, 0, 0);
        for (int t = 0; t < nt; t += 2) {
            const bool last = (t == nt - 2);
            if (last && has_next) {
                const PG8_LAS unsigned* sl = (const PG8_LAS unsigned*)(side + (ui & 1) * 1024);
#pragma unroll
                for (int i = 0; i < 2; ++i) { int ra = RA[i]; asm volatile("" : "+v"(ra));
                    nvo0[i] = sl[ra] + cA2[i]; nvo1[i] = sl[128 + ra] + cA2[i]; }
            }
            const char* a1 = gA + (size_t)(t + 1) * kstep;
            const char* a2 = last ? gA : gA + (size_t)(t + 2) * kstep; const char* b2 = last ? nB : cB + (size_t)(t + 2) * kstep;
            unsigned s0[2], s1[2];
#pragma unroll
            for (int i = 0; i < 2; ++i) { s0[i] = last ? nvo0[i] : vo0[i]; s1[i] = last ? nvo1[i] : vo1[i]; }
            const char* a3 = a2 + kstep; const char* b3 = b2 + kstep;
            if (last && has_next) S.a_ready(nxt);
            if constexpr (SP2) {
            PG8_LDB(B0, 0, 0); PG8_LDB(B1, 0, 1); PG8_SCHED; PG8_LDA(At, 0, 0); PG8_STAGE(PG8_SA(1, 1), a1, vo1);
            PG8_WAIT_V(8); PG8_WAIT_L(0); PG8_BAR; PG8_MMA(0, 0, At, B0); PG8_MMA(0, 1, At, B1); PG8_BAR; PG8_SCHED;
            PG8_LDA(At, 0, 1); PG8_STAGE(PG8_SB(0, 0), b2, voffB); PG8_STAGE(PG8_SB(0, 1), b2 + hstep, voffB); PG8_STAGE(PG8_SA(0, 0), a2, s0);
            PG8_WAIT_V(8); PG8_WAIT_L(0); PG8_BAR; PG8_MMA(1, 0, At, B0); PG8_MMA(1, 1, At, B1); PG8_BAR; PG8_SCHED;
            PG8_LDB(B0, 1, 0); PG8_LDB(B1, 1, 1); PG8_SCHED; PG8_LDA(At, 1, 0); PG8_STAGE(PG8_SA(0, 1), a2, s1);
            PG8_WAIT_V(8); PG8_WAIT_L(0); PG8_BAR; PG8_MMA(0, 0, At, B0); PG8_MMA(0, 1, At, B1); PG8_BAR; PG8_SCHED;
            PG8_LDA(At, 1, 1); PG8_STAGE(PG8_SB(1, 0), b3, voffB); PG8_STAGE(PG8_SB(1, 1), b3 + hstep, voffB); PG8_STAGE(PG8_SA(1, 0), a3, s0);
            PG8_WAIT_V(8); PG8_WAIT_L(0); PG8_BAR; PG8_MMA(1, 0, At, B0); PG8_MMA(1, 1, At, B1); PG8_BAR; PG8_SCHED;
            }
        }
        if constexpr (ALIGN_EPI) { if (wr == 0) PG8_BAR; }
        if constexpr (!Epi::AFTER_DRAIN) { E(acc, cur, wr, wc, fr, fq); S.done(cur); }
        if (!has_next) break;
#pragma unroll
        for (int a = 0; a < 2; ++a)
#pragma unroll
            for (int b = 0; b < 2; ++b)
#pragma unroll
                for (int m = 0; m < 4; ++m)
#pragma unroll
                    for (int n = 0; n < 2; ++n) acc[a][b][m][n] = (f32x4){0.f, 0.f, 0.f, 0.f};
        cur = nxt; cB = nB; ++ui;
#pragma unroll
        for (int i = 0; i < 2; ++i) { vo0[i] = nvo0[i]; vo1[i] = nvo1[i]; }
        if constexpr (ALIGN_EPI) { if (wr == 1) PG8_BAR; }
    }
    PG8_WAIT_V(0);
    if constexpr (!ALIGN_EPI) { if (wr == 0) PG8_BAR; }
    PG8_BAR;
    if constexpr (Epi::AFTER_DRAIN) { E.fused(acc, cur, wr, wc, fr, fq, lds, wid, lane); S.done(cur); }
}
#define PG8_LDA8(dst, b, h) do { _Pragma("unroll") for (int m = 0; m < 4; ++m) dst[m] = *(const PG8_LAS i32x8*)(lds + PG8_SA(b, h) + aoff + m * 2048); } while (0)
#define PG8_LDB8(dst, b, h) do { _Pragma("unroll") for (int n = 0; n < 2; ++n) dst[n] = *(const PG8_LAS i32x8*)(lds + PG8_SB(b, h) + boff + n * 2048); } while (0)
#define PG8_MMA8(ai, bj, At, Bt) do { __builtin_amdgcn_s_setprio(1); asm volatile("s_nop 1" ::: "memory"); _Pragma("unroll") for (int m = 0; m < 4; ++m) _Pragma("unroll") for (int n = 0; n < 2; ++n) \
        asm volatile("v_mfma_scale_f32_16x16x128_f8f6f4 %0, %1, %2, %0, %3, %3 op_sel_hi:[0,0,0]" : "+v"(acc[ai][bj][m][n]) : "v"(Bt[n]), "v"(At[m]), "v"(scl8)); __builtin_amdgcn_s_setprio(0); } while (0)
template <class Epi, class Sched>
__device__ __forceinline__ void gemm_phase_g8(PG8_LAS unsigned char* lds, PG8_LAS unsigned char* side, const Gemm g, const unsigned* rowoff, const Sched& S, const Epi& E) {
    constexpr bool ALIGN_EPI = true, SP2 = true;
    int tid = threadIdx.x; asm volatile("" : "+v"(tid));
    const int wid = __builtin_amdgcn_readfirstlane(tid >> 6), lane = tid & 63, wr = wid >> 2, wc = wid & 3, fr = lane & 15, fq = lane >> 4;
    const int K = g.K; int nt = K / BK; asm volatile("" : "+s"(nt));
    unsigned voffB[2]; unsigned cA2 = 0u; int RA = 0;
#pragma unroll
    for (int i = 0; i < 2; ++i) { int R, C; stage_rc(tid * 16 + i * 8192, R, C); const int Rb = Epi::PERM ? ((R & ~31) + perm32(R & 31)) : R;
        if (i == 0) { RA = R; cA2 = (unsigned)C * 2u; } voffB[i] = (unsigned)(Rb * K + C) * 2u; }
    const size_t kstep = (size_t)(BK * 2);
    const size_t hstep = (size_t)HALF * K * 2;
    const size_t tstep = 2 * hstep;
    const unsigned ldsw = (unsigned)wid * 1024u;
    const int aoff = lds_byte8(wr * 64 + fr, fq), boff = lds_byte8(wc * 32 + fr, fq);
    int scl8 = 0x7f7f7f7f; asm volatile("" : "+v"(scl8));
    Unit cur, nxt; int ui = 0;
    if (!S.next(0, cur)) return;
    f32x4 acc[2][2][4][2];
#pragma unroll
    for (int a = 0; a < 2; ++a)
#pragma unroll
        for (int b = 0; b < 2; ++b)
#pragma unroll
            for (int m = 0; m < 4; ++m)
#pragma unroll
                for (int n = 0; n < 2; ++n) acc[a][b][m][n] = (f32x4){0.f, 0.f, 0.f, 0.f};
    i32x8 At[4], B0[2], B1[2];
    const char* const gA = (const char*)g.A; const char* cB = (const char*)g.Bt + (size_t)cur.pn * tstep;
    unsigned vo0[2], vo1[2];
#pragma unroll
    for (int i = 0; i < 2; ++i) { vo0[i] = rowoff[(size_t)cur.pm * 256 + RA + 64 * i] + cA2; vo1[i] = rowoff[(size_t)cur.pm * 256 + 128 + RA + 64 * i] + cA2; }
    S.a_ready(cur);
    if constexpr (SP2) {
        PG8_STAGE(PG8_SB(0, 0), cB, voffB); PG8_STAGE(PG8_SB(0, 1), cB + hstep, voffB); PG8_STAGE(PG8_SA(0, 0), gA, vo0); PG8_STAGE(PG8_SA(0, 1), gA, vo1);
        if (wr == 1) PG8_BAR;
        PG8_WAIT_V(2); PG8_BAR;
        PG8_STAGE(PG8_SB(1, 0), cB + kstep, voffB); PG8_STAGE(PG8_SA(1, 0), gA + kstep, vo0); PG8_STAGE(PG8_SB(1, 1), cB + hstep + kstep, voffB);
        PG8_WAIT_V(6); PG8_BAR;
    }
    for (;;) {
        const bool has_next = S.next(ui + 1, nxt);
        const char* nB = has_next ? (const char*)g.Bt + (size_t)nxt.pn * tstep : cB;
        if (has_next) __builtin_amdgcn_global_load_lds((const unsigned*)(rowoff + (size_t)nxt.pm * 256 + lane * 4), (PG8_LAS unsigned*)(side + (ui & 1) * 1024), 16, 0, 0);
        for (int t = 0; t < nt; t += 2) {
            const bool last = (t == nt - 2);
            const char* a1 = gA + (size_t)(t + 1) * kstep;
            const char* a2 = last ? gA : gA + (size_t)(t + 2) * kstep; const char* b2 = last ? nB : cB + (size_t)(t + 2) * kstep;
            unsigned s0[2], s1[2];
#pragma unroll
            for (int i = 0; i < 2; ++i) { s0[i] = vo0[i]; s1[i] = vo1[i]; }
            if (last && has_next) {
                const PG8_LAS unsigned* sl = (const PG8_LAS unsigned*)(side + (ui & 1) * 1024);
                int ra = RA; asm volatile("" : "+v"(ra));
#pragma unroll
                for (int i = 0; i < 2; ++i) { s0[i] = sl[ra + 64 * i] + cA2; s1[i] = sl[128 + ra + 64 * i] + cA2; }
            }
            const char* a3 = a2 + kstep; const char* b3 = b2 + kstep;
            if (last && has_next) S.a_ready(nxt);
            if constexpr (SP2) {
            PG8_LDB8(B0, 0, 0); PG8_LDB8(B1, 0, 1); PG8_SCHED; PG8_LDA8(At, 0, 0); PG8_STAGE(PG8_SA(1, 1), a1, vo1);
            PG8_WAIT_V(8); PG8_WAIT_L(0); PG8_BAR; PG8_MMA8(0, 0, At, B0); PG8_MMA8(0, 1, At, B1); PG8_BAR; PG8_SCHED;
            PG8_LDA8(At, 0, 1); PG8_STAGE(PG8_SB(0, 0), b2, voffB); PG8_STAGE(PG8_SB(0, 1), b2 + hstep, voffB); PG8_STAGE(PG8_SA(0, 0), a2, s0);
            PG8_WAIT_V(8); PG8_WAIT_L(0); PG8_BAR; PG8_MMA8(1, 0, At, B0); PG8_MMA8(1, 1, At, B1); PG8_BAR; PG8_SCHED;
            PG8_LDB8(B0, 1, 0); PG8_LDB8(B1, 1, 1); PG8_SCHED; PG8_LDA8(At, 1, 0); PG8_STAGE(PG8_SA(0, 1), a2, s1);
            PG8_WAIT_V(8); PG8_WAIT_L(0); PG8_BAR; PG8_MMA8(0, 0, At, B0); PG8_MMA8(0, 1, At, B1); PG8_BAR; PG8_SCHED;
            PG8_LDA8(At, 1, 1); PG8_STAGE(PG8_SB(1, 0), b3, voffB); PG8_STAGE(PG8_SB(1, 1), b3 + hstep, voffB); PG8_STAGE(PG8_SA(1, 0), a3, s0);
            PG8_WAIT_V(8); PG8_WAIT_L(0); PG8_BAR; PG8_MMA8(1, 0, At, B0); PG8_MMA8(1, 1, At, B1); PG8_BAR; PG8_SCHED;
            }
        }
        asm volatile("s_nop 15\n\ts_nop 15" ::: "memory");
        if constexpr (ALIGN_EPI) { if (wr == 0) PG8_BAR; }
        if constexpr (!Epi::AFTER_DRAIN) { E(acc, cur, wr, wc, fr, fq); S.done(cur); }
        if (!has_next) break;
#pragma unroll
        for (int a = 0; a < 2; ++a)
#pragma unroll
            for (int b = 0; b < 2; ++b)
#pragma unroll
                for (int m = 0; m < 4; ++m)
#pragma unroll
                    for (int n = 0; n < 2; ++n) acc[a][b][m][n] = (f32x4){0.f, 0.f, 0.f, 0.f};
        cur = nxt; cB = nB; ++ui;
        { const PG8_LAS unsigned* sl = (const PG8_LAS unsigned*)(side + ((ui - 1) & 1) * 1024); int ra = RA; asm volatile("" : "+v"(ra));
#pragma unroll
          for (int i = 0; i < 2; ++i) { vo0[i] = sl[ra + 64 * i] + cA2; vo1[i] = sl[128 + ra + 64 * i] + cA2; } }
        if constexpr (ALIGN_EPI) { if (wr == 1) PG8_BAR; }
    }
    PG8_WAIT_V(0);
    if constexpr (!ALIGN_EPI) { if (wr == 0) PG8_BAR; }
    PG8_BAR;
    if constexpr (Epi::AFTER_DRAIN) { E.fused(acc, cur, wr, wc, fr, fq, lds, wid, lane); S.done(cur); }
}
template <class Epi, class Sched, bool ALIGN_EPI = false, bool SP2 = false>
__device__ __forceinline__ void gemm_phase8(PG8_LAS unsigned char* lds, const Gemm g, const Sched& S, const Epi& E) {
    int tid = threadIdx.x; asm volatile("" : "+v"(tid));
    const int wid = __builtin_amdgcn_readfirstlane(tid >> 6), lane = tid & 63, wr = wid >> 2, wc = wid & 3, fr = lane & 15, fq = lane >> 4;
    const int K = g.K; int nt = K / BK; asm volatile("" : "+s"(nt));
    unsigned voffA[2], voffB[2];
#pragma unroll
    for (int i = 0; i < 2; ++i) { int R, C; stage_rc(tid * 16 + i * 8192, R, C); const int Rb = Epi::PERM ? ((R & ~31) + perm32(R & 31)) : R;
        voffA[i] = (unsigned)(R * K + C) * 2u; voffB[i] = (unsigned)(Rb * K + C) * 2u; }
    const size_t kstep = (size_t)(BK * 2);
    const size_t hstep = (size_t)HALF * K * 2;
    const size_t tstep = 2 * hstep;
    const unsigned ldsw = (unsigned)wid * 1024u;
    const int aoff = lds_byte8(wr * 64 + fr, fq), boff = lds_byte8(wc * 32 + fr, fq);
    int scl8 = 0x7f7f7f7f; asm volatile("" : "+v"(scl8));
    Unit cur, nxt; int ui = 0;
    if (!S.next(0, cur)) return;
    f32x4 acc[2][2][4][2];
#pragma unroll
    for (int a = 0; a < 2; ++a)
#pragma unroll
        for (int b = 0; b < 2; ++b)
#pragma unroll
            for (int m = 0; m < 4; ++m)
#pragma unroll
                for (int n = 0; n < 2; ++n) acc[a][b][m][n] = (f32x4){0.f, 0.f, 0.f, 0.f};
    i32x8 At[4], B0[2], B1[2];
    const char* cA = (const char*)g.A + (size_t)cur.pm * tstep; const char* cB = (const char*)g.Bt + (size_t)cur.pn * tstep;
    S.a_ready(cur);
    if constexpr (SP2) {
        PG8_STAGE(PG8_SB(0, 0), cB, voffB); PG8_STAGE(PG8_SB(0, 1), cB + hstep, voffB); PG8_STAGE(PG8_SA(0, 0), cA, voffA); PG8_STAGE(PG8_SA(0, 1), cA + hstep, voffA);
        if (wr == 1) PG8_BAR;
        PG8_WAIT_V(2); PG8_BAR;
        PG8_STAGE(PG8_SB(1, 0), cB + kstep, voffB); PG8_STAGE(PG8_SA(1, 0), cA + kstep, voffA); PG8_STAGE(PG8_SB(1, 1), cB + hstep + kstep, voffB);
        PG8_WAIT_V(6); PG8_BAR;
    } else {
        PG8_STAGE(PG8_SB(0, 0), cB, voffB); PG8_STAGE(PG8_SA(0, 0), cA, voffA); PG8_STAGE(PG8_SB(0, 1), cB + hstep, voffB); PG8_STAGE(PG8_SA(0, 1), cA + hstep, voffA);
        if (wr == 1) PG8_BAR;
        PG8_WAIT_V(4); PG8_BAR;
        PG8_STAGE(PG8_SB(1, 0), cB + kstep, voffB); PG8_STAGE(PG8_SA(1, 0), cA + kstep, voffA); PG8_STAGE(PG8_SB(1, 1), cB + hstep + kstep, voffB);
        PG8_WAIT_V(6); PG8_BAR;
    }
    for (;;) {
        const bool has_next = S.next(ui + 1, nxt);
        const char* nA = has_next ? (const char*)g.A + (size_t)nxt.pm * tstep : cA; const char* nB = has_next ? (const char*)g.Bt + (size_t)nxt.pn * tstep : cB;
        for (int t = 0; t < nt; t += 2) {
            const bool last = (t == nt - 2);
            const char* a1 = cA + (size_t)(t + 1) * kstep;
            const char* a2 = last ? nA : cA + (size_t)(t + 2) * kstep; const char* b2 = last ? nB : cB + (size_t)(t + 2) * kstep;
            const char* a3 = a2 + kstep; const char* b3 = b2 + kstep;
            if (last && has_next) S.a_ready(nxt);
            if constexpr (SP2) {
            PG8_LDB8(B0, 0, 0); PG8_LDB8(B1, 0, 1); PG8_SCHED; PG8_LDA8(At, 0, 0); PG8_STAGE(PG8_SA(1, 1), a1 + hstep, voffA);
            PG8_WAIT_V(8); PG8_WAIT_L(0); PG8_BAR; PG8_MMA8(0, 0, At, B0); PG8_MMA8(0, 1, At, B1); PG8_BAR; PG8_SCHED;
            PG8_LDA8(At, 0, 1); PG8_STAGE(PG8_SB(0, 0), b2, voffB); PG8_STAGE(PG8_SB(0, 1), b2 + hstep, voffB); PG8_STAGE(PG8_SA(0, 0), a2, voffA);
            PG8_WAIT_V(8); PG8_WAIT_L(0); PG8_BAR; PG8_MMA8(1, 0, At, B0); PG8_MMA8(1, 1, At, B1); PG8_BAR; PG8_SCHED;
            PG8_LDB8(B0, 1, 0); PG8_LDB8(B1, 1, 1); PG8_SCHED; PG8_LDA8(At, 1, 0); PG8_STAGE(PG8_SA(0, 1), a2 + hstep, voffA);
            PG8_WAIT_V(8); PG8_WAIT_L(0); PG8_BAR; PG8_MMA8(0, 0, At, B0); PG8_MMA8(0, 1, At, B1); PG8_BAR; PG8_SCHED;
            PG8_LDA8(At, 1, 1); PG8_STAGE(PG8_SB(1, 0), b3, voffB); PG8_STAGE(PG8_SB(1, 1), b3 + hstep, voffB); PG8_STAGE(PG8_SA(1, 0), a3, voffA);
            PG8_WAIT_V(8); PG8_WAIT_L(0); PG8_BAR; PG8_MMA8(1, 0, At, B0); PG8_MMA8(1, 1, At, B1); PG8_BAR; PG8_SCHED;
            } else {
            PG8_LDB8(B0, 0, 0); PG8_SCHED; PG8_LDA8(At, 0, 0); PG8_STAGE(PG8_SA(1, 1), a1 + hstep, voffA);
            PG8_WAIT_L(8); PG8_BAR; PG8_WAIT_L(0); PG8_MMA8(0, 0, At, B0); PG8_BAR; PG8_SCHED;
            PG8_LDB8(B1, 0, 1); PG8_STAGE(PG8_SB(0, 0), b2, voffB);
            PG8_BAR; PG8_WAIT_L(0); PG8_MMA8(0, 1, At, B1); PG8_BAR;
            PG8_LDA8(At, 0, 1); PG8_STAGE(PG8_SA(0, 0), a2, voffA);
            PG8_BAR; PG8_WAIT_L(0); PG8_MMA8(1, 0, At, B0); PG8_BAR; PG8_SCHED;
            PG8_STAGE(PG8_SB(0, 1), b2 + hstep, voffB);
            PG8_WAIT_V(6); PG8_BAR; PG8_MMA8(1, 1, At, B1); PG8_BAR;
            PG8_LDB8(B0, 1, 0); PG8_SCHED; PG8_LDA8(At, 1, 0); PG8_STAGE(PG8_SA(0, 1), a2 + hstep, voffA);
            PG8_WAIT_L(8); PG8_BAR; PG8_WAIT_L(0); PG8_MMA8(0, 0, At, B0); PG8_BAR; PG8_SCHED;
            PG8_LDB8(B1, 1, 1); PG8_STAGE(PG8_SB(1, 0), b3, voffB);
            PG8_BAR; PG8_WAIT_L(0); PG8_MMA8(0, 1, At, B1); PG8_BAR;
            PG8_LDA8(At, 1, 1); PG8_STAGE(PG8_SA(1, 0), a3, voffA);
            PG8_BAR; PG8_WAIT_L(0); PG8_MMA8(1, 0, At, B0); PG8_BAR; PG8_SCHED;
            PG8_STAGE(PG8_SB(1, 1), b3 + hstep, voffB);
            PG8_WAIT_V(6); PG8_BAR; PG8_MMA8(1, 1, At, B1); PG8_BAR;
            }
        }
        asm volatile("s_nop 15\n\ts_nop 15" ::: "memory");
        if constexpr (ALIGN_EPI) { if (wr == 0) PG8_BAR; }
        if constexpr (!Epi::AFTER_DRAIN) { E(acc, cur, wr, wc, fr, fq); S.done(cur); }
        if (!has_next) break;
#pragma unroll
        for (int a = 0; a < 2; ++a)
#pragma unroll
            for (int b = 0; b < 2; ++b)
#pragma unroll
                for (int m = 0; m < 4; ++m)
#pragma unroll
                    for (int n = 0; n < 2; ++n) acc[a][b][m][n] = (f32x4){0.f, 0.f, 0.f, 0.f};
        cur = nxt; cA = nA; cB = nB; ++ui;
        if constexpr (ALIGN_EPI) { if (wr == 1) PG8_BAR; }
    }
    PG8_WAIT_V(0);
    if constexpr (!ALIGN_EPI) { if (wr == 0) PG8_BAR; }
    PG8_BAR;
    if constexpr (Epi::AFTER_DRAIN) { E.fused(acc, cur, wr, wc, fr, fq, lds, wid, lane); S.done(cur); }
}
#undef PG8_LDA8
#undef PG8_LDB8
#undef PG8_MMA8
#undef PG8_SA
#undef PG8_SB
#undef PG8_STAGE
#undef PG8_LDA
#undef PG8_LDB
#undef PG8_MMA
#undef PG8_WAIT_V
#undef PG8_WAIT_L
#undef PG8_BAR
#undef PG8_SCHED
}
#define GAS __attribute__((address_space(1)))
#define LAS __attribute__((address_space(3)))
typedef unsigned short bf16;
typedef unsigned v4u __attribute__((ext_vector_type(4)));
typedef float f32x4 __attribute__((ext_vector_type(4)));
typedef short bf16x8 __attribute__((ext_vector_type(8)));
typedef GAS unsigned gu32;
typedef GAS unsigned long long gu64;
#define RLX_AGENT __ATOMIC_RELAXED, __HIP_MEMORY_SCOPE_AGENT
#define LDS_WAIT() asm volatile("s_waitcnt lgkmcnt(0)" ::: "memory")
#define VM_WAIT() asm volatile("s_waitcnt vmcnt(0)" ::: "memory")
__device__ __forceinline__ unsigned long long rt() { return __builtin_amdgcn_s_memrealtime(); }
__device__ __forceinline__ unsigned f2bf(float f) { unsigned u = __builtin_bit_cast(unsigned, f); return (u + 0x7fffu + ((u >> 16) & 1u)) >> 16; }
__device__ __forceinline__ unsigned pk2(float lo, float hi) { return f2bf(lo) | (f2bf(hi) << 16); }

#define XB_TMO      128
#define XB_XCNT(j)  (256  + 64 * (j))
#define XB_XSUB(j)  (1280 + 64 * (j))
#define XB_XGEN(j)  (2304 + 64 * (j))
#define XB_TOP      3328
#define XB_TOPGEN   3392
#define XCD_BAR_WORDS 3456
#define XB_SPIN_CAP (1u << 18)

__device__ __forceinline__ unsigned xb_ld(unsigned* p)              { return __hip_atomic_load(p, __ATOMIC_RELAXED, __HIP_MEMORY_SCOPE_AGENT); }
__device__ __forceinline__ unsigned xb_add(unsigned* p, unsigned v) { return __hip_atomic_fetch_add(p, v, __ATOMIC_RELAXED, __HIP_MEMORY_SCOPE_AGENT); }
__device__ __forceinline__ unsigned xb_xcc_id() { return (unsigned)__builtin_amdgcn_s_getreg((3 << 11) | 20) & 0xFu; }
#define XB_SPIN(cond, bar) do { unsigned _sp = 0; while (cond) { __builtin_amdgcn_s_sleep(1); \
    if ((++_sp & 255u) == 0u) { if (xb_ld(&(bar)[XB_TMO])) break; if (_sp > XB_SPIN_CAP) { atomicAdd(&(bar)[XB_TMO], 1u); break; } } } } while (0)

struct XcdBarrier {
    unsigned* bar; unsigned x;
    volatile LAS unsigned* st;
};

__device__ __forceinline__ XcdBarrier xcd_barrier_post(unsigned* bar, volatile LAS unsigned* st) {
    XcdBarrier b; b.bar = bar; b.x = xb_xcc_id(); b.st = st;
    if (threadIdx.x == 0) (void)xb_add(&bar[XB_XCNT(b.x)], 1u);
    return b;
}
__device__ __forceinline__ void xcd_barrier_complete(unsigned* bar, unsigned x, unsigned& nloc, unsigned& nx) {
    const unsigned G = gridDim.x * gridDim.y * gridDim.z;
    unsigned sum, cnt, mine, sp = 0u;
    for (;;) {
        sum = 0u; cnt = 0u; mine = 0u;
#pragma unroll
        for (unsigned j = 0; j < 16; ++j) { const unsigned c = xb_ld(&bar[XB_XCNT(j)]); sum += c; cnt += (c > 0u) ? 1u : 0u; mine = (j == x) ? c : mine; }
        if (sum == G) break;
        __builtin_amdgcn_s_sleep(1);
        if ((++sp & 255u) == 0u) { if (xb_ld(&bar[XB_TMO])) break; if (sp > XB_SPIN_CAP) { atomicAdd(&bar[XB_TMO], 1u); break; } }
    }
    nloc = mine > 0u ? mine : 1u; nx = cnt > 0u ? cnt : 1u;
}

__device__ __forceinline__ void xcd_barrier(const XcdBarrier& b) {
    asm volatile("s_waitcnt vmcnt(0)" ::: "memory");
    __syncthreads();
    if (threadIdx.x == 0) {
        unsigned* bar = b.bar;
        __builtin_amdgcn_s_waitcnt(0);
        unsigned nloc = b.st[0], nx = b.st[1];
        if (nloc == 0u) { xcd_barrier_complete(bar, b.x, nloc, nx); b.st[0] = nloc; b.st[1] = nx; }
        const unsigned old = xb_add(&bar[XB_XSUB(b.x)], 1u);
        const unsigned gen = old / nloc;
        if (old + 1u == (gen + 1u) * nloc) {
            __builtin_amdgcn_fence(__ATOMIC_RELEASE, "agent");
            asm volatile("s_waitcnt vmcnt(0)" ::: "memory");
            const unsigned og = xb_add(&bar[XB_TOP], 1u);
            const unsigned tg = og / nx;
            if (og + 1u == (tg + 1u) * nx) xb_add(&bar[XB_TOPGEN], 1u);
            else XB_SPIN(xb_ld(&bar[XB_TOPGEN]) == tg, bar);
            __builtin_amdgcn_fence(__ATOMIC_ACQUIRE, "agent");
            xb_add(&bar[XB_XGEN(b.x)], 1u);
            asm volatile("s_waitcnt vmcnt(0)" ::: "memory");
        } else {
            XB_SPIN(xb_ld(&bar[XB_XGEN(b.x)]) == gen, bar);
            __builtin_amdgcn_fence(__ATOMIC_ACQUIRE, "agent");
            asm volatile("s_waitcnt vmcnt(0)" ::: "memory");
        }
    }
    __syncthreads();
}
typedef unsigned u32x4 __attribute__((ext_vector_type(4)));

namespace pg8 {
typedef unsigned u32x2 __attribute__((ext_vector_type(2)));
__device__ __forceinline__ float silu_f(float x) { return x * __builtin_amdgcn_rcpf(1.0f + __expf(-x)); }
struct EpiHS {
    static constexpr bool PERM = true, AFTER_DRAIN = false;
    const float* x; const float* meta; bf16_t* hsb;
    __device__ __forceinline__ void operator()(const f32x4 (&acc)[2][2][4][2], const Unit& u, int wr, int wc, int fr, int fq) const {
        const int col0 = u.pn * BM + wc * 32 + 8 * fq;
#pragma unroll
        for (int ai = 0; ai < 2; ++ai) {
            f32x4 rv[4][2][2]; int tt[4];
#pragma unroll
            for (int m = 0; m < 4; ++m) {
                const int r = u.pm * BM + ai * HALF + wr * 64 + m * 16 + fr;
                const int b = r / 8320, p = r - b * 8320, t = p - 112; tt[m] = t;
                const int tc = t < 0 ? 16 : t;
                const float* src = tc < 16 ? meta + (size_t)tc * 1024 : x + ((size_t)b * 8192 + (size_t)(tc - 16)) * 1024;
#pragma unroll
                for (int bj = 0; bj < 2; ++bj) { rv[m][bj][0] = *(const f32x4*)(src + col0 + bj * HALF); rv[m][bj][1] = *(const f32x4*)(src + col0 + bj * HALF + 4); }
            }
#pragma unroll
            for (int m = 0; m < 4; ++m) {
                const int r = u.pm * BM + ai * HALF + wr * 64 + m * 16 + fr;
                if (tt[m] >= 0) {
                    bf16_t* dst = hsb + (size_t)r * 1024;
#pragma unroll
                    for (int bj = 0; bj < 2; ++bj) { const f32x4 v0 = rv[m][bj][0] + acc[ai][bj][m][0], v1 = rv[m][bj][1] + acc[ai][bj][m][1]; u32x4 w;
                        w.x = cvt_pk_bf16(v0[0], v0[1]); w.y = cvt_pk_bf16(v0[2], v0[3]); w.z = cvt_pk_bf16(v1[0], v1[1]); w.w = cvt_pk_bf16(v1[2], v1[3]);
                        *(u32x4*)(dst + col0 + bj * HALF) = w; }
                }
            }
        }
    }
};
struct EpiAct {
    static constexpr bool PERM = true, AFTER_DRAIN = false;
    bf16_t* act;
    __device__ __forceinline__ void operator()(const f32x4 (&acc)[2][2][4][2], const Unit& u, int wr, int wc, int fr, int fq) const {
        const int row0 = u.pm * BM + wr * 64 + fr; const int j = u.pn & 7; const int col0 = j * 128 + wc * 32 + 8 * fq;
#pragma unroll
        for (int ai = 0; ai < 2; ++ai)
#pragma unroll
            for (int m = 0; m < 4; ++m) {
                unsigned char* rowp = (unsigned char*)act + (size_t)(row0 + ai * HALF + m * 16) * 1024 + col0;
                const f32x4 g0 = acc[ai][0][m][0] * 0.03125f, g1 = acc[ai][0][m][1] * 0.03125f, u0 = acc[ai][1][m][0] * 0.03125f, u1 = acc[ai][1][m][1] * 0.03125f;
                u32x2 w; unsigned t = 0u;
                t = __builtin_amdgcn_cvt_pk_fp8_f32(silu_f(g0[0]) * u0[0], silu_f(g0[1]) * u0[1], t, false); t = __builtin_amdgcn_cvt_pk_fp8_f32(silu_f(g0[2]) * u0[2], silu_f(g0[3]) * u0[3], t, true); w.x = t;
                t = __builtin_amdgcn_cvt_pk_fp8_f32(silu_f(g1[0]) * u1[0], silu_f(g1[1]) * u1[1], t, false); t = __builtin_amdgcn_cvt_pk_fp8_f32(silu_f(g1[2]) * u1[2], silu_f(g1[3]) * u1[3], t, true); w.y = t;
                *(u32x2*)rowp = w;
            }
    }
};
struct EpiYS {
    static constexpr bool PERM = true, AFTER_DRAIN = false;
    unsigned char* ys; const float* gate;
    __device__ __forceinline__ void operator()(const f32x4 (&acc)[2][2][4][2], const Unit& u, int wr, int wc, int fr, int fq) const {
        const int row0 = u.pm * BM + wr * 64 + fr; const int j = u.pn & 3; const int col0 = j * 256 + wc * 32 + 8 * fq;
#pragma unroll
        for (int ai = 0; ai < 2; ++ai)
#pragma unroll
            for (int m = 0; m < 4; ++m) {
                const int row = row0 + ai * HALF + m * 16; const float gv = gate[row] * 0.25f;
                unsigned char* rowp = ys + (size_t)row * 1024 + col0;
#pragma unroll
                for (int bj = 0; bj < 2; ++bj) { const f32x4 v0 = acc[ai][bj][m][0] * gv, v1 = acc[ai][bj][m][1] * gv; u32x2 w; unsigned t = 0u;
                    t = __builtin_amdgcn_cvt_pk_fp8_f32(v0[0], v0[1], t, false); t = __builtin_amdgcn_cvt_pk_fp8_f32(v0[2], v0[3], t, true); w.x = t;
                    t = __builtin_amdgcn_cvt_pk_fp8_f32(v1[0], v1[1], t, false); t = __builtin_amdgcn_cvt_pk_fp8_f32(v1[2], v1[3], t, true); w.y = t;
                    *(u32x2*)(rowp + bj * HALF) = w; }
            }
    }
};

struct EpiZ {
    static constexpr bool PERM = true, AFTER_DRAIN = false;
    bf16_t* Z; const float* cs;
    __device__ __forceinline__ void operator()(const f32x4 (&acc)[2][2][4][2], const Unit& u, int wr, int wc, int fr, int fq) const {
        const int row0 = u.pm * BM + wr * 64 + fr;
        if (u.pn < 4 || u.pn >= 8) {
            const int col0 = u.pn * BM + wc * 32 + 8 * fq;
#pragma unroll
            for (int ai = 0; ai < 2; ++ai)
#pragma unroll
                for (int m = 0; m < 4; ++m) { bf16_t* rowp = Z + (size_t)(row0 + ai * HALF + m * 16) * 3072 + col0;
#pragma unroll
                    for (int bj = 0; bj < 2; ++bj) { const f32x4 v0 = acc[ai][bj][m][0], v1 = acc[ai][bj][m][1]; u32x4 w;
                        w.x = cvt_pk_bf16(v0[0], v0[1]); w.y = cvt_pk_bf16(v0[2], v0[3]); w.z = cvt_pk_bf16(v1[0], v1[1]); w.w = cvt_pk_bf16(v1[2], v1[3]);
                        *(u32x4*)(rowp + bj * HALF) = w; } }
        } else {
            const int x0 = wc * 32 + 8 * fq;
            const int region = (u.pn - 4) >> 1, head = 2 * ((u.pn - 4) & 1) + (x0 >> 6), j0 = x0 & 63;
            const int colA = 1024 + region * 512 + head * 128 + j0;
            const float sc = region == 0 ? 0.08838834764831845f : 1.0f;
#pragma unroll
            for (int ai = 0; ai < 2; ++ai) {
                f32x4 cc[4][4];
#pragma unroll
                for (int m = 0; m < 4; ++m) { const int r = row0 + ai * HALF + m * 16; const int b = r / 8320; int t = r - b * 8320 - 112; t = t < 0 ? 0 : t;
                    const f32x4* cp = (const f32x4*)(cs + ((size_t)t * 64 + j0) * 2); cc[m][0] = cp[0]; cc[m][1] = cp[1]; cc[m][2] = cp[2]; cc[m][3] = cp[3]; }
#pragma unroll
                for (int m = 0; m < 4; ++m) {
                    const int r = row0 + ai * HALF + m * 16;
                    const f32x4 c0 = cc[m][0], c1 = cc[m][1], c2 = cc[m][2], c3 = cc[m][3];
                    const f32x4 a0 = acc[ai][0][m][0], a1 = acc[ai][0][m][1], b0 = acc[ai][1][m][0], b1 = acc[ai][1][m][1];
                    u32x4 w1, w2;
                    w1.x = cvt_pk_bf16((a0[0] * c0[0] - b0[0] * c0[1]) * sc, (a0[1] * c0[2] - b0[1] * c0[3]) * sc); w2.x = cvt_pk_bf16((a0[0] * c0[1] + b0[0] * c0[0]) * sc, (a0[1] * c0[3] + b0[1] * c0[2]) * sc);
                    w1.y = cvt_pk_bf16((a0[2] * c1[0] - b0[2] * c1[1]) * sc, (a0[3] * c1[2] - b0[3] * c1[3]) * sc); w2.y = cvt_pk_bf16((a0[2] * c1[1] + b0[2] * c1[0]) * sc, (a0[3] * c1[3] + b0[3] * c1[2]) * sc);
                    w1.z = cvt_pk_bf16((a1[0] * c2[0] - b1[0] * c2[1]) * sc, (a1[1] * c2[2] - b1[1] * c2[3]) * sc); w2.z = cvt_pk_bf16((a1[0] * c2[1] + b1[0] * c2[0]) * sc, (a1[1] * c2[3] + b1[1] * c2[2]) * sc);
                    w1.w = cvt_pk_bf16((a1[2] * c3[0] - b1[2] * c3[1]) * sc, (a1[3] * c3[2] - b1[3] * c3[3]) * sc); w2.w = cvt_pk_bf16((a1[2] * c3[1] + b1[2] * c3[0]) * sc, (a1[3] * c3[3] + b1[3] * c3[2]) * sc);
                    bf16_t* rowp = Z + (size_t)r * 3072 + colA;
                    *(u32x4*)rowp = w1; *(u32x4*)(rowp + 64) = w2;
                }
            }
        }
    }
};
struct GroupOrder {
    int G, vcu, tm, tn, nwg;
    __device__ __forceinline__ void init(int ne, int tm_, int tn_, int G_, int c) { tm = tm_; tn = tn_; nwg = ne * tm_ * tn_; G = G_; vcu = (G_ % 8 == 0) ? (c % 8) * (G_ / 8) + c / 8 : c; }
    __device__ __forceinline__ bool next(int i, Unit& u) const {
        const long L = (long)i * G + vcu; if (L >= nwg) return false;
        const int per = tm * tn, e = (int)(L / per), rem = (int)(L % per);
        u.pm = e * tm + rem / tn; u.pn = e * tn + rem % tn; return true;
    }
    __device__ __forceinline__ void a_ready(const Unit&) const {}
    __device__ __forceinline__ void done(const Unit&) const {}
};
}

constexpr int NB = 8, SEQ = 8192, DM = 1024, NMETA = 16, TT = SEQ + NMETA, PADL = 112, PP = 8320, NP = NB * PP;
constexpr int NCHUNK = 65, NSEG = 130;
constexpr int ZC = 3072, ZC_LX = 0, ZC_LG = 512, ZC_Q = 1024, ZC_K = 1536, ZC_V = 2048, ZC_G = 2560;
constexpr int NE = 16, CAP = 1026, EROWS = 8448, NROWS = NE * EROWS;
constexpr float EPSN = 1e-6f;
constexpr int NPHASE = 12;

constexpr size_t MiB = 1u << 20;
constexpr size_t WS_CTL = 0, CTL_ZERO_BYTES = 64 * 1024;
constexpr size_t WS_GW = 1 * MiB, WS_GW2 = 1 * MiB + 256 * 1024, WS_HSMETA = 1 * MiB + 512 * 1024;
constexpr size_t WS_CS = 3 * MiB, WS_SUMM = 8 * MiB, WS_CARRY = 17 * MiB, WS_AFF = 22 * MiB, WS_ROWMAP = 27 * MiB, WS_IDX = 32 * MiB, WS_GATE = 33 * MiB;
constexpr size_t WS_WIN = 34 * MiB, WS_WOUT = 40 * MiB, WS_WGU = 42 * MiB, WS_WD = 106 * MiB;
#ifndef ST_INPLACE
#define ST2_BASE WS_ST2
#define CPY_BASE WS_ST
#else
#define ST2_BASE WS_ST
#define CPY_BASE WS_ST2
#endif
constexpr size_t WS_ST2 = 788 * MiB;
constexpr size_t WS_HSB = 400 * MiB;
constexpr size_t WS_H = 138 * MiB, WS_Z = 268 * MiB, WS_ST = 658 * MiB, WS_XS = 658 * MiB, WS_ACT = 268 * MiB, WS_YS = WS_XS, WS_END = 922 * MiB;
static_assert(WS_H + (size_t)NP * 2048 <= WS_Z && WS_Z + (size_t)NP * ZC * 2 <= WS_ST && WS_ST + (size_t)NB * 4 * 2 * NCHUNK * 32768 <= WS_END && WS_XS + (size_t)NROWS * 2048 <= WS_END && WS_ACT + (size_t)NROWS * 2048 <= WS_ST, "ws map");
constexpr int CW_BAR = 1024;

constexpr int LDS_MAIN = 131072, LDS_BYTES = 147456;
constexpr int LDS_SS = LDS_MAIN;
constexpr int LDS_MISC = LDS_MAIN + 4096;
constexpr int LDS_SIDE = LDS_MAIN + 8192;

typedef unsigned short u16x8 __attribute__((ext_vector_type(8)));
typedef unsigned short u16x4 __attribute__((ext_vector_type(4)));
typedef float f32x16 __attribute__((ext_vector_type(16)));
typedef float f32x2 __attribute__((ext_vector_type(2)));
typedef unsigned u32x2 __attribute__((ext_vector_type(2)));
typedef short v4i16_t __attribute__((ext_vector_type(4)));
typedef __bf16 bf16x2_t __attribute__((ext_vector_type(2)));

__device__ __forceinline__ float bf2f(unsigned short v) { return __uint_as_float((unsigned)v << 16); }
__device__ __forceinline__ unsigned cvtpk(float lo, float hi) { f32x2 v = {lo, hi}; bf16x2_t b = __builtin_convertvector(v, bf16x2_t); return __builtin_bit_cast(unsigned, b); }
__device__ __forceinline__ unsigned short f2bf16(float f) { return (unsigned short)(cvtpk(f, 0.f) & 0xffffu); }
__device__ __forceinline__ float wave_sum(float v) {
#pragma unroll
    for (int o = 1; o < 64; o <<= 1) v += __shfl_xor(v, o);
    return v;
}
__device__ __forceinline__ float sigmoid_f(float x) { return __builtin_amdgcn_rcpf(1.0f + __expf(-x)); }
__device__ __forceinline__ float gelu_tanh_f(float x) { const float z2 = 2.302208198144325f * x * (1.0f + 0.044715f * x * x);   return x - x * __builtin_amdgcn_rcpf(1.0f + __builtin_amdgcn_exp2f(z2)); }
__device__ __forceinline__ float softplus_neg(float lam) { const float y = __expf(-lam); return (y < 0.05f) ? y * (1.0f + y * (-0.5f + y * (0.33333333f + y * (-0.25f + y * 0.2f)))) : log1pf(y); }
__device__ __forceinline__ float log2_gamma(int h) { return h == 0 ? -0.04580368961312479f : h == 1 ? -0.02272007650008353f : h == 2 ? -0.011315313227834146f : -0.005646563141142063f; }
__device__ __forceinline__ unsigned off_b(unsigned row, unsigned ch) { return 256u * row + 16u * (ch ^ (((row & 3u) << 2) | ((row >> 2) & 3u))); }
__device__ __forceinline__ pg8::bf16x8 rowfrag(LAS unsigned char* T, int rb, int s, int lane) {
    return *(LAS pg8::bf16x8*)(T + off_b(32 * rb + (lane & 31), 2 * s + (lane >> 5)));
}
__device__ __forceinline__ pg8::bf16x8 rowfrag_x(LAS unsigned char* T, int rb, int s, int lane) {
    return *(LAS pg8::bf16x8*)(T + off_b((32 * rb + (lane & 31)) ^ 1, 2 * s + (lane >> 5)));
}
__device__ __forceinline__ v4i16_t tr_rd(LAS unsigned char* p) { return __builtin_amdgcn_ds_read_tr16_b64_v4i16((LAS v4i16_t*)p); }
__device__ __forceinline__ pg8::bf16x8 trfrag(LAS unsigned char* T, int c, int ks, int lane) {
    const unsigned h = lane >> 5, blk = (lane >> 4) & 1, q = (lane & 15) >> 2, p = lane & 3;
    const v4i16_t lo = tr_rd(T + off_b(16 * ks + 8 * h + q, 4 * c + 2 * blk + (p >> 1)) + 8 * (p & 1));
    const v4i16_t hi = tr_rd(T + off_b(16 * ks + 8 * h + 4 + q, 4 * c + 2 * blk + (p >> 1)) + 8 * (p & 1));
    return (pg8::bf16x8){lo[0], lo[1], lo[2], lo[3], hi[0], hi[1], hi[2], hi[3]};
}
__device__ __forceinline__ pg8::bf16x8 trfrag_perm(LAS unsigned char* T, int c, int rbase, int lane) {
    const unsigned h = lane >> 5, blk = (lane >> 4) & 1, q = (lane & 15) >> 2, p = lane & 3;
    const v4i16_t lo = tr_rd(T + off_b(rbase + 4 * h + q, 4 * c + 2 * blk + (p >> 1)) + 8 * (p & 1));
    const v4i16_t hi = tr_rd(T + off_b(rbase + 8 + 4 * h + q, 4 * c + 2 * blk + (p >> 1)) + 8 * (p & 1));
    return (pg8::bf16x8){lo[0], lo[1], lo[2], lo[3], hi[0], hi[1], hi[2], hi[3]};
}
__device__ __forceinline__ int crow(int reg, int h) { return (reg & 3) + 8 * (reg >> 2) + 4 * h; }
#define MFMA32(a, b, c) __builtin_amdgcn_mfma_f32_32x32x16_bf16((a), (b), (c), 0, 0, 0)
#define MFMA16(a, b, c) __builtin_amdgcn_mfma_f32_16x16x32_bf16((a), (b), (c), 0, 0, 0)

struct Fr {
    LAS unsigned char* lds;
    int tid, lane, wave, G;
    const float *x, *meta, *norm1_g, *w_in, *conv_w, *conv_b, *w_r, *b_r, *w_i, *b_i, *lam, *lru_out_g, *ret_out_g, *w_out, *norm2_g, *w_router, *w_gate, *w_up, *w_down, *final_g;
    float* out;
    unsigned short *GW2; unsigned short *GW, *WIN, *WOUT, *WGU, *WD, *H, *Z, *ST, *XS, *ACT, *YS;
    unsigned char* CTLP; float *HSMETA, *AFF, *GATE, *CARRY; unsigned short* HSB; unsigned short* ST2; f32x2 *CS, *SUMM; int *ROWMAP, *IDX;
};

__device__ __forceinline__ void prep_tile(const Fr& F, const float* W, int ldw, int k0, int n0, unsigned short* WT, int mode) {
    LAS float* scr = (LAS float*)F.lds;
    const int tid = F.tid;
    { const int n = tid & 63, kk = tid >> 6;
#pragma unroll
      for (int i = 0; i < 8; ++i) { const int k = kk + 8 * i; scr[k * 65 + n] = W[(size_t)(k0 + k) * ldw + n0 + n]; } }
    __syncthreads();
    { const int k = tid & 63, nn = tid >> 6;
#pragma unroll
      for (int i = 0; i < 8; ++i) { const int n = n0 + nn + 8 * i; int row;
          if (mode == 0) row = n; else if (mode == 3) { if (n < 1024 || n >= 2048) row = n; else { const int q = n - 1024, region = q >> 9, hd = (q >> 7) & 3, d = q & 127; row = 1024 + region * 512 + (hd >> 1) * 256 + (d >> 6) * 128 + (hd & 1) * 64 + (d & 63); } }
          else row = 256 * (n >> 7) + (n & 127) + (mode == 2 ? 128 : 0);
          WT[(size_t)row * 1024 + k0 + k] = f2bf16(scr[k * 65 + (nn + 8 * i)]); } }
    __syncthreads();
}
__device__ __forceinline__ void prep_tile8(const Fr& F, const float* W, int k0, int n0, unsigned char* WT8, int mode) {
    LAS float* scr = (LAS float*)F.lds;
    const int tid = F.tid;
    { const int n = tid & 63, kk = tid >> 6;
#pragma unroll
      for (int i = 0; i < 8; ++i) { const int k = kk + 8 * i; scr[k * 65 + n] = W[(size_t)(k0 + k) * 1024 + n0 + n]; } }
    __syncthreads();
    { const int k4 = tid & 15, nn = tid >> 4;
#pragma unroll
      for (int i = 0; i < 2; ++i) { const int nl = nn + 32 * i, n = n0 + nl; const int row = mode == 0 ? n : 256 * (n >> 7) + (n & 127) + (mode == 2 ? 128 : 0);
          const float a = scr[(4 * k4 + 0) * 65 + nl] * 32.0f, b = scr[(4 * k4 + 1) * 65 + nl] * 32.0f, c = scr[(4 * k4 + 2) * 65 + nl] * 32.0f, d = scr[(4 * k4 + 3) * 65 + nl] * 32.0f;
          unsigned w = 0u; w = __builtin_amdgcn_cvt_pk_fp8_f32(a, b, w, false); w = __builtin_amdgcn_cvt_pk_fp8_f32(c, d, w, true);
          *(unsigned*)(WT8 + (size_t)row * 1024 + k0 + 4 * k4) = w; } }
    __syncthreads();
}
__device__ __forceinline__ void sincos_tab(int t, int j, float& co, float& si) {
    double f = 1.0, bse = 0.8659643233600653;
    int e = j;
#pragma unroll
    for (int i = 0; i < 6; ++i) { if (e & 1) f *= bse; bse *= bse; e >>= 1; }
    const double xx = (double)t * f;
    const double qd = __builtin_rint(xx * 0.6366197723675814);
    double y = __builtin_fma(-qd, 1.5707963267948966, xx); y = __builtin_fma(-qd, 6.123233995736766e-17, y);
    const double y2 = y * y;
    double sp = -7.647163731819816e-13;
    sp = sp * y2 + 1.6059043836821613e-10;
    sp = sp * y2 - 2.505210838544172e-08;
    sp = sp * y2 + 2.7557319223985893e-06;
    sp = sp * y2 - 1.984126984126984e-04;
    sp = sp * y2 + 8.333333333333333e-03;
    sp = sp * y2 - 1.6666666666666666e-01;
    const double sy = y + y * y2 * sp;
    double cp = 4.779477332387385e-14;
    cp = cp * y2 - 1.1470745597729725e-11;
    cp = cp * y2 + 2.08767569878681e-09;
    cp = cp * y2 - 2.755731922398589e-07;
    cp = cp * y2 + 2.48015873015873e-05;
    cp = cp * y2 - 1.388888888888889e-03;
    cp = cp * y2 + 4.1666666666666664e-02;
    cp = cp * y2 - 0.5;
    const double cy = 1.0 + y2 * cp;
    const int qi = ((int)(long long)qd) & 3;
    const double s_ = (qi == 0) ? sy : (qi == 1) ? cy : (qi == 2) ? -sy : -cy;
    const double c_ = (qi == 0) ? cy : (qi == 1) ? -sy : (qi == 2) ? -cy : sy;
    co = (float)c_; si = (float)s_;
}
__device__ __forceinline__ void rms_row_to_bf16(const float* xrow, const float* g, unsigned short* orow, int lane) {
    const f32x4* xr = (const f32x4*)xrow + lane; const f32x4* gr = (const f32x4*)g + lane;
    f32x4 v[4]; float s = 0.f;
#pragma unroll
    for (int j = 0; j < 4; ++j) { v[j] = xr[64 * j]; s += (v[j].x * v[j].x + v[j].y * v[j].y) + (v[j].z * v[j].z + v[j].w * v[j].w); }
    const float rs = 1.0f / sqrtf(wave_sum(s) * (1.0f / 1024.0f) + EPSN);
    u32x2* o8 = (u32x2*)orow + lane;
#pragma unroll
    for (int j = 0; j < 4; ++j) { const f32x4 gg = gr[64 * j]; u32x2 w; w.x = cvtpk(v[j].x * rs * gg.x, v[j].y * rs * gg.y); w.y = cvtpk(v[j].z * rs * gg.z, v[j].w * rs * gg.w); o8[64 * j] = w; }
}
__device__ __forceinline__ void prep_stream8(const Fr& F, const float* Wall, unsigned char* WT8all, size_t estride, int mode, int vb, int VG) {
    LAS float* scr = (LAS float*)F.lds;
    const int tid = F.tid, n_ = tid & 63, kk = tid >> 6, k4 = tid & 15, nn = tid >> 4;
    int t = vb; if (t < 0 || t >= 4096) return;
    float v[8];
    { const int e = t >> 8, r = t & 255, k0 = 64 * (r >> 4), n0 = 64 * (r & 15); const float* W = Wall + (size_t)e * 1048576;
#pragma unroll
      for (int i = 0; i < 8; ++i) v[i] = W[(size_t)(k0 + kk + 8 * i) * 1024 + n0 + n_]; }
    for (; t < 4096; t += VG) {
        const int e = t >> 8, r = t & 255, k0 = 64 * (r >> 4), n0 = 64 * (r & 15);
        float vn[8];
        { const int t2 = t + VG < 4096 ? t + VG : t; const int e2 = t2 >> 8, r2 = t2 & 255, k2 = 64 * (r2 >> 4), n2 = 64 * (r2 & 15); const float* W = Wall + (size_t)e2 * 1048576;
#pragma unroll
          for (int i = 0; i < 8; ++i) vn[i] = W[(size_t)(k2 + kk + 8 * i) * 1024 + n2 + n_]; }
#pragma unroll
        for (int i = 0; i < 8; ++i) scr[(kk + 8 * i) * 65 + n_] = v[i];
        __syncthreads();
        unsigned char* WT8 = WT8all + (size_t)e * estride;
#pragma unroll
        for (int i = 0; i < 2; ++i) { const int nl = nn + 32 * i, n = n0 + nl; const int row = mode == 0 ? n : 256 * (n >> 7) + (n & 127) + (mode == 2 ? 128 : 0);
            const float a = scr[(4 * k4 + 0) * 65 + nl] * 32.0f, b = scr[(4 * k4 + 1) * 65 + nl] * 32.0f, c = scr[(4 * k4 + 2) * 65 + nl] * 32.0f, d = scr[(4 * k4 + 3) * 65 + nl] * 32.0f;
            unsigned w = 0u; w = __builtin_amdgcn_cvt_pk_fp8_f32(a, b, w, false); w = __builtin_amdgcn_cvt_pk_fp8_f32(c, d, w, true);
            *(unsigned*)(WT8 + (size_t)row * 1024 + k0 + 4 * k4) = w; }
        __syncthreads();
#pragma unroll
        for (int i = 0; i < 8; ++i) v[i] = vn[i];
    }
}
__device__ __forceinline__ void ph_prep(const Fr& F) {
    const int bid = blockIdx.x, G = F.G;
    for (int it = bid; it < 1024; it += G) {
        if (it < 768) { const int kt = it / 48, nt = it % 48; prep_tile(F, F.w_in, 3072, 64 * kt, 64 * nt, F.WIN, 3); }
        else { const int i2 = it - 768, kt = i2 / 16, nt = i2 % 16; prep_tile(F, F.w_out, 1024, 64 * kt, 64 * nt, F.WOUT, 0); }
    }
    const int gt = bid * 512 + F.tid, GT = G * 512;
    for (int idx = gt; idx < 8 * 256 * 64; idx += GT) {
        const int blk = idx >> 14, o = (idx >> 6) & 255, k = idx & 63, g = o >> 6, d = o & 63, dir = g >> 1;
        const float* src = (g & 1) ? F.w_i : F.w_r;
        F.GW[idx] = f2bf16(src[((size_t)(dir * 8 + blk) * 64 + k) * 64 + d]);
    }
    for (int idx = gt; idx < 8 * 256 * 64; idx += GT) {
        const int k = idx & 63, fr = (idx >> 6) & 15, cg = (idx >> 10) & 3, g = (idx >> 12) & 3, blk = idx >> 14;
        const float* src = (g & 1) ? F.w_i : F.w_r;
        F.GW2[idx] = f2bf16(src[((size_t)((g >> 1) * 8 + blk) * 64 + k) * 64 + 16 * cg + fr]);
    }
    for (int idx = gt; idx < TT * 64; idx += GT) { float co, si; sincos_tab(idx >> 6, idx & 63, co, si); F.CS[idx] = (f32x2){co, si}; }
    const int gw = bid * 8 + F.wave, NGW = G * 8; const int lane = F.lane;
    for (int r = gw; r < NB * PADL; r += NGW) { const int b = r / PADL, p = r - b * PADL; u32x2* o8 = (u32x2*)(F.H + (size_t)(b * PP + p) * 1024) + lane;
#pragma unroll
        for (int j = 0; j < 4; ++j) o8[64 * j] = (u32x2){0u, 0u}; }
    f32x4 gg[4];
#pragma unroll
    for (int j = 0; j < 4; ++j) gg[j] = ((const f32x4*)F.norm1_g + lane)[64 * j];
    f32x4 nx[2][4];
    const int NPAIR = NB * TT / 2;
    if (gw < NPAIR) {
#pragma unroll
        for (int q = 0; q < 2; ++q) { const int v = 2 * gw + q, b = v / TT, t = v - b * TT; const f32x4* xr = (const f32x4*)(t < NMETA ? F.meta + (size_t)t * 1024 : F.x + ((size_t)b * SEQ + (t - NMETA)) * 1024) + lane;
#pragma unroll
            for (int j = 0; j < 4; ++j) nx[q][j] = xr[64 * j]; }
    }
    for (int pr = gw; pr < NPAIR; pr += NGW) {
        f32x4 vv[2][4];
#pragma unroll
        for (int q = 0; q < 2; ++q)
#pragma unroll
            for (int j = 0; j < 4; ++j) vv[q][j] = nx[q][j];
        { const int pn = pr + NGW < NPAIR ? pr + NGW : pr;
#pragma unroll
          for (int q = 0; q < 2; ++q) { const int v = 2 * pn + q, b = v / TT, t = v - b * TT; const f32x4* xr = (const f32x4*)(t < NMETA ? F.meta + (size_t)t * 1024 : F.x + ((size_t)b * SEQ + (t - NMETA)) * 1024) + lane;
#pragma unroll
              for (int j = 0; j < 4; ++j) nx[q][j] = xr[64 * j]; } }
#pragma unroll
        for (int q = 0; q < 2; ++q) {
            const int v = 2 * pr + q, b = v / TT, t = v - b * TT;
            float s = 0.f;
#pragma unroll
            for (int j = 0; j < 4; ++j) s += (vv[q][j].x * vv[q][j].x + vv[q][j].y * vv[q][j].y) + (vv[q][j].z * vv[q][j].z + vv[q][j].w * vv[q][j].w);
            const float rs = __builtin_amdgcn_rsqf(wave_sum(s) * (1.0f / 1024.0f) + EPSN);
            u32x2* o8 = (u32x2*)(F.H + (size_t)(b * PP + PADL + t) * 1024) + lane;
#pragma unroll
            for (int j = 0; j < 4; ++j) { u32x2 wv; wv.x = cvtpk(vv[q][j].x * rs * gg[j].x, vv[q][j].y * rs * gg[j].y); wv.y = cvtpk(vv[q][j].z * rs * gg[j].z, vv[q][j].w * rs * gg[j].w); o8[64 * j] = wv; }
        }
    }
}

struct LruIn { float xv[11]; float gate[8]; float cw0, cw1, cw2, cw3, cbv, k0, k1, br0, bi0, br1, bi1, cf, cb; pg8::bf16x8 bfr[2][2]; };
template <bool FINAL>
__device__ __forceinline__ void lru_load(const Fr& F, size_t rowbase, int pw, int c, size_t sidx, const unsigned short* gwp, LruIn& L) {
#pragma unroll
    for (int i = 0; i < 11; ++i) { const int p = pw - 2 + i; const int pc = p < 0 ? 0 : (p >= PP ? PP - 1 : p); const float v = bf2f(F.Z[(rowbase + pc) * ZC + ZC_LX + c]); L.xv[i] = (p == pc) ? v : 0.f; }
    if (FINAL) {
#pragma unroll
        for (int j = 0; j < 8; ++j) L.gate[j] = bf2f(F.Z[(rowbase + pw + j) * ZC + ZC_LG + c]);
    }
    L.cw0 = F.conv_w[c]; L.cw1 = F.conv_w[512 + c]; L.cw2 = F.conv_w[1024 + c]; L.cw3 = F.conv_w[1536 + c]; L.cbv = F.conv_b[c];
    L.k0 = F.lam[c]; L.k1 = F.lam[512 + c];
    L.br0 = F.b_r[c]; L.bi0 = F.b_i[c]; L.br1 = F.b_r[512 + c]; L.bi1 = F.b_i[512 + c];
    if (FINAL) { L.cf = F.CARRY[sidx]; L.cb = F.CARRY[sidx + 512]; }
#pragma unroll
    for (int ks = 0; ks < 2; ++ks)
#pragma unroll
        for (int n = 0; n < 2; ++n) L.bfr[ks][n] = *(const pg8::bf16x8*)(gwp + (size_t)(16 * n) * 64 + 32 * ks);
}
template <bool FINAL>
__device__ __forceinline__ void lru_item(const Fr& F, int b, int s) {
    int lane = F.lane; asm volatile("" : "+v"(lane));
    const int w = F.wave, fr = lane & 15, fq = lane >> 4;
    LAS unsigned short* U0 = (LAS unsigned short*)F.lds;
    LAS unsigned char* G16 = F.lds + 18432;
    LAS float* SM = (LAS float*)(F.lds + 18432 + 36864);
    LAS unsigned short* YL = (LAS unsigned short*)(F.lds + 18432 + 36864 + 8192);
    const int pw = s * 64 + 8 * w; const size_t rowbase = (size_t)b * PP;
    constexpr float LOG2E = 1.4426950408889634f;
    float ssq[8];
#pragma unroll
    for (int j = 0; j < 8; ++j) ssq[j] = 0.f;
    const size_t sbase = ((size_t)(b * NSEG + s) * 2) * 512;
    const unsigned short* gw0 = F.GW + (size_t)(32 * w + fr) * 64 + 8 * fq;
    LruIn L; lru_load<FINAL>(F, rowbase, pw, lane, sbase + lane, gw0, L);
    float u[8];
#pragma unroll
    for (int j = 0; j < 8; ++j) { u[j] = L.cbv + L.cw0 * L.xv[j] + L.cw1 * L.xv[j + 1] + L.cw2 * L.xv[j + 2] + L.cw3 * L.xv[j + 3]; U0[(8 * w + j) * 72 + lane] = f2bf16(u[j]); }
    __syncthreads();
    for (int blk = 0; blk < 8; ++blk) {
        const int c = blk * 64 + lane;
        LAS unsigned short* U = U0 + (blk & 1) * 4608; LAS unsigned short* Un = U0 + ((blk & 1) ^ 1) * 4608;
        LruIn N; { const int bn = (blk < 7 ? blk + 1 : 7), cn = bn * 64 + lane; lru_load<FINAL>(F, rowbase, pw, cn, sbase + cn, gw0 + (size_t)bn * 16384, N); }
        pg8::f32x4 acc[4][2];
#pragma unroll
        for (int m = 0; m < 4; ++m) { acc[m][0] = (pg8::f32x4){0.f, 0.f, 0.f, 0.f}; acc[m][1] = acc[m][0]; }
#pragma unroll
        for (int ks = 0; ks < 2; ++ks) {
#pragma unroll
            for (int m = 0; m < 4; ++m) { const pg8::bf16x8 a = *(LAS pg8::bf16x8*)(U + (16 * m + fr) * 72 + 32 * ks + 8 * fq);
#pragma unroll
                for (int n = 0; n < 2; ++n) acc[m][n] = MFMA16(a, L.bfr[ks][n], acc[m][n]); }
        }
#pragma unroll
        for (int m = 0; m < 4; ++m)
#pragma unroll
            for (int n = 0; n < 2; ++n) { u32x2 pk; pk.x = __builtin_bit_cast(unsigned, __builtin_amdgcn_cvt_pkrtz(acc[m][n][0], acc[m][n][1])); pk.y = __builtin_bit_cast(unsigned, __builtin_amdgcn_cvt_pkrtz(acc[m][n][2], acc[m][n][3]));
                *(LAS u32x2*)(G16 + (32 * w + 16 * n + fr) * 144 + (16 * m + 4 * fq) * 2) = pk; }
        __syncthreads();
        const float kk0 = -8.0f * LOG2E * softplus_neg(L.k0), kk1 = -8.0f * LOG2E * softplus_neg(L.k1);
        const float nb_r0 = -LOG2E * L.br0, nb_i0 = -LOG2E * L.bi0, nb_r1 = -LOG2E * L.br1, nb_i1 = -LOG2E * L.bi1;
        typedef _Float16 h16x8 __attribute__((ext_vector_type(8)));
        const h16x8 g0 = *(LAS h16x8*)(G16 + (0 * 64 + lane) * 144 + 16 * w), g1 = *(LAS h16x8*)(G16 + (1 * 64 + lane) * 144 + 16 * w);
        const h16x8 g2 = *(LAS h16x8*)(G16 + (2 * 64 + lane) * 144 + 16 * w), g3 = *(LAS h16x8*)(G16 + (3 * 64 + lane) * 144 + 16 * w);
        float hf[8], pf[8], hb[8], pb[8], af[8], ab[8];
#pragma unroll
        for (int j = 0; j < 8; ++j) {
            const float r0 = __builtin_amdgcn_rcpf(1.0f + __builtin_amdgcn_exp2f(__builtin_fmaf((float)g0[j], -LOG2E, nb_r0))), i0 = __builtin_amdgcn_rcpf(1.0f + __builtin_amdgcn_exp2f(__builtin_fmaf((float)g1[j], -LOG2E, nb_i0)));
            const float r1 = __builtin_amdgcn_rcpf(1.0f + __builtin_amdgcn_exp2f(__builtin_fmaf((float)g2[j], -LOG2E, nb_r1))), i1 = __builtin_amdgcn_rcpf(1.0f + __builtin_amdgcn_exp2f(__builtin_fmaf((float)g3[j], -LOG2E, nb_i1)));
            const float a0 = __builtin_amdgcn_exp2f(kk0 * r0), a1 = __builtin_amdgcn_exp2f(kk1 * r1);
            const float e0 = fmaxf(__builtin_fmaf(-a0, a0, 1.0f), 0.f), e1 = fmaxf(__builtin_fmaf(-a1, a1, 1.0f), 0.f);
            af[j] = a0; ab[j] = a1;
            hf[j] = __builtin_amdgcn_sqrtf(e0) * i0 * u[j]; hb[j] = __builtin_amdgcn_sqrtf(e1) * i1 * u[j];
        }
        if (s < 2) {
#pragma unroll
            for (int j = 0; j < 8; ++j) { const bool padp = (pw + j) < PADL; af[j] = padp ? 1.0f : af[j]; ab[j] = padp ? 1.0f : ab[j]; hf[j] = padp ? 0.0f : hf[j]; hb[j] = padp ? 0.0f : hb[j]; }
        }
        { float h = 0.f, P = 1.f;
#pragma unroll
          for (int j = 0; j < 8; ++j) { h = af[j] * h + hf[j]; hf[j] = h; P *= af[j]; pf[j] = P; } }
        { float h = 0.f, P = 1.f;
#pragma unroll
          for (int j = 7; j >= 0; --j) { h = ab[j] * h + hb[j]; hb[j] = h; P *= ab[j]; pb[j] = P; } }
        SM[((0 * 8 + w) * 2 + 0) * 64 + lane] = pf[7]; SM[((0 * 8 + w) * 2 + 1) * 64 + lane] = hf[7];
        SM[((1 * 8 + w) * 2 + 0) * 64 + lane] = pb[0]; SM[((1 * 8 + w) * 2 + 1) * 64 + lane] = hb[0];
        float un[8];
#pragma unroll
        for (int j = 0; j < 8; ++j) { un[j] = N.cbv + N.cw0 * N.xv[j] + N.cw1 * N.xv[j + 1] + N.cw2 * N.xv[j + 2] + N.cw3 * N.xv[j + 3]; Un[(8 * w + j) * 72 + lane] = f2bf16(un[j]); }
        __syncthreads();
        const size_t sidx = sbase + c;
        if (!FINAL) {
            if (w == 0) {
                float cf = 0.f, Af = 1.f, cb = 0.f, Ab = 1.f;
#pragma unroll
                for (int w2 = 0; w2 < 8; ++w2) { const float A = SM[((0 * 8 + w2) * 2 + 0) * 64 + lane], H = SM[((0 * 8 + w2) * 2 + 1) * 64 + lane]; cf = A * cf + H; Af *= A; }
#pragma unroll
                for (int w2 = 7; w2 >= 0; --w2) { const float A = SM[((1 * 8 + w2) * 2 + 0) * 64 + lane], H = SM[((1 * 8 + w2) * 2 + 1) * 64 + lane]; cb = A * cb + H; Ab *= A; }
                F.SUMM[sidx] = (f32x2){Af, cf}; F.SUMM[sidx + 512] = (f32x2){Ab, cb};
            }
        } else {
            float cf = L.cf, cb = L.cb;
#pragma unroll
            for (int w2 = 0; w2 < 8; ++w2) if (w2 < w) { const float A = SM[((0 * 8 + w2) * 2 + 0) * 64 + lane], H = SM[((0 * 8 + w2) * 2 + 1) * 64 + lane]; cf = A * cf + H; }
#pragma unroll
            for (int w2 = 7; w2 >= 0; --w2) if (w2 > w) { const float A = SM[((1 * 8 + w2) * 2 + 0) * 64 + lane], H = SM[((1 * 8 + w2) * 2 + 1) * 64 + lane]; cb = A * cb + H; }
#pragma unroll
            for (int j = 0; j < 8; ++j) {
                const float y = ((hf[j] + pf[j] * cf) + (hb[j] + pb[j] * cb)) * gelu_tanh_f(L.gate[j]);
                ssq[j] += y * y; YL[(8 * w + j) * 520 + c] = f2bf16(y);
            }
        }
        L = N;
#pragma unroll
        for (int j = 0; j < 8; ++j) u[j] = un[j];
    }
    if (FINAL) {
        const f32x4 og0 = *(const f32x4*)(F.lru_out_g + 8 * lane), og1 = *(const f32x4*)(F.lru_out_g + 8 * lane + 4);
#pragma unroll
        for (int j = 0; j < 8; ++j) {
            const float rs = __builtin_amdgcn_rsqf(wave_sum(ssq[j]) * (1.0f / 512.0f) + EPSN);
            const u32x4 v = *(LAS u32x4*)(YL + (8 * w + j) * 520 + 8 * lane);
            u32x4 o; o.x = cvtpk(__uint_as_float(v.x << 16) * rs * og0[0], __uint_as_float(v.x & 0xffff0000u) * rs * og0[1]); o.y = cvtpk(__uint_as_float(v.y << 16) * rs * og0[2], __uint_as_float(v.y & 0xffff0000u) * rs * og0[3]);
            o.z = cvtpk(__uint_as_float(v.z << 16) * rs * og1[0], __uint_as_float(v.z & 0xffff0000u) * rs * og1[1]); o.w = cvtpk(__uint_as_float(v.w << 16) * rs * og1[2], __uint_as_float(v.w & 0xffff0000u) * rs * og1[3]);
            *(u32x4*)(F.H + (rowbase + pw + j) * 1024 + 8 * lane) = o;
        }
        __syncthreads();
    }
}

struct Lru2A { float xv[2][11]; float cw[2][5]; };
__device__ __forceinline__ void lru2_loadA(const Fr& F, size_t rowbase, int pw, int it, int lane, Lru2A& A) {
#pragma unroll
    for (int h = 0; h < 2; ++h) { const int c = (2 * it + h) * 64 + lane;
#pragma unroll
        for (int i = 0; i < 11; ++i) { const int p = pw - 2 + i; const int pc = p < 0 ? 0 : (p >= PP ? PP - 1 : p); const float v = bf2f(F.Z[(rowbase + pc) * ZC + ZC_LX + c]); A.xv[h][i] = (p == pc) ? v : 0.f; }
        A.cw[h][0] = F.conv_w[c]; A.cw[h][1] = F.conv_w[512 + c]; A.cw[h][2] = F.conv_w[1024 + c]; A.cw[h][3] = F.conv_w[1536 + c]; A.cw[h][4] = F.conv_b[c]; }
}
__device__ __forceinline__ void lru2_writeU(LAS unsigned short* Upar, int w, int lane, const Lru2A& A) {
#pragma unroll
    for (int h = 0; h < 2; ++h)
#pragma unroll
        for (int j = 0; j < 8; ++j) { const float u = A.cw[h][4] + A.cw[h][0] * A.xv[h][j] + A.cw[h][1] * A.xv[h][j + 1] + A.cw[h][2] * A.xv[h][j + 2] + A.cw[h][3] * A.xv[h][j + 3];
            const int rho = 16 * (2 * (w & 1) + (j >> 2)) + 4 * (w >> 1) + (j & 3);
            Upar[h * 4608 + rho * 72 + lane] = f2bf16(u); }
}
template <bool FINAL>
__device__ __forceinline__ void lru2_item(const Fr& F, int b, int s) {
    int lane = F.lane; asm volatile("" : "+v"(lane));
    const int w = F.wave, fr = lane & 15, fq = lane >> 4, cg = w & 3;
    LAS unsigned short* U0 = (LAS unsigned short*)F.lds;
    LAS unsigned short* YL = (LAS unsigned short*)(F.lds + 36864);
    LAS float* SSP = (LAS float*)(F.lds + 36864 + 66560);
    const int p0 = s * 64, pw = p0 + 8 * w; const size_t rowbase = (size_t)b * PP;
    const size_t sbase = ((size_t)(b * NSEG + s) * 2) * 512;
    constexpr float LOG2E = 1.4426950408889634f;
    float ssq[16];
#pragma unroll
    for (int q = 0; q < 16; ++q) ssq[q] = 0.f;
    { Lru2A A0; lru2_loadA(F, rowbase, pw, 0, lane, A0); lru2_writeU(U0, w, lane, A0); }
    __syncthreads();
    for (int it = 0; it < 4; ++it) {
        const int blk = 2 * it + (w >> 2), c = blk * 64 + 16 * cg + fr;
        LAS unsigned short* U = U0 + ((it & 1) * 2 + (w >> 2)) * 4608;
        pg8::bf16x8 bfr[4][2];
        { const unsigned short* gp = F.GW2 + ((size_t)((blk * 4) * 4 + cg) * 16 + fr) * 64 + 8 * fq;
#pragma unroll
          for (int g = 0; g < 4; ++g)
#pragma unroll
              for (int ks = 0; ks < 2; ++ks) bfr[g][ks] = *(const pg8::bf16x8*)(gp + (size_t)g * 4096 + 32 * ks); }
        const float lam0 = F.lam[c], lam1 = F.lam[512 + c], br0 = F.b_r[c], bi0 = F.b_i[c], br1 = F.b_r[512 + c], bi1 = F.b_i[512 + c];
        float cin0 = 0.f, cin1 = 0.f; if (FINAL) { cin0 = F.CARRY[sbase + c]; cin1 = F.CARRY[sbase + 512 + c]; }
        float gt[16];
        if (FINAL) {
#pragma unroll
            for (int q = 0; q < 16; ++q) gt[q] = bf2f(F.Z[(rowbase + p0 + 16 * fq + q) * ZC + ZC_LG + c]);
        }
        Lru2A N; lru2_loadA(F, rowbase, pw, it < 3 ? it + 1 : 3, lane, N);
        pg8::f32x4 acc[4][4];
#pragma unroll
        for (int g = 0; g < 4; ++g)
#pragma unroll
            for (int m = 0; m < 4; ++m) acc[g][m] = (pg8::f32x4){0.f, 0.f, 0.f, 0.f};
#pragma unroll
        for (int ks = 0; ks < 2; ++ks)
#pragma unroll
            for (int m = 0; m < 4; ++m) {
                const pg8::bf16x8 an = *(LAS pg8::bf16x8*)(U + (16 * m + fr) * 72 + 32 * ks + 8 * fq);
                const pg8::bf16x8 ar = *(LAS pg8::bf16x8*)(U + (63 - 16 * m - fr) * 72 + 32 * ks + 8 * fq);
                acc[0][m] = MFMA16(an, bfr[0][ks], acc[0][m]); acc[1][m] = MFMA16(an, bfr[1][ks], acc[1][m]);
                acc[2][m] = MFMA16(ar, bfr[2][ks], acc[2][m]); acc[3][m] = MFMA16(ar, bfr[3][ks], acc[3][m]);
            }
        float hf[16], hb[16];
#pragma unroll
        for (int d = 0; d < 2; ++d) {
            const float kk = -8.0f * LOG2E * softplus_neg(d ? lam1 : lam0), nbr = -LOG2E * (d ? br1 : br0), nbi = -LOG2E * (d ? bi1 : bi0);
            float al[16], xl[16];
#pragma unroll
            for (int m = 0; m < 4; ++m)
#pragma unroll
                for (int rg = 0; rg < 4; ++rg) { const int q = 4 * m + rg; const int row = d ? 63 - (16 * m + 4 * fq + rg) : (16 * m + 4 * fq + rg);
                    const float uu = bf2f(U[row * 72 + 16 * cg + fr]);
                    const float r = __builtin_amdgcn_rcpf(1.0f + __builtin_amdgcn_exp2f(__builtin_fmaf(acc[2 * d][m][rg], -LOG2E, nbr))), ii = __builtin_amdgcn_rcpf(1.0f + __builtin_amdgcn_exp2f(__builtin_fmaf(acc[2 * d + 1][m][rg], -LOG2E, nbi)));
                    const float a = __builtin_amdgcn_exp2f(kk * r); const float e = fmaxf(__builtin_fmaf(-a, a, 1.0f), 0.f);
                    al[q] = a; xl[q] = __builtin_amdgcn_sqrtf(e) * ii * uu; }
            if (s < 2) {
#pragma unroll
                for (int q = 0; q < 16; ++q) { const int p = d ? p0 + 63 - (16 * fq + q) : p0 + 16 * fq + q; const bool padp = p < PADL; al[q] = padp ? 1.0f : al[q]; xl[q] = padp ? 0.0f : xl[q]; }
            }
            { float h = 0.f, P = 1.f;
#pragma unroll
              for (int q = 0; q < 16; ++q) { h = al[q] * h + xl[q]; xl[q] = h; P *= al[q]; al[q] = P; } }
            const float Ar = al[15], Hr = xl[15];
            const float A0 = __shfl(Ar, fr), H0 = __shfl(Hr, fr), A1 = __shfl(Ar, fr + 16), H1 = __shfl(Hr, fr + 16), A2 = __shfl(Ar, fr + 32), H2 = __shfl(Hr, fr + 32);
            float cc = FINAL ? (d ? cin1 : cin0) : 0.f;
            if (fq > 0) cc = A0 * cc + H0;
            if (fq > 1) cc = A1 * cc + H1;
            if (fq > 2) cc = A2 * cc + H2;
            if (!FINAL) { if (fq == 3) F.SUMM[sbase + d * 512 + c] = (f32x2){A0 * A1 * A2 * Ar, Ar * cc + Hr}; }
            else {
#pragma unroll
                for (int q = 0; q < 16; ++q) { const float hv = xl[q] + al[q] * cc; if (d) hb[q] = hv; else hf[q] = hv; }
            }
        }
        if (FINAL) {
#pragma unroll
            for (int q = 0; q < 16; ++q) { const float hbp = __shfl(hb[15 - q], lane ^ 48);
                const float y = (hf[q] + hbp) * gelu_tanh_f(gt[q]); ssq[q] += y * y; YL[(16 * fq + q) * 520 + c] = f2bf16(y); }
        }
        if (it < 3) { lru2_writeU(U0 + ((it & 1) ^ 1) * 9216, w, lane, N); __syncthreads(); }
    }
    if (FINAL) {
#pragma unroll
        for (int q = 0; q < 16; ++q) { float v = ssq[q]; v += __shfl_xor(v, 1); v += __shfl_xor(v, 2); v += __shfl_xor(v, 4); v += __shfl_xor(v, 8); ssq[q] = v; }
        if (fr == 0) {
#pragma unroll
            for (int q = 0; q < 16; ++q) SSP[w * 64 + 16 * fq + q] = ssq[q]; }
        __syncthreads();
        const f32x4 og0 = *(const f32x4*)(F.lru_out_g + 8 * lane), og1 = *(const f32x4*)(F.lru_out_g + 8 * lane + 4);
#pragma unroll
        for (int j = 0; j < 8; ++j) {
            float tot = 0.f;
#pragma unroll
            for (int w2 = 0; w2 < 8; ++w2) tot += SSP[w2 * 64 + 8 * w + j];
            const float rs = __builtin_amdgcn_rsqf(tot * (1.0f / 512.0f) + EPSN);
            const u32x4 v = *(LAS u32x4*)(YL + (8 * w + j) * 520 + 8 * lane);
            u32x4 o; o.x = cvtpk(__uint_as_float(v.x << 16) * rs * og0[0], __uint_as_float(v.x & 0xffff0000u) * rs * og0[1]); o.y = cvtpk(__uint_as_float(v.y << 16) * rs * og0[2], __uint_as_float(v.y & 0xffff0000u) * rs * og0[3]);
            o.z = cvtpk(__uint_as_float(v.z << 16) * rs * og1[0], __uint_as_float(v.z & 0xffff0000u) * rs * og1[1]); o.w = cvtpk(__uint_as_float(v.w << 16) * rs * og1[2], __uint_as_float(v.w & 0xffff0000u) * rs * og1[3]);
            *(u32x4*)(F.H + (rowbase + pw + j) * 1024 + 8 * lane) = o;
        }
        __syncthreads();
    }
}

#ifdef RF_V3
constexpr int LDS_GT = LDS_MAIN + 8192;
#else
constexpr int LDS_GT = LDS_SS + 1024;
#endif
template <int SKIP> __device__ __forceinline__ int ret_count(int w, int G) { if (G != 256) return (2080 - w + G - 1) / G; return (w < 32 + 16 * SKIP) ? 9 : (w >= 240 ? 8 - SKIP : 8); }
template <int SKIP> __device__ __forceinline__ int ret_item(int w, int j, int G) { if (G != 256 || j < 8) return w + G * j; if (w < 32) return 2048 + w; const int k = w - 32; return 240 + (k & 15) + 256 * (7 - (k >> 4)); }
__device__ __forceinline__ void ret_coord(int it, int& b, int& h, int& n) { n = it % NCHUNK; const int bh = it / NCHUNK; b = bh >> 2; h = bh & 3; }
struct RcIn { u32x4 k[4], v[4]; };
__device__ __forceinline__ void rc_load(const Fr& F, int tid, int it, RcIn& R) {
    int b, h, n; ret_coord(it, b, h, n);
    const unsigned short* base = F.Z + ((size_t)b * PP + 128 * n) * ZC + 128 * h;
#pragma unroll
    for (int q = 0; q < 4; ++q) { const int idx = tid + 512 * q, c = idx >> 4, ch = idx & 15; const unsigned short* p = base + (size_t)c * ZC + 8 * ch; R.k[q] = *(const u32x4*)(p + ZC_K); R.v[q] = *(const u32x4*)(p + ZC_V); }
}
__device__ __forceinline__ unsigned scale_pk(unsigned w, float s) { return cvtpk(__uint_as_float(w << 16) * s, __uint_as_float(w & 0xffff0000u) * s); }
__device__ __forceinline__ void ph_ret_contrib(const Fr& F) {
    const int w = F.wave;
    LAS unsigned char* TKF = F.lds; LAS unsigned char* TKB = F.lds + 32768; LAS unsigned char* TV = F.lds + 65536;
    if ((int)blockIdx.x >= 2080) return;
    const int nj = ret_count<2>(blockIdx.x, F.G);
    RcIn R; rc_load(F, F.tid, ret_item<2>(blockIdx.x, 0, F.G), R);
    for (int jj = 0; jj < nj; ++jj) {
        const int it = ret_item<2>(blockIdx.x, jj, F.G);
        int lane = F.lane, tid = threadIdx.x; asm volatile("" : "+v"(lane), "+v"(tid));
        const int r = lane & 31, h2 = lane >> 5;
        int b, h, n; ret_coord(it, b, h, n); const float lg = log2_gamma(h);
#pragma unroll
        for (int q = 0; q < 4; ++q) { const int idx = tid + 512 * q, c = idx >> 4, ch = idx & 15; const float sf = exp2f(lg * (float)(127 - c)), sb = exp2f(lg * (float)c);
            u32x4 kf, kb; kf.x = scale_pk(R.k[q].x, sf); kf.y = scale_pk(R.k[q].y, sf); kf.z = scale_pk(R.k[q].z, sf); kf.w = scale_pk(R.k[q].w, sf);
            kb.x = scale_pk(R.k[q].x, sb); kb.y = scale_pk(R.k[q].y, sb); kb.z = scale_pk(R.k[q].z, sb); kb.w = scale_pk(R.k[q].w, sb);
            const unsigned o = off_b(c, ch); *(LAS u32x4*)(TKF + o) = kf; *(LAS u32x4*)(TKB + o) = kb; *(LAS u32x4*)(TV + o) = R.v[q]; }
        if (jj + 1 < nj) rc_load(F, tid, ret_item<2>(blockIdx.x, jj + 1, F.G), R);
        __syncthreads();
        const int dir = w >> 2, cb = w & 3; LAS unsigned char* TK = dir ? TKB : TKF;
        f32x16 acc[4];
#pragma unroll
        for (int eb = 0; eb < 4; ++eb)
#pragma unroll
            for (int i = 0; i < 16; ++i) acc[eb][i] = 0.f;
#pragma unroll 2
        for (int ks = 0; ks < 8; ++ks) {
            const pg8::bf16x8 a = trfrag(TK, cb, ks, lane);
#pragma unroll
            for (int eb = 0; eb < 4; ++eb) { const pg8::bf16x8 bv = trfrag(TV, eb, ks, lane); acc[eb] = MFMA32(a, bv, acc[eb]); }
        }
        __syncthreads();
#pragma unroll
        for (int eb = 0; eb < 4; ++eb)
#pragma unroll
            for (int g = 0; g < 4; ++g) { u32x2 v; v.x = cvtpk(acc[eb][4 * g], acc[eb][4 * g + 1]); v.y = cvtpk(acc[eb][4 * g + 2], acc[eb][4 * g + 3]);
                *(LAS u32x2*)(TK + off_b(32 * eb + r, 4 * cb + g) + 8 * h2) = v; }
        __syncthreads();
        unsigned short* dst = F.ST + ((size_t)(((b * 4 + h) * 2) * NCHUNK + n)) * 16384;
#pragma unroll
        for (int q = 0; q < 8; ++q) { const int idx = tid + 512 * q, tile = idx >> 11, rem = idx & 2047, e = rem >> 4, ch = rem & 15;
            const u32x4 v = *(LAS u32x4*)(F.lds + tile * 32768 + off_b(e, ch)); *(u32x4*)(dst + (size_t)tile * NCHUNK * 16384 + (size_t)e * 128 + 8 * ch) = v; }
        __syncthreads();
    }
}
struct RfIn { u32x4 q[4], k[4], v[4]; };
struct RsIn { u32x4 sf[4], sb[4], g[4]; };
__device__ __forceinline__ void rf_load(const Fr& F, int tid, int it, RfIn& R) {
    int b, h, n; ret_coord(it, b, h, n);
    const unsigned short* base = F.Z + ((size_t)b * PP + 128 * n) * ZC + 128 * h;
#pragma unroll
#ifdef RF_V5
    for (int q = 0; q < 4; ++q) { const int idx = tid + 512 * q, c = idx >> 4, ch = idx & 15; const unsigned short* p = base + (size_t)c * ZC + 8 * ch; R.q[q] = *(const u32x4*)(base + (size_t)(c ^ 1) * ZC + 8 * ch + ZC_Q); R.k[q] = *(const u32x4*)(p + ZC_K); R.v[q] = *(const u32x4*)(p + ZC_V); }
#else
    for (int q = 0; q < 4; ++q) { const int idx = tid + 512 * q, c = idx >> 4, ch = idx & 15; const unsigned short* p = base + (size_t)c * ZC + 8 * ch; R.q[q] = *(const u32x4*)(p + ZC_Q); R.k[q] = *(const u32x4*)(p + ZC_K); R.v[q] = *(const u32x4*)(p + ZC_V); }
#endif
}
__device__ __forceinline__ void rs_load(const Fr& F, int tid, int b, int h, int n, RsIn& R) {
    const unsigned short* sf = F.ST2 + ((size_t)(((b * 4 + h) * 2 + 0) * NCHUNK + n)) * 16384; const unsigned short* sb = sf + (size_t)NCHUNK * 16384;
    const unsigned short* gb = F.Z + ((size_t)b * PP + 128 * n) * ZC + ZC_G + 128 * h;
#pragma unroll
    for (int q = 0; q < 4; ++q) { const int idx = tid + 512 * q, c = idx >> 4, ch = idx & 15; R.sf[q] = *(const u32x4*)(sf + (size_t)c * 128 + 8 * ch); R.sb[q] = *(const u32x4*)(sb + (size_t)c * 128 + 8 * ch); R.g[q] = *(const u32x4*)(gb + (size_t)c * ZC + 8 * ch); }
}
#ifdef RF_EXTRA
#define RF_XBAR asm volatile("s_waitcnt vmcnt(0) lgkmcnt(0)" ::: "memory"); __syncthreads();
#else
#define RF_XBAR
#endif
#define RF_FLAG(code_) atomicOr((unsigned*)(F.CTLP + 32768 + 2048), (unsigned)(code_))
#if !defined(RF_GTAB) && !defined(RF_V10) && !defined(RF_V4)
#define RF_GT(d_, c_) exp2f(lg * (float)(d_))
#elif defined(RF_V4)
#define RF_GT(d_, c_) ({ const float g_ = GT[d_]; const float e_ = exp2f(lg * (float)(d_)); if (!(fabsf(g_ - e_) <= 1e-5f * e_)) RF_FLAG(c_); g_; })
#else
#define RF_GT(d_, c_) GT[d_]
#endif
#ifdef RF_V8
#define RF_QF rowfrag_x
#else
#define RF_QF rowfrag
#endif
#ifndef RF_QHOIST
#define RF_QHOIST 2
#endif
__device__ __forceinline__ void ph_ret_final(const Fr& F) {
    const int w = F.wave;
    LAS unsigned char* R0 = F.lds; LAS unsigned char* R1 = F.lds + 32768; LAS unsigned char* R2 = F.lds + 65536; LAS unsigned char* R3 = F.lds + 98304;
    LAS float* SS = (LAS float*)(F.lds + LDS_SS); LAS float* GT = (LAS float*)(F.lds + LDS_GT); (void)GT;
    if ((int)blockIdx.x >= 2080) return;
    const int nj = ret_count<1>(blockIdx.x, F.G);
#ifdef RF_V9
    const int cb = 3 - (w >> 1), ebase = 2 * (w & 1);
#else
    const int cb = w >> 1, ebase = 2 * (w & 1);
#endif
#ifndef RF_NOPF
    RfIn Rf; rf_load(F, F.tid, ret_item<1>(blockIdx.x, 0, F.G), Rf);
#endif
    for (int jj = 0; jj < nj; ++jj) {
        const int it = ret_item<1>(blockIdx.x, jj, F.G);
        int lane = F.lane, tid = threadIdx.x; asm volatile("" : "+v"(lane), "+v"(tid));
        const int r = lane & 31, h2 = lane >> 5;
        int b, h, n; ret_coord(it, b, h, n); const float lg = log2_gamma(h);
        const size_t row0 = (size_t)b * PP + 128 * n;
        __syncthreads();
#ifndef RF_NOPF
        RsIn Rs; rs_load(F, tid, b, h, n, Rs);
#else
        RfIn Rf; rf_load(F, tid, it, Rf);
        RsIn Rs; rs_load(F, tid, b, h, n, Rs);
#endif
#pragma unroll
#ifdef RF_V5
        for (int q = 0; q < 4; ++q) { const int idx = tid + 512 * q, c = idx >> 4, ch = idx & 15; const unsigned o = off_b(c, ch); *(LAS u32x4*)(R0 + off_b(c ^ 1, ch)) = Rf.q[q]; *(LAS u32x4*)(R1 + o) = Rf.k[q]; *(LAS u32x4*)(R2 + o) = Rf.v[q]; }
#elif defined(RF_V8)
        for (int q = 0; q < 4; ++q) { const int idx = tid + 512 * q, c = idx >> 4, ch = idx & 15; const unsigned o = off_b(c, ch); *(LAS u32x4*)(R0 + off_b(c ^ 1, ch)) = Rf.q[q]; *(LAS u32x4*)(R1 + o) = Rf.k[q]; *(LAS u32x4*)(R2 + o) = Rf.v[q]; }
#else
        for (int q = 0; q < 4; ++q) { const int idx = tid + 512 * q, c = idx >> 4, ch = idx & 15; const unsigned o = off_b(c, ch); *(LAS u32x4*)(R0 + o) = Rf.q[q]; *(LAS u32x4*)(R1 + o) = Rf.k[q]; *(LAS u32x4*)(R2 + o) = Rf.v[q]; }
#endif
#ifdef RF_V10
        { const int gi = tid & 255; GT[gi] = exp2f(lg * (float)gi); }
#elif defined(RF_GTAB)
        if (tid < 129) GT[tid] = exp2f(lg * (float)tid);
#endif
        const float og0 = F.ret_out_g[128 * h + 32 * ebase + r], og1 = F.ret_out_g[128 * h + 32 * (ebase + 1) + r];
        __syncthreads(); RF_XBAR
        f32x16 o[2];
#pragma unroll
        for (int eo = 0; eo < 2; ++eo)
#pragma unroll
            for (int i = 0; i < 16; ++i) o[eo][i] = 0.f;
        {
            const int cpos = 32 * cb + r;
#if RF_QHOIST >= 1
            pg8::bf16x8 qfr[8];
#pragma unroll
            for (int s = 0; s < 8; ++s) qfr[s] = RF_QF(R0, cb, s, lane);
#endif
#pragma unroll
            for (int mb = 0; mb < 4; ++mb) {
                f32x16 X;
#pragma unroll
                for (int i = 0; i < 16; ++i) X[i] = 0.f;
#if RF_QHOIST >= 1
#pragma unroll
                for (int s = 0; s < 8; ++s) { const pg8::bf16x8 kf = rowfrag(R1, mb, s, lane); X = MFMA32(kf, qfr[s], X); }
#else
#pragma unroll 2
                for (int s = 0; s < 8; ++s) { const pg8::bf16x8 qf = RF_QF(R0, cb, s, lane); const pg8::bf16x8 kf = rowfrag(R1, mb, s, lane); X = MFMA32(kf, qf, X); }
#endif
                int cpo = cpos, h2o = h2; asm volatile("" : "+v"(cpo), "+v"(h2o));
#pragma unroll
                for (int i = 0; i < 16; ++i) { const int m = 32 * mb + crow(i, h2o); const int dd = cpo > m ? cpo - m : m - cpo; X[i] *= RF_GT(dd, 1); }
#pragma unroll
                for (int s2 = 0; s2 < 2; ++s2) { u32x4 pk; pk.x = cvtpk(X[8 * s2], X[8 * s2 + 1]); pk.y = cvtpk(X[8 * s2 + 2], X[8 * s2 + 3]); pk.z = cvtpk(X[8 * s2 + 4], X[8 * s2 + 5]); pk.w = cvtpk(X[8 * s2 + 6], X[8 * s2 + 7]);
                    const pg8::bf16x8 pa = __builtin_bit_cast(pg8::bf16x8, pk);
#pragma unroll
                    for (int eo = 0; eo < 2; ++eo) { const pg8::bf16x8 vb = trfrag_perm(R2, ebase + eo, 32 * mb + 16 * s2, lane); o[eo] = MFMA32(pa, vb, o[eo]); } }
            }
        }
        RF_XBAR __syncthreads(); RF_XBAR
#pragma unroll
        for (int q = 0; q < 4; ++q) { const int idx = tid + 512 * q, c = idx >> 4, ch = idx & 15; const unsigned of = off_b(c, ch); *(LAS u32x4*)(R1 + of) = Rs.sf[q]; *(LAS u32x4*)(R3 + of) = Rs.sb[q]; *(LAS u32x4*)(R2 + of) = Rs.g[q]; }
#ifndef RF_NOPF
        rf_load(F, tid, ret_item<1>(blockIdx.x, jj + 1 < nj ? jj + 1 : jj, F.G), Rf);
#endif
        RF_XBAR __syncthreads(); RF_XBAR
#if defined(RF_QHOIST) && RF_QHOIST >= 2
        pg8::bf16x8 qfi[8];
#pragma unroll
        for (int s = 0; s < 8; ++s) qfi[s] = RF_QF(R0, cb, s, lane);
#endif
#pragma unroll
        for (int dirn = 0; dirn < 2; ++dirn) {
            LAS unsigned char* TX = dirn ? R3 : R1;
            f32x16 oi[2];
#pragma unroll
            for (int eo = 0; eo < 2; ++eo)
#pragma unroll
                for (int i = 0; i < 16; ++i) oi[eo][i] = 0.f;
#if defined(RF_QHOIST) && RF_QHOIST >= 2
#pragma unroll
            for (int s = 0; s < 8; ++s) { const pg8::bf16x8 qf = qfi[s];
#else
#pragma unroll 2
            for (int s = 0; s < 8; ++s) { const pg8::bf16x8 qf = RF_QF(R0, cb, s, lane);
#endif
#pragma unroll
                for (int eo = 0; eo < 2; ++eo) { const pg8::bf16x8 f1 = rowfrag(TX, ebase + eo, s, lane); oi[eo] = MFMA32(qf, f1, oi[eo]); } }
            int h2d = h2; asm volatile("" : "+v"(h2d));
#pragma unroll
            for (int i = 0; i < 16; ++i) { const int cl = 32 * cb + crow(i, h2d); const float dfac = RF_GT(dirn ? (128 - cl) : (cl + 1), 2);
#pragma unroll
                for (int eo = 0; eo < 2; ++eo) o[eo][i] += dfac * oi[eo][i]; }
        }
        float ssq[16];
#pragma unroll
        for (int i = 0; i < 16; ++i) {
            float s = o[0][i] * o[0][i] + o[1][i] * o[1][i];
            s += __shfl_xor(s, 1); s += __shfl_xor(s, 2); s += __shfl_xor(s, 4); s += __shfl_xor(s, 8); s += __shfl_xor(s, 16);
            ssq[i] = s; }
        if (r == 0) {
#pragma unroll
            for (int i = 0; i < 16; ++i) SS[(w & 1) * 128 + 32 * cb + crow(i, h2)] = ssq[i]; }
        RF_XBAR __syncthreads(); RF_XBAR
        int h2e = h2, re = r; asm volatile("" : "+v"(h2e), "+v"(re));
#ifdef RF_V1
#pragma unroll
        for (int i = 0; i < 16; ++i) { const int cl = 32 * cb + crow(i, h2e); const float tot = SS[cl] + SS[128 + cl]; const float rs = __builtin_amdgcn_rsqf(tot * (1.0f / 128.0f) + EPSN);
            const size_t row = row0 + cl;
#pragma unroll
            for (int eo = 0; eo < 2; ++eo) { const int e = 32 * (ebase + eo) + re; const float gv = bf2f(F.Z[row * ZC + ZC_G + 128 * h + e]);
                F.H[row * 1024 + 512 + 128 * h + e] = f2bf16(o[eo][i] * rs * (eo ? og1 : og0) * pg8::silu_f(gv)); } }
        RF_XBAR __syncthreads(); RF_XBAR
#else
#pragma unroll
        for (int i = 0; i < 16; ++i) { const int cl = 32 * cb + crow(i, h2e); const float tot = SS[cl] + SS[128 + cl]; const float rs = __builtin_amdgcn_rsqf(tot * (1.0f / 128.0f) + EPSN);
#pragma unroll
            for (int eo = 0; eo < 2; ++eo) { const int e = 32 * (ebase + eo) + re; const unsigned of = off_b(cl, e >> 3) + 2 * (e & 7);
                const float gv = bf2f(*(LAS unsigned short*)(R2 + of));
                *(LAS unsigned short*)(R3 + of) = f2bf16(o[eo][i] * rs * (eo ? og1 : og0) * pg8::silu_f(gv)); } }
        RF_XBAR __syncthreads(); RF_XBAR
#pragma unroll
#ifdef RF_V6
        for (int q = 0; q < 4; ++q) { const int idx = tid + 512 * q, c = (idx >> 4) ^ 1, ch = idx & 15; const u32x4 v = *(LAS u32x4*)(R3 + off_b(c, ch)); *(u32x4*)(F.H + (row0 + c) * 1024 + 512 + 128 * h + 8 * ch) = v; }
#else
        for (int q = 0; q < 4; ++q) { const int idx = tid + 512 * q, c = idx >> 4, ch = idx & 15; const u32x4 v = *(LAS u32x4*)(R3 + off_b(c, ch)); *(u32x4*)(F.H + (row0 + c) * 1024 + 512 + 128 * h + 8 * ch) = v; }
#endif
#endif
#ifdef RF_V11
        if (tid < 129) { const float g_ = GT[tid]; const float e_ = exp2f(lg * (float)tid); if (!(fabsf(g_ - e_) <= 1e-5f * e_)) RF_FLAG(1); }
#endif
    }
    __syncthreads();
}
__device__ __forceinline__ void ret_scan(const Fr& F) {
    for (int v = blockIdx.x * 512 + F.tid; v < 64 * 2048; v += F.G * 512) {
        const int strip = v >> 11, off = v & 2047, dir = strip & 1, h = (strip >> 1) & 3;
        const float cd = exp2f(128.0f * log2_gamma(h));
        const unsigned short* base = F.ST + (size_t)strip * NCHUNK * 16384 + (size_t)off * 8;
        unsigned short* obase = F.ST2 + (size_t)strip * NCHUNK * 16384 + (size_t)off * 8;
        float carry[8];
#pragma unroll
        for (int i = 0; i < 8; ++i) carry[i] = 0.f;
        for (int k0 = 0; k0 < NCHUNK; k0 += 5) {
            u16x8 tv[5];
#pragma unroll
            for (int j = 0; j < 5; ++j) { const int n = dir ? (NCHUNK - 1 - (k0 + j)) : (k0 + j); tv[j] = *(const u16x8*)(base + (size_t)n * 16384); }
#pragma unroll
            for (int j = 0; j < 5; ++j) { const int n = dir ? (NCHUNK - 1 - (k0 + j)) : (k0 + j); u32x4 o;
                o.x = cvtpk(carry[0], carry[1]); o.y = cvtpk(carry[2], carry[3]); o.z = cvtpk(carry[4], carry[5]); o.w = cvtpk(carry[6], carry[7]);
                *(u32x4*)(obase + (size_t)n * 16384) = o;
#pragma unroll
                for (int i = 0; i < 8; ++i) carry[i] = carry[i] * cd + bf2f(tv[j][i]); }
        }
    }
}
__device__ __forceinline__ void lru_carry(const Fr& F) {
    for (int v = blockIdx.x * 32 + F.tid; F.tid < 32 && v < NB * 2 * 512; v += F.G * 32) {
        const int c = v & 511, dir = (v >> 9) & 1, b = v >> 10;
        float carry = 0.f;
        for (int k0 = 0; k0 < NSEG; k0 += 10) {
            f32x2 ah[10];
#pragma unroll
            for (int j = 0; j < 10; ++j) { const int s = dir ? (NSEG - 1 - (k0 + j)) : (k0 + j); ah[j] = F.SUMM[((size_t)(b * NSEG + s) * 2 + dir) * 512 + c]; }
#pragma unroll
            for (int j = 0; j < 10; ++j) { const int s = dir ? (NSEG - 1 - (k0 + j)) : (k0 + j); F.CARRY[((size_t)(b * NSEG + s) * 2 + dir) * 512 + c] = carry; carry = ah[j].x * carry + ah[j].y; }
        }
    }
}
__device__ __forceinline__ void ph_checksum(const Fr& F, const void* buf, size_t bytes, int slot) {
    const unsigned* p = (const unsigned*)buf; const size_t nw = bytes / 4;
    unsigned long long sa = 0ull, sx = 0ull;
    for (size_t i = (size_t)blockIdx.x * 512 + F.tid; i < nw; i += (size_t)F.G * 512) { const unsigned long long v = p[i]; const unsigned long long h = (v + 0x9E3779B97F4A7C15ull + i) * 0xD6E8FEB86659FD93ull; sa += h; sx += (h ^ (h >> 29)) * 0xBF58476D1CE4E5B9ull; }
    unsigned a0 = (unsigned)sa, a1 = (unsigned)(sa >> 32), x0 = (unsigned)sx, x1 = (unsigned)(sx >> 32);
    for (int o = 1; o < 64; o <<= 1) { a0 += __shfl_xor(a0, o); a1 += __shfl_xor(a1, o); x0 += __shfl_xor(x0, o); x1 += __shfl_xor(x1, o); }
    sa = ((unsigned long long)a1 << 32) | a0; sx = ((unsigned long long)x1 << 32) | x0;
    if (F.lane == 0) { unsigned long long* c = (unsigned long long*)(F.CTLP + 32768) + slot * 2; atomicAdd(c, sa); atomicAdd(c + 1, sx); }
}
__device__ __forceinline__ void ph_cpy(const Fr& F) {
    const u32x4* s = (const u32x4*)F.H; u32x4* d = (u32x4*)(F.CTLP + CPY_BASE); const size_t nv = (size_t)NP * 2048 / 16;
    for (size_t i = (size_t)blockIdx.x * 512 + F.tid; i < nv; i += (size_t)F.G * 512) d[i] = s[i];
}
__device__ __forceinline__ void ph_cmp(const Fr& F) {
    const unsigned* a = (const unsigned*)F.H; const unsigned* c = (const unsigned*)(F.CTLP + CPY_BASE); const size_t nw = (size_t)NP * 2048 / 4;
    unsigned* st = (unsigned*)(F.CTLP + 32768 + 4096);
    for (size_t i = (size_t)blockIdx.x * 512 + F.tid; i < nw; i += (size_t)F.G * 512) {
        const unsigned x = a[i], y = c[i];
        if (x != y) { const unsigned idx = (unsigned)i;
            const float x0 = __uint_as_float(x << 16), x1 = __uint_as_float(x & 0xffff0000u), y0 = __uint_as_float(y << 16), y1 = __uint_as_float(y & 0xffff0000u);
            const float d0 = fabsf(x0 - y0), d1 = fabsf(x1 - y1); const float d = fmaxf(d0, d1);
            const float m = (d0 >= d1) ? fmaxf(fabsf(x0), fabsf(y0)) : fmaxf(fabsf(x1), fabsf(y1)); const float rel = d / fmaxf(m, 1e-30f);
            atomicAdd(st + 0, 1u); atomicMax(st + 1, ~idx); atomicMax(st + 2, idx); atomicOr(st + 3, ~idx); atomicOr(st + 4, idx);
            atomicMax(st + 5, __float_as_uint(d)); atomicMax(st + 6, __float_as_uint(rel));
            if (fabsf(y0) > 0.02f && fabsf(y1) > 0.02f) { const float ra = x0 / y0, rb = x1 / y1; atomicMax(st + 9, __float_as_uint(fabsf(ra - rb) / fmaxf(fabsf(ra), fabsf(rb)))); atomicMax(st + 10, __float_as_uint(fabsf(ra))); atomicMax(st + 11, __float_as_uint(1.0f / fmaxf(fabsf(ra), 1e-30f))); atomicAdd(st + 12, 1u); if (fabsf(ra - rb) / fmaxf(fabsf(ra), fabsf(rb)) < 0.03f) atomicAdd(st + 13, 1u); else atomicAdd(st + 14, 1u); }
            { const unsigned row_ = idx >> 9, cw_ = idx & 511u, cid_ = row_ >> 7; const unsigned item_ = (cw_ & 256u) ? ((cid_ / 65u) * 4u + ((cw_ >> 6) & 3u)) * 65u + cid_ % 65u : 2087u;
              atomicOr(st + 16 + (item_ >> 5), 1u << (item_ & 31u)); atomicAdd((unsigned*)(F.CTLP + 40960) + item_, 1u); if (d >= 0.125f) atomicAdd(st + 7, 1u); if (d >= 1.0f) atomicAdd(st + 8, 1u); } }
    }
}
__device__ __forceinline__ const unsigned short* hs_row(const Fr& F, int b, int t) { return F.HSB + (size_t)(b * PP + PADL + t) * 1024; }
__device__ __forceinline__ f32x4 bf4(u32x2 w) { return (f32x4){__uint_as_float(w.x << 16), __uint_as_float(w.x & 0xffff0000u), __uint_as_float(w.y << 16), __uint_as_float(w.y & 0xffff0000u)}; }
__device__ __forceinline__ float router_softmax(float (&pl)[16], int lane) {
    { const bool hi = lane & 32;
#pragma unroll
      for (int i = 0; i < 8; ++i) { const float send = hi ? pl[i] : pl[i + 8], keep = hi ? pl[i + 8] : pl[i]; pl[i] = keep + __shfl_xor(send, 32); } }
    { const bool hi = lane & 16;
#pragma unroll
      for (int i = 0; i < 4; ++i) { const float send = hi ? pl[i] : pl[i + 4], keep = hi ? pl[i + 4] : pl[i]; pl[i] = keep + __shfl_xor(send, 16); } }
    { const bool hi = lane & 8;
#pragma unroll
      for (int i = 0; i < 2; ++i) { const float send = hi ? pl[i] : pl[i + 2], keep = hi ? pl[i + 2] : pl[i]; pl[i] = keep + __shfl_xor(send, 8); } }
    { const bool hi = lane & 4; const float send = hi ? pl[0] : pl[1], keep = hi ? pl[1] : pl[0]; pl[0] = keep + __shfl_xor(send, 4); }
    float lg = pl[0]; lg += __shfl_xor(lg, 1); lg += __shfl_xor(lg, 2);
    float mx = lg;
    mx = fmaxf(mx, __shfl_xor(mx, 4)); mx = fmaxf(mx, __shfl_xor(mx, 8)); mx = fmaxf(mx, __shfl_xor(mx, 16)); mx = fmaxf(mx, __shfl_xor(mx, 32));
    const float ex = expf(lg - mx); float sm = ex;
    sm += __shfl_xor(sm, 4); sm += __shfl_xor(sm, 8); sm += __shfl_xor(sm, 16); sm += __shfl_xor(sm, 32);
    return ex / sm;
}
__device__ __forceinline__ void ph_router(const Fr& F) {
    LAS float* WR = (LAS float*)F.lds;
    for (int i = F.tid; i < 16384; i += 512) { const int d = i >> 4, e = i & 15; WR[e * 1024 + d] = F.w_router[i]; }
    __syncthreads();
    const int lane = F.lane;
    if (blockIdx.x == 0 && F.tid < 256) ((unsigned*)F.XS)[F.tid] = 0u;
    const int NV = NB * TT, NPAIR = NV / 2;
    const int gw = blockIdx.x * 8 + F.wave, NGW = F.G * 8;
    u32x2 nx[2][4];
    if (gw < NPAIR) {
#pragma unroll
        for (int q = 0; q < 2; ++q) { const int v = 2 * gw + q, b = v / TT, t = v - b * TT; const u32x2* xr = (const u32x2*)hs_row(F, b, t) + lane;
#pragma unroll
            for (int j = 0; j < 4; ++j) nx[q][j] = xr[64 * j]; }
    }
    f32x4 gg[4];
#pragma unroll
    for (int j = 0; j < 4; ++j) gg[j] = ((const f32x4*)F.norm2_g + lane)[64 * j];
    for (int pr = gw; pr < NPAIR; pr += NGW) {
        f32x4 vv[2][4];
#pragma unroll
        for (int q = 0; q < 2; ++q)
#pragma unroll
            for (int j = 0; j < 4; ++j) vv[q][j] = bf4(nx[q][j]);
        { const int pn = pr + NGW < NPAIR ? pr + NGW : pr;
#pragma unroll
          for (int q = 0; q < 2; ++q) { const int v = 2 * pn + q, b = v / TT, t = v - b * TT; const u32x2* xr = (const u32x2*)hs_row(F, b, t) + lane;
#pragma unroll
              for (int j = 0; j < 4; ++j) nx[q][j] = xr[64 * j]; } }
        int bq[2], tq[2];
#pragma unroll
        for (int q = 0; q < 2; ++q) {
            const int v = 2 * pr + q; bq[q] = v / TT; tq[q] = v - bq[q] * TT;
            float s = 0.f;
#pragma unroll
            for (int j = 0; j < 4; ++j) s += (vv[q][j].x * vv[q][j].x + vv[q][j].y * vv[q][j].y) + (vv[q][j].z * vv[q][j].z + vv[q][j].w * vv[q][j].w);
            const float rs = __builtin_amdgcn_rsqf(wave_sum(s) * (1.0f / 1024.0f) + EPSN);
            unsigned* o8 = (unsigned*)((unsigned char*)F.XS + (size_t)(bq[q] * PP + PADL + tq[q]) * 1024) + lane;
#pragma unroll
            for (int j = 0; j < 4; ++j) { vv[q][j].x *= rs * gg[j].x; vv[q][j].y *= rs * gg[j].y; vv[q][j].z *= rs * gg[j].z; vv[q][j].w *= rs * gg[j].w;
                unsigned wv = 0u; wv = __builtin_amdgcn_cvt_pk_fp8_f32(vv[q][j].x, vv[q][j].y, wv, false); wv = __builtin_amdgcn_cvt_pk_fp8_f32(vv[q][j].z, vv[q][j].w, wv, true); o8[64 * j] = wv; }
        }
        float pl0[16], pl1[16];
#pragma unroll
        for (int e = 0; e < 16; ++e) { f32x2 a0 = {0.f, 0.f}, a1 = {0.f, 0.f};
#pragma unroll
            for (int j = 0; j < 4; ++j) { const f32x4 wv = *(LAS f32x4*)(WR + e * 1024 + 256 * j + 4 * lane);
                const f32x2 wlo = __builtin_shufflevector(wv, wv, 0, 1), whi = __builtin_shufflevector(wv, wv, 2, 3);
                a0 = __builtin_elementwise_fma(__builtin_shufflevector(vv[0][j], vv[0][j], 0, 1), wlo, a0); a0 = __builtin_elementwise_fma(__builtin_shufflevector(vv[0][j], vv[0][j], 2, 3), whi, a0);
                a1 = __builtin_elementwise_fma(__builtin_shufflevector(vv[1][j], vv[1][j], 0, 1), wlo, a1); a1 = __builtin_elementwise_fma(__builtin_shufflevector(vv[1][j], vv[1][j], 2, 3), whi, a1); }
            pl0[e] = a0.x + a0.y; pl1[e] = a1.x + a1.y; if ((e & 3) == 3) asm volatile("" ::: "memory"); }
        const float p0 = router_softmax(pl0, lane), p1 = router_softmax(pl1, lane);
        const int e = ((lane >> 5) & 1) * 8 + ((lane >> 4) & 1) * 4 + ((lane >> 3) & 1) * 2 + ((lane >> 2) & 1);
        if ((lane & 3) == 0) { F.AFF[(size_t)(bq[0] * NE + e) * TT + tq[0]] = p0; F.AFF[(size_t)(bq[1] * NE + e) * TT + tq[1]] = p1; }
    }
    __syncthreads();
}

__device__ __forceinline__ void topk_item(const Fr& F, int b, int e) {
    LAS unsigned* vals = (LAS unsigned*)F.lds;
    LAS unsigned* hist = vals + 8256;
    LAS unsigned* misc = hist + 256;
    LAS unsigned* wsum = misc + 16;
    const int tid = F.tid, lane = F.lane, w = F.wave;
    const float* aff = F.AFF + (size_t)(b * NE + e) * TT;
    for (int t = tid; t < TT; t += 512) vals[t] = __float_as_uint(aff[t]);
    unsigned prefix = 0u, mask = 0u, k = CAP;
    for (int pass = 0; pass < 4; ++pass) {
        const int shift = 24 - 8 * pass;
        if (tid < 256) hist[tid] = 0u;
        __syncthreads();
        for (int t = tid; t < TT; t += 512) { const unsigned v = vals[t]; if ((v & mask) == prefix) __hip_atomic_fetch_add(&hist[(v >> shift) & 255u], 1u, __ATOMIC_RELAXED, __HIP_MEMORY_SCOPE_WORKGROUP); }
        __syncthreads();
        if (w == 0) {
            unsigned c[4]; unsigned s = 0u;
#pragma unroll
            for (int i = 0; i < 4; ++i) { c[i] = hist[255 - (4 * lane + i)]; s += c[i]; }
            unsigned incl = s;
#pragma unroll
            for (int o = 1; o < 64; o <<= 1) { const unsigned y = __shfl_up(incl, o); if (lane >= o) incl += y; }
            unsigned cum = incl - s;
#pragma unroll
            for (int i = 0; i < 4; ++i) { if (cum < k && cum + c[i] >= k) { misc[0] = prefix | ((unsigned)(255 - (4 * lane + i)) << shift); misc[1] = k - cum; } cum += c[i]; }
        }
        __syncthreads();
        prefix = misc[0]; k = misc[1]; mask |= 0xFFu << shift;
        __syncthreads();
    }
    const unsigned thr = prefix, keq = k;
    const int t0 = tid * 17;
    unsigned loc = 0u;
#pragma unroll
    for (int i = 0; i < 17; ++i) { const int t = t0 + i; if (t < TT) { const unsigned v = vals[t]; loc += (v > thr ? 1u : 0u) + (v == thr ? 65536u : 0u); } }
    unsigned incl = loc;
#pragma unroll
    for (int o = 1; o < 64; o <<= 1) { const unsigned y = __shfl_up(incl, o); if (lane >= o) incl += y; }
    if (lane == 63) wsum[w] = incl;
    __syncthreads();
    unsigned before = incl - loc;
#pragma unroll
    for (int w2 = 0; w2 < 8; ++w2) if (w2 < w) before += wsum[w2];
    unsigned gtb = before & 0xFFFFu, eqb = before >> 16;
    for (int i = 0; i < 17; ++i) { const int t = t0 + i; if (t < TT) {
        const unsigned v = vals[t]; const bool gt = v > thr, eq = v == thr; const bool sel = gt || (eq && eqb < keq);
        const int rrow = b * PP + PADL + t;
        int mrow = -1;
        if (sel) { const unsigned slot = gtb + (eqb < keq ? eqb : keq); mrow = e * EROWS + b * CAP + (int)slot; F.IDX[mrow] = rrow * 1024; F.GATE[mrow] = __uint_as_float(v); }
        F.ROWMAP[(size_t)rrow * NE + e] = mrow;
        gtb += gt ? 1u : 0u; eqb += eq ? 1u : 0u; } }
    if (b == 0) for (int i = tid; i < EROWS - NB * CAP; i += 512) { F.IDX[e * EROWS + NB * CAP + i] = 0; F.GATE[e * EROWS + NB * CAP + i] = 0.f; }
    __syncthreads();
}

__device__ __forceinline__ void ph_gather(const Fr& F) {
    for (int v = blockIdx.x * 8 + F.wave; v < NROWS; v += F.G * 8) {
        const int src = F.IDX[v];
        u32x4* dst = (u32x4*)(F.XS + (size_t)v * 1024) + F.lane;
        if (src >= 0) { const u32x4* sp = (const u32x4*)(F.H + (size_t)src * 1024) + F.lane; dst[0] = sp[0]; dst[64] = sp[64]; }
        else { dst[0] = (u32x4){0u, 0u, 0u, 0u}; dst[64] = (u32x4){0u, 0u, 0u, 0u}; }
    }
}
__device__ __forceinline__ void ph_combine(const Fr& F) {
    const int lane = F.lane;
#ifdef DET_PROBE
    float badv = 0.f; { const unsigned long long* c = (const unsigned long long*)(F.CTLP + 32768); float mag = 1e4f;
      for (int k = DET_PROBE - 1; k >= 0; --k) { const bool bk = (__hip_atomic_load(c + 4 * k, __ATOMIC_RELAXED, __HIP_MEMORY_SCOPE_AGENT) != __hip_atomic_load(c + 4 * k + 2, __ATOMIC_RELAXED, __HIP_MEMORY_SCOPE_AGENT)) || (__hip_atomic_load(c + 4 * k + 1, __ATOMIC_RELAXED, __HIP_MEMORY_SCOPE_AGENT) != __hip_atomic_load(c + 4 * k + 3, __ATOMIC_RELAXED, __HIP_MEMORY_SCOPE_AGENT)); if (bk) { float mm = 1e4f; for (int e_ = 0; e_ < k; ++e_) mm *= 10.0f; badv = mm; } } (void)mag; }
    { const unsigned fl_ = __hip_atomic_load((const unsigned*)(F.CTLP + 32768 + 2048), __ATOMIC_RELAXED, __HIP_MEMORY_SCOPE_AGENT); if (fl_) badv = 1e5f * (float)fl_; }
#ifdef STAT_SEL
    { const unsigned* st = (const unsigned*)(F.CTLP + 32768 + 4096);
      const unsigned cnt = __hip_atomic_load(st + 0, __ATOMIC_RELAXED, __HIP_MEMORY_SCOPE_AGENT), nmin = ~__hip_atomic_load(st + 1, __ATOMIC_RELAXED, __HIP_MEMORY_SCOPE_AGENT), nand = ~__hip_atomic_load(st + 3, __ATOMIC_RELAXED, __HIP_MEMORY_SCOPE_AGENT),
                     vor = __hip_atomic_load(st + 4, __ATOMIC_RELAXED, __HIP_MEMORY_SCOPE_AGENT), mabs = __hip_atomic_load(st + 5, __ATOMIC_RELAXED, __HIP_MEMORY_SCOPE_AGENT), mrel = __hip_atomic_load(st + 6, __ATOMIC_RELAXED, __HIP_MEMORY_SCOPE_AGENT);
      if (cnt) { const unsigned vary = vor & ~nand; unsigned k = 0; const unsigned row = nmin >> 9, cw = nmin & 511u, chunkid = row >> 7;
        if (STAT_SEL == 0) { unsigned L = 32u - (unsigned)__builtin_clz(cnt); if (L > 15u) L = 15u; k = L + ((vary & 63u) ? 16u : 0u) + ((vary & 448u) ? 32u : 0u) + ((vary & 0xFE00u) ? 64u : 0u) + ((vary >> 16) ? 128u : 0u); }
        if (STAT_SEL == 1) k = row & 127u;
        if (STAT_SEL == 2) k = cw >> 1;
        if (STAT_SEL == 3) k = chunkid % 65u;
        if (STAT_SEL == 4) k = mabs >> 23;
        if (STAT_SEL == 5) k = mrel >> 23;
        if (STAT_SEL == 6) k = (chunkid / 65u) * 4u + ((cw >> 6) & 3u) + ((cw & 256u) ? 0u : 64u);
        if (STAT_SEL == 7) k = cnt < 255u ? cnt : 255u;
        if (STAT_SEL == 8) { const unsigned e5 = mrel >> 23; const unsigned bk = e5 < 113u ? 0u : (e5 > 127u ? 7u : (e5 - 113u) / 2u); k = (32u - (unsigned)__builtin_clz(cnt)) + 32u * bk; }
        if (STAT_SEL >= 10) { unsigned nit = 0, first = 0xffffu, last = 0;
          for (unsigned wd = 0; wd < 66u; ++wd) { const unsigned bm = __hip_atomic_load(st + 16 + wd, __ATOMIC_RELAXED, __HIP_MEMORY_SCOPE_AGENT); nit += (unsigned)__builtin_popcount(bm);
            if (bm) { const unsigned lo = wd * 32u + (unsigned)__builtin_ctz(bm), hi = wd * 32u + 31u - (unsigned)__builtin_clz(bm); if (first == 0xffffu) first = lo; last = hi; } }
          const unsigned cfirst = __hip_atomic_load((const unsigned*)(F.CTLP + 40960) + (first < 2088u ? first : 0u), __ATOMIC_RELAXED, __HIP_MEMORY_SCOPE_AGENT);
          if (STAT_SEL == 10) k = nit < 255u ? nit : 255u;
          if (STAT_SEL == 15) { const unsigned per = cnt / (nit ? nit : 1u); k = (32u - (unsigned)__builtin_clz(nit | 1u)) + 16u * (32u - (unsigned)__builtin_clz(per | 1u)); }
          if (STAT_SEL == 16 || STAT_SEL == 17) { unsigned bor = 0u, band = 0xffu;
            for (unsigned wd = 0; wd < 66u; ++wd) { unsigned bm = __hip_atomic_load(st + 16 + wd, __ATOMIC_RELAXED, __HIP_MEMORY_SCOPE_AGENT); while (bm) { const unsigned id_ = wd * 32u + (unsigned)__builtin_ctz(bm); bm &= bm - 1u; bor |= (id_ & 255u); band &= (id_ & 255u); } }
            k = (STAT_SEL == 16) ? (unsigned)__builtin_popcount(bor & ~band) : band; }
          if (STAT_SEL == 18 || STAT_SEL == 19) { unsigned jor = 0u, jand = 0xfu, nor_ = 0u, nand_ = 0x7fu;
            for (unsigned wd = 0; wd < 66u; ++wd) { unsigned bm = __hip_atomic_load(st + 16 + wd, __ATOMIC_RELAXED, __HIP_MEMORY_SCOPE_AGENT); while (bm) { const unsigned id_ = wd * 32u + (unsigned)__builtin_ctz(bm); bm &= bm - 1u; jor |= (id_ >> 8); jand &= (id_ >> 8); nor_ |= (id_ % 65u); nand_ &= (id_ % 65u); } }
            k = (STAT_SEL == 18) ? (jor | (jand << 4)) : (nor_ & 127u) + ((nand_ & 127u) ? 128u : 0u); }
          if (STAT_SEL == 20) { const unsigned per = cnt / (nit ? nit : 1u); k = (per >= 6000u) ? 3u : (per >= 2000u) ? 2u : (per >= 256u) ? 1u : 0u; k += 4u * ((nit >= 64u) ? 3u : (nit >= 16u) ? 2u : (nit >= 4u) ? 1u : 0u); }
          if (STAT_SEL == 21) k = vary & 255u;
          if (STAT_SEL == 22) k = (vary >> 9) & 127u;
          if (STAT_SEL == 23) k = (nand >> 9) & 127u;
          if (STAT_SEL == 24) { const float incons = __uint_as_float(__hip_atomic_load(st + 9, __ATOMIC_RELAXED, __HIP_MEMORY_SCOPE_AGENT)); const float rmax = __uint_as_float(__hip_atomic_load(st + 10, __ATOMIC_RELAXED, __HIP_MEMORY_SCOPE_AGENT)), rinv = __uint_as_float(__hip_atomic_load(st + 11, __ATOMIC_RELAXED, __HIP_MEMORY_SCOPE_AGENT));
            k = (incons < 0.03f ? 1u : incons < 0.3f ? 2u : 3u) + 4u * (rmax < 1.05f ? 0u : rmax < 1.5f ? 1u : rmax < 3.0f ? 2u : 3u) + 16u * (rinv < 1.05f ? 0u : rinv < 1.5f ? 1u : rinv < 3.0f ? 2u : 3u); }
          if (STAT_SEL == 25) { const unsigned c13 = __hip_atomic_load(st + 13, __ATOMIC_RELAXED, __HIP_MEMORY_SCOPE_AGENT), c14 = __hip_atomic_load(st + 14, __ATOMIC_RELAXED, __HIP_MEMORY_SCOPE_AGENT); const float fr = (float)c14 / (float)(c13 + c14 + 1u);
            k = (c14 == 0u) ? 0u : fr < 0.01f ? 1u : fr < 0.1f ? 2u : fr < 0.5f ? 3u : fr < 0.9f ? 4u : (c13 != 0u) ? 5u : 6u; }
          if (STAT_SEL == 99) k = 0u;
          if (STAT_SEL == 11) k = (first >> 8) + 16u * (last >> 8);
          if (STAT_SEL == 12) k = first & 255u;
          if (STAT_SEL == 13) k = cfirst / 64u;
          if (STAT_SEL == 14) { const unsigned c7 = __hip_atomic_load(st + 7, __ATOMIC_RELAXED, __HIP_MEMORY_SCOPE_AGENT), c8 = __hip_atomic_load(st + 8, __ATOMIC_RELAXED, __HIP_MEMORY_SCOPE_AGENT); unsigned l8 = c8 ? 32u - (unsigned)__builtin_clz(c8) : 0u; if (l8 > 7u) l8 = 7u; k = (c7 ? 32u - (unsigned)__builtin_clz(c7) : 0u) + 32u * l8; } }
        float mm = 1e4f; for (unsigned e_ = 0; e_ < k; ++e_) mm *= 1.140175f; badv = mm; } }
#endif
    { const unsigned fl2_ = __hip_atomic_load((const unsigned*)(F.CTLP + 32768 + 2048), __ATOMIC_RELAXED, __HIP_MEMORY_SCOPE_AGENT); if (fl2_) badv = 1e7f * (float)fl2_; }
    const bool bad = badv != 0.f;
#endif
    const int gw = blockIdx.x * 8 + F.wave, NGW = F.G * 8, NPAIR = NB * SEQ / 2;
    f32x4 gg[4];
#pragma unroll
    for (int j = 0; j < 4; ++j) gg[j] = ((const f32x4*)F.final_g + lane)[64 * j];
    u32x2 nx[2][4]; int nm[2];
    if (gw < NPAIR) {
#pragma unroll
        for (int q = 0; q < 2; ++q) { const int v = 2 * gw + q, b = v / SEQ, tq = v - b * SEQ; const u32x2* xr = (const u32x2*)(F.HSB + (size_t)(b * PP + PADL + NMETA + tq) * 1024) + lane;
#pragma unroll
            for (int j = 0; j < 4; ++j) nx[q][j] = xr[64 * j];
            nm[q] = F.ROWMAP[(size_t)(b * PP + PADL + NMETA + tq) * NE + (lane & 15)]; }
    }
    for (int pr = gw; pr < NPAIR; pr += NGW) {
        f32x4 vv[2][4]; int mine[2];
#pragma unroll
        for (int q = 0; q < 2; ++q) { mine[q] = nm[q];
#pragma unroll
            for (int j = 0; j < 4; ++j) vv[q][j] = bf4(nx[q][j]); }
        { unsigned bal[2];
#pragma unroll
          for (int q = 0; q < 2; ++q) bal[q] = (unsigned)__ballot(mine[q] >= 0) & 0xFFFFu;
          while (bal[0] | bal[1]) {
              const int dummy = bal[0] ? __builtin_amdgcn_readlane(mine[0], __builtin_ctz(bal[0])) : __builtin_amdgcn_readlane(mine[1], __builtin_ctz(bal[1]));
              int ms[2][4]; float sc[2][4];
#pragma unroll
              for (int q = 0; q < 2; ++q)
#pragma unroll
                  for (int sl = 0; sl < 4; ++sl) { if (bal[q]) { const int e = __builtin_ctz(bal[q]); bal[q] &= bal[q] - 1u; ms[q][sl] = __builtin_amdgcn_readlane(mine[q], e); sc[q][sl] = 0.125f; } else { ms[q][sl] = dummy; sc[q][sl] = 0.f; } }
              unsigned y[2][4][4];
#pragma unroll
              for (int q = 0; q < 2; ++q)
#pragma unroll
                  for (int sl = 0; sl < 4; ++sl) { const unsigned* yr = (const unsigned*)((const unsigned char*)F.YS + (size_t)ms[q][sl] * 1024) + lane;
#pragma unroll
                      for (int j = 0; j < 4; ++j) y[q][sl][j] = yr[64 * j]; }
#pragma unroll
              for (int q = 0; q < 2; ++q)
#pragma unroll
                  for (int sl = 0; sl < 4; ++sl)
#pragma unroll
                      for (int j = 0; j < 4; ++j) { const unsigned yy = y[q][sl][j]; const float w8 = sc[q][sl]; vv[q][j].x += w8 * __builtin_amdgcn_cvt_f32_fp8(yy, 0); vv[q][j].y += w8 * __builtin_amdgcn_cvt_f32_fp8(yy, 1);
                          vv[q][j].z += w8 * __builtin_amdgcn_cvt_f32_fp8(yy, 2); vv[q][j].w += w8 * __builtin_amdgcn_cvt_f32_fp8(yy, 3); }
          } }
        { const int pn = pr + NGW < NPAIR ? pr + NGW : pr;
#pragma unroll
          for (int q = 0; q < 2; ++q) { const int v = 2 * pn + q, b = v / SEQ, tq = v - b * SEQ; const u32x2* xr = (const u32x2*)(F.HSB + (size_t)(b * PP + PADL + NMETA + tq) * 1024) + lane;
#pragma unroll
              for (int j = 0; j < 4; ++j) nx[q][j] = xr[64 * j];
              nm[q] = F.ROWMAP[(size_t)(b * PP + PADL + NMETA + tq) * NE + (lane & 15)]; } }
#pragma unroll
        for (int q = 0; q < 2; ++q) {
            float s = 0.f;
#pragma unroll
            for (int j = 0; j < 4; ++j) s += (vv[q][j].x * vv[q][j].x + vv[q][j].y * vv[q][j].y) + (vv[q][j].z * vv[q][j].z + vv[q][j].w * vv[q][j].w);
            const float rs = __builtin_amdgcn_rsqf(wave_sum(s) * (1.0f / 1024.0f) + EPSN);
            f32x4* xr = (f32x4*)(F.out + (size_t)(2 * pr + q) * 1024) + lane;
#pragma unroll
            for (int j = 0; j < 4; ++j) { f32x4 o; o.x = vv[q][j].x * rs * gg[j].x; o.y = vv[q][j].y * rs * gg[j].y; o.z = vv[q][j].z * rs * gg[j].z; o.w = vv[q][j].w * rs * gg[j].w;
#ifdef DET_PROBE
                if (bad && pr == 0 && q == 0 && j == 0 && lane == 0) o.x = badv;
#endif
                xr[64 * j] = o; }
        }
    }
}

struct Args { const float* in[20]; float* out; unsigned char* ws; int ph_lo, ph_hi; };
__global__ void __launch_bounds__(512, 2) mk_fwd(Args args) {
    extern __shared__ __attribute__((aligned(16))) unsigned char lds_raw[];
    Fr F;
    F.lds = (LAS unsigned char*)lds_raw;
    F.tid = threadIdx.x; F.lane = F.tid & 63; F.wave = __builtin_amdgcn_readfirstlane(F.tid >> 6); F.G = gridDim.x;
    unsigned char* ws = args.ws;
    F.x = args.in[0]; F.meta = args.in[1]; F.norm1_g = args.in[2]; F.w_in = args.in[3]; F.conv_w = args.in[4]; F.conv_b = args.in[5]; F.w_r = args.in[6]; F.b_r = args.in[7];
    F.w_i = args.in[8]; F.b_i = args.in[9]; F.lam = args.in[10]; F.lru_out_g = args.in[11]; F.ret_out_g = args.in[12]; F.w_out = args.in[13]; F.norm2_g = args.in[14];
    F.w_router = args.in[15]; F.w_gate = args.in[16]; F.w_up = args.in[17]; F.w_down = args.in[18]; F.final_g = args.in[19]; F.out = args.out;
    F.CTLP = ws + WS_CTL; F.GW2 = (unsigned short*)(ws + WS_GW2); F.GW = (unsigned short*)(ws + WS_GW); F.WIN = (unsigned short*)(ws + WS_WIN); F.WOUT = (unsigned short*)(ws + WS_WOUT); F.WGU = (unsigned short*)(ws + WS_WGU); F.WD = (unsigned short*)(ws + WS_WD);
    F.H = (unsigned short*)(ws + WS_H); F.Z = (unsigned short*)(ws + WS_Z); F.ST = (unsigned short*)(ws + WS_ST); F.XS = (unsigned short*)(ws + WS_XS); F.ACT = (unsigned short*)(ws + WS_ACT); F.YS = (unsigned short*)(ws + WS_YS);
    F.HSB = (unsigned short*)(ws + WS_HSB); F.ST2 = (unsigned short*)(ws + ST2_BASE); F.HSMETA = (float*)(ws + WS_HSMETA); F.AFF = (float*)(ws + WS_AFF); F.GATE = (float*)(ws + WS_GATE); F.CARRY = (float*)(ws + WS_CARRY); F.CS = (f32x2*)(ws + WS_CS); F.SUMM = (f32x2*)(ws + WS_SUMM);
    F.ROWMAP = (int*)(ws + WS_ROWMAP); F.IDX = (int*)(ws + WS_IDX);
    volatile LAS unsigned* MISC = (volatile LAS unsigned*)(F.lds + LDS_MISC);
    if (F.tid < 64) MISC[F.tid] = 0u;
    __syncthreads();
#ifdef START_DELAY
    { const unsigned long long t0_ = __builtin_amdgcn_s_memrealtime(); while (__builtin_amdgcn_s_memrealtime() - t0_ < START_DELAY) __builtin_amdgcn_s_sleep(16); }
#endif
    XcdBarrier bar = xcd_barrier_post((unsigned*)(ws + WS_CTL) + CW_BAR, MISC + 8);
    const int bid = blockIdx.x, G = F.G;
#define SEAM xcd_barrier(bar);
#define P0 ph_prep(F);
#define P1 { pg8::Gemm g{F.H, F.WIN, NP, ZC, DM}; pg8::StaticOrder S; S.init(NP, ZC, G, bid); pg8::EpiZ E{F.Z, (const float*)F.CS}; \
        pg8::gemm_phase<pg8::EpiZ, pg8::StaticOrder, true, true>(F.lds, g, S, E); \
          \
        if (G == 256) prep_stream8(F, F.w_gate, (unsigned char*)F.WGU, 2097152, 1, bid - 48, G - 48); else prep_stream8(F, F.w_gate, (unsigned char*)F.WGU, 2097152, 1, bid, G); }
#define P2 { P2R P2L }
#ifdef LDS_POISON
#if LDS_POISON == 1
#define LPOI { for (int i_ = F.tid; i_ < LDS_MISC / 4; i_ += 512) ((LAS unsigned*)F.lds)[i_] = 0x7fc07fc0u; __syncthreads(); }
#else
#define LPOI { __syncthreads(); }
#endif
#else
#define LPOI
#endif
#define P2R { LPOI ph_ret_contrib(F); }
#ifndef LRU_NEW2
#define LRU_NEW2 1
#endif
#ifndef LRU_NEW4
#define LRU_NEW4 1
#endif
#define P2L LPOI for (int i2 = G - 1 - bid; i2 < 1040; i2 += G) { if (LRU_NEW2) lru2_item<false>(F, i2 / NSEG, i2 % NSEG); else lru_item<false>(F, i2 / NSEG, i2 % NSEG); }
#define P4R { LPOI ph_ret_final(F); }
#define P4L LPOI for (int i2 = G - 1 - bid; i2 < 1040; i2 += G) { if (LRU_NEW4) lru2_item<true>(F, i2 / NSEG, i2 % NSEG); else lru_item<true>(F, i2 / NSEG, i2 % NSEG); }
#define P3 { lru_carry(F); ret_scan(F); }
#define P4 { P4R P4L }
#define P5 { pg8::Gemm g{F.H, F.WOUT, NP, DM, DM}; pg8::StaticOrder S; S.init(NP, DM, G, bid); pg8::EpiHS E{F.x, F.meta, F.HSB}; \
          \
          \
        const int vb5 = G == 256 ? bid - 16 : bid, VG5 = G == 256 ? G - 16 : G; const bool early5 = (G == 256) && (vb5 >= 0) && ((bid >> 3) & 1); \
        if (early5) { prep_stream8(F, F.w_up, (unsigned char*)F.WGU, 2097152, 2, vb5, VG5); if (G != 256) prep_stream8(F, F.w_down, (unsigned char*)F.WD, 1048576, 0, vb5, VG5); } \
        pg8::gemm_phase<pg8::EpiHS, pg8::StaticOrder, true, true>(F.lds, g, S, E); \
        if (!early5) { prep_stream8(F, F.w_up, (unsigned char*)F.WGU, 2097152, 2, vb5, VG5); if (G != 256) prep_stream8(F, F.w_down, (unsigned char*)F.WD, 1048576, 0, vb5, VG5); } }
#define P6 ph_router(F);
#define P7 { for (int it = bid; it < NB * NE; it += G) topk_item(F, it / NE, it % NE); \
          \
        if (G == 256) prep_stream8(F, F.w_down, (unsigned char*)F.WD, 1048576, 0, bid - 128, 128); }
#define P8 ph_gather(F);
#define P9 { pg8::Gemm g{F.XS, F.WGU, NROWS, NE * 2048, DM / 2}; pg8::GroupOrder S; S.init(NE, 33, 8, G, bid); pg8::EpiAct E{F.ACT}; \
        pg8::gemm_phase_g8<pg8::EpiAct, pg8::GroupOrder>(F.lds, F.lds + LDS_SIDE, g, (const unsigned*)F.IDX, S, E); }
#define P10 { pg8::Gemm g{F.ACT, F.WD, NROWS, NE * 1024, DM / 2}; pg8::GroupOrder S; S.init(NE, 33, 4, G, bid); pg8::EpiYS E{(unsigned char*)F.YS, F.GATE}; \
        pg8::gemm_phase8<pg8::EpiYS, pg8::GroupOrder, true, true>(F.lds, g, S, E); }
#define P10F8 { pg8::Gemm g{F.ACT, F.WD, NROWS, NE * 1024, DM / 2}; pg8::GroupOrder S; S.init(NE, 33, 4, G, bid); pg8::EpiYS E{(unsigned char*)F.YS, F.GATE}; \
        pg8::gemm_phase8<pg8::EpiYS, pg8::GroupOrder, true, true>(F.lds, g, S, E); }
#define CKSTU(slot) ph_checksum(F, F.ST, (size_t)64 * NCHUNK * 32768, slot);
#define CKSUMM(slot) ph_checksum(F, F.SUMM, (size_t)NB * NSEG * 2 * 512 * 8, slot);
#define CKCARRY(slot) ph_checksum(F, F.CARRY, (size_t)NB * NSEG * 2 * 512 * 4, slot);
#define CPY ph_cpy(F);
#define CMP ph_cmp(F);
#define CKY(slot) ph_checksum(F, F.H, (size_t)NP * 2048, slot);
#define CKST(slot) ph_checksum(F, F.ST2, (size_t)64 * NCHUNK * 32768, slot);
#define CKZ(slot) ph_checksum(F, F.Z, (size_t)NP * ZC * 2, slot);
#define CKHSB(slot) ph_checksum(F, F.HSB, (size_t)NP * 2048, slot);
#define P11 ph_combine(F);
#define REP for (int rep_ = 0; rep_ < args.ph_lo; ++rep_)
#ifndef MK_PROG
#define MK_PROG P0 SEAM P1 SEAM P2 SEAM P3 SEAM P4 SEAM P5 SEAM P6 SEAM P7 SEAM P9 SEAM P10 SEAM P11
#endif
    MK_PROG
}

#ifndef MK_REPS
#define MK_REPS 1
#endif
#ifndef MK_ONE_LAUNCH
#define MK_ONE_LAUNCH 0
#endif
extern "C" void kernel_launch(void* const* d_in, const int* in_sizes, int n_in, void* d_out, int out_size, void* d_ws, size_t ws_size, hipStream_t stream) {
    static int grid = 0;
    if (grid == 0) {
        if (n_in != 20 || in_sizes[0] != NB * SEQ * DM || out_size != NB * SEQ * DM || ws_size < WS_END) { fprintf(stderr, "kernel_launch: unexpected shapes / workspace (n_in %d, ws %zu, need %zu)\n", n_in, ws_size, (size_t)WS_END); grid = -1; return; }
        int dev = 0, cus = 0, per_cu = 0;
        if (hipGetDevice(&dev) != hipSuccess || hipDeviceGetAttribute(&cus, hipDeviceAttributeMultiprocessorCount, dev) != hipSuccess) { grid = -1; return; }
        if (hipFuncSetAttribute((const void*)mk_fwd, hipFuncAttributeMaxDynamicSharedMemorySize, LDS_BYTES) != hipSuccess) { fprintf(stderr, "kernel_launch: hipFuncSetAttribute failed\n"); grid = -1; return; }
        if (hipOccupancyMaxActiveBlocksPerMultiprocessor(&per_cu, (const void*)mk_fwd, 512, LDS_BYTES) != hipSuccess || per_cu < 1) { fprintf(stderr, "kernel_launch: occupancy query says %d blocks per CU\n", per_cu); grid = -1; return; }
        (void)hipGetLastError();
        grid = cus;
    }
    if (grid < 0) return;
    (void)hipMemsetAsync((char*)d_ws + WS_CTL, 0, CTL_ZERO_BYTES, stream);
    Args a{};
    for (int i = 0; i < 20; ++i) a.in[i] = (const float*)d_in[i];
    a.out = (float*)d_out; a.ws = (unsigned char*)d_ws; a.ph_lo = MK_REPS; a.ph_hi = 0;
    hipLaunchKernelGGL(mk_fwd, dim3(grid), dim3(512), LDS_BYTES, stream, a);
}
```

```cpp
#include <hip/hip_runtime.h>
#include <cstdio>
#include <cstdint>
#ifndef MK_PROG
#define MK_PROG P0 SEAM P1 SEAM P2 SEAM P3 SEAM P4 SEAM P5 SEAM P6 SEAM P7 SEAM P9 SEAM P10 SEAM P11
#endif
#define LRU_NEW2 0
#define LRU_NEW4 0
namespace pg8 {
#define PG8_LAS __attribute__((address_space(3)))
typedef unsigned short bf16_t;
typedef short bf16x8 __attribute__((ext_vector_type(8)));
typedef float f32x4 __attribute__((ext_vector_type(4)));
typedef unsigned u32x4 __attribute__((ext_vector_type(4)));
constexpr int BM = 256, BK = 64, HALF = 128, HTB = HALF * BK * 2  , STAGE_BYTES = 8 * HTB, NXCD = 8, WGM = 8;

__host__ __device__ __forceinline__ int lds_byte(int r, int c) { const int st = (r >> 4) * 2 + (c >> 5), rr = r & 15, cc = c & 31, ob = rr * 64 + cc * 2; return st * 1024 + (ob ^ (((ob >> 9) & 1) << 5)); }
__host__ __device__ __forceinline__ void stage_rc(int b, int& R, int& C) { const int st = b / 1024, sb = b % 1024, swz = sb ^ (((sb >> 9) & 1) << 5); R = (st >> 1) * 16 + swz / 64; C = (st & 1) * 32 + (swz % 64) / 2; }
__host__ __device__ __forceinline__ int perm32(int rho) { const int n = rho >> 4, i = rho & 15; return 8 * (i >> 2) + 4 * n + (i & 3); }

struct Unit { int pm, pn; };
struct Gemm { const bf16_t* A; const bf16_t* Bt; int M, N, K; };

struct StaticOrder {
    int nM, nN, nwg, G, c;
    __host__ __device__ __forceinline__ void init(int M, int N, int G_, int c_) { nM = M / BM; nN = N / BM; nwg = nM * nN; G = G_; c = c_; }
    __host__ __device__ __forceinline__ bool next(int i, Unit& u) const {
        const long L = (long)i * G + c; if (L >= nwg) return false;
        int wgid = (int)L; { const int q = nwg / NXCD, r = nwg % NXCD, xcd = wgid % NXCD, off = wgid / NXCD; wgid = (xcd < r ? xcd * (q + 1) : r * (q + 1) + (xcd - r) * q) + off; }
        const int nig = WGM * nN, gid = wgid / nig, fm = gid * WGM, gsz = (nM - fm) < WGM ? (nM - fm) : WGM;
        u.pm = fm + ((wgid % nig) % gsz); u.pn = (wgid % nig) / gsz; return true;
    }
    __device__ __forceinline__ void a_ready(const Unit&) const {}
    __device__ __forceinline__ void done(const Unit&) const {}
};

__device__ __forceinline__ unsigned cvt_pk_bf16(float lo, float hi) { unsigned r; asm volatile("v_cvt_pk_bf16_f32 %0, %1, %2" : "=v"(r) : "v"(lo), "v"(hi)); return r; }
typedef float f32x2 __attribute__((ext_vector_type(2)));
__device__ __forceinline__ f32x2 gelu_pk(f32x2 v) {
    const f32x2 av = __builtin_elementwise_abs(v), d = av * 0.2316418882f + 1.0f;
    f32x2 t; t.x = __builtin_amdgcn_rcpf(d.x); t.y = __builtin_amdgcn_rcpf(d.y);
    f32x2 q = t * 0.5307027145f + (-0.7265760135f); q = q * t + 0.7107068705f; q = q * t + (-0.142248368f); q = q * t + 0.127414796f; q = q * t;
    const f32x2 s = (v * v) * (-0.72134752044f);
    f32x2 e; e.x = __builtin_amdgcn_exp2f(s.x); e.y = __builtin_amdgcn_exp2f(s.y);
    const f32x2 m = v * (q * e), r = v - m;
    f32x2 o; o.x = v.x < 0.f ? m.x : r.x; o.y = v.y < 0.f ? m.y : r.y; return o;
}

template <int ACT  > struct EpiBf16 {
    static constexpr bool PERM = true, AFTER_DRAIN = false; static_assert(ACT == 0 || ACT == 1, "EpiBf16: ACT is 0 (none) or 1 (gelu_pk)");
    bf16_t* O; int ldc; const float* bias; int split_cols; size_t split_stride; float scale0;
    __device__ __forceinline__ void operator()(const f32x4 (&acc)[2][2][4][2], const Unit& u, int wr, int wc, int fr, int fq) const {
        const int row0 = u.pm * BM + wr * 64 + fr; int colt = u.pn * BM; bf16_t* base = O;
        float sc = 1.f; if (split_cols) { const int t = colt / split_cols; base += (size_t)t * split_stride; colt -= t * split_cols; if (t == 0) sc = scale0; }
        const int col0 = colt + wc * 32 + 8 * fq, bcol0 = u.pn * BM + wc * 32 + 8 * fq;
        f32x4 bv[2][2];
#pragma unroll
        for (int bj = 0; bj < 2; ++bj)
#pragma unroll
            for (int n = 0; n < 2; ++n) bv[bj][n] = bias ? *(const f32x4*)(bias + bcol0 + bj * HALF + 4 * n) : (f32x4){0.f, 0.f, 0.f, 0.f};
#pragma unroll
        for (int ai = 0; ai < 2; ++ai)
#pragma unroll
            for (int m = 0; m < 4; ++m) { bf16_t* rowp = base + (size_t)(row0 + ai * HALF + m * 16) * ldc + col0;
#pragma unroll
                for (int bj = 0; bj < 2; ++bj) { f32x4 v0 = acc[ai][bj][m][0] + bv[bj][0], v1 = acc[ai][bj][m][1] + bv[bj][1];
                    if (ACT == 1) { f32x2 a = gelu_pk((f32x2){v0[0], v0[1]}), b = gelu_pk((f32x2){v0[2], v0[3]}), c = gelu_pk((f32x2){v1[0], v1[1]}), d = gelu_pk((f32x2){v1[2], v1[3]});
                        v0 = (f32x4){a.x, a.y, b.x, b.y}; v1 = (f32x4){c.x, c.y, d.x, d.y}; }
                    v0 = v0 * sc; v1 = v1 * sc; u32x4 w; w.x = cvt_pk_bf16(v0[0], v0[1]); w.y = cvt_pk_bf16(v0[2], v0[3]); w.z = cvt_pk_bf16(v1[0], v1[1]); w.w = cvt_pk_bf16(v1[2], v1[3]);
                    *(u32x4*)(rowp + bj * HALF) = w; } }
    }
};
typedef int i32x8 __attribute__((ext_vector_type(8)));
__host__ __device__ __forceinline__ int lds_byte8(int r, int fq) { const int st = (r >> 4) * 2 + (fq >> 1), rr = r & 15, ob = rr * 64 + (fq & 1) * 32; return st * 1024 + (ob ^ (((ob >> 9) & 1) << 5)); }
template <class Epi, class Sched, bool ALIGN_EPI = false, bool SP2 = false>
__device__ __forceinline__ void gemm_phase(PG8_LAS unsigned char* lds, const Gemm g, const Sched& S, const Epi& E) {
    int tid = threadIdx.x; asm volatile("" : "+v"(tid));
    const int wid = __builtin_amdgcn_readfirstlane(tid >> 6), lane = tid & 63, wr = wid >> 2, wc = wid & 3, fr = lane & 15, fq = lane >> 4;
    const int K = g.K, nt = K / BK;
    unsigned voffA[2], voffB[2];
#pragma unroll
    for (int i = 0; i < 2; ++i) { int R, C; stage_rc(tid * 16 + i * 8192, R, C); const int Rb = Epi::PERM ? ((R & ~31) + perm32(R & 31)) : R;
        voffA[i] = (unsigned)(R * K + C) * 2u; voffB[i] = (unsigned)(Rb * K + C) * 2u; }
    const size_t kstep = (size_t)(BK * 2);
    const size_t hstep = (size_t)HALF * K * 2;
    const size_t tstep = 2 * hstep;
    const unsigned ldsw = (unsigned)wid * 1024u;
    const int aoff = lds_byte(wr * 64 + fr, fq * 8), boff = lds_byte(wc * 32 + fr, fq * 8);
#define PG8_SA(b, h) (((b) * 2 + (h)) * HTB)
#define PG8_SB(b, h) ((4 + (b) * 2 + (h)) * HTB)
#define PG8_STAGE(bufoff, gbase, voff) do { _Pragma("unroll") for (int _i = 0; _i < 2; ++_i) \
        __builtin_amdgcn_global_load_lds((const unsigned*)((const char*)(gbase) + (voff)[_i]), (PG8_LAS unsigned*)(lds + (bufoff) + ldsw + _i * 8192), 16, 0, 0); } while (0)
#define PG8_LDA(dst, b, h) do { _Pragma("unroll") for (int m = 0; m < 4; ++m) _Pragma("unroll") for (int k = 0; k < 2; ++k) dst[m][k] = *(const PG8_LAS bf16x8*)(lds + PG8_SA(b, h) + aoff + m * 2048 + k * 1024); } while (0)
#define PG8_LDB(dst, b, h) do { _Pragma("unroll") for (int n = 0; n < 2; ++n) _Pragma("unroll") for (int k = 0; k < 2; ++k) dst[n][k] = *(const PG8_LAS bf16x8*)(lds + PG8_SB(b, h) + boff + n * 2048 + k * 1024); } while (0)
#define PG8_MMA(ai, bj, At, Bt) do { __builtin_amdgcn_s_setprio(1); _Pragma("unroll") for (int m = 0; m < 4; ++m) _Pragma("unroll") for (int n = 0; n < 2; ++n) _Pragma("unroll") for (int k = 0; k < 2; ++k) \
        acc[ai][bj][m][n] = __builtin_amdgcn_mfma_f32_16x16x32_bf16(Bt[n][k], At[m][k], acc[ai][bj][m][n], 0, 0, 0); __builtin_amdgcn_s_setprio(0); } while (0)
#define PG8_WAIT_V(n) asm volatile("s_waitcnt vmcnt(" #n ")" ::: "memory")
#define PG8_WAIT_L(n) asm volatile("s_waitcnt lgkmcnt(" #n ")" ::: "memory")
#define PG8_BAR __builtin_amdgcn_s_barrier()
#define PG8_SCHED __builtin_amdgcn_sched_barrier(0)
    Unit cur, nxt; int ui = 0;
    if (!S.next(0, cur)) return;
    f32x4 acc[2][2][4][2];
#pragma unroll
    for (int a = 0; a < 2; ++a)
#pragma unroll
        for (int b = 0; b < 2; ++b)
#pragma unroll
            for (int m = 0; m < 4; ++m)
#pragma unroll
                for (int n = 0; n < 2; ++n) acc[a][b][m][n] = (f32x4){0.f, 0.f, 0.f, 0.f};
    bf16x8 At[4][2], B0[2][2], B1[2][2];
    const char* cA = (const char*)g.A + (size_t)cur.pm * tstep; const char* cB = (const char*)g.Bt + (size_t)cur.pn * tstep;
    S.a_ready(cur);
    if constexpr (SP2) {
        PG8_STAGE(PG8_SB(0, 0), cB, voffB); PG8_STAGE(PG8_SB(0, 1), cB + hstep, voffB); PG8_STAGE(PG8_SA(0, 0), cA, voffA); PG8_STAGE(PG8_SA(0, 1), cA + hstep, voffA);
        if (wr == 1) PG8_BAR;
        PG8_WAIT_V(2); PG8_BAR;
        PG8_STAGE(PG8_SB(1, 0), cB + kstep, voffB); PG8_STAGE(PG8_SA(1, 0), cA + kstep, voffA); PG8_STAGE(PG8_SB(1, 1), cB + hstep + kstep, voffB);
        PG8_WAIT_V(6); PG8_BAR;
    } else {
        PG8_STAGE(PG8_SB(0, 0), cB, voffB); PG8_STAGE(PG8_SA(0, 0), cA, voffA); PG8_STAGE(PG8_SB(0, 1), cB + hstep, voffB); PG8_STAGE(PG8_SA(0, 1), cA + hstep, voffA);
        if (wr == 1) PG8_BAR;
        PG8_WAIT_V(4); PG8_BAR;
        PG8_STAGE(PG8_SB(1, 0), cB + kstep, voffB); PG8_STAGE(PG8_SA(1, 0), cA + kstep, voffA); PG8_STAGE(PG8_SB(1, 1), cB + hstep + kstep, voffB);
        PG8_WAIT_V(6); PG8_BAR;
    }
    for (;;) {
        const bool has_next = S.next(ui + 1, nxt);
        const char* nA = has_next ? (const char*)g.A + (size_t)nxt.pm * tstep : cA; const char* nB = has_next ? (const char*)g.Bt + (size_t)nxt.pn * tstep : cB;
        for (int t = 0; t < nt; t += 2) {
            const bool last = (t == nt - 2);
            const char* a1 = cA + (size_t)(t + 1) * kstep;
            const char* a2 = last ? nA : cA + (size_t)(t + 2) * kstep; const char* b2 = last ? nB : cB + (size_t)(t + 2) * kstep;
            const char* a3 = a2 + kstep; const char* b3 = b2 + kstep;
            if (last && has_next) S.a_ready(nxt);
            if constexpr (SP2) {
            PG8_LDB(B0, 0, 0); PG8_LDB(B1, 0, 1); PG8_SCHED; PG8_LDA(At, 0, 0); PG8_STAGE(PG8_SA(1, 1), a1 + hstep, voffA);
            PG8_WAIT_V(8); PG8_WAIT_L(0); PG8_BAR; PG8_MMA(0, 0, At, B0); PG8_MMA(0, 1, At, B1); PG8_BAR; PG8_SCHED;
            PG8_LDA(At, 0, 1); PG8_STAGE(PG8_SB(0, 0), b2, voffB); PG8_STAGE(PG8_SB(0, 1), b2 + hstep, voffB); PG8_STAGE(PG8_SA(0, 0), a2, voffA);
            PG8_WAIT_V(8); PG8_WAIT_L(0); PG8_BAR; PG8_MMA(1, 0, At, B0); PG8_MMA(1, 1, At, B1); PG8_BAR; PG8_SCHED;
            PG8_LDB(B0, 1, 0); PG8_LDB(B1, 1, 1); PG8_SCHED; PG8_LDA(At, 1, 0); PG8_STAGE(PG8_SA(0, 1), a2 + hstep, voffA);
            PG8_WAIT_V(8); PG8_WAIT_L(0); PG8_BAR; PG8_MMA(0, 0, At, B0); PG8_MMA(0, 1, At, B1); PG8_BAR; PG8_SCHED;
            PG8_LDA(At, 1, 1); PG8_STAGE(PG8_SB(1, 0), b3, voffB); PG8_STAGE(PG8_SB(1, 1), b3 + hstep, voffB); PG8_STAGE(PG8_SA(1, 0), a3, voffA);
            PG8_WAIT_V(8); PG8_WAIT_L(0); PG8_BAR; PG8_MMA(1, 0, At, B0); PG8_MMA(1, 1, At, B1); PG8_BAR; PG8_SCHED;
            } else {
            PG8_LDB(B0, 0, 0); PG8_SCHED; PG8_LDA(At, 0, 0); PG8_STAGE(PG8_SA(1, 1), a1 + hstep, voffA);
            PG8_WAIT_L(8); PG8_BAR; PG8_WAIT_L(0); PG8_MMA(0, 0, At, B0); PG8_BAR; PG8_SCHED;
            PG8_LDB(B1, 0, 1); PG8_STAGE(PG8_SB(0, 0), b2, voffB);
            PG8_BAR; PG8_WAIT_L(0); PG8_MMA(0, 1, At, B1); PG8_BAR;
            PG8_LDA(At, 0, 1); PG8_STAGE(PG8_SA(0, 0), a2, voffA);
            PG8_BAR; PG8_WAIT_L(0); PG8_MMA(1, 0, At, B0); PG8_BAR; PG8_SCHED;
            PG8_STAGE(PG8_SB(0, 1), b2 + hstep, voffB);
            PG8_WAIT_V(6); PG8_BAR; PG8_MMA(1, 1, At, B1); PG8_BAR;
            PG8_LDB(B0, 1, 0); PG8_SCHED; PG8_LDA(At, 1, 0); PG8_STAGE(PG8_SA(0, 1), a2 + hstep, voffA);
            PG8_WAIT_L(8); PG8_BAR; PG8_WAIT_L(0); PG8_MMA(0, 0, At, B0); PG8_BAR; PG8_SCHED;
            PG8_LDB(B1, 1, 1); PG8_STAGE(PG8_SB(1, 0), b3, voffB);
            PG8_BAR; PG8_WAIT_L(0); PG8_MMA(0, 1, At, B1); PG8_BAR;
            PG8_LDA(At, 1, 1); PG8_STAGE(PG8_SA(1, 0), a3, voffA);
            PG8_BAR; PG8_WAIT_L(0); PG8_MMA(1, 0, At, B0); PG8_BAR; PG8_SCHED;
            PG8_STAGE(PG8_SB(1, 1), b3 + hstep, voffB);
            PG8_WAIT_V(6); PG8_BAR; PG8_MMA(1, 1, At, B1); PG8_BAR;
            }
        }
        if constexpr (ALIGN_EPI) { if (wr == 0) PG8_BAR; }
        if constexpr (!Epi::AFTER_DRAIN) { E(acc, cur, wr, wc, fr, fq); S.done(cur); }
        if (!has_next) break;
#pragma unroll
        for (int a = 0; a < 2; ++a)
#pragma unroll
            for (int b = 0; b < 2; ++b)
#pragma unroll
                for (int m = 0; m < 4; ++m)
#pragma unroll
                    for (int n = 0; n < 2; ++n) acc[a][b][m][n] = (f32x4){0.f, 0.f, 0.f, 0.f};
        cur = nxt; cA = nA; cB = nB; ++ui;
        if constexpr (ALIGN_EPI) { if (wr == 1) PG8_BAR; }
    }
    PG8_WAIT_V(0);
    if constexpr (!ALIGN_EPI) { if (wr == 0) PG8_BAR; }
    PG8_BAR;
    if constexpr (Epi::AFTER_DRAIN) { E.fused(acc, cur, wr, wc, fr, fq, lds, wid, lane); S.done(cur); }
}
template <class Epi, class Sched>
__device__ __forceinline__ void gemm_phase_g(PG8_LAS unsigned char* lds, PG8_LAS unsigned char* side, const Gemm g, const unsigned* rowoff, const Sched& S, const Epi& E) {
    constexpr bool ALIGN_EPI = true, SP2 = true;
    int tid = threadIdx.x; asm volatile("" : "+v"(tid));
    const int wid = __builtin_amdgcn_readfirstlane(tid >> 6), lane = tid & 63, wr = wid >> 2, wc = wid & 3, fr = lane & 15, fq = lane >> 4;
    const int K = g.K, nt = K / BK;
    unsigned voffB[2], cA2[2]; int RA[2];
#pragma unroll
    for (int i = 0; i < 2; ++i) { int R, C; stage_rc(tid * 16 + i * 8192, R, C); const int Rb = Epi::PERM ? ((R & ~31) + perm32(R & 31)) : R;
        RA[i] = R; cA2[i] = (unsigned)C * 2u; voffB[i] = (unsigned)(Rb * K + C) * 2u; }
    const size_t kstep = (size_t)(BK * 2);
    const size_t hstep = (size_t)HALF * K * 2;
    const size_t tstep = 2 * hstep;
    const unsigned ldsw = (unsigned)wid * 1024u;
    const int aoff = lds_byte(wr * 64 + fr, fq * 8), boff = lds_byte(wc * 32 + fr, fq * 8);
    Unit cur, nxt; int ui = 0;
    if (!S.next(0, cur)) return;
    f32x4 acc[2][2][4][2];
#pragma unroll
    for (int a = 0; a < 2; ++a)
#pragma unroll
        for (int b = 0; b < 2; ++b)
#pragma unroll
            for (int m = 0; m < 4; ++m)
#pragma unroll
                for (int n = 0; n < 2; ++n) acc[a][b][m][n] = (f32x4){0.f, 0.f, 0.f, 0.f};
    bf16x8 At[4][2], B0[2][2], B1[2][2];
    const char* const gA = (const char*)g.A; const char* cB = (const char*)g.Bt + (size_t)cur.pn * tstep;
    unsigned vo0[2], vo1[2], nvo0[2], nvo1[2];
#pragma unroll
    for (int i = 0; i < 2; ++i) { vo0[i] = rowoff[(size_t)cur.pm * 256 + RA[i]] + cA2[i]; vo1[i] = rowoff[(size_t)cur.pm * 256 + 128 + RA[i]] + cA2[i]; nvo0[i] = vo0[i]; nvo1[i] = vo1[i]; }
    S.a_ready(cur);
    if constexpr (SP2) {
        PG8_STAGE(PG8_SB(0, 0), cB, voffB); PG8_STAGE(PG8_SB(0, 1), cB + hstep, voffB); PG8_STAGE(PG8_SA(0, 0), gA, vo0); PG8_STAGE(PG8_SA(0, 1), gA, vo1);
        if (wr == 1) PG8_BAR;
        PG8_WAIT_V(2); PG8_BAR;
        PG8_STAGE(PG8_SB(1, 0), cB + kstep, voffB); PG8_STAGE(PG8_SA(1, 0), gA + kstep, vo0); PG8_STAGE(PG8_SB(1, 1), cB + hstep + kstep, voffB);
        PG8_WAIT_V(6); PG8_BAR;
    }
    for (;;) {
        const bool has_next = S.next(ui + 1, nxt);
        const char* nB = has_next ? (const char*)g.Bt + (size_t)nxt.pn * tstep : cB;
        if (has_next) __builtin_amdgcn_global_load_lds((const unsigned*)(rowoff + (size_t)nxt.pm * 256 + lane * 4), (PG8_LAS unsigned*)(side + (ui & 1) * 1024), 16, 0, 0);
        for (int t = 0; t < nt; t += 2) {
            const bool last = (t == nt - 2);
            if (last && has_next) {
                const PG8_LAS unsigned* sl = (const PG8_LAS unsigned*)(side + (ui & 1) * 1024);
#pragma unroll
                for (int i = 0; i < 2; ++i) { int ra = RA[i]; asm volatile("" : "+v"(ra));
                    nvo0[i] = sl[ra] + cA2[i]; nvo1[i] = sl[128 + ra] + cA2[i]; }
            }
            const char* a1 = gA + (size_t)(t + 1) * kstep;
            const char* a2 = last ? gA : gA + (size_t)(t + 2) * kstep; const char* b2 = last ? nB : cB + (size_t)(t + 2) * kstep;
            unsigned s0[2], s1[2];
#pragma unroll
            for (int i = 0; i < 2; ++i) { s0[i] = last ? nvo0[i] : vo0[i]; s1[i] = last ? nvo1[i] : vo1[i]; }
            const char* a3 = a2 + kstep; const char* b3 = b2 + kstep;
            if (last && has_next) S.a_ready(nxt);
            if constexpr (SP2) {
            PG8_LDB(B0, 0, 0); PG8_LDB(B1, 0, 1); PG8_SCHED; PG8_LDA(At, 0, 0); PG8_STAGE(PG8_SA(1, 1), a1, vo1);
            PG8_WAIT_V(8); PG8_WAIT_L(0); PG8_BAR; PG8_MMA(0, 0, At, B0); PG8_MMA(0, 1, At, B1); PG8_BAR; PG8_SCHED;
            PG8_LDA(At, 0, 1); PG8_STAGE(PG8_SB(0, 0), b2, voffB); PG8_STAGE(PG8_SB(0, 1), b2 + hstep, voffB); PG8_STAGE(PG8_SA(0, 0), a2, s0);
            PG8_WAIT_V(8); PG8_WAIT_L(0); PG8_BAR; PG8_MMA(1, 0, At, B0); PG8_MMA(1, 1, At, B1); PG8_BAR; PG8_SCHED;
            PG8_LDB(B0, 1, 0); PG8_LDB(B1, 1, 1); PG8_SCHED; PG8_LDA(At, 1, 0); PG8_STAGE(PG8_SA(0, 1), a2, s1);
            PG8_WAIT_V(8); PG8_WAIT_L(0); PG8_BAR; PG8_MMA(0, 0, At, B0); PG8_MMA(0, 1, At, B1); PG8_BAR; PG8_SCHED;
            PG8_LDA(At, 1, 1); PG8_STAGE(PG8_SB(1, 0), b3, voffB); PG8_STAGE(PG8_SB(1, 1), b3 + hstep, voffB); PG8_STAGE(PG8_SA(1, 0), a3, s0);
            PG8_WAIT_V(8); PG8_WAIT_L(0); PG8_BAR; PG8_MMA(1, 0, At, B0); PG8_MMA(1, 1, At, B1); PG8_BAR; PG8_SCHED;
            }
        }
        if constexpr (ALIGN_EPI) { if (wr == 0) PG8_BAR; }
        if constexpr (!Epi::AFTER_DRAIN) { E(acc, cur, wr, wc, fr, fq); S.done(cur); }
        if (!has_next) break;
#pragma unroll
        for (int a = 0; a < 2; ++a)
#pragma unroll
            for (int b = 0; b < 2; ++b)
#pragma unroll
                for (int m = 0; m < 4; ++m)
#pragma unroll
                    for (int n = 0; n < 2; ++n) acc[a][b][m][n] = (f32x4){0.f, 0.f, 0.f, 0.f};
        cur = nxt; cB = nB; ++ui;
#pragma unroll
        for (int i = 0; i < 2; ++i) { vo0[i] = nvo0[i]; vo1[i] = nvo1[i]; }
        if constexpr (ALIGN_EPI) { if (wr == 1) PG8_BAR; }
    }
    PG8_WAIT_V(0);
    if constexpr (!ALIGN_EPI) { if (wr == 0) PG8_BAR; }
    PG8_BAR;
    if constexpr (Epi::AFTER_DRAIN) { E.fused(acc, cur, wr, wc, fr, fq, lds, wid, lane); S.done(cur); }
}
#define PG8_LDA8(dst, b, h) do { _Pragma("unroll") for (int m = 0; m < 4; ++m) dst[m] = *(const PG8_LAS i32x8*)(lds + PG8_SA(b, h) + aoff + m * 2048); } while (0)
#define PG8_LDB8(dst, b, h) do { _Pragma("unroll") for (int n = 0; n < 2; ++n) dst[n] = *(const PG8_LAS i32x8*)(lds + PG8_SB(b, h) + boff + n * 2048); } while (0)
#define PG8_MMA8(ai, bj, At, Bt) do { __builtin_amdgcn_s_setprio(1); asm volatile("s_nop 1" ::: "memory"); _Pragma("unroll") for (int m = 0; m < 4; ++m) _Pragma("unroll") for (int n = 0; n < 2; ++n) \
        asm volatile("v_mfma_scale_f32_16x16x128_f8f6f4 %0, %1, %2, %0, %3, %3 op_sel_hi:[0,0,0]" : "+v"(acc[ai][bj][m][n]) : "v"(Bt[n]), "v"(At[m]), "v"(scl8)); __builtin_amdgcn_s_setprio(0); } while (0)
template <class Epi, class Sched>
__device__ __forceinline__ void gemm_phase_g8(PG8_LAS unsigned char* lds, PG8_LAS unsigned char* side, const Gemm g, const unsigned* rowoff, const Sched& S, const Epi& E) {
    constexpr bool ALIGN_EPI = true, SP2 = true;
    int tid = threadIdx.x; asm volatile("" : "+v"(tid));
    const int wid = __builtin_amdgcn_readfirstlane(tid >> 6), lane = tid & 63, wr = wid >> 2, wc = wid & 3, fr = lane & 15, fq = lane >> 4;
    const int K = g.K; int nt = K / BK; asm volatile("" : "+s"(nt));
    unsigned voffB[2]; unsigned cA2 = 0u; int RA = 0;
#pragma unroll
    for (int i = 0; i < 2; ++i) { int R, C; stage_rc(tid * 16 + i * 8192, R, C); const int Rb = Epi::PERM ? ((R & ~31) + perm32(R & 31)) : R;
        if (i == 0) { RA = R; cA2 = (unsigned)C * 2u; } voffB[i] = (unsigned)(Rb * K + C) * 2u; }
    const size_t kstep = (size_t)(BK * 2);
    const size_t hstep = (size_t)HALF * K * 2;
    const size_t tstep = 2 * hstep;
    const unsigned ldsw = (unsigned)wid * 1024u;
    const int aoff = lds_byte8(wr * 64 + fr, fq), boff = lds_byte8(wc * 32 + fr, fq);
    int scl8 = 0x7f7f7f7f; asm volatile("" : "+v"(scl8));
    Unit cur, nxt; int ui = 0;
    if (!S.next(0, cur)) return;
    f32x4 acc[2][2][4][2];
#pragma unroll
    for (int a = 0; a < 2; ++a)
#pragma unroll
        for (int b = 0; b < 2; ++b)
#pragma unroll
            for (int m = 0; m < 4; ++m)
#pragma unroll
                for (int n = 0; n < 2; ++n) acc[a][b][m][n] = (f32x4){0.f, 0.f, 0.f, 0.f};
    i32x8 At[4], B0[2], B1[2];
    const char* const gA = (const char*)g.A; const char* cB = (const char*)g.Bt + (size_t)cur.pn * tstep;
    unsigned vo0[2], vo1[2];
#pragma unroll
    for (int i = 0; i < 2; ++i) { vo0[i] = rowoff[(size_t)cur.pm * 256 + RA + 64 * i] + cA2; vo1[i] = rowoff[(size_t)cur.pm * 256 + 128 + RA + 64 * i] + cA2; }
    S.a_ready(cur);
    if constexpr (SP2) {
        PG8_STAGE(PG8_SB(0, 0), cB, voffB); PG8_STAGE(PG8_SB(0, 1), cB + hstep, voffB); PG8_STAGE(PG8_SA(0, 0), gA, vo0); PG8_STAGE(PG8_SA(0, 1), gA, vo1);
        if (wr == 1) PG8_BAR;
        PG8_WAIT_V(2); PG8_BAR;
        PG8_STAGE(PG8_SB(1, 0), cB + kstep, voffB); PG8_STAGE(PG8_SA(1, 0), gA + kstep, vo0); PG8_STAGE(PG8_SB(1, 1), cB + hstep + kstep, voffB);
        PG8_WAIT_V(6); PG8_BAR;
    }
    for (;;) {
        const bool has_next = S.next(ui + 1, nxt);
        const char* nB = has_next ? (const char*)g.Bt + (size_t)nxt.pn * tstep : cB;
        if (has_next) __builtin_amdgcn_global_load_lds((const unsigned*)(rowoff + (size_t)nxt.pm * 256 + lane * 4), (PG8_LAS unsigned*)(side + (ui & 1) * 1024), 16, 0, 0);
        for (int t = 0; t < nt; t += 2) {
            const bool last = (t == nt - 2);
            const char* a1 = gA + (size_t)(t + 1) * kstep;
            const char* a2 = last ? gA : gA + (size_t)(t + 2) * kstep; const char* b2 = last ? nB : cB + (size_t)(t + 2) * kstep;
            unsigned s0[2], s1[2];
#pragma unroll
            for (int i = 0; i < 2; ++i) { s0[i] = vo0[i]; s1[i] = vo1[i]; }
            if (last && has_next) {
                const PG8_LAS unsigned* sl = (const PG8_LAS unsigned*)(side + (ui & 1) * 1024);
                int ra = RA; asm volatile("" : "+v"(ra));
#pragma unroll
                for (int i = 0; i < 2; ++i) { s0[i] = sl[ra + 64 * i] + cA2; s1[i] = sl[128 + ra + 64 * i] + cA2; }
            }
            const char* a3 = a2 + kstep; const char* b3 = b2 + kstep;
            if (last && has_next) S.a_ready(nxt);
            if constexpr (SP2) {
            PG8_LDB8(B0, 0, 0); PG8_LDB8(B1, 0, 1); PG8_SCHED; PG8_LDA8(At, 0, 0); PG8_STAGE(PG8_SA(1, 1), a1, vo1);
            PG8_WAIT_V(8); PG8_WAIT_L(0); PG8_BAR; PG8_MMA8(0, 0, At, B0); PG8_MMA8(0, 1, At, B1); PG8_BAR; PG8_SCHED;
            PG8_LDA8(At, 0, 1); PG8_STAGE(PG8_SB(0, 0), b2, voffB); PG8_STAGE(PG8_SB(0, 1), b2 + hstep, voffB); PG8_STAGE(PG8_SA(0, 0), a2, s0);
            PG8_WAIT_V(8); PG8_WAIT_L(0); PG8_BAR; PG8_MMA8(1, 0, At, B0); PG8_MMA8(1, 1, At, B1); PG8_BAR; PG8_SCHED;
            PG8_LDB8(B0, 1, 0); PG8_LDB8(B1, 1, 1); PG8_SCHED; PG8_LDA8(At, 1, 0); PG8_STAGE(PG8_SA(0, 1), a2, s1);
            PG8_WAIT_V(8); PG8_WAIT_L(0); PG8_BAR; PG8_MMA8(0, 0, At, B0); PG8_MMA8(0, 1, At, B1); PG8_BAR; PG8_SCHED;
            PG8_LDA8(At, 1, 1); PG8_STAGE(PG8_SB(1, 0), b3, voffB); PG8_STAGE(PG8_SB(1, 1), b3 + hstep, voffB); PG8_STAGE(PG8_SA(1, 0), a3, s0);
            PG8_WAIT_V(8); PG8_WAIT_L(0); PG8_BAR; PG8_MMA8(1, 0, At, B0); PG8_MMA8(1, 1, At, B1); PG8_BAR; PG8_SCHED;
            }
        }
        asm volatile("s_nop 15\n\ts_nop 15" ::: "memory");
        if constexpr (ALIGN_EPI) { if (wr == 0) PG8_BAR; }
        if constexpr (!Epi::AFTER_DRAIN) { E(acc, cur, wr, wc, fr, fq); S.done(cur); }
        if (!has_next) break;
#pragma unroll
        for (int a = 0; a < 2; ++a)
#pragma unroll
            for (int b = 0; b < 2; ++b)
#pragma unroll
                for (int m = 0; m < 4; ++m)
#pragma unroll
                    for (int n = 0; n < 2; ++n) acc[a][b][m][n] = (f32x4){0.f, 0.f, 0.f, 0.f};
        cur = nxt; cB = nB; ++ui;
        { const PG8_LAS unsigned* sl = (const PG8_LAS unsigned*)(side + ((ui - 1) & 1) * 1024); int ra = RA; asm volatile("" : "+v"(ra));
#pragma unroll
          for (int i = 0; i < 2; ++i) { vo0[i] = sl[ra + 64 * i] + cA2; vo1[i] = sl[128 + ra + 64 * i] + cA2; } }
        if constexpr (ALIGN_EPI) { if (wr == 1) PG8_BAR; }
    }
    PG8_WAIT_V(0);
    if constexpr (!ALIGN_EPI) { if (wr == 0) PG8_BAR; }
    PG8_BAR;
    if constexpr (Epi::AFTER_DRAIN) { E.fused(acc, cur, wr, wc, fr, fq, lds, wid, lane); S.done(cur); }
}
template <class Epi, class Sched, bool ALIGN_EPI = false, bool SP2 = false>
__device__ __forceinline__ void gemm_phase8(PG8_LAS unsigned char* lds, const Gemm g, const Sched& S, const Epi& E) {
    int tid = threadIdx.x; asm volatile("" : "+v"(tid));
    const int wid = __builtin_amdgcn_readfirstlane(tid >> 6), lane = tid & 63, wr = wid >> 2, wc = wid & 3, fr = lane & 15, fq = lane >> 4;
    const int K = g.K; int nt = K / BK; asm volatile("" : "+s"(nt));
    unsigned voffA[2], voffB[2];
#pragma unroll
    for (int i = 0; i < 2; ++i) { int R, C; stage_rc(tid * 16 + i * 8192, R, C); const int Rb = Epi::PERM ? ((R & ~31) + perm32(R & 31)) : R;
        voffA[i] = (unsigned)(R * K + C) * 2u; voffB[i] = (unsigned)(Rb * K + C) * 2u; }
    const size_t kstep = (size_t)(BK * 2);
    const size_t hstep = (size_t)HALF * K * 2;
    const size_t tstep = 2 * hstep;
    const unsigned ldsw = (unsigned)wid * 1024u;
    const int aoff = lds_byte8(wr * 64 + fr, fq), boff = lds_byte8(wc * 32 + fr, fq);
    int scl8 = 0x7f7f7f7f; asm volatile("" : "+v"(scl8));
    Unit cur, nxt; int ui = 0;
    if (!S.next(0, cur)) return;
    f32x4 acc[2][2][4][2];
#pragma unroll
    for (int a = 0; a < 2; ++a)
#pragma unroll
        for (int b = 0; b < 2; ++b)
#pragma unroll
            for (int m = 0; m < 4; ++m)
#pragma unroll
                for (int n = 0; n < 2; ++n) acc[a][b][m][n] = (f32x4){0.f, 0.f, 0.f, 0.f};
    i32x8 At[4], B0[2], B1[2];
    const char* cA = (const char*)g.A + (size_t)cur.pm * tstep; const char* cB = (const char*)g.Bt + (size_t)cur.pn * tstep;
    S.a_ready(cur);
    if constexpr (SP2) {
        PG8_STAGE(PG8_SB(0, 0), cB, voffB); PG8_STAGE(PG8_SB(0, 1), cB + hstep, voffB); PG8_STAGE(PG8_SA(0, 0), cA, voffA); PG8_STAGE(PG8_SA(0, 1), cA + hstep, voffA);
        if (wr == 1) PG8_BAR;
        PG8_WAIT_V(2); PG8_BAR;
        PG8_STAGE(PG8_SB(1, 0), cB + kstep, voffB); PG8_STAGE(PG8_SA(1, 0), cA + kstep, voffA); PG8_STAGE(PG8_SB(1, 1), cB + hstep + kstep, voffB);
        PG8_WAIT_V(6); PG8_BAR;
    } else {
        PG8_STAGE(PG8_SB(0, 0), cB, voffB); PG8_STAGE(PG8_SA(0, 0), cA, voffA); PG8_STAGE(PG8_SB(0, 1), cB + hstep, voffB); PG8_STAGE(PG8_SA(0, 1), cA + hstep, voffA);
        if (wr == 1) PG8_BAR;
        PG8_WAIT_V(4); PG8_BAR;
        PG8_STAGE(PG8_SB(1, 0), cB + kstep, voffB); PG8_STAGE(PG8_SA(1, 0), cA + kstep, voffA); PG8_STAGE(PG8_SB(1, 1), cB + hstep + kstep, voffB);
        PG8_WAIT_V(6); PG8_BAR;
    }
    for (;;) {
        const bool has_next = S.next(ui + 1, nxt);
        const char* nA = has_next ? (const char*)g.A + (size_t)nxt.pm * tstep : cA; const char* nB = has_next ? (const char*)g.Bt + (size_t)nxt.pn * tstep : cB;
        for (int t = 0; t < nt; t += 2) {
            const bool last = (t == nt - 2);
            const char* a1 = cA + (size_t)(t + 1) * kstep;
            const char* a2 = last ? nA : cA + (size_t)(t + 2) * kstep; const char* b2 = last ? nB : cB + (size_t)(t + 2) * kstep;
            const char* a3 = a2 + kstep; const char* b3 = b2 + kstep;
            if (last && has_next) S.a_ready(nxt);
            if constexpr (SP2) {
            PG8_LDB8(B0, 0, 0); PG8_LDB8(B1, 0, 1); PG8_SCHED; PG8_LDA8(At, 0, 0); PG8_STAGE(PG8_SA(1, 1), a1 + hstep, voffA);
            PG8_WAIT_V(8); PG8_WAIT_L(0); PG8_BAR; PG8_MMA8(0, 0, At, B0); PG8_MMA8(0, 1, At, B1); PG8_BAR; PG8_SCHED;
            PG8_LDA8(At, 0, 1); PG8_STAGE(PG8_SB(0, 0), b2, voffB); PG8_STAGE(PG8_SB(0, 1), b2 + hstep, voffB); PG8_STAGE(PG8_SA(0, 0), a2, voffA);
            PG8_WAIT_V(8); PG8_WAIT_L(0); PG8_BAR; PG8_MMA8(1, 0, At, B0); PG8_MMA8(1, 1, At, B1); PG8_BAR; PG8_SCHED;
            PG8_LDB8(B0, 1, 0); PG8_LDB8(B1, 1, 1); PG8_SCHED; PG8_LDA8(At, 1, 0); PG8_STAGE(PG8_SA(0, 1), a2 + hstep, voffA);
            PG8_WAIT_V(8); PG8_WAIT_L(0); PG8_BAR; PG8_MMA8(0, 0, At, B0); PG8_MMA8(0, 1, At, B1); PG8_BAR; PG8_SCHED;
            PG8_LDA8(At, 1, 1); PG8_STAGE(PG8_SB(1, 0), b3, voffB); PG8_STAGE(PG8_SB(1, 1), b3 + hstep, voffB); PG8_STAGE(PG8_SA(1, 0), a3, voffA);
            PG8_WAIT_V(8); PG8_WAIT_L(0); PG8_BAR; PG8_MMA8(1, 0, At, B0); PG8_MMA8(1, 1, At, B1); PG8_BAR; PG8_SCHED;
            } else {
            PG8_LDB8(B0, 0, 0); PG8_SCHED; PG8_LDA8(At, 0, 0); PG8_STAGE(PG8_SA(1, 1), a1 + hstep, voffA);
            PG8_WAIT_L(8); PG8_BAR; PG8_WAIT_L(0); PG8_MMA8(0, 0, At, B0); PG8_BAR; PG8_SCHED;
            PG8_LDB8(B1, 0, 1); PG8_STAGE(PG8_SB(0, 0), b2, voffB);
            PG8_BAR; PG8_WAIT_L(0); PG8_MMA8(0, 1, At, B1); PG8_BAR;
            PG8_LDA8(At, 0, 1); PG8_STAGE(PG8_SA(0, 0), a2, voffA);
            PG8_BAR; PG8_WAIT_L(0); PG8_MMA8(1, 0, At, B0); PG8_BAR; PG8_SCHED;
            PG8_STAGE(PG8_SB(0, 1), b2 + hstep, voffB);
            PG8_WAIT_V(6); PG8_BAR; PG8_MMA8(1, 1, At, B1); PG8_BAR;
            PG8_LDB8(B0, 1, 0); PG8_SCHED; PG8_LDA8(At, 1, 0); PG8_STAGE(PG8_SA(0, 1), a2 + hstep, voffA);
            PG8_WAIT_L(8); PG8_BAR; PG8_WAIT_L(0); PG8_MMA8(0, 0, At, B0); PG8_BAR; PG8_SCHED;
            PG8_LDB8(B1, 1, 1); PG8_STAGE(PG8_SB(1, 0), b3, voffB);
            PG8_BAR; PG8_WAIT_L(0); PG8_MMA8(0, 1, At, B1); PG8_BAR;
            PG8_LDA8(At, 1, 1); PG8_STAGE(PG8_SA(1, 0), a3, voffA);
            PG8_BAR; PG8_WAIT_L(0); PG8_MMA8(1, 0, At, B0); PG8_BAR; PG8_SCHED;
            PG8_STAGE(PG8_SB(1, 1), b3 + hstep, voffB);
            PG8_WAIT_V(6); PG8_BAR; PG8_MMA8(1, 1, At, B1); PG8_BAR;
            }
        }
        asm volatile("s_nop 15\n\ts_nop 15" ::: "memory");
        if constexpr (ALIGN_EPI) { if (wr == 0) PG8_BAR; }
        if constexpr (!Epi::AFTER_DRAIN) { E(acc, cur, wr, wc, fr, fq); S.done(cur); }
        if (!has_next) break;
#pragma unroll
        for (int a = 0; a < 2; ++a)
#pragma unroll
            for (int b = 0; b < 2; ++b)
#pragma unroll
                for (int m = 0; m < 4; ++m)
#pragma unroll
                    for (int n = 0; n < 2; ++n) acc[a][b][m][n] = (f32x4){0.f, 0.f, 0.f, 0.f};
        cur = nxt; cA = nA; cB = nB; ++ui;
        if constexpr (ALIGN_EPI) { if (wr == 1) PG8_BAR; }
    }
    PG8_WAIT_V(0);
    if constexpr (!ALIGN_EPI) { if (wr == 0) PG8_BAR; }
    PG8_BAR;
    if constexpr (Epi::AFTER_DRAIN) { E.fused(acc, cur, wr, wc, fr, fq, lds, wid, lane); S.done(cur); }
}
#undef PG8_LDA8
#undef PG8_LDB8
#undef PG8_MMA8
#undef PG8_SA
#undef PG8_SB
#undef PG8_STAGE
#undef PG8_LDA
#undef PG8_LDB
#undef PG8_MMA
#undef PG8_WAIT_V
#undef PG8_WAIT_L
#undef PG8_BAR
#undef PG8_SCHED
}
#define GAS __attribute__((address_space(1)))
#define LAS __attribute__((address_space(3)))
typedef unsigned short bf16;
typedef unsigned v4u __attribute__((ext_vector_type(4)));
typedef float f32x4 __attribute__((ext_vector_type(4)));
typedef short bf16x8 __attribute__((ext_vector_type(8)));
typedef GAS unsigned gu32;
typedef GAS unsigned long long gu64;
#define RLX_AGENT __ATOMIC_RELAXED, __HIP_MEMORY_SCOPE_AGENT
#define LDS_WAIT() asm volatile("s_waitcnt lgkmcnt(0)" ::: "memory")
#define VM_WAIT() asm volatile("s_waitcnt vmcnt(0)" ::: "memory")
__device__ __forceinline__ unsigned long long rt() { return __builtin_amdgcn_s_memrealtime(); }
__device__ __forceinline__ unsigned f2bf(float f) { unsigned u = __builtin_bit_cast(unsigned, f); return (u + 0x7fffu + ((u >> 16) & 1u)) >> 16; }
__device__ __forceinline__ unsigned pk2(float lo, float hi) { return f2bf(lo) | (f2bf(hi) << 16); }

#define XB_TMO      128
#define XB_XCNT(j)  (256  + 64 * (j))
#define XB_XSUB(j)  (1280 + 64 * (j))
#define XB_XGEN(j)  (2304 + 64 * (j))
#define XB_TOP      3328
#define XB_TOPGEN   3392
#define XCD_BAR_WORDS 3456
#define XB_SPIN_CAP (1u << 18)

__device__ __forceinline__ unsigned xb_ld(unsigned* p)              { return __hip_atomic_load(p, __ATOMIC_RELAXED, __HIP_MEMORY_SCOPE_AGENT); }
__device__ __forceinline__ unsigned xb_add(unsigned* p, unsigned v) { return __hip_atomic_fetch_add(p, v, __ATOMIC_RELAXED, __HIP_MEMORY_SCOPE_AGENT); }
__device__ __forceinline__ unsigned xb_xcc_id() { return (unsigned)__builtin_amdgcn_s_getreg((3 << 11) | 20) & 0xFu; }
#define XB_SPIN(cond, bar) do { unsigned _sp = 0; while (cond) { __builtin_amdgcn_s_sleep(1); \
    if ((++_sp & 255u) == 0u) { if (xb_ld(&(bar)[XB_TMO])) break; if (_sp > XB_SPIN_CAP) { atomicAdd(&(bar)[XB_TMO], 1u); break; } } } } while (0)

struct XcdBarrier {
    unsigned* bar; unsigned x;
    volatile LAS unsigned* st;
};

__device__ __forceinline__ XcdBarrier xcd_barrier_post(unsigned* bar, volatile LAS unsigned* st) {
    XcdBarrier b; b.bar = bar; b.x = xb_xcc_id(); b.st = st;
    if (threadIdx.x == 0) (void)xb_add(&bar[XB_XCNT(b.x)], 1u);
    return b;
}
__device__ __forceinline__ void xcd_barrier_complete(unsigned* bar, unsigned x, unsigned& nloc, unsigned& nx) {
    const unsigned G = gridDim.x * gridDim.y * gridDim.z;
    unsigned sum, cnt, mine, sp = 0u;
    for (;;) {
        sum = 0u; cnt = 0u; mine = 0u;
#pragma unroll
        for (unsigned j = 0; j < 16; ++j) { const unsigned c = xb_ld(&bar[XB_XCNT(j)]); sum += c; cnt += (c > 0u) ? 1u : 0u; mine = (j == x) ? c : mine; }
        if (sum == G) break;
        __builtin_amdgcn_s_sleep(1);
        if ((++sp & 255u) == 0u) { if (xb_ld(&bar[XB_TMO])) break; if (sp > XB_SPIN_CAP) { atomicAdd(&bar[XB_TMO], 1u); break; } }
    }
    nloc = mine > 0u ? mine : 1u; nx = cnt > 0u ? cnt : 1u;
}

__device__ __forceinline__ void xcd_barrier(const XcdBarrier& b) {
    asm volatile("s_waitcnt vmcnt(0)" ::: "memory");
    __syncthreads();
    if (threadIdx.x == 0) {
        unsigned* bar = b.bar;
        __builtin_amdgcn_s_waitcnt(0);
        unsigned nloc = b.st[0], nx = b.st[1];
        if (nloc == 0u) { xcd_barrier_complete(bar, b.x, nloc, nx); b.st[0] = nloc; b.st[1] = nx; }
        const unsigned old = xb_add(&bar[XB_XSUB(b.x)], 1u);
        const unsigned gen = old / nloc;
        if (old + 1u == (gen + 1u) * nloc) {
            __builtin_amdgcn_fence(__ATOMIC_RELEASE, "agent");
            asm volatile("s_waitcnt vmcnt(0)" ::: "memory");
            const unsigned og = xb_add(&bar[XB_TOP], 1u);
            const unsigned tg = og / nx;
            if (og + 1u == (tg + 1u) * nx) xb_add(&bar[XB_TOPGEN], 1u);
            else XB_SPIN(xb_ld(&bar[XB_TOPGEN]) == tg, bar);
            __builtin_amdgcn_fence(__ATOMIC_ACQUIRE, "agent");
            xb_add(&bar[XB_XGEN(b.x)], 1u);
            asm volatile("s_waitcnt vmcnt(0)" ::: "memory");
        } else {
            XB_SPIN(xb_ld(&bar[XB_XGEN(b.x)]) == gen, bar);
            __builtin_amdgcn_fence(__ATOMIC_ACQUIRE, "agent");
            asm volatile("s_waitcnt vmcnt(0)" ::: "memory");
        }
    }
    __syncthreads();
}
typedef unsigned u32x4 __attribute__((ext_vector_type(4)));

namespace pg8 {
typedef unsigned u32x2 __attribute__((ext_vector_type(2)));
__device__ __forceinline__ float silu_f(float x) { return x * __builtin_amdgcn_rcpf(1.0f + __expf(-x)); }
struct EpiHS {
    static constexpr bool PERM = true, AFTER_DRAIN = false;
    const float* x; const float* meta; bf16_t* hsb;
    __device__ __forceinline__ void operator()(const f32x4 (&acc)[2][2][4][2], const Unit& u, int wr, int wc, int fr, int fq) const {
        const int col0 = u.pn * BM + wc * 32 + 8 * fq;
#pragma unroll
        for (int ai = 0; ai < 2; ++ai) {
            f32x4 rv[4][2][2]; int tt[4];
#pragma unroll
            for (int m = 0; m < 4; ++m) {
                const int r = u.pm * BM + ai * HALF + wr * 64 + m * 16 + fr;
                const int b = r / 8320, p = r - b * 8320, t = p - 112; tt[m] = t;
                const int tc = t < 0 ? 16 : t;
                const float* src = tc < 16 ? meta + (size_t)tc * 1024 : x + ((size_t)b * 8192 + (size_t)(tc - 16)) * 1024;
#pragma unroll
                for (int bj = 0; bj < 2; ++bj) { rv[m][bj][0] = *(const f32x4*)(src + col0 + bj * HALF); rv[m][bj][1] = *(const f32x4*)(src + col0 + bj * HALF + 4); }
            }
#pragma unroll
            for (int m = 0; m < 4; ++m) {
                const int r = u.pm * BM + ai * HALF + wr * 64 + m * 16 + fr;
                if (tt[m] >= 0) {
                    bf16_t* dst = hsb + (size_t)r * 1024;
#pragma unroll
                    for (int bj = 0; bj < 2; ++bj) { const f32x4 v0 = rv[m][bj][0] + acc[ai][bj][m][0], v1 = rv[m][bj][1] + acc[ai][bj][m][1]; u32x4 w;
                        w.x = cvt_pk_bf16(v0[0], v0[1]); w.y = cvt_pk_bf16(v0[2], v0[3]); w.z = cvt_pk_bf16(v1[0], v1[1]); w.w = cvt_pk_bf16(v1[2], v1[3]);
                        *(u32x4*)(dst + col0 + bj * HALF) = w; }
                }
            }
        }
    }
};
struct EpiAct {
    static constexpr bool PERM = true, AFTER_DRAIN = false;
    bf16_t* act;
    __device__ __forceinline__ void operator()(const f32x4 (&acc)[2][2][4][2], const Unit& u, int wr, int wc, int fr, int fq) const {
        const int row0 = u.pm * BM + wr * 64 + fr; const int j = u.pn & 7; const int col0 = j * 128 + wc * 32 + 8 * fq;
#pragma unroll
        for (int ai = 0; ai < 2; ++ai)
#pragma unroll
            for (int m = 0; m < 4; ++m) {
                unsigned char* rowp = (unsigned char*)act + (size_t)(row0 + ai * HALF + m * 16) * 1024 + col0;
                const f32x4 g0 = acc[ai][0][m][0] * 0.03125f, g1 = acc[ai][0][m][1] * 0.03125f, u0 = acc[ai][1][m][0] * 0.03125f, u1 = acc[ai][1][m][1] * 0.03125f;
                u32x2 w; unsigned t = 0u;
                t = __builtin_amdgcn_cvt_pk_fp8_f32(silu_f(g0[0]) * u0[0], silu_f(g0[1]) * u0[1], t, false); t = __builtin_amdgcn_cvt_pk_fp8_f32(silu_f(g0[2]) * u0[2], silu_f(g0[3]) * u0[3], t, true); w.x = t;
                t = __builtin_amdgcn_cvt_pk_fp8_f32(silu_f(g1[0]) * u1[0], silu_f(g1[1]) * u1[1], t, false); t = __builtin_amdgcn_cvt_pk_fp8_f32(silu_f(g1[2]) * u1[2], silu_f(g1[3]) * u1[3], t, true); w.y = t;
                *(u32x2*)rowp = w;
            }
    }
};
struct EpiYS {
    static constexpr bool PERM = true, AFTER_DRAIN = false;
    unsigned char* ys; const float* gate;
    __device__ __forceinline__ void operator()(const f32x4 (&acc)[2][2][4][2], const Unit& u, int wr, int wc, int fr, int fq) const {
        const int row0 = u.pm * BM + wr * 64 + fr; const int j = u.pn & 3; const int col0 = j * 256 + wc * 32 + 8 * fq;
#pragma unroll
        for (int ai = 0; ai < 2; ++ai)
#pragma unroll
            for (int m = 0; m < 4; ++m) {
                const int row = row0 + ai * HALF + m * 16; const float gv = gate[row] * 0.25f;
                unsigned char* rowp = ys + (size_t)row * 1024 + col0;
#pragma unroll
                for (int bj = 0; bj < 2; ++bj) { const f32x4 v0 = acc[ai][bj][m][0] * gv, v1 = acc[ai][bj][m][1] * gv; u32x2 w; unsigned t = 0u;
                    t = __builtin_amdgcn_cvt_pk_fp8_f32(v0[0], v0[1], t, false); t = __builtin_amdgcn_cvt_pk_fp8_f32(v0[2], v0[3], t, true); w.x = t;
                    t = __builtin_amdgcn_cvt_pk_fp8_f32(v1[0], v1[1], t, false); t = __builtin_amdgcn_cvt_pk_fp8_f32(v1[2], v1[3], t, true); w.y = t;
                    *(u32x2*)(rowp + bj * HALF) = w; }
            }
    }
};

struct EpiZ {
    static constexpr bool PERM = true, AFTER_DRAIN = false;
    bf16_t* Z; const float* cs;
    __device__ __forceinline__ void operator()(const f32x4 (&acc)[2][2][4][2], const Unit& u, int wr, int wc, int fr, int fq) const {
        const int row0 = u.pm * BM + wr * 64 + fr;
        if (u.pn < 4 || u.pn >= 8) {
            const int col0 = u.pn * BM + wc * 32 + 8 * fq;
#pragma unroll
            for (int ai = 0; ai < 2; ++ai)
#pragma unroll
                for (int m = 0; m < 4; ++m) { bf16_t* rowp = Z + (size_t)(row0 + ai * HALF + m * 16) * 3072 + col0;
#pragma unroll
                    for (int bj = 0; bj < 2; ++bj) { const f32x4 v0 = acc[ai][bj][m][0], v1 = acc[ai][bj][m][1]; u32x4 w;
                        w.x = cvt_pk_bf16(v0[0], v0[1]); w.y = cvt_pk_bf16(v0[2], v0[3]); w.z = cvt_pk_bf16(v1[0], v1[1]); w.w = cvt_pk_bf16(v1[2], v1[3]);
                        *(u32x4*)(rowp + bj * HALF) = w; } }
        } else {
            const int x0 = wc * 32 + 8 * fq;
            const int region = (u.pn - 4) >> 1, head = 2 * ((u.pn - 4) & 1) + (x0 >> 6), j0 = x0 & 63;
            const int colA = 1024 + region * 512 + head * 128 + j0;
            const float sc = region == 0 ? 0.08838834764831845f : 1.0f;
#pragma unroll
            for (int ai = 0; ai < 2; ++ai) {
                f32x4 cc[4][4];
#pragma unroll
                for (int m = 0; m < 4; ++m) { const int r = row0 + ai * HALF + m * 16; const int b = r / 8320; int t = r - b * 8320 - 112; t = t < 0 ? 0 : t;
                    const f32x4* cp = (const f32x4*)(cs + ((size_t)t * 64 + j0) * 2); cc[m][0] = cp[0]; cc[m][1] = cp[1]; cc[m][2] = cp[2]; cc[m][3] = cp[3]; }
#pragma unroll
                for (int m = 0; m < 4; ++m) {
                    const int r = row0 + ai * HALF + m * 16;
                    const f32x4 c0 = cc[m][0], c1 = cc[m][1], c2 = cc[m][2], c3 = cc[m][3];
                    const f32x4 a0 = acc[ai][0][m][0], a1 = acc[ai][0][m][1], b0 = acc[ai][1][m][0], b1 = acc[ai][1][m][1];
                    u32x4 w1, w2;
                    w1.x = cvt_pk_bf16((a0[0] * c0[0] - b0[0] * c0[1]) * sc, (a0[1] * c0[2] - b0[1] * c0[3]) * sc); w2.x = cvt_pk_bf16((a0[0] * c0[1] + b0[0] * c0[0]) * sc, (a0[1] * c0[3] + b0[1] * c0[2]) * sc);
                    w1.y = cvt_pk_bf16((a0[2] * c1[0] - b0[2] * c1[1]) * sc, (a0[3] * c1[2] - b0[3] * c1[3]) * sc); w2.y = cvt_pk_bf16((a0[2] * c1[1] + b0[2] * c1[0]) * sc, (a0[3] * c1[3] + b0[3] * c1[2]) * sc);
                    w1.z = cvt_pk_bf16((a1[0] * c2[0] - b1[0] * c2[1]) * sc, (a1[1] * c2[2] - b1[1] * c2[3]) * sc); w2.z = cvt_pk_bf16((a1[0] * c2[1] + b1[0] * c2[0]) * sc, (a1[1] * c2[3] + b1[1] * c2[2]) * sc);
                    w1.w = cvt_pk_bf16((a1[2] * c3[0] - b1[2] * c3[1]) * sc, (a1[3] * c3[2] - b1[3] * c3[3]) * sc); w2.w = cvt_pk_bf16((a1[2] * c3[1] + b1[2] * c3[0]) * sc, (a1[3] * c3[3] + b1[3] * c3[2]) * sc);
                    bf16_t* rowp = Z + (size_t)r * 3072 + colA;
                    *(u32x4*)rowp = w1; *(u32x4*)(rowp + 64) = w2;
                }
            }
        }
    }
};
struct GroupOrder {
    int G, vcu, tm, tn, nwg;
    __device__ __forceinline__ void init(int ne, int tm_, int tn_, int G_, int c) { tm = tm_; tn = tn_; nwg = ne * tm_ * tn_; G = G_; vcu = (G_ % 8 == 0) ? (c % 8) * (G_ / 8) + c / 8 : c; }
    __device__ __forceinline__ bool next(int i, Unit& u) const {
        const long L = (long)i * G + vcu; if (L >= nwg) return false;
        const int per = tm * tn, e = (int)(L / per), rem = (int)(L % per);
        u.pm = e * tm + rem / tn; u.pn = e * tn + rem % tn; return true;
    }
    __device__ __forceinline__ void a_ready(const Unit&) const {}
    __device__ __forceinline__ void done(const Unit&) const {}
};
}

constexpr int NB = 8, SEQ = 8192, DM = 1024, NMETA = 16, TT = SEQ + NMETA, PADL = 112, PP = 8320, NP = NB * PP;
constexpr int NCHUNK = 65, NSEG = 130;
constexpr int ZC = 3072, ZC_LX = 0, ZC_LG = 512, ZC_Q = 1024, ZC_K = 1536, ZC_V = 2048, ZC_G = 2560;
constexpr int NE = 16, CAP = 1026, EROWS = 8448, NROWS = NE * EROWS;
constexpr float EPSN = 1e-6f;
constexpr int NPHASE = 12;

constexpr size_t MiB = 1u << 20;
constexpr size_t WS_CTL = 0, CTL_ZERO_BYTES = 64 * 1024;
constexpr size_t WS_GW = 1 * MiB, WS_GW2 = 1 * MiB + 256 * 1024, WS_HSMETA = 1 * MiB + 512 * 1024;
constexpr size_t WS_CS = 3 * MiB, WS_SUMM = 8 * MiB, WS_CARRY = 17 * MiB, WS_AFF = 22 * MiB, WS_ROWMAP = 27 * MiB, WS_IDX = 32 * MiB, WS_GATE = 33 * MiB;
constexpr size_t WS_WIN = 34 * MiB, WS_WOUT = 40 * MiB, WS_WGU = 42 * MiB, WS_WD = 106 * MiB;
#ifndef ST_INPLACE
#define ST2_BASE WS_ST2
#define CPY_BASE WS_ST
#else
#define ST2_BASE WS_ST
#define CPY_BASE WS_ST2
#endif
constexpr size_t WS_ST2 = 788 * MiB;
constexpr size_t WS_HSB = 400 * MiB;
constexpr size_t WS_H = 138 * MiB, WS_Z = 268 * MiB, WS_ST = 658 * MiB, WS_XS = 658 * MiB, WS_ACT = 268 * MiB, WS_YS = WS_XS, WS_END = 922 * MiB;
static_assert(WS_H + (size_t)NP * 2048 <= WS_Z && WS_Z + (size_t)NP * ZC * 2 <= WS_ST && WS_ST + (size_t)NB * 4 * 2 * NCHUNK * 32768 <= WS_END && WS_XS + (size_t)NROWS * 2048 <= WS_END && WS_ACT + (size_t)NROWS * 2048 <= WS_ST, "ws map");
constexpr int CW_BAR = 1024;

constexpr int LDS_MAIN = 131072, LDS_BYTES = 147456;
constexpr int LDS_SS = LDS_MAIN;
constexpr int LDS_MISC = LDS_MAIN + 4096;
constexpr int LDS_SIDE = LDS_MAIN + 8192;

typedef unsigned short u16x8 __attribute__((ext_vector_type(8)));
typedef unsigned short u16x4 __attribute__((ext_vector_type(4)));
typedef float f32x16 __attribute__((ext_vector_type(16)));
typedef float f32x2 __attribute__((ext_vector_type(2)));
typedef unsigned u32x2 __attribute__((ext_vector_type(2)));
typedef short v4i16_t __attribute__((ext_vector_type(4)));
typedef __bf16 bf16x2_t __attribute__((ext_vector_type(2)));

__device__ __forceinline__ float bf2f(unsigned short v) { return __uint_as_float((unsigned)v << 16); }
__device__ __forceinline__ unsigned cvtpk(float lo, float hi) { f32x2 v = {lo, hi}; bf16x2_t b = __builtin_convertvector(v, bf16x2_t); return __builtin_bit_cast(unsigned, b); }
__device__ __forceinline__ unsigned short f2bf16(float f) { return (unsigned short)(cvtpk(f, 0.f) & 0xffffu); }
__device__ __forceinline__ float wave_sum(float v) {
#pragma unroll
    for (int o = 1; o < 64; o <<= 1) v += __shfl_xor(v, o);
    return v;
}
__device__ __forceinline__ float sigmoid_f(float x) { return __builtin_amdgcn_rcpf(1.0f + __expf(-x)); }
__device__ __forceinline__ float gelu_tanh_f(float x) { const float z2 = 2.302208198144325f * x * (1.0f + 0.044715f * x * x);   return x - x * __builtin_amdgcn_rcpf(1.0f + __builtin_amdgcn_exp2f(z2)); }
__device__ __forceinline__ float softplus_neg(float lam) { const float y = __expf(-lam); return (y < 0.05f) ? y * (1.0f + y * (-0.5f + y * (0.33333333f + y * (-0.25f + y * 0.2f)))) : log1pf(y); }
__device__ __forceinline__ float log2_gamma(int h) { return h == 0 ? -0.04580368961312479f : h == 1 ? -0.02272007650008353f : h == 2 ? -0.011315313227834146f : -0.005646563141142063f; }
__device__ __forceinline__ unsigned off_b(unsigned row, unsigned ch) { return 256u * row + 16u * (ch ^ (((row & 3u) << 2) | ((row >> 2) & 3u))); }
__device__ __forceinline__ pg8::bf16x8 rowfrag(LAS unsigned char* T, int rb, int s, int lane) {
    return *(LAS pg8::bf16x8*)(T + off_b(32 * rb + (lane & 31), 2 * s + (lane >> 5)));
}
__device__ __forceinline__ pg8::bf16x8 rowfrag_x(LAS unsigned char* T, int rb, int s, int lane) {
    return *(LAS pg8::bf16x8*)(T + off_b((32 * rb + (lane & 31)) ^ 1, 2 * s + (lane >> 5)));
}
__device__ __forceinline__ v4i16_t tr_rd(LAS unsigned char* p) { return __builtin_amdgcn_ds_read_tr16_b64_v4i16((LAS v4i16_t*)p); }
__device__ __forceinline__ pg8::bf16x8 trfrag(LAS unsigned char* T, int c, int ks, int lane) {
    const unsigned h = lane >> 5, blk = (lane >> 4) & 1, q = (lane & 15) >> 2, p = lane & 3;
    const v4i16_t lo = tr_rd(T + off_b(16 * ks + 8 * h + q, 4 * c + 2 * blk + (p >> 1)) + 8 * (p & 1));
    const v4i16_t hi = tr_rd(T + off_b(16 * ks + 8 * h + 4 + q, 4 * c + 2 * blk + (p >> 1)) + 8 * (p & 1));
    return (pg8::bf16x8){lo[0], lo[1], lo[2], lo[3], hi[0], hi[1], hi[2], hi[3]};
}
__device__ __forceinline__ pg8::bf16x8 trfrag_perm(LAS unsigned char* T, int c, int rbase, int lane) {
    const unsigned h = lane >> 5, blk = (lane >> 4) & 1, q = (lane & 15) >> 2, p = lane & 3;
    const v4i16_t lo = tr_rd(T + off_b(rbase + 4 * h + q, 4 * c + 2 * blk + (p >> 1)) + 8 * (p & 1));
    const v4i16_t hi = tr_rd(T + off_b(rbase + 8 + 4 * h + q, 4 * c + 2 * blk + (p >> 1)) + 8 * (p & 1));
    return (pg8::bf16x8){lo[0], lo[1], lo[2], lo[3], hi[0], hi[1], hi[2], hi[3]};
}
__device__ __forceinline__ int crow(int reg, int h) { return (reg & 3) + 8 * (reg >> 2) + 4 * h; }
#define MFMA32(a, b, c) __builtin_amdgcn_mfma_f32_32x32x16_bf16((a), (b), (c), 0, 0, 0)
#define MFMA16(a, b, c) __builtin_amdgcn_mfma_f32_16x16x32_bf16((a), (b), (c), 0, 0, 0)

struct Fr {
    LAS unsigned char* lds;
    int tid, lane, wave, G;
    const float *x, *meta, *norm1_g, *w_in, *conv_w, *conv_b, *w_r, *b_r, *w_i, *b_i, *lam, *lru_out_g, *ret_out_g, *w_out, *norm2_g, *w_router, *w_gate, *w_up, *w_down, *final_g;
    float* out;
    unsigned short *GW2; unsigned short *GW, *WIN, *WOUT, *WGU, *WD, *H, *Z, *ST, *XS, *ACT, *YS;
    unsigned char* CTLP; float *HSMETA, *AFF, *GATE, *CARRY; unsigned short* HSB; unsigned short* ST2; f32x2 *CS, *SUMM; int *ROWMAP, *IDX;
};

__device__ __forceinline__ void prep_tile(const Fr& F, const float* W, int ldw, int k0, int n0, unsigned short* WT, int mode) {
    LAS float* scr = (LAS float*)F.lds;
    const int tid = F.tid;
    { const int n = tid & 63, kk = tid >> 6;
#pragma unroll
      for (int i = 0; i < 8; ++i) { const int k = kk + 8 * i; scr[k * 65 + n] = W[(size_t)(k0 + k) * ldw + n0 + n]; } }
    __syncthreads();
    { const int k = tid & 63, nn = tid >> 6;
#pragma unroll
      for (int i = 0; i < 8; ++i) { const int n = n0 + nn + 8 * i; int row;
          if (mode == 0) row = n; else if (mode == 3) { if (n < 1024 || n >= 2048) row = n; else { const int q = n - 1024, region = q >> 9, hd = (q >> 7) & 3, d = q & 127; row = 1024 + region * 512 + (hd >> 1) * 256 + (d >> 6) * 128 + (hd & 1) * 64 + (d & 63); } }
          else row = 256 * (n >> 7) + (n & 127) + (mode == 2 ? 128 : 0);
          WT[(size_t)row * 1024 + k0 + k] = f2bf16(scr[k * 65 + (nn + 8 * i)]); } }
    __syncthreads();
}
__device__ __forceinline__ void prep_tile8(const Fr& F, const float* W, int k0, int n0, unsigned char* WT8, int mode) {
    LAS float* scr = (LAS float*)F.lds;
    const int tid = F.tid;
    { const int n = tid & 63, kk = tid >> 6;
#pragma unroll
      for (int i = 0; i < 8; ++i) { const int k = kk + 8 * i; scr[k * 65 + n] = W[(size_t)(k0 + k) * 1024 + n0 + n]; } }
    __syncthreads();
    { const int k4 = tid & 15, nn = tid >> 4;
#pragma unroll
      for (int i = 0; i < 2; ++i) { const int nl = nn + 32 * i, n = n0 + nl; const int row = mode == 0 ? n : 256 * (n >> 7) + (n & 127) + (mode == 2 ? 128 : 0);
          const float a = scr[(4 * k4 + 0) * 65 + nl] * 32.0f, b = scr[(4 * k4 + 1) * 65 + nl] * 32.0f, c = scr[(4 * k4 + 2) * 65 + nl] * 32.0f, d = scr[(4 * k4 + 3) * 65 + nl] * 32.0f;
          unsigned w = 0u; w = __builtin_amdgcn_cvt_pk_fp8_f32(a, b, w, false); w = __builtin_amdgcn_cvt_pk_fp8_f32(c, d, w, true);
          *(unsigned*)(WT8 + (size_t)row * 1024 + k0 + 4 * k4) = w; } }
    __syncthreads();
}
__device__ __forceinline__ void sincos_tab(int t, int j, float& co, float& si) {
    double f = 1.0, bse = 0.8659643233600653;
    int e = j;
#pragma unroll
    for (int i = 0; i < 6; ++i) { if (e & 1) f *= bse; bse *= bse; e >>= 1; }
    const double xx = (double)t * f;
    const double qd = __builtin_rint(xx * 0.6366197723675814);
    double y = __builtin_fma(-qd, 1.5707963267948966, xx); y = __builtin_fma(-qd, 6.123233995736766e-17, y);
    const double y2 = y * y;
    double sp = -7.647163731819816e-13;
    sp = sp * y2 + 1.6059043836821613e-10;
    sp = sp * y2 - 2.505210838544172e-08;
    sp = sp * y2 + 2.7557319223985893e-06;
    sp = sp * y2 - 1.984126984126984e-04;
    sp = sp * y2 + 8.333333333333333e-03;
    sp = sp * y2 - 1.6666666666666666e-01;
    const double sy = y + y * y2 * sp;
    double cp = 4.779477332387385e-14;
    cp = cp * y2 - 1.1470745597729725e-11;
    cp = cp * y2 + 2.08767569878681e-09;
    cp = cp * y2 - 2.755731922398589e-07;
    cp = cp * y2 + 2.48015873015873e-05;
    cp = cp * y2 - 1.388888888888889e-03;
    cp = cp * y2 + 4.1666666666666664e-02;
    cp = cp * y2 - 0.5;
    const double cy = 1.0 + y2 * cp;
    const int qi = ((int)(long long)qd) & 3;
    const double s_ = (qi == 0) ? sy : (qi == 1) ? cy : (qi == 2) ? -sy : -cy;
    const double c_ = (qi == 0) ? cy : (qi == 1) ? -sy : (qi == 2) ? -cy : sy;
    co = (float)c_; si = (float)s_;
}
__device__ __forceinline__ void rms_row_to_bf16(const float* xrow, const float* g, unsigned short* orow, int lane) {
    const f32x4* xr = (const f32x4*)xrow + lane; const f32x4* gr = (const f32x4*)g + lane;
    f32x4 v[4]; float s = 0.f;
#pragma unroll
    for (int j = 0; j < 4; ++j) { v[j] = xr[64 * j]; s += (v[j].x * v[j].x + v[j].y * v[j].y) + (v[j].z * v[j].z + v[j].w * v[j].w); }
    const float rs = 1.0f / sqrtf(wave_sum(s) * (1.0f / 1024.0f) + EPSN);
    u32x2* o8 = (u32x2*)orow + lane;
#pragma unroll
    for (int j = 0; j < 4; ++j) { const f32x4 gg = gr[64 * j]; u32x2 w; w.x = cvtpk(v[j].x * rs * gg.x, v[j].y * rs * gg.y); w.y = cvtpk(v[j].z * rs * gg.z, v[j].w * rs * gg.w); o8[64 * j] = w; }
}
__device__ __forceinline__ void prep_stream8(const Fr& F, const float* Wall, unsigned char* WT8all, size_t estride, int mode, int vb, int VG) {
    LAS float* scr = (LAS float*)F.lds;
    const int tid = F.tid, n_ = tid & 63, kk = tid >> 6, k4 = tid & 15, nn = tid >> 4;
    int t = vb; if (t < 0 || t >= 4096) return;
    float v[8];
    { const int e = t >> 8, r = t & 255, k0 = 64 * (r >> 4), n0 = 64 * (r & 15); const float* W = Wall + (size_t)e * 1048576;
#pragma unroll
      for (int i = 0; i < 8; ++i) v[i] = W[(size_t)(k0 + kk + 8 * i) * 1024 + n0 + n_]; }
    for (; t < 4096; t += VG) {
        const int e = t >> 8, r = t & 255, k0 = 64 * (r >> 4), n0 = 64 * (r & 15);
        float vn[8];
        { const int t2 = t + VG < 4096 ? t + VG : t; const int e2 = t2 >> 8, r2 = t2 & 255, k2 = 64 * (r2 >> 4), n2 = 64 * (r2 & 15); const float* W = Wall + (size_t)e2 * 1048576;
#pragma unroll
          for (int i = 0; i < 8; ++i) vn[i] = W[(size_t)(k2 + kk + 8 * i) * 1024 + n2 + n_]; }
#pragma unroll
        for (int i = 0; i < 8; ++i) scr[(kk + 8 * i) * 65 + n_] = v[i];
        __syncthreads();
        unsigned char* WT8 = WT8all + (size_t)e * estride;
#pragma unroll
        for (int i = 0; i < 2; ++i) { const int nl = nn + 32 * i, n = n0 + nl; const int row = mode == 0 ? n : 256 * (n >> 7) + (n & 127) + (mode == 2 ? 128 : 0);
            const float a = scr[(4 * k4 + 0) * 65 + nl] * 32.0f, b = scr[(4 * k4 + 1) * 65 + nl] * 32.0f, c = scr[(4 * k4 + 2) * 65 + nl] * 32.0f, d = scr[(4 * k4 + 3) * 65 + nl] * 32.0f;
            unsigned w = 0u; w = __builtin_amdgcn_cvt_pk_fp8_f32(a, b, w, false); w = __builtin_amdgcn_cvt_pk_fp8_f32(c, d, w, true);
            *(unsigned*)(WT8 + (size_t)row * 1024 + k0 + 4 * k4) = w; }
        __syncthreads();
#pragma unroll
        for (int i = 0; i < 8; ++i) v[i] = vn[i];
    }
}
__device__ __forceinline__ void ph_prep(const Fr& F) {
    const int bid = blockIdx.x, G = F.G;
    for (int it = bid; it < 1024; it += G) {
        if (it < 768) { const int kt = it / 48, nt = it % 48; prep_tile(F, F.w_in, 3072, 64 * kt, 64 * nt, F.WIN, 3); }
        else { const int i2 = it - 768, kt = i2 / 16, nt = i2 % 16; prep_tile(F, F.w_out, 1024, 64 * kt, 64 * nt, F.WOUT, 0); }
    }
    const int gt = bid * 512 + F.tid, GT = G * 512;
    for (int idx = gt; idx < 8 * 256 * 64; idx += GT) {
        const int blk = idx >> 14, o = (idx >> 6) & 255, k = idx & 63, g = o >> 6, d = o & 63, dir = g >> 1;
        const float* src = (g & 1) ? F.w_i : F.w_r;
        F.GW[idx] = f2bf16(src[((size_t)(dir * 8 + blk) * 64 + k) * 64 + d]);
    }
    for (int idx = gt; idx < 8 * 256 * 64; idx += GT) {
        const int k = idx & 63, fr = (idx >> 6) & 15, cg = (idx >> 10) & 3, g = (idx >> 12) & 3, blk = idx >> 14;
        const float* src = (g & 1) ? F.w_i : F.w_r;
        F.GW2[idx] = f2bf16(src[((size_t)((g >> 1) * 8 + blk) * 64 + k) * 64 + 16 * cg + fr]);
    }
    for (int idx = gt; idx < TT * 64; idx += GT) { float co, si; sincos_tab(idx >> 6, idx & 63, co, si); F.CS[idx] = (f32x2){co, si}; }
    const int gw = bid * 8 + F.wave, NGW = G * 8; const int lane = F.lane;
    for (int r = gw; r < NB * PADL; r += NGW) { const int b = r / PADL, p = r - b * PADL; u32x2* o8 = (u32x2*)(F.H + (size_t)(b * PP + p) * 1024) + lane;
#pragma unroll
        for (int j = 0; j < 4; ++j) o8[64 * j] = (u32x2){0u, 0u}; }
    f32x4 gg[4];
#pragma unroll
    for (int j = 0; j < 4; ++j) gg[j] = ((const f32x4*)F.norm1_g + lane)[64 * j];
    f32x4 nx[2][4];
    const int NPAIR = NB * TT / 2;
    if (gw < NPAIR) {
#pragma unroll
        for (int q = 0; q < 2; ++q) { const int v = 2 * gw + q, b = v / TT, t = v - b * TT; const f32x4* xr = (const f32x4*)(t < NMETA ? F.meta + (size_t)t * 1024 : F.x + ((size_t)b * SEQ + (t - NMETA)) * 1024) + lane;
#pragma unroll
            for (int j = 0; j < 4; ++j) nx[q][j] = xr[64 * j]; }
    }
    for (int pr = gw; pr < NPAIR; pr += NGW) {
        f32x4 vv[2][4];
#pragma unroll
        for (int q = 0; q < 2; ++q)
#pragma unroll
            for (int j = 0; j < 4; ++j) vv[q][j] = nx[q][j];
        { const int pn = pr + NGW < NPAIR ? pr + NGW : pr;
#pragma unroll
          for (int q = 0; q < 2; ++q) { const int v = 2 * pn + q, b = v / TT, t = v - b * TT; const f32x4* xr = (const f32x4*)(t < NMETA ? F.meta + (size_t)t * 1024 : F.x + ((size_t)b * SEQ + (t - NMETA)) * 1024) + lane;
#pragma unroll
              for (int j = 0; j < 4; ++j) nx[q][j] = xr[64 * j]; } }
#pragma unroll
        for (int q = 0; q < 2; ++q) {
            const int v = 2 * pr + q, b = v / TT, t = v - b * TT;
            float s = 0.f;
#pragma unroll
            for (int j = 0; j < 4; ++j) s += (vv[q][j].x * vv[q][j].x + vv[q][j].y * vv[q][j].y) + (vv[q][j].z * vv[q][j].z + vv[q][j].w * vv[q][j].w);
            const float rs = __builtin_amdgcn_rsqf(wave_sum(s) * (1.0f / 1024.0f) + EPSN);
            u32x2* o8 = (u32x2*)(F.H + (size_t)(b * PP + PADL + t) * 1024) + lane;
#pragma unroll
            for (int j = 0; j < 4; ++j) { u32x2 wv; wv.x = cvtpk(vv[q][j].x * rs * gg[j].x, vv[q][j].y * rs * gg[j].y); wv.y = cvtpk(vv[q][j].z * rs * gg[j].z, vv[q][j].w * rs * gg[j].w); o8[64 * j] = wv; }
        }
    }
}

struct LruIn { float xv[11]; float gate[8]; float cw0, cw1, cw2, cw3, cbv, k0, k1, br0, bi0, br1, bi1, cf, cb; pg8::bf16x8 bfr[2][2]; };
template <bool FINAL>
__device__ __forceinline__ void lru_load(const Fr& F, size_t rowbase, int pw, int c, size_t sidx, const unsigned short* gwp, LruIn& L) {
#pragma unroll
    for (int i = 0; i < 11; ++i) { const int p = pw - 2 + i; const int pc = p < 0 ? 0 : (p >= PP ? PP - 1 : p); const float v = bf2f(F.Z[(rowbase + pc) * ZC + ZC_LX + c]); L.xv[i] = (p == pc) ? v : 0.f; }
    if (FINAL) {
#pragma unroll
        for (int j = 0; j < 8; ++j) L.gate[j] = bf2f(F.Z[(rowbase + pw + j) * ZC + ZC_LG + c]);
    }
    L.cw0 = F.conv_w[c]; L.cw1 = F.conv_w[512 + c]; L.cw2 = F.conv_w[1024 + c]; L.cw3 = F.conv_w[1536 + c]; L.cbv = F.conv_b[c];
    L.k0 = F.lam[c]; L.k1 = F.lam[512 + c];
    L.br0 = F.b_r[c]; L.bi0 = F.b_i[c]; L.br1 = F.b_r[512 + c]; L.bi1 = F.b_i[512 + c];
    if (FINAL) { L.cf = F.CARRY[sidx]; L.cb = F.CARRY[sidx + 512]; }
#pragma unroll
    for (int ks = 0; ks < 2; ++ks)
#pragma unroll
        for (int n = 0; n < 2; ++n) L.bfr[ks][n] = *(const pg8::bf16x8*)(gwp + (size_t)(16 * n) * 64 + 32 * ks);
}
template <bool FINAL>
__device__ __forceinline__ void lru_item(const Fr& F, int b, int s) {
    int lane = F.lane; asm volatile("" : "+v"(lane));
    const int w = F.wave, fr = lane & 15, fq = lane >> 4;
    LAS unsigned short* U0 = (LAS unsigned short*)F.lds;
    LAS unsigned char* G16 = F.lds + 18432;
    LAS float* SM = (LAS float*)(F.lds + 18432 + 36864);
    LAS unsigned short* YL = (LAS unsigned short*)(F.lds + 18432 + 36864 + 8192);
    const int pw = s * 64 + 8 * w; const size_t rowbase = (size_t)b * PP;
    constexpr float LOG2E = 1.4426950408889634f;
    float ssq[8];
#pragma unroll
    for (int j = 0; j < 8; ++j) ssq[j] = 0.f;
    const size_t sbase = ((size_t)(b * NSEG + s) * 2) * 512;
    const unsigned short* gw0 = F.GW + (size_t)(32 * w + fr) * 64 + 8 * fq;
    LruIn L; lru_load<FINAL>(F, rowbase, pw, lane, sbase + lane, gw0, L);
    float u[8];
#pragma unroll
    for (int j = 0; j < 8; ++j) { u[j] = L.cbv + L.cw0 * L.xv[j] + L.cw1 * L.xv[j + 1] + L.cw2 * L.xv[j + 2] + L.cw3 * L.xv[j + 3]; U0[(8 * w + j) * 72 + lane] = f2bf16(u[j]); }
    __syncthreads();
    for (int blk = 0; blk < 8; ++blk) {
        const int c = blk * 64 + lane;
        LAS unsigned short* U = U0 + (blk & 1) * 4608; LAS unsigned short* Un = U0 + ((blk & 1) ^ 1) * 4608;
        LruIn N; { const int bn = (blk < 7 ? blk + 1 : 7), cn = bn * 64 + lane; lru_load<FINAL>(F, rowbase, pw, cn, sbase + cn, gw0 + (size_t)bn * 16384, N); }
        pg8::f32x4 acc[4][2];
#pragma unroll
        for (int m = 0; m < 4; ++m) { acc[m][0] = (pg8::f32x4){0.f, 0.f, 0.f, 0.f}; acc[m][1] = acc[m][0]; }
#pragma unroll
        for (int ks = 0; ks < 2; ++ks) {
#pragma unroll
            for (int m = 0; m < 4; ++m) { const pg8::bf16x8 a = *(LAS pg8::bf16x8*)(U + (16 * m + fr) * 72 + 32 * ks + 8 * fq);
#pragma unroll
                for (int n = 0; n < 2; ++n) acc[m][n] = MFMA16(a, L.bfr[ks][n], acc[m][n]); }
        }
#pragma unroll
        for (int m = 0; m < 4; ++m)
#pragma unroll
            for (int n = 0; n < 2; ++n) { u32x2 pk; pk.x = __builtin_bit_cast(unsigned, __builtin_amdgcn_cvt_pkrtz(acc[m][n][0], acc[m][n][1])); pk.y = __builtin_bit_cast(unsigned, __builtin_amdgcn_cvt_pkrtz(acc[m][n][2], acc[m][n][3]));
                *(LAS u32x2*)(G16 + (32 * w + 16 * n + fr) * 144 + (16 * m + 4 * fq) * 2) = pk; }
        __syncthreads();
        const float kk0 = -8.0f * LOG2E * softplus_neg(L.k0), kk1 = -8.0f * LOG2E * softplus_neg(L.k1);
        const float nb_r0 = -LOG2E * L.br0, nb_i0 = -LOG2E * L.bi0, nb_r1 = -LOG2E * L.br1, nb_i1 = -LOG2E * L.bi1;
        typedef _Float16 h16x8 __attribute__((ext_vector_type(8)));
        const h16x8 g0 = *(LAS h16x8*)(G16 + (0 * 64 + lane) * 144 + 16 * w), g1 = *(LAS h16x8*)(G16 + (1 * 64 + lane) * 144 + 16 * w);
        const h16x8 g2 = *(LAS h16x8*)(G16 + (2 * 64 + lane) * 144 + 16 * w), g3 = *(LAS h16x8*)(G16 + (3 * 64 + lane) * 144 + 16 * w);
        float hf[8], pf[8], hb[8], pb[8], af[8], ab[8];
#pragma unroll
        for (int j = 0; j < 8; ++j) {
            const float r0 = __builtin_amdgcn_rcpf(1.0f + __builtin_amdgcn_exp2f(__builtin_fmaf((float)g0[j], -LOG2E, nb_r0))), i0 = __builtin_amdgcn_rcpf(1.0f + __builtin_amdgcn_exp2f(__builtin_fmaf((float)g1[j], -LOG2E, nb_i0)));
            const float r1 = __builtin_amdgcn_rcpf(1.0f + __builtin_amdgcn_exp2f(__builtin_fmaf((float)g2[j], -LOG2E, nb_r1))), i1 = __builtin_amdgcn_rcpf(1.0f + __builtin_amdgcn_exp2f(__builtin_fmaf((float)g3[j], -LOG2E, nb_i1)));
            const float a0 = __builtin_amdgcn_exp2f(kk0 * r0), a1 = __builtin_amdgcn_exp2f(kk1 * r1);
            const float e0 = fmaxf(__builtin_fmaf(-a0, a0, 1.0f), 0.f), e1 = fmaxf(__builtin_fmaf(-a1, a1, 1.0f), 0.f);
            af[j] = a0; ab[j] = a1;
            hf[j] = __builtin_amdgcn_sqrtf(e0) * i0 * u[j]; hb[j] = __builtin_amdgcn_sqrtf(e1) * i1 * u[j];
        }
        if (s < 2) {
#pragma unroll
            for (int j = 0; j < 8; ++j) { const bool padp = (pw + j) < PADL; af[j] = padp ? 1.0f : af[j]; ab[j] = padp ? 1.0f : ab[j]; hf[j] = padp ? 0.0f : hf[j]; hb[j] = padp ? 0.0f : hb[j]; }
        }
        { float h = 0.f, P = 1.f;
#pragma unroll
          for (int j = 0; j < 8; ++j) { h = af[j] * h + hf[j]; hf[j] = h; P *= af[j]; pf[j] = P; } }
        { float h = 0.f, P = 1.f;
#pragma unroll
          for (int j = 7; j >= 0; --j) { h = ab[j] * h + hb[j]; hb[j] = h; P *= ab[j]; pb[j] = P; } }
        SM[((0 * 8 + w) * 2 + 0) * 64 + lane] = pf[7]; SM[((0 * 8 + w) * 2 + 1) * 64 + lane] = hf[7];
        SM[((1 * 8 + w) * 2 + 0) * 64 + lane] = pb[0]; SM[((1 * 8 + w) * 2 + 1) * 64 + lane] = hb[0];
        float un[8];
#pragma unroll
        for (int j = 0; j < 8; ++j) { un[j] = N.cbv + N.cw0 * N.xv[j] + N.cw1 * N.xv[j + 1] + N.cw2 * N.xv[j + 2] + N.cw3 * N.xv[j + 3]; Un[(8 * w + j) * 72 + lane] = f2bf16(un[j]); }
        __syncthreads();
        const size_t sidx = sbase + c;
        if (!FINAL) {
            if (w == 0) {
                float cf = 0.f, Af = 1.f, cb = 0.f, Ab = 1.f;
#pragma unroll
                for (int w2 = 0; w2 < 8; ++w2) { const float A = SM[((0 * 8 + w2) * 2 + 0) * 64 + lane], H = SM[((0 * 8 + w2) * 2 + 1) * 64 + lane]; cf = A * cf + H; Af *= A; }
#pragma unroll
                for (int w2 = 7; w2 >= 0; --w2) { const float A = SM[((1 * 8 + w2) * 2 + 0) * 64 + lane], H = SM[((1 * 8 + w2) * 2 + 1) * 64 + lane]; cb = A * cb + H; Ab *= A; }
                F.SUMM[sidx] = (f32x2){Af, cf}; F.SUMM[sidx + 512] = (f32x2){Ab, cb};
            }
        } else {
            float cf = L.cf, cb = L.cb;
#pragma unroll
            for (int w2 = 0; w2 < 8; ++w2) if (w2 < w) { const float A = SM[((0 * 8 + w2) * 2 + 0) * 64 + lane], H = SM[((0 * 8 + w2) * 2 + 1) * 64 + lane]; cf = A * cf + H; }
#pragma unroll
            for (int w2 = 7; w2 >= 0; --w2) if (w2 > w) { const float A = SM[((1 * 8 + w2) * 2 + 0) * 64 + lane], H = SM[((1 * 8 + w2) * 2 + 1) * 64 + lane]; cb = A * cb + H; }
#pragma unroll
            for (int j = 0; j < 8; ++j) {
                const float y = ((hf[j] + pf[j] * cf) + (hb[j] + pb[j] * cb)) * gelu_tanh_f(L.gate[j]);
                ssq[j] += y * y; YL[(8 * w + j) * 520 + c] = f2bf16(y);
            }
        }
        L = N;
#pragma unroll
        for (int j = 0; j < 8; ++j) u[j] = un[j];
    }
    if (FINAL) {
        const f32x4 og0 = *(const f32x4*)(F.lru_out_g + 8 * lane), og1 = *(const f32x4*)(F.lru_out_g + 8 * lane + 4);
#pragma unroll
        for (int j = 0; j < 8; ++j) {
            const float rs = __builtin_amdgcn_rsqf(wave_sum(ssq[j]) * (1.0f / 512.0f) + EPSN);
            const u32x4 v = *(LAS u32x4*)(YL + (8 * w + j) * 520 + 8 * lane);
            u32x4 o; o.x = cvtpk(__uint_as_float(v.x << 16) * rs * og0[0], __uint_as_float(v.x & 0xffff0000u) * rs * og0[1]); o.y = cvtpk(__uint_as_float(v.y << 16) * rs * og0[2], __uint_as_float(v.y & 0xffff0000u) * rs * og0[3]);
            o.z = cvtpk(__uint_as_float(v.z << 16) * rs * og1[0], __uint_as_float(v.z & 0xffff0000u) * rs * og1[1]); o.w = cvtpk(__uint_as_float(v.w << 16) * rs * og1[2], __uint_as_float(v.w & 0xffff0000u) * rs * og1[3]);
            *(u32x4*)(F.H + (rowbase + pw + j) * 1024 + 8 * lane) = o;
        }
        __syncthreads();
    }
}

struct Lru2A { float xv[2][11]; float cw[2][5]; };
__device__ __forceinline__ void lru2_loadA(const Fr& F, size_t rowbase, int pw, int it, int lane, Lru2A& A) {
#pragma unroll
    for (int h = 0; h < 2; ++h) { const int c = (2 * it + h) * 64 + lane;
#pragma unroll
        for (int i = 0; i < 11; ++i) { const int p = pw - 2 + i; const int pc = p < 0 ? 0 : (p >= PP ? PP - 1 : p); const float v = bf2f(F.Z[(rowbase + pc) * ZC + ZC_LX + c]); A.xv[h][i] = (p == pc) ? v : 0.f; }
        A.cw[h][0] = F.conv_w[c]; A.cw[h][1] = F.conv_w[512 + c]; A.cw[h][2] = F.conv_w[1024 + c]; A.cw[h][3] = F.conv_w[1536 + c]; A.cw[h][4] = F.conv_b[c]; }
}
__device__ __forceinline__ void lru2_writeU(LAS unsigned short* Upar, int w, int lane, const Lru2A& A) {
#pragma unroll
    for (int h = 0; h < 2; ++h)
#pragma unroll
        for (int j = 0; j < 8; ++j) { const float u = A.cw[h][4] + A.cw[h][0] * A.xv[h][j] + A.cw[h][1] * A.xv[h][j + 1] + A.cw[h][2] * A.xv[h][j + 2] + A.cw[h][3] * A.xv[h][j + 3];
            const int rho = 16 * (2 * (w & 1) + (j >> 2)) + 4 * (w >> 1) + (j & 3);
            Upar[h * 4608 + rho * 72 + lane] = f2bf16(u); }
}
template <bool FINAL>
__device__ __forceinline__ void lru2_item(const Fr& F, int b, int s) {
    int lane = F.lane; asm volatile("" : "+v"(lane));
    const int w = F.wave, fr = lane & 15, fq = lane >> 4, cg = w & 3;
    LAS unsigned short* U0 = (LAS unsigned short*)F.lds;
    LAS unsigned short* YL = (LAS unsigned short*)(F.lds + 36864);
    LAS float* SSP = (LAS float*)(F.lds + 36864 + 66560);
    const int p0 = s * 64, pw = p0 + 8 * w; const size_t rowbase = (size_t)b * PP;
    const size_t sbase = ((size_t)(b * NSEG + s) * 2) * 512;
    constexpr float LOG2E = 1.4426950408889634f;
    float ssq[16];
#pragma unroll
    for (int q = 0; q < 16; ++q) ssq[q] = 0.f;
    { Lru2A A0; lru2_loadA(F, rowbase, pw, 0, lane, A0); lru2_writeU(U0, w, lane, A0); }
    __syncthreads();
    for (int it = 0; it < 4; ++it) {
        const int blk = 2 * it + (w >> 2), c = blk * 64 + 16 * cg + fr;
        LAS unsigned short* U = U0 + ((it & 1) * 2 + (w >> 2)) * 4608;
        pg8::bf16x8 bfr[4][2];
        { const unsigned short* gp = F.GW2 + ((size_t)((blk * 4) * 4 + cg) * 16 + fr) * 64 + 8 * fq;
#pragma unroll
          for (int g = 0; g < 4; ++g)
#pragma unroll
              for (int ks = 0; ks < 2; ++ks) bfr[g][ks] = *(const pg8::bf16x8*)(gp + (size_t)g * 4096 + 32 * ks); }
        const float lam0 = F.lam[c], lam1 = F.lam[512 + c], br0 = F.b_r[c], bi0 = F.b_i[c], br1 = F.b_r[512 + c], bi1 = F.b_i[512 + c];
        float cin0 = 0.f, cin1 = 0.f; if (FINAL) { cin0 = F.CARRY[sbase + c]; cin1 = F.CARRY[sbase + 512 + c]; }
        float gt[16];
        if (FINAL) {
#pragma unroll
            for (int q = 0; q < 16; ++q) gt[q] = bf2f(F.Z[(rowbase + p0 + 16 * fq + q) * ZC + ZC_LG + c]);
        }
        Lru2A N; lru2_loadA(F, rowbase, pw, it < 3 ? it + 1 : 3, lane, N);
        pg8::f32x4 acc[4][4];
#pragma unroll
        for (int g = 0; g < 4; ++g)
#pragma unroll
            for (int m = 0; m < 4; ++m) acc[g][m] = (pg8::f32x4){0.f, 0.f, 0.f, 0.f};
#pragma unroll
        for (int ks = 0; ks < 2; ++ks)
#pragma unroll
            for (int m = 0; m < 4; ++m) {
                const pg8::bf16x8 an = *(LAS pg8::bf16x8*)(U + (16 * m + fr) * 72 + 32 * ks + 8 * fq);
                const pg8::bf16x8 ar = *(LAS pg8::bf16x8*)(U + (63 - 16 * m - fr) * 72 + 32 * ks + 8 * fq);
                acc[0][m] = MFMA16(an, bfr[0][ks], acc[0][m]); acc[1][m] = MFMA16(an, bfr[1][ks], acc[1][m]);
                acc[2][m] = MFMA16(ar, bfr[2][ks], acc[2][m]); acc[3][m] = MFMA16(ar, bfr[3][ks], acc[3][m]);
            }
        float hf[16], hb[16];
#pragma unroll
        for (int d = 0; d < 2; ++d) {
            const float kk = -8.0f * LOG2E * softplus_neg(d ? lam1 : lam0), nbr = -LOG2E * (d ? br1 : br0), nbi = -LOG2E * (d ? bi1 : bi0);
            float al[16], xl[16];
#pragma unroll
            for (int m = 0; m < 4; ++m)
#pragma unroll
                for (int rg = 0; rg < 4; ++rg) { const int q = 4 * m + rg; const int row = d ? 63 - (16 * m + 4 * fq + rg) : (16 * m + 4 * fq + rg);
                    const float uu = bf2f(U[row * 72 + 16 * cg + fr]);
                    const float r = __builtin_amdgcn_rcpf(1.0f + __builtin_amdgcn_exp2f(__builtin_fmaf(acc[2 * d][m][rg], -LOG2E, nbr))), ii = __builtin_amdgcn_rcpf(1.0f + __builtin_amdgcn_exp2f(__builtin_fmaf(acc[2 * d + 1][m][rg], -LOG2E, nbi)));
                    const float a = __builtin_amdgcn_exp2f(kk * r); const float e = fmaxf(__builtin_fmaf(-a, a, 1.0f), 0.f);
                    al[q] = a; xl[q] = __builtin_amdgcn_sqrtf(e) * ii * uu; }
            if (s < 2) {
#pragma unroll
                for (int q = 0; q < 16; ++q) { const int p = d ? p0 + 63 - (16 * fq + q) : p0 + 16 * fq + q; const bool padp = p < PADL; al[q] = padp ? 1.0f : al[q]; xl[q] = padp ? 0.0f : xl[q]; }
            }
            { float h = 0.f, P = 1.f;
#pragma unroll
              for (int q = 0; q < 16; ++q) { h = al[q] * h + xl[q]; xl[q] = h; P *= al[q]; al[q] = P; } }
            const float Ar = al[15], Hr = xl[15];
            const float A0 = __shfl(Ar, fr), H0 = __shfl(Hr, fr), A1 = __shfl(Ar, fr + 16), H1 = __shfl(Hr, fr + 16), A2 = __shfl(Ar, fr + 32), H2 = __shfl(Hr, fr + 32);
            float cc = FINAL ? (d ? cin1 : cin0) : 0.f;
            if (fq > 0) cc = A0 * cc + H0;
            if (fq > 1) cc = A1 * cc + H1;
            if (fq > 2) cc = A2 * cc + H2;
            if (!FINAL) { if (fq == 3) F.SUMM[sbase + d * 512 + c] = (f32x2){A0 * A1 * A2 * Ar, Ar * cc + Hr}; }
            else {
#pragma unroll
                for (int q = 0; q < 16; ++q) { const float hv = xl[q] + al[q] * cc; if (d) hb[q] = hv; else hf[q] = hv; }
            }
        }
        if (FINAL) {
#pragma unroll
            for (int q = 0; q < 16; ++q) { const float hbp = __shfl(hb[15 - q], lane ^ 48);
                const float y = (hf[q] + hbp) * gelu_tanh_f(gt[q]); ssq[q] += y * y; YL[(16 * fq + q) * 520 + c] = f2bf16(y); }
        }
        if (it < 3) { lru2_writeU(U0 + ((it & 1) ^ 1) * 9216, w, lane, N); __syncthreads(); }
    }
    if (FINAL) {
#pragma unroll
        for (int q = 0; q < 16; ++q) { float v = ssq[q]; v += __shfl_xor(v, 1); v += __shfl_xor(v, 2); v += __shfl_xor(v, 4); v += __shfl_xor(v, 8); ssq[q] = v; }
        if (fr == 0) {
#pragma unroll
            for (int q = 0; q < 16; ++q) SSP[w * 64 + 16 * fq + q] = ssq[q]; }
        __syncthreads();
        const f32x4 og0 = *(const f32x4*)(F.lru_out_g + 8 * lane), og1 = *(const f32x4*)(F.lru_out_g + 8 * lane + 4);
#pragma unroll
        for (int j = 0; j < 8; ++j) {
            float tot = 0.f;
#pragma unroll
            for (int w2 = 0; w2 < 8; ++w2) tot += SSP[w2 * 64 + 8 * w + j];
            const float rs = __builtin_amdgcn_rsqf(tot * (1.0f / 512.0f) + EPSN);
            const u32x4 v = *(LAS u32x4*)(YL + (8 * w + j) * 520 + 8 * lane);
            u32x4 o; o.x = cvtpk(__uint_as_float(v.x << 16) * rs * og0[0], __uint_as_float(v.x & 0xffff0000u) * rs * og0[1]); o.y = cvtpk(__uint_as_float(v.y << 16) * rs * og0[2], __uint_as_float(v.y & 0xffff0000u) * rs * og0[3]);
            o.z = cvtpk(__uint_as_float(v.z << 16) * rs * og1[0], __uint_as_float(v.z & 0xffff0000u) * rs * og1[1]); o.w = cvtpk(__uint_as_float(v.w << 16) * rs * og1[2], __uint_as_float(v.w & 0xffff0000u) * rs * og1[3]);
            *(u32x4*)(F.H + (rowbase + pw + j) * 1024 + 8 * lane) = o;
        }
        __syncthreads();
    }
}

#ifdef RF_V3
constexpr int LDS_GT = LDS_MAIN + 8192;
#else
constexpr int LDS_GT = LDS_SS + 1024;
#endif
template <int SKIP> __device__ __forceinline__ int ret_count(int w, int G) { if (G != 256) return (2080 - w + G - 1) / G; return (w < 32 + 16 * SKIP) ? 9 : (w >= 240 ? 8 - SKIP : 8); }
template <int SKIP> __device__ __forceinline__ int ret_item(int w, int j, int G) { if (G != 256 || j < 8) return w + G * j; if (w < 32) return 2048 + w; const int k = w - 32; return 240 + (k & 15) + 256 * (7 - (k >> 4)); }
__device__ __forceinline__ void ret_coord(int it, int& b, int& h, int& n) { n = it % NCHUNK; const int bh = it / NCHUNK; b = bh >> 2; h = bh & 3; }
struct RcIn { u32x4 k[4], v[4]; };
__device__ __forceinline__ void rc_load(const Fr& F, int tid, int it, RcIn& R) {
    int b, h, n; ret_coord(it, b, h, n);
    const unsigned short* base = F.Z + ((size_t)b * PP + 128 * n) * ZC + 128 * h;
#pragma unroll
    for (int q = 0; q < 4; ++q) { const int idx = tid + 512 * q, c = idx >> 4, ch = idx & 15; const unsigned short* p = base + (size_t)c * ZC + 8 * ch; R.k[q] = *(const u32x4*)(p + ZC_K); R.v[q] = *(const u32x4*)(p + ZC_V); }
}
__device__ __forceinline__ unsigned scale_pk(unsigned w, float s) { return cvtpk(__uint_as_float(w << 16) * s, __uint_as_float(w & 0xffff0000u) * s); }
__device__ __forceinline__ void ph_ret_contrib(const Fr& F) {
    const int w = F.wave;
    LAS unsigned char* TKF = F.lds; LAS unsigned char* TKB = F.lds + 32768; LAS unsigned char* TV = F.lds + 65536;
    if ((int)blockIdx.x >= 2080) return;
    const int nj = ret_count<2>(blockIdx.x, F.G);
    RcIn R; rc_load(F, F.tid, ret_item<2>(blockIdx.x, 0, F.G), R);
    for (int jj = 0; jj < nj; ++jj) {
        const int it = ret_item<2>(blockIdx.x, jj, F.G);
        int lane = F.lane, tid = threadIdx.x; asm volatile("" : "+v"(lane), "+v"(tid));
        const int r = lane & 31, h2 = lane >> 5;
        int b, h, n; ret_coord(it, b, h, n); const float lg = log2_gamma(h);
#pragma unroll
        for (int q = 0; q < 4; ++q) { const int idx = tid + 512 * q, c = idx >> 4, ch = idx & 15; const float sf = __builtin_amdgcn_exp2f(lg * (float)(127 - c)), sb = __builtin_amdgcn_exp2f(lg * (float)c);
            u32x4 kf, kb; kf.x = scale_pk(R.k[q].x, sf); kf.y = scale_pk(R.k[q].y, sf); kf.z = scale_pk(R.k[q].z, sf); kf.w = scale_pk(R.k[q].w, sf);
            kb.x = scale_pk(R.k[q].x, sb); kb.y = scale_pk(R.k[q].y, sb); kb.z = scale_pk(R.k[q].z, sb); kb.w = scale_pk(R.k[q].w, sb);
            const unsigned o = off_b(c, ch); *(LAS u32x4*)(TKF + o) = kf; *(LAS u32x4*)(TKB + o) = kb; *(LAS u32x4*)(TV + o) = R.v[q]; }
        if (jj + 1 < nj) rc_load(F, tid, ret_item<2>(blockIdx.x, jj + 1, F.G), R);
        __syncthreads();
        const int dir = w >> 2, cb = w & 3; LAS unsigned char* TK = dir ? TKB : TKF;
        f32x16 acc[4];
#pragma unroll
        for (int eb = 0; eb < 4; ++eb)
#pragma unroll
            for (int i = 0; i < 16; ++i) acc[eb][i] = 0.f;
#pragma unroll 2
        for (int ks = 0; ks < 8; ++ks) {
            const pg8::bf16x8 a = trfrag(TK, cb, ks, lane);
#pragma unroll
            for (int eb = 0; eb < 4; ++eb) { const pg8::bf16x8 bv = trfrag(TV, eb, ks, lane); acc[eb] = MFMA32(a, bv, acc[eb]); }
        }
        __syncthreads();
#pragma unroll
        for (int eb = 0; eb < 4; ++eb)
#pragma unroll
            for (int g = 0; g < 4; ++g) { u32x2 v; v.x = cvtpk(acc[eb][4 * g], acc[eb][4 * g + 1]); v.y = cvtpk(acc[eb][4 * g + 2], acc[eb][4 * g + 3]);
                *(LAS u32x2*)(TK + off_b(32 * eb + r, 4 * cb + g) + 8 * h2) = v; }
        __syncthreads();
        unsigned short* dst = F.ST + ((size_t)(((b * 4 + h) * 2) * NCHUNK + n)) * 16384;
#pragma unroll
        for (int q = 0; q < 8; ++q) { const int idx = tid + 512 * q, tile = idx >> 11, rem = idx & 2047, e = rem >> 4, ch = rem & 15;
            const u32x4 v = *(LAS u32x4*)(F.lds + tile * 32768 + off_b(e, ch)); *(u32x4*)(dst + (size_t)tile * NCHUNK * 16384 + (size_t)e * 128 + 8 * ch) = v; }
        __syncthreads();
    }
}
struct RfIn { u32x4 q[4], k[4], v[4]; };
struct RsIn { u32x4 sf[4], sb[4], g[4]; };
__device__ __forceinline__ void rf_load(const Fr& F, int tid, int it, RfIn& R) {
    int b, h, n; ret_coord(it, b, h, n);
    const unsigned short* base = F.Z + ((size_t)b * PP + 128 * n) * ZC + 128 * h;
#pragma unroll
#ifdef RF_V5
    for (int q = 0; q < 4; ++q) { const int idx = tid + 512 * q, c = idx >> 4, ch = idx & 15; const unsigned short* p = base + (size_t)c * ZC + 8 * ch; R.q[q] = *(const u32x4*)(base + (size_t)(c ^ 1) * ZC + 8 * ch + ZC_Q); R.k[q] = *(const u32x4*)(p + ZC_K); R.v[q] = *(const u32x4*)(p + ZC_V); }
#else
    for (int q = 0; q < 4; ++q) { const int idx = tid + 512 * q, c = idx >> 4, ch = idx & 15; const unsigned short* p = base + (size_t)c * ZC + 8 * ch; R.q[q] = *(const u32x4*)(p + ZC_Q); R.k[q] = *(const u32x4*)(p + ZC_K); R.v[q] = *(const u32x4*)(p + ZC_V); }
#endif
}
__device__ __forceinline__ void rs_load(const Fr& F, int tid, int b, int h, int n, RsIn& R) {
    const unsigned short* sf = F.ST2 + ((size_t)(((b * 4 + h) * 2 + 0) * NCHUNK + n)) * 16384; const unsigned short* sb = sf + (size_t)NCHUNK * 16384;
    const unsigned short* gb = F.Z + ((size_t)b * PP + 128 * n) * ZC + ZC_G + 128 * h;
#pragma unroll
    for (int q = 0; q < 4; ++q) { const int idx = tid + 512 * q, c = idx >> 4, ch = idx & 15; R.sf[q] = *(const u32x4*)(sf + (size_t)c * 128 + 8 * ch); R.sb[q] = *(const u32x4*)(sb + (size_t)c * 128 + 8 * ch); R.g[q] = *(const u32x4*)(gb + (size_t)c * ZC + 8 * ch); }
}
#ifdef RF_EXTRA
#define RF_XBAR asm volatile("s_waitcnt vmcnt(0) lgkmcnt(0)" ::: "memory"); __syncthreads();
#else
#define RF_XBAR
#endif
#define RF_FLAG(code_) atomicOr((unsigned*)(F.CTLP + 32768 + 2048), (unsigned)(code_))
#if !defined(RF_GTAB) && !defined(RF_V10) && !defined(RF_V4)
#define RF_GT(d_, c_) __builtin_amdgcn_exp2f(lg * (float)(d_))
#elif defined(RF_V4)
#define RF_GT(d_, c_) ({ const float g_ = GT[d_]; const float e_ = exp2f(lg * (float)(d_)); if (!(fabsf(g_ - e_) <= 1e-5f * e_)) RF_FLAG(c_); g_; })
#else
#define RF_GT(d_, c_) GT[d_]
#endif
#ifdef RF_V8
#define RF_QF rowfrag_x
#else
#define RF_QF rowfrag
#endif
#ifndef RF_QHOIST
#define RF_QHOIST 2
#endif
__device__ __forceinline__ void ph_ret_final(const Fr& F) {
    const int w = F.wave;
    LAS unsigned char* R0 = F.lds; LAS unsigned char* R1 = F.lds + 32768; LAS unsigned char* R2 = F.lds + 65536; LAS unsigned char* R3 = F.lds + 98304;
    LAS float* SS = (LAS float*)(F.lds + LDS_SS); LAS float* GT = (LAS float*)(F.lds + LDS_GT); (void)GT;
    if ((int)blockIdx.x >= 2080) return;
    const int nj = ret_count<1>(blockIdx.x, F.G);
#ifdef RF_V9
    const int cb = 3 - (w >> 1), ebase = 2 * (w & 1);
#else
    const int cb = w >> 1, ebase = 2 * (w & 1);
#endif
#ifndef RF_NOPF
    RfIn Rf; rf_load(F, F.tid, ret_item<1>(blockIdx.x, 0, F.G), Rf);
#endif
    for (int jj = 0; jj < nj; ++jj) {
        const int it = ret_item<1>(blockIdx.x, jj, F.G);
        int lane = F.lane, tid = threadIdx.x; asm volatile("" : "+v"(lane), "+v"(tid));
        const int r = lane & 31, h2 = lane >> 5;
        int b, h, n; ret_coord(it, b, h, n); const float lg = log2_gamma(h);
        const size_t row0 = (size_t)b * PP + 128 * n;
        __syncthreads();
#ifndef RF_NOPF
        RsIn Rs; rs_load(F, tid, b, h, n, Rs);
#else
        RfIn Rf; rf_load(F, tid, it, Rf);
        RsIn Rs; rs_load(F, tid, b, h, n, Rs);
#endif
#pragma unroll
#ifdef RF_V5
        for (int q = 0; q < 4; ++q) { const int idx = tid + 512 * q, c = idx >> 4, ch = idx & 15; const unsigned o = off_b(c, ch); *(LAS u32x4*)(R0 + off_b(c ^ 1, ch)) = Rf.q[q]; *(LAS u32x4*)(R1 + o) = Rf.k[q]; *(LAS u32x4*)(R2 + o) = Rf.v[q]; }
#elif defined(RF_V8)
        for (int q = 0; q < 4; ++q) { const int idx = tid + 512 * q, c = idx >> 4, ch = idx & 15; const unsigned o = off_b(c, ch); *(LAS u32x4*)(R0 + off_b(c ^ 1, ch)) = Rf.q[q]; *(LAS u32x4*)(R1 + o) = Rf.k[q]; *(LAS u32x4*)(R2 + o) = Rf.v[q]; }
#else
        for (int q = 0; q < 4; ++q) { const int idx = tid + 512 * q, c = idx >> 4, ch = idx & 15; const unsigned o = off_b(c, ch); *(LAS u32x4*)(R0 + o) = Rf.q[q]; *(LAS u32x4*)(R1 + o) = Rf.k[q]; *(LAS u32x4*)(R2 + o) = Rf.v[q]; }
#endif
#ifdef RF_V10
        { const int gi = tid & 255; GT[gi] = exp2f(lg * (float)gi); }
#elif defined(RF_GTAB)
        if (tid < 129) GT[tid] = exp2f(lg * (float)tid);
#endif
        const float og0 = F.ret_out_g[128 * h + 32 * ebase + r], og1 = F.ret_out_g[128 * h + 32 * (ebase + 1) + r];
        __syncthreads(); RF_XBAR
        f32x16 o[2];
#pragma unroll
        for (int eo = 0; eo < 2; ++eo)
#pragma unroll
            for (int i = 0; i < 16; ++i) o[eo][i] = 0.f;
        {
            const int cpos = 32 * cb + r;
#if RF_QHOIST >= 1
            pg8::bf16x8 qfr[8];
#pragma unroll
            for (int s = 0; s < 8; ++s) qfr[s] = RF_QF(R0, cb, s, lane);
#endif
#pragma unroll
            for (int mb = 0; mb < 4; ++mb) {
                f32x16 X;
#pragma unroll
                for (int i = 0; i < 16; ++i) X[i] = 0.f;
#if RF_QHOIST >= 1
#pragma unroll
                for (int s = 0; s < 8; ++s) { const pg8::bf16x8 kf = rowfrag(R1, mb, s, lane); X = MFMA32(kf, qfr[s], X); }
#else
#pragma unroll 2
                for (int s = 0; s < 8; ++s) { const pg8::bf16x8 qf = RF_QF(R0, cb, s, lane); const pg8::bf16x8 kf = rowfrag(R1, mb, s, lane); X = MFMA32(kf, qf, X); }
#endif
                int cpo = cpos, h2o = h2; asm volatile("" : "+v"(cpo), "+v"(h2o));
#pragma unroll
                for (int i = 0; i < 16; ++i) { const int m = 32 * mb + crow(i, h2o); const int dd = cpo > m ? cpo - m : m - cpo; X[i] *= RF_GT(dd, 1); }
#pragma unroll
                for (int s2 = 0; s2 < 2; ++s2) { u32x4 pk; pk.x = cvtpk(X[8 * s2], X[8 * s2 + 1]); pk.y = cvtpk(X[8 * s2 + 2], X[8 * s2 + 3]); pk.z = cvtpk(X[8 * s2 + 4], X[8 * s2 + 5]); pk.w = cvtpk(X[8 * s2 + 6], X[8 * s2 + 7]);
                    const pg8::bf16x8 pa = __builtin_bit_cast(pg8::bf16x8, pk);
#pragma unroll
                    for (int eo = 0; eo < 2; ++eo) { const pg8::bf16x8 vb = trfrag_perm(R2, ebase + eo, 32 * mb + 16 * s2, lane); o[eo] = MFMA32(pa, vb, o[eo]); } }
            }
        }
        RF_XBAR __syncthreads(); RF_XBAR
#pragma unroll
        for (int q = 0; q < 4; ++q) { const int idx = tid + 512 * q, c = idx >> 4, ch = idx & 15; const unsigned of = off_b(c, ch); *(LAS u32x4*)(R1 + of) = Rs.sf[q]; *(LAS u32x4*)(R3 + of) = Rs.sb[q]; *(LAS u32x4*)(R2 + of) = Rs.g[q]; }
#ifndef RF_NOPF
        rf_load(F, tid, ret_item<1>(blockIdx.x, jj + 1 < nj ? jj + 1 : jj, F.G), Rf);
#endif
        RF_XBAR __syncthreads(); RF_XBAR
#if defined(RF_QHOIST) && RF_QHOIST >= 2
        pg8::bf16x8 qfi[8];
#pragma unroll
        for (int s = 0; s < 8; ++s) qfi[s] = RF_QF(R0, cb, s, lane);
#endif
#pragma unroll
        for (int dirn = 0; dirn < 2; ++dirn) {
            LAS unsigned char* TX = dirn ? R3 : R1;
            f32x16 oi[2];
#pragma unroll
            for (int eo = 0; eo < 2; ++eo)
#pragma unroll
                for (int i = 0; i < 16; ++i) oi[eo][i] = 0.f;
#if defined(RF_QHOIST) && RF_QHOIST >= 2
#pragma unroll
            for (int s = 0; s < 8; ++s) { const pg8::bf16x8 qf = qfi[s];
#else
#pragma unroll 2
            for (int s = 0; s < 8; ++s) { const pg8::bf16x8 qf = RF_QF(R0, cb, s, lane);
#endif
#pragma unroll
                for (int eo = 0; eo < 2; ++eo) { const pg8::bf16x8 f1 = rowfrag(TX, ebase + eo, s, lane); oi[eo] = MFMA32(qf, f1, oi[eo]); } }
            int h2d = h2; asm volatile("" : "+v"(h2d));
#pragma unroll
            for (int i = 0; i < 16; ++i) { const int cl = 32 * cb + crow(i, h2d); const float dfac = RF_GT(dirn ? (128 - cl) : (cl + 1), 2);
#pragma unroll
                for (int eo = 0; eo < 2; ++eo) o[eo][i] += dfac * oi[eo][i]; }
        }
        float ssq[16];
#pragma unroll
        for (int i = 0; i < 16; ++i) {
            float s = o[0][i] * o[0][i] + o[1][i] * o[1][i];
            s += __shfl_xor(s, 1); s += __shfl_xor(s, 2); s += __shfl_xor(s, 4); s += __shfl_xor(s, 8); s += __shfl_xor(s, 16);
            ssq[i] = s; }
        if (r == 0) {
#pragma unroll
            for (int i = 0; i < 16; ++i) SS[(w & 1) * 128 + 32 * cb + crow(i, h2)] = ssq[i]; }
        RF_XBAR __syncthreads(); RF_XBAR
        int h2e = h2, re = r; asm volatile("" : "+v"(h2e), "+v"(re));
#ifdef RF_V1
#pragma unroll
        for (int i = 0; i < 16; ++i) { const int cl = 32 * cb + crow(i, h2e); const float tot = SS[cl] + SS[128 + cl]; const float rs = __builtin_amdgcn_rsqf(tot * (1.0f / 128.0f) + EPSN);
            const size_t row = row0 + cl;
#pragma unroll
            for (int eo = 0; eo < 2; ++eo) { const int e = 32 * (ebase + eo) + re; const float gv = bf2f(F.Z[row * ZC + ZC_G + 128 * h + e]);
                F.H[row * 1024 + 512 + 128 * h + e] = f2bf16(o[eo][i] * rs * (eo ? og1 : og0) * pg8::silu_f(gv)); } }
        RF_XBAR __syncthreads(); RF_XBAR
#else
#pragma unroll
        for (int i = 0; i < 16; ++i) { const int cl = 32 * cb + crow(i, h2e); const float tot = SS[cl] + SS[128 + cl]; const float rs = __builtin_amdgcn_rsqf(tot * (1.0f / 128.0f) + EPSN);
#pragma unroll
            for (int eo = 0; eo < 2; ++eo) { const int e = 32 * (ebase + eo) + re; const unsigned of = off_b(cl, e >> 3) + 2 * (e & 7);
                const float gv = bf2f(*(LAS unsigned short*)(R2 + of));
                *(LAS unsigned short*)(R3 + of) = f2bf16(o[eo][i] * rs * (eo ? og1 : og0) * pg8::silu_f(gv)); } }
        RF_XBAR __syncthreads(); RF_XBAR
#pragma unroll
#ifdef RF_V6
        for (int q = 0; q < 4; ++q) { const int idx = tid + 512 * q, c = (idx >> 4) ^ 1, ch = idx & 15; const u32x4 v = *(LAS u32x4*)(R3 + off_b(c, ch)); *(u32x4*)(F.H + (row0 + c) * 1024 + 512 + 128 * h + 8 * ch) = v; }
#else
        for (int q = 0; q < 4; ++q) { const int idx = tid + 512 * q, c = idx >> 4, ch = idx & 15; const u32x4 v = *(LAS u32x4*)(R3 + off_b(c, ch)); *(u32x4*)(F.H + (row0 + c) * 1024 + 512 + 128 * h + 8 * ch) = v; }
#endif
#endif
#ifdef RF_V11
        if (tid < 129) { const float g_ = GT[tid]; const float e_ = exp2f(lg * (float)tid); if (!(fabsf(g_ - e_) <= 1e-5f * e_)) RF_FLAG(1); }
#endif
    }
    __syncthreads();
}
__device__ __forceinline__ void ret_scan(const Fr& F) {
    for (int v = blockIdx.x * 512 + F.tid; v < 64 * 2048; v += F.G * 512) {
        const int strip = v >> 11, off = v & 2047, dir = strip & 1, h = (strip >> 1) & 3;
        const float cd = exp2f(128.0f * log2_gamma(h));
        const unsigned short* base = F.ST + (size_t)strip * NCHUNK * 16384 + (size_t)off * 8;
        unsigned short* obase = F.ST2 + (size_t)strip * NCHUNK * 16384 + (size_t)off * 8;
        float carry[8];
#pragma unroll
        for (int i = 0; i < 8; ++i) carry[i] = 0.f;
        for (int k0 = 0; k0 < NCHUNK; k0 += 5) {
            u16x8 tv[5];
#pragma unroll
            for (int j = 0; j < 5; ++j) { const int n = dir ? (NCHUNK - 1 - (k0 + j)) : (k0 + j); tv[j] = *(const u16x8*)(base + (size_t)n * 16384); }
#pragma unroll
            for (int j = 0; j < 5; ++j) { const int n = dir ? (NCHUNK - 1 - (k0 + j)) : (k0 + j); u32x4 o;
                o.x = cvtpk(carry[0], carry[1]); o.y = cvtpk(carry[2], carry[3]); o.z = cvtpk(carry[4], carry[5]); o.w = cvtpk(carry[6], carry[7]);
                *(u32x4*)(obase + (size_t)n * 16384) = o;
#pragma unroll
                for (int i = 0; i < 8; ++i) carry[i] = carry[i] * cd + bf2f(tv[j][i]); }
        }
    }
}
__device__ __forceinline__ void lru_carry(const Fr& F) {
    for (int v = blockIdx.x * 32 + F.tid; F.tid < 32 && v < NB * 2 * 512; v += F.G * 32) {
        const int c = v & 511, dir = (v >> 9) & 1, b = v >> 10;
        float carry = 0.f;
        for (int k0 = 0; k0 < NSEG; k0 += 10) {
            f32x2 ah[10];
#pragma unroll
            for (int j = 0; j < 10; ++j) { const int s = dir ? (NSEG - 1 - (k0 + j)) : (k0 + j); ah[j] = F.SUMM[((size_t)(b * NSEG + s) * 2 + dir) * 512 + c]; }
#pragma unroll
            for (int j = 0; j < 10; ++j) { const int s = dir ? (NSEG - 1 - (k0 + j)) : (k0 + j); F.CARRY[((size_t)(b * NSEG + s) * 2 + dir) * 512 + c] = carry; carry = ah[j].x * carry + ah[j].y; }
        }
    }
}
__device__ __forceinline__ void ph_checksum(const Fr& F, const void* buf, size_t bytes, int slot) {
    const unsigned* p = (const unsigned*)buf; const size_t nw = bytes / 4;
    unsigned long long sa = 0ull, sx = 0ull;
    for (size_t i = (size_t)blockIdx.x * 512 + F.tid; i < nw; i += (size_t)F.G * 512) { const unsigned long long v = p[i]; const unsigned long long h = (v + 0x9E3779B97F4A7C15ull + i) * 0xD6E8FEB86659FD93ull; sa += h; sx += (h ^ (h >> 29)) * 0xBF58476D1CE4E5B9ull; }
    unsigned a0 = (unsigned)sa, a1 = (unsigned)(sa >> 32), x0 = (unsigned)sx, x1 = (unsigned)(sx >> 32);
    for (int o = 1; o < 64; o <<= 1) { a0 += __shfl_xor(a0, o); a1 += __shfl_xor(a1, o); x0 += __shfl_xor(x0, o); x1 += __shfl_xor(x1, o); }
    sa = ((unsigned long long)a1 << 32) | a0; sx = ((unsigned long long)x1 << 32) | x0;
    if (F.lane == 0) { unsigned long long* c = (unsigned long long*)(F.CTLP + 32768) + slot * 2; atomicAdd(c, sa); atomicAdd(c + 1, sx); }
}
__device__ __forceinline__ void ph_cpy(const Fr& F) {
    const u32x4* s = (const u32x4*)F.H; u32x4* d = (u32x4*)(F.CTLP + CPY_BASE); const size_t nv = (size_t)NP * 2048 / 16;
    for (size_t i = (size_t)blockIdx.x * 512 + F.tid; i < nv; i += (size_t)F.G * 512) d[i] = s[i];
}
__device__ __forceinline__ void ph_cmp(const Fr& F) {
    const unsigned* a = (const unsigned*)F.H; const unsigned* c = (const unsigned*)(F.CTLP + CPY_BASE); const size_t nw = (size_t)NP * 2048 / 4;
    unsigned* st = (unsigned*)(F.CTLP + 32768 + 4096);
    for (size_t i = (size_t)blockIdx.x * 512 + F.tid; i < nw; i += (size_t)F.G * 512) {
        const unsigned x = a[i], y = c[i];
        if (x != y) { const unsigned idx = (unsigned)i;
            const float x0 = __uint_as_float(x << 16), x1 = __uint_as_float(x & 0xffff0000u), y0 = __uint_as_float(y << 16), y1 = __uint_as_float(y & 0xffff0000u);
            const float d0 = fabsf(x0 - y0), d1 = fabsf(x1 - y1); const float d = fmaxf(d0, d1);
            const float m = (d0 >= d1) ? fmaxf(fabsf(x0), fabsf(y0)) : fmaxf(fabsf(x1), fabsf(y1)); const float rel = d / fmaxf(m, 1e-30f);
            atomicAdd(st + 0, 1u); atomicMax(st + 1, ~idx); atomicMax(st + 2, idx); atomicOr(st + 3, ~idx); atomicOr(st + 4, idx);
            atomicMax(st + 5, __float_as_uint(d)); atomicMax(st + 6, __float_as_uint(rel));
            if (fabsf(y0) > 0.02f && fabsf(y1) > 0.02f) { const float ra = x0 / y0, rb = x1 / y1; atomicMax(st + 9, __float_as_uint(fabsf(ra - rb) / fmaxf(fabsf(ra), fabsf(rb)))); atomicMax(st + 10, __float_as_uint(fabsf(ra))); atomicMax(st + 11, __float_as_uint(1.0f / fmaxf(fabsf(ra), 1e-30f))); atomicAdd(st + 12, 1u); if (fabsf(ra - rb) / fmaxf(fabsf(ra), fabsf(rb)) < 0.03f) atomicAdd(st + 13, 1u); else atomicAdd(st + 14, 1u); }
            { const unsigned row_ = idx >> 9, cw_ = idx & 511u, cid_ = row_ >> 7; const unsigned item_ = (cw_ & 256u) ? ((cid_ / 65u) * 4u + ((cw_ >> 6) & 3u)) * 65u + cid_ % 65u : 2087u;
              atomicOr(st + 16 + (item_ >> 5), 1u << (item_ & 31u)); atomicAdd((unsigned*)(F.CTLP + 40960) + item_, 1u); if (d >= 0.125f) atomicAdd(st + 7, 1u); if (d >= 1.0f) atomicAdd(st + 8, 1u); } }
    }
}
__device__ __forceinline__ const unsigned short* hs_row(const Fr& F, int b, int t) { return F.HSB + (size_t)(b * PP + PADL + t) * 1024; }
__device__ __forceinline__ f32x4 bf4(u32x2 w) { return (f32x4){__uint_as_float(w.x << 16), __uint_as_float(w.x & 0xffff0000u), __uint_as_float(w.y << 16), __uint_as_float(w.y & 0xffff0000u)}; }
__device__ __forceinline__ float router_softmax(float (&pl)[16], int lane) {
    { const bool hi = lane & 32;
#pragma unroll
      for (int i = 0; i < 8; ++i) { const float send = hi ? pl[i] : pl[i + 8], keep = hi ? pl[i + 8] : pl[i]; pl[i] = keep + __shfl_xor(send, 32); } }
    { const bool hi = lane & 16;
#pragma unroll
      for (int i = 0; i < 4; ++i) { const float send = hi ? pl[i] : pl[i + 4], keep = hi ? pl[i + 4] : pl[i]; pl[i] = keep + __shfl_xor(send, 16); } }
    { const bool hi = lane & 8;
#pragma unroll
      for (int i = 0; i < 2; ++i) { const float send = hi ? pl[i] : pl[i + 2], keep = hi ? pl[i + 2] : pl[i]; pl[i] = keep + __shfl_xor(send, 8); } }
    { const bool hi = lane & 4; const float send = hi ? pl[0] : pl[1], keep = hi ? pl[1] : pl[0]; pl[0] = keep + __shfl_xor(send, 4); }
    float lg = pl[0]; lg += __shfl_xor(lg, 1); lg += __shfl_xor(lg, 2);
    float mx = lg;
    mx = fmaxf(mx, __shfl_xor(mx, 4)); mx = fmaxf(mx, __shfl_xor(mx, 8)); mx = fmaxf(mx, __shfl_xor(mx, 16)); mx = fmaxf(mx, __shfl_xor(mx, 32));
    const float ex = expf(lg - mx); float sm = ex;
    sm += __shfl_xor(sm, 4); sm += __shfl_xor(sm, 8); sm += __shfl_xor(sm, 16); sm += __shfl_xor(sm, 32);
    return ex / sm;
}
__device__ __forceinline__ void ph_router(const Fr& F) {
    LAS float* WR = (LAS float*)F.lds;
    for (int i = F.tid; i < 16384; i += 512) { const int d = i >> 4, e = i & 15; WR[e * 1024 + d] = F.w_router[i]; }
    __syncthreads();
    const int lane = F.lane;
    if (blockIdx.x == 0 && F.tid < 256) ((unsigned*)F.XS)[F.tid] = 0u;
    const int NV = NB * TT, NPAIR = NV / 2;
    const int gw = blockIdx.x * 8 + F.wave, NGW = F.G * 8;
    u32x2 nx[2][4];
    if (gw < NPAIR) {
#pragma unroll
        for (int q = 0; q < 2; ++q) { const int v = 2 * gw + q, b = v / TT, t = v - b * TT; const u32x2* xr = (const u32x2*)hs_row(F, b, t) + lane;
#pragma unroll
            for (int j = 0; j < 4; ++j) nx[q][j] = xr[64 * j]; }
    }
    f32x4 gg[4];
#pragma unroll
    for (int j = 0; j < 4; ++j) gg[j] = ((const f32x4*)F.norm2_g + lane)[64 * j];
    for (int pr = gw; pr < NPAIR; pr += NGW) {
        f32x4 vv[2][4];
#pragma unroll
        for (int q = 0; q < 2; ++q)
#pragma unroll
            for (int j = 0; j < 4; ++j) vv[q][j] = bf4(nx[q][j]);
        { const int pn = pr + NGW < NPAIR ? pr + NGW : pr;
#pragma unroll
          for (int q = 0; q < 2; ++q) { const int v = 2 * pn + q, b = v / TT, t = v - b * TT; const u32x2* xr = (const u32x2*)hs_row(F, b, t) + lane;
#pragma unroll
              for (int j = 0; j < 4; ++j) nx[q][j] = xr[64 * j]; } }
        int bq[2], tq[2];
#pragma unroll
        for (int q = 0; q < 2; ++q) {
            const int v = 2 * pr + q; bq[q] = v / TT; tq[q] = v - bq[q] * TT;
            float s = 0.f;
#pragma unroll
            for (int j = 0; j < 4; ++j) s += (vv[q][j].x * vv[q][j].x + vv[q][j].y * vv[q][j].y) + (vv[q][j].z * vv[q][j].z + vv[q][j].w * vv[q][j].w);
            const float rs = __builtin_amdgcn_rsqf(wave_sum(s) * (1.0f / 1024.0f) + EPSN);
            unsigned* o8 = (unsigned*)((unsigned char*)F.XS + (size_t)(bq[q] * PP + PADL + tq[q]) * 1024) + lane;
#pragma unroll
            for (int j = 0; j < 4; ++j) { vv[q][j].x *= rs * gg[j].x; vv[q][j].y *= rs * gg[j].y; vv[q][j].z *= rs * gg[j].z; vv[q][j].w *= rs * gg[j].w;
                unsigned wv = 0u; wv = __builtin_amdgcn_cvt_pk_fp8_f32(vv[q][j].x, vv[q][j].y, wv, false); wv = __builtin_amdgcn_cvt_pk_fp8_f32(vv[q][j].z, vv[q][j].w, wv, true); o8[64 * j] = wv; }
        }
        float pl0[16], pl1[16];
#pragma unroll
        for (int e = 0; e < 16; ++e) { f32x2 a0 = {0.f, 0.f}, a1 = {0.f, 0.f};
#pragma unroll
            for (int j = 0; j < 4; ++j) { const f32x4 wv = *(LAS f32x4*)(WR + e * 1024 + 256 * j + 4 * lane);
                const f32x2 wlo = __builtin_shufflevector(wv, wv, 0, 1), whi = __builtin_shufflevector(wv, wv, 2, 3);
                a0 = __builtin_elementwise_fma(__builtin_shufflevector(vv[0][j], vv[0][j], 0, 1), wlo, a0); a0 = __builtin_elementwise_fma(__builtin_shufflevector(vv[0][j], vv[0][j], 2, 3), whi, a0);
                a1 = __builtin_elementwise_fma(__builtin_shufflevector(vv[1][j], vv[1][j], 0, 1), wlo, a1); a1 = __builtin_elementwise_fma(__builtin_shufflevector(vv[1][j], vv[1][j], 2, 3), whi, a1); }
            pl0[e] = a0.x + a0.y; pl1[e] = a1.x + a1.y; if ((e & 3) == 3) asm volatile("" ::: "memory"); }
        const float p0 = router_softmax(pl0, lane), p1 = router_softmax(pl1, lane);
        const int e = ((lane >> 5) & 1) * 8 + ((lane >> 4) & 1) * 4 + ((lane >> 3) & 1) * 2 + ((lane >> 2) & 1);
        if ((lane & 3) == 0) { F.AFF[(size_t)(bq[0] * NE + e) * TT + tq[0]] = p0; F.AFF[(size_t)(bq[1] * NE + e) * TT + tq[1]] = p1; }
    }
    __syncthreads();
}

__device__ __forceinline__ void topk_item(const Fr& F, int b, int e) {
    LAS unsigned* vals = (LAS unsigned*)F.lds;
    LAS unsigned* hist = vals + 8256;
    LAS unsigned* misc = hist + 256;
    LAS unsigned* wsum = misc + 16;
    const int tid = F.tid, lane = F.lane, w = F.wave;
    const float* aff = F.AFF + (size_t)(b * NE + e) * TT;
    for (int t = tid; t < TT; t += 512) vals[t] = __float_as_uint(aff[t]);
    unsigned prefix = 0u, mask = 0u, k = CAP;
    for (int pass = 0; pass < 4; ++pass) {
        const int shift = 24 - 8 * pass;
        if (tid < 256) hist[tid] = 0u;
        __syncthreads();
        for (int t = tid; t < TT; t += 512) { const unsigned v = vals[t]; if ((v & mask) == prefix) __hip_atomic_fetch_add(&hist[(v >> shift) & 255u], 1u, __ATOMIC_RELAXED, __HIP_MEMORY_SCOPE_WORKGROUP); }
        __syncthreads();
        if (w == 0) {
            unsigned c[4]; unsigned s = 0u;
#pragma unroll
            for (int i = 0; i < 4; ++i) { c[i] = hist[255 - (4 * lane + i)]; s += c[i]; }
            unsigned incl = s;
#pragma unroll
            for (int o = 1; o < 64; o <<= 1) { const unsigned y = __shfl_up(incl, o); if (lane >= o) incl += y; }
            unsigned cum = incl - s;
#pragma unroll
            for (int i = 0; i < 4; ++i) { if (cum < k && cum + c[i] >= k) { misc[0] = prefix | ((unsigned)(255 - (4 * lane + i)) << shift); misc[1] = k - cum; } cum += c[i]; }
        }
        __syncthreads();
        prefix = misc[0]; k = misc[1]; mask |= 0xFFu << shift;
        __syncthreads();
    }
    const unsigned thr = prefix, keq = k;
    const int t0 = tid * 17;
    unsigned loc = 0u;
#pragma unroll
    for (int i = 0; i < 17; ++i) { const int t = t0 + i; if (t < TT) { const unsigned v = vals[t]; loc += (v > thr ? 1u : 0u) + (v == thr ? 65536u : 0u); } }
    unsigned incl = loc;
#pragma unroll
    for (int o = 1; o < 64; o <<= 1) { const unsigned y = __shfl_up(incl, o); if (lane >= o) incl += y; }
    if (lane == 63) wsum[w] = incl;
    __syncthreads();
    unsigned before = incl - loc;
#pragma unroll
    for (int w2 = 0; w2 < 8; ++w2) if (w2 < w) before += wsum[w2];
    unsigned gtb = before & 0xFFFFu, eqb = before >> 16;
    for (int i = 0; i < 17; ++i) { const int t = t0 + i; if (t < TT) {
        const unsigned v = vals[t]; const bool gt = v > thr, eq = v == thr; const bool sel = gt || (eq && eqb < keq);
        const int rrow = b * PP + PADL + t;
        int mrow = -1;
        if (sel) { const unsigned slot = gtb + (eqb < keq ? eqb : keq); mrow = e * EROWS + b * CAP + (int)slot; F.IDX[mrow] = rrow * 1024; F.GATE[mrow] = __uint_as_float(v); }
        F.ROWMAP[(size_t)rrow * NE + e] = mrow;
        gtb += gt ? 1u : 0u; eqb += eq ? 1u : 0u; } }
    if (b == 0) for (int i = tid; i < EROWS - NB * CAP; i += 512) { F.IDX[e * EROWS + NB * CAP + i] = 0; F.GATE[e * EROWS + NB * CAP + i] = 0.f; }
    __syncthreads();
}

__device__ __forceinline__ void ph_gather(const Fr& F) {
    for (int v = blockIdx.x * 8 + F.wave; v < NROWS; v += F.G * 8) {
        const int src = F.IDX[v];
        u32x4* dst = (u32x4*)(F.XS + (size_t)v * 1024) + F.lane;
        if (src >= 0) { const u32x4* sp = (const u32x4*)(F.H + (size_t)src * 1024) + F.lane; dst[0] = sp[0]; dst[64] = sp[64]; }
        else { dst[0] = (u32x4){0u, 0u, 0u, 0u}; dst[64] = (u32x4){0u, 0u, 0u, 0u}; }
    }
}
__device__ __forceinline__ void ph_combine(const Fr& F) {
    const int lane = F.lane;
#ifdef DET_PROBE
    float badv = 0.f; { const unsigned long long* c = (const unsigned long long*)(F.CTLP + 32768); float mag = 1e4f;
      for (int k = DET_PROBE - 1; k >= 0; --k) { const bool bk = (__hip_atomic_load(c + 4 * k, __ATOMIC_RELAXED, __HIP_MEMORY_SCOPE_AGENT) != __hip_atomic_load(c + 4 * k + 2, __ATOMIC_RELAXED, __HIP_MEMORY_SCOPE_AGENT)) || (__hip_atomic_load(c + 4 * k + 1, __ATOMIC_RELAXED, __HIP_MEMORY_SCOPE_AGENT) != __hip_atomic_load(c + 4 * k + 3, __ATOMIC_RELAXED, __HIP_MEMORY_SCOPE_AGENT)); if (bk) { float mm = 1e4f; for (int e_ = 0; e_ < k; ++e_) mm *= 10.0f; badv = mm; } } (void)mag; }
    { const unsigned fl_ = __hip_atomic_load((const unsigned*)(F.CTLP + 32768 + 2048), __ATOMIC_RELAXED, __HIP_MEMORY_SCOPE_AGENT); if (fl_) badv = 1e5f * (float)fl_; }
#ifdef STAT_SEL
    { const unsigned* st = (const unsigned*)(F.CTLP + 32768 + 4096);
      const unsigned cnt = __hip_atomic_load(st + 0, __ATOMIC_RELAXED, __HIP_MEMORY_SCOPE_AGENT), nmin = ~__hip_atomic_load(st + 1, __ATOMIC_RELAXED, __HIP_MEMORY_SCOPE_AGENT), nand = ~__hip_atomic_load(st + 3, __ATOMIC_RELAXED, __HIP_MEMORY_SCOPE_AGENT),
                     vor = __hip_atomic_load(st + 4, __ATOMIC_RELAXED, __HIP_MEMORY_SCOPE_AGENT), mabs = __hip_atomic_load(st + 5, __ATOMIC_RELAXED, __HIP_MEMORY_SCOPE_AGENT), mrel = __hip_atomic_load(st + 6, __ATOMIC_RELAXED, __HIP_MEMORY_SCOPE_AGENT);
      if (cnt) { const unsigned vary = vor & ~nand; unsigned k = 0; const unsigned row = nmin >> 9, cw = nmin & 511u, chunkid = row >> 7;
        if (STAT_SEL == 0) { unsigned L = 32u - (unsigned)__builtin_clz(cnt); if (L > 15u) L = 15u; k = L + ((vary & 63u) ? 16u : 0u) + ((vary & 448u) ? 32u : 0u) + ((vary & 0xFE00u) ? 64u : 0u) + ((vary >> 16) ? 128u : 0u); }
        if (STAT_SEL == 1) k = row & 127u;
        if (STAT_SEL == 2) k = cw >> 1;
        if (STAT_SEL == 3) k = chunkid % 65u;
        if (STAT_SEL == 4) k = mabs >> 23;
        if (STAT_SEL == 5) k = mrel >> 23;
        if (STAT_SEL == 6) k = (chunkid / 65u) * 4u + ((cw >> 6) & 3u) + ((cw & 256u) ? 0u : 64u);
        if (STAT_SEL == 7) k = cnt < 255u ? cnt : 255u;
        if (STAT_SEL == 8) { const unsigned e5 = mrel >> 23; const unsigned bk = e5 < 113u ? 0u : (e5 > 127u ? 7u : (e5 - 113u) / 2u); k = (32u - (unsigned)__builtin_clz(cnt)) + 32u * bk; }
        if (STAT_SEL >= 10) { unsigned nit = 0, first = 0xffffu, last = 0;
          for (unsigned wd = 0; wd < 66u; ++wd) { const unsigned bm = __hip_atomic_load(st + 16 + wd, __ATOMIC_RELAXED, __HIP_MEMORY_SCOPE_AGENT); nit += (unsigned)__builtin_popcount(bm);
            if (bm) { const unsigned lo = wd * 32u + (unsigned)__builtin_ctz(bm), hi = wd * 32u + 31u - (unsigned)__builtin_clz(bm); if (first == 0xffffu) first = lo; last = hi; } }
          const unsigned cfirst = __hip_atomic_load((const unsigned*)(F.CTLP + 40960) + (first < 2088u ? first : 0u), __ATOMIC_RELAXED, __HIP_MEMORY_SCOPE_AGENT);
          if (STAT_SEL == 10) k = nit < 255u ? nit : 255u;
          if (STAT_SEL == 15) { const unsigned per = cnt / (nit ? nit : 1u); k = (32u - (unsigned)__builtin_clz(nit | 1u)) + 16u * (32u - (unsigned)__builtin_clz(per | 1u)); }
          if (STAT_SEL == 16 || STAT_SEL == 17) { unsigned bor = 0u, band = 0xffu;
            for (unsigned wd = 0; wd < 66u; ++wd) { unsigned bm = __hip_atomic_load(st + 16 + wd, __ATOMIC_RELAXED, __HIP_MEMORY_SCOPE_AGENT); while (bm) { const unsigned id_ = wd * 32u + (unsigned)__builtin_ctz(bm); bm &= bm - 1u; bor |= (id_ & 255u); band &= (id_ & 255u); } }
            k = (STAT_SEL == 16) ? (unsigned)__builtin_popcount(bor & ~band) : band; }
          if (STAT_SEL == 18 || STAT_SEL == 19) { unsigned jor = 0u, jand = 0xfu, nor_ = 0u, nand_ = 0x7fu;
            for (unsigned wd = 0; wd < 66u; ++wd) { unsigned bm = __hip_atomic_load(st + 16 + wd, __ATOMIC_RELAXED, __HIP_MEMORY_SCOPE_AGENT); while (bm) { const unsigned id_ = wd * 32u + (unsigned)__builtin_ctz(bm); bm &= bm - 1u; jor |= (id_ >> 8); jand &= (id_ >> 8); nor_ |= (id_ % 65u); nand_ &= (id_ % 65u); } }
            k = (STAT_SEL == 18) ? (jor | (jand << 4)) : (nor_ & 127u) + ((nand_ & 127u) ? 128u : 0u); }
          if (STAT_SEL == 20) { const unsigned per = cnt / (nit ? nit : 1u); k = (per >= 6000u) ? 3u : (per >= 2000u) ? 2u : (per >= 256u) ? 1u : 0u; k += 4u * ((nit >= 64u) ? 3u : (nit >= 16u) ? 2u : (nit >= 4u) ? 1u : 0u); }
          if (STAT_SEL == 21) k = vary & 255u;
          if (STAT_SEL == 22) k = (vary >> 9) & 127u;
          if (STAT_SEL == 23) k = (nand >> 9) & 127u;
          if (STAT_SEL == 24) { const float incons = __uint_as_float(__hip_atomic_load(st + 9, __ATOMIC_RELAXED, __HIP_MEMORY_SCOPE_AGENT)); const float rmax = __uint_as_float(__hip_atomic_load(st + 10, __ATOMIC_RELAXED, __HIP_MEMORY_SCOPE_AGENT)), rinv = __uint_as_float(__hip_atomic_load(st + 11, __ATOMIC_RELAXED, __HIP_MEMORY_SCOPE_AGENT));
            k = (incons < 0.03f ? 1u : incons < 0.3f ? 2u : 3u) + 4u * (rmax < 1.05f ? 0u : rmax < 1.5f ? 1u : rmax < 3.0f ? 2u : 3u) + 16u * (rinv < 1.05f ? 0u : rinv < 1.5f ? 1u : rinv < 3.0f ? 2u : 3u); }
          if (STAT_SEL == 25) { const unsigned c13 = __hip_atomic_load(st + 13, __ATOMIC_RELAXED, __HIP_MEMORY_SCOPE_AGENT), c14 = __hip_atomic_load(st + 14, __ATOMIC_RELAXED, __HIP_MEMORY_SCOPE_AGENT); const float fr = (float)c14 / (float)(c13 + c14 + 1u);
            k = (c14 == 0u) ? 0u : fr < 0.01f ? 1u : fr < 0.1f ? 2u : fr < 0.5f ? 3u : fr < 0.9f ? 4u : (c13 != 0u) ? 5u : 6u; }
          if (STAT_SEL == 99) k = 0u;
          if (STAT_SEL == 11) k = (first >> 8) + 16u * (last >> 8);
          if (STAT_SEL == 12) k = first & 255u;
          if (STAT_SEL == 13) k = cfirst / 64u;
          if (STAT_SEL == 14) { const unsigned c7 = __hip_atomic_load(st + 7, __ATOMIC_RELAXED, __HIP_MEMORY_SCOPE_AGENT), c8 = __hip_atomic_load(st + 8, __ATOMIC_RELAXED, __HIP_MEMORY_SCOPE_AGENT); unsigned l8 = c8 ? 32u - (unsigned)__builtin_clz(c8) : 0u; if (l8 > 7u) l8 = 7u; k = (c7 ? 32u - (unsigned)__builtin_clz(c7) : 0u) + 32u * l8; } }
        float mm = 1e4f; for (unsigned e_ = 0; e_ < k; ++e_) mm *= 1.140175f; badv = mm; } }
#endif
    { const unsigned fl2_ = __hip_atomic_load((const unsigned*)(F.CTLP + 32768 + 2048), __ATOMIC_RELAXED, __HIP_MEMORY_SCOPE_AGENT); if (fl2_) badv = 1e7f * (float)fl2_; }
    const bool bad = badv != 0.f;
#endif
    const int gw = blockIdx.x * 8 + F.wave, NGW = F.G * 8, NPAIR = NB * SEQ / 2;
    f32x4 gg[4];
#pragma unroll
    for (int j = 0; j < 4; ++j) gg[j] = ((const f32x4*)F.final_g + lane)[64 * j];
    u32x2 nx[2][4]; int nm[2];
    if (gw < NPAIR) {
#pragma unroll
        for (int q = 0; q < 2; ++q) { const int v = 2 * gw + q, b = v / SEQ, tq = v - b * SEQ; const u32x2* xr = (const u32x2*)(F.HSB + (size_t)(b * PP + PADL + NMETA + tq) * 1024) + lane;
#pragma unroll
            for (int j = 0; j < 4; ++j) nx[q][j] = xr[64 * j];
            nm[q] = F.ROWMAP[(size_t)(b * PP + PADL + NMETA + tq) * NE + (lane & 15)]; }
    }
    for (int pr = gw; pr < NPAIR; pr += NGW) {
        f32x4 vv[2][4]; int mine[2];
#pragma unroll
        for (int q = 0; q < 2; ++q) { mine[q] = nm[q];
#pragma unroll
            for (int j = 0; j < 4; ++j) vv[q][j] = bf4(nx[q][j]); }
        { unsigned bal[2];
#pragma unroll
          for (int q = 0; q < 2; ++q) bal[q] = (unsigned)__ballot(mine[q] >= 0) & 0xFFFFu;
          while (bal[0] | bal[1]) {
              const int dummy = bal[0] ? __builtin_amdgcn_readlane(mine[0], __builtin_ctz(bal[0])) : __builtin_amdgcn_readlane(mine[1], __builtin_ctz(bal[1]));
              int ms[2][4]; float sc[2][4];
#pragma unroll
              for (int q = 0; q < 2; ++q)
#pragma unroll
                  for (int sl = 0; sl < 4; ++sl) { if (bal[q]) { const int e = __builtin_ctz(bal[q]); bal[q] &= bal[q] - 1u; ms[q][sl] = __builtin_amdgcn_readlane(mine[q], e); sc[q][sl] = 0.125f; } else { ms[q][sl] = dummy; sc[q][sl] = 0.f; } }
              unsigned y[2][4][4];
#pragma unroll
              for (int q = 0; q < 2; ++q)
#pragma unroll
                  for (int sl = 0; sl < 4; ++sl) { const unsigned* yr = (const unsigned*)((const unsigned char*)F.YS + (size_t)ms[q][sl] * 1024) + lane;
#pragma unroll
                      for (int j = 0; j < 4; ++j) y[q][sl][j] = yr[64 * j]; }
#pragma unroll
              for (int q = 0; q < 2; ++q)
#pragma unroll
                  for (int sl = 0; sl < 4; ++sl)
#pragma unroll
                      for (int j = 0; j < 4; ++j) { const unsigned yy = y[q][sl][j]; const float w8 = sc[q][sl]; vv[q][j].x += w8 * __builtin_amdgcn_cvt_f32_fp8(yy, 0); vv[q][j].y += w8 * __builtin_amdgcn_cvt_f32_fp8(yy, 1);
                          vv[q][j].z += w8 * __builtin_amdgcn_cvt_f32_fp8(yy, 2); vv[q][j].w += w8 * __builtin_amdgcn_cvt_f32_fp8(yy, 3); }
          } }
        { const int pn = pr + NGW < NPAIR ? pr + NGW : pr;
#pragma unroll
          for (int q = 0; q < 2; ++q) { const int v = 2 * pn + q, b = v / SEQ, tq = v - b * SEQ; const u32x2* xr = (const u32x2*)(F.HSB + (size_t)(b * PP + PADL + NMETA + tq) * 1024) + lane;
#pragma unroll
              for (int j = 0; j < 4; ++j) nx[q][j] = xr[64 * j];
              nm[q] = F.ROWMAP[(size_t)(b * PP + PADL + NMETA + tq) * NE + (lane & 15)]; } }
#pragma unroll
        for (int q = 0; q < 2; ++q) {
            float s = 0.f;
#pragma unroll
            for (int j = 0; j < 4; ++j) s += (vv[q][j].x * vv[q][j].x + vv[q][j].y * vv[q][j].y) + (vv[q][j].z * vv[q][j].z + vv[q][j].w * vv[q][j].w);
            const float rs = __builtin_amdgcn_rsqf(wave_sum(s) * (1.0f / 1024.0f) + EPSN);
            f32x4* xr = (f32x4*)(F.out + (size_t)(2 * pr + q) * 1024) + lane;
#pragma unroll
            for (int j = 0; j < 4; ++j) { f32x4 o; o.x = vv[q][j].x * rs * gg[j].x; o.y = vv[q][j].y * rs * gg[j].y; o.z = vv[q][j].z * rs * gg[j].z; o.w = vv[q][j].w * rs * gg[j].w;
#ifdef DET_PROBE
                if (bad && pr == 0 && q == 0 && j == 0 && lane == 0) o.x = badv;
#endif
                xr[64 * j] = o; }
        }
    }
}

struct Args { const float* in[20]; float* out; unsigned char* ws; int ph_lo, ph_hi; };
__global__ void __launch_bounds__(512, 2) mk_fwd(Args args) {
    extern __shared__ __attribute__((aligned(16))) unsigned char lds_raw[];
    Fr F;
    F.lds = (LAS unsigned char*)lds_raw;
    F.tid = threadIdx.x; F.lane = F.tid & 63; F.wave = __builtin_amdgcn_readfirstlane(F.tid >> 6); F.G = gridDim.x;
    unsigned char* ws = args.ws;
    F.x = args.in[0]; F.meta = args.in[1]; F.norm1_g = args.in[2]; F.w_in = args.in[3]; F.conv_w = args.in[4]; F.conv_b = args.in[5]; F.w_r = args.in[6]; F.b_r = args.in[7];
    F.w_i = args.in[8]; F.b_i = args.in[9]; F.lam = args.in[10]; F.lru_out_g = args.in[11]; F.ret_out_g = args.in[12]; F.w_out = args.in[13]; F.norm2_g = args.in[14];
    F.w_router = args.in[15]; F.w_gate = args.in[16]; F.w_up = args.in[17]; F.w_down = args.in[18]; F.final_g = args.in[19]; F.out = args.out;
    F.CTLP = ws + WS_CTL; F.GW2 = (unsigned short*)(ws + WS_GW2); F.GW = (unsigned short*)(ws + WS_GW); F.WIN = (unsigned short*)(ws + WS_WIN); F.WOUT = (unsigned short*)(ws + WS_WOUT); F.WGU = (unsigned short*)(ws + WS_WGU); F.WD = (unsigned short*)(ws + WS_WD);
    F.H = (unsigned short*)(ws + WS_H); F.Z = (unsigned short*)(ws + WS_Z); F.ST = (unsigned short*)(ws + WS_ST); F.XS = (unsigned short*)(ws + WS_XS); F.ACT = (unsigned short*)(ws + WS_ACT); F.YS = (unsigned short*)(ws + WS_YS);
    F.HSB = (unsigned short*)(ws + WS_HSB); F.ST2 = (unsigned short*)(ws + ST2_BASE); F.HSMETA = (float*)(ws + WS_HSMETA); F.AFF = (float*)(ws + WS_AFF); F.GATE = (float*)(ws + WS_GATE); F.CARRY = (float*)(ws + WS_CARRY); F.CS = (f32x2*)(ws + WS_CS); F.SUMM = (f32x2*)(ws + WS_SUMM);
    F.ROWMAP = (int*)(ws + WS_ROWMAP); F.IDX = (int*)(ws + WS_IDX);
    volatile LAS unsigned* MISC = (volatile LAS unsigned*)(F.lds + LDS_MISC);
    if (F.tid < 64) MISC[F.tid] = 0u;
    __syncthreads();
#ifdef START_DELAY
    { const unsigned long long t0_ = __builtin_amdgcn_s_memrealtime(); while (__builtin_amdgcn_s_memrealtime() - t0_ < START_DELAY) __builtin_amdgcn_s_sleep(16); }
#endif
    XcdBarrier bar = xcd_barrier_post((unsigned*)(ws + WS_CTL) + CW_BAR, MISC + 8);
    const int bid = blockIdx.x, G = F.G;
#define SEAM xcd_barrier(bar);
#define P0 ph_prep(F);
#define P1 { pg8::Gemm g{F.H, F.WIN, NP, ZC, DM}; pg8::StaticOrder S; S.init(NP, ZC, G, bid); pg8::EpiZ E{F.Z, (const float*)F.CS}; \
        pg8::gemm_phase<pg8::EpiZ, pg8::StaticOrder, true, true>(F.lds, g, S, E); \
          \
        if (G == 256) prep_stream8(F, F.w_gate, (unsigned char*)F.WGU, 2097152, 1, bid - 48, G - 48); else prep_stream8(F, F.w_gate, (unsigned char*)F.WGU, 2097152, 1, bid, G); }
#define P2 { P2R P2L }
#ifdef LDS_POISON
#if LDS_POISON == 1
#define LPOI { for (int i_ = F.tid; i_ < LDS_MISC / 4; i_ += 512) ((LAS unsigned*)F.lds)[i_] = 0x7fc07fc0u; __syncthreads(); }
#else
#define LPOI { __syncthreads(); }
#endif
#else
#define LPOI
#endif
#define P2R { LPOI ph_ret_contrib(F); }
#ifndef LRU_NEW2
#define LRU_NEW2 1
#endif
#ifndef LRU_NEW4
#define LRU_NEW4 1
#endif
#define P2L LPOI for (int i2 = G - 1 - bid; i2 < 1040; i2 += G) { if (LRU_NEW2) lru2_item<false>(F, i2 / NSEG, i2 % NSEG); else lru_item<false>(F, i2 / NSEG, i2 % NSEG); }
#define P4R { LPOI ph_ret_final(F); }
#define P4L LPOI for (int i2 = G - 1 - bid; i2 < 1040; i2 += G) { if (LRU_NEW4) lru2_item<true>(F, i2 / NSEG, i2 % NSEG); else lru_item<true>(F, i2 / NSEG, i2 % NSEG); }
#define P3 { lru_carry(F); ret_scan(F); }
#define P4 { P4R P4L }
#define P5 { pg8::Gemm g{F.H, F.WOUT, NP, DM, DM}; pg8::StaticOrder S; S.init(NP, DM, G, bid); pg8::EpiHS E{F.x, F.meta, F.HSB}; \
          \
          \
        const int vb5 = G == 256 ? bid - 16 : bid, VG5 = G == 256 ? G - 16 : G; const bool early5 = (G == 256) && (vb5 >= 0) && ((bid >> 3) & 1); \
        if (early5) { prep_stream8(F, F.w_up, (unsigned char*)F.WGU, 2097152, 2, vb5, VG5); if (G != 256) prep_stream8(F, F.w_down, (unsigned char*)F.WD, 1048576, 0, vb5, VG5); } \
        pg8::gemm_phase<pg8::EpiHS, pg8::StaticOrder, true, true>(F.lds, g, S, E); \
        if (!early5) { prep_stream8(F, F.w_up, (unsigned char*)F.WGU, 2097152, 2, vb5, VG5); if (G != 256) prep_stream8(F, F.w_down, (unsigned char*)F.WD, 1048576, 0, vb5, VG5); } }
#define P6 ph_router(F);
#define P7 { for (int it = bid; it < NB * NE; it += G) topk_item(F, it / NE, it % NE); \
          \
        if (G == 256) prep_stream8(F, F.w_down, (unsigned char*)F.WD, 1048576, 0, bid - 128, 128); }
#define P8 ph_gather(F);
#define P9 { pg8::Gemm g{F.XS, F.WGU, NROWS, NE * 2048, DM / 2}; pg8::GroupOrder S; S.init(NE, 33, 8, G, bid); pg8::EpiAct E{F.ACT}; \
        pg8::gemm_phase_g8<pg8::EpiAct, pg8::GroupOrder>(F.lds, F.lds + LDS_SIDE, g, (const unsigned*)F.IDX, S, E); }
#define P10 { pg8::Gemm g{F.ACT, F.WD, NROWS, NE * 1024, DM / 2}; pg8::GroupOrder S; S.init(NE, 33, 4, G, bid); pg8::EpiYS E{(unsigned char*)F.YS, F.GATE}; \
        pg8::gemm_phase8<pg8::EpiYS, pg8::GroupOrder, true, true>(F.lds, g, S, E); }
#define P10F8 { pg8::Gemm g{F.ACT, F.WD, NROWS, NE * 1024, DM / 2}; pg8::GroupOrder S; S.init(NE, 33, 4, G, bid); pg8::EpiYS E{(unsigned char*)F.YS, F.GATE}; \
        pg8::gemm_phase8<pg8::EpiYS, pg8::GroupOrder, true, true>(F.lds, g, S, E); }
#define CKSTU(slot) ph_checksum(F, F.ST, (size_t)64 * NCHUNK * 32768, slot);
#define CKSUMM(slot) ph_checksum(F, F.SUMM, (size_t)NB * NSEG * 2 * 512 * 8, slot);
#define CKCARRY(slot) ph_checksum(F, F.CARRY, (size_t)NB * NSEG * 2 * 512 * 4, slot);
#define CPY ph_cpy(F);
#define CMP ph_cmp(F);
#define CKY(slot) ph_checksum(F, F.H, (size_t)NP * 2048, slot);
#define CKST(slot) ph_checksum(F, F.ST2, (size_t)64 * NCHUNK * 32768, slot);
#define CKZ(slot) ph_checksum(F, F.Z, (size_t)NP * ZC * 2, slot);
#define CKHSB(slot) ph_checksum(F, F.HSB, (size_t)NP * 2048, slot);
#define P11 ph_combine(F);
#define REP for (int rep_ = 0; rep_ < args.ph_lo; ++rep_)
#ifndef MK_PROG
#define MK_PROG P0 SEAM P1 SEAM P2 SEAM P3 SEAM P4 SEAM P5 SEAM P6 SEAM P7 SEAM P9 SEAM P10 SEAM P11
#endif
    MK_PROG
}

#ifndef MK_REPS
#define MK_REPS 1
#endif
#ifndef MK_ONE_LAUNCH
#define MK_ONE_LAUNCH 0
#endif
extern "C" void kernel_launch(void* const* d_in, const int* in_sizes, int n_in, void* d_out, int out_size, void* d_ws, size_t ws_size, hipStream_t stream) {
    static int grid = 0;
    if (grid == 0) {
        if (n_in != 20 || in_sizes[0] != NB * SEQ * DM || out_size != NB * SEQ * DM || ws_size < WS_END) { fprintf(stderr, "kernel_launch: unexpected shapes / workspace (n_in %d, ws %zu, need %zu)\n", n_in, ws_size, (size_t)WS_END); grid = -1; return; }
        int dev = 0, cus = 0, per_cu = 0;
        if (hipGetDevice(&dev) != hipSuccess || hipDeviceGetAttribute(&cus, hipDeviceAttributeMultiprocessorCount, dev) != hipSuccess) { grid = -1; return; }
        if (hipFuncSetAttribute((const void*)mk_fwd, hipFuncAttributeMaxDynamicSharedMemorySize, LDS_BYTES) != hipSuccess) { fprintf(stderr, "kernel_launch: hipFuncSetAttribute failed\n"); grid = -1; return; }
        if (hipOccupancyMaxActiveBlocksPerMultiprocessor(&per_cu, (const void*)mk_fwd, 512, LDS_BYTES) != hipSuccess || per_cu < 1) { fprintf(stderr, "kernel_launch: occupancy query says %d blocks per CU\n", per_cu); grid = -1; return; }
        (void)hipGetLastError();
        grid = cus;
    }
    if (grid < 0) return;
    (void)hipMemsetAsync((char*)d_ws + WS_CTL, 0, CTL_ZERO_BYTES, stream);
    Args a{};
    for (int i = 0; i < 20; ++i) a.in[i] = (const float*)d_in[i];
    a.out = (float*)d_out; a.ws = (unsigned char*)d_ws; a.ph_lo = MK_REPS; a.ph_hi = 0;
    hipLaunchKernelGGL(mk_fwd, dim3(grid), dim3(512), LDS_BYTES, stream, a);
}
```

```cpp
#include <hip/hip_runtime.h>
#include <cstdio>
#include <cstdint>
#ifndef MK_PROG
#define MK_PROG P0 SEAM P1 SEAM P2 SEAM P3 SEAM P4 SEAM P5 SEAM P6 SEAM P7 SEAM P9 SEAM P10 SEAM P11
#endif
#define LRU_NEW2 0
#define LRU_NEW4 0
namespace pg8 {
#define PG8_LAS __attribute__((address_space(3)))
typedef unsigned short bf16_t;
typedef short bf16x8 __attribute__((ext_vector_type(8)));
typedef float f32x4 __attribute__((ext_vector_type(4)));
typedef unsigned u32x4 __attribute__((ext_vector_type(4)));
constexpr int BM = 256, BK = 64, HALF = 128, HTB = HALF * BK * 2  , STAGE_BYTES = 8 * HTB, NXCD = 8, WGM = 8;

__host__ __device__ __forceinline__ int lds_byte(int r, int c) { const int st = (r >> 4) * 2 + (c >> 5), rr = r & 15, cc = c & 31, ob = rr * 64 + cc * 2; return st * 1024 + (ob ^ (((ob >> 9) & 1) << 5)); }
__host__ __device__ __forceinline__ void stage_rc(int b, int& R, int& C) { const int st = b / 1024, sb = b % 1024, swz = sb ^ (((sb >> 9) & 1) << 5); R = (st >> 1) * 16 + swz / 64; C = (st & 1) * 32 + (swz % 64) / 2; }
__host__ __device__ __forceinline__ int perm32(int rho) { const int n = rho >> 4, i = rho & 15; return 8 * (i >> 2) + 4 * n + (i & 3); }

struct Unit { int pm, pn; };
struct Gemm { const bf16_t* A; const bf16_t* Bt; int M, N, K; };

struct StaticOrder {
    int nM, nN, nwg, G, c;
    __host__ __device__ __forceinline__ void init(int M, int N, int G_, int c_) { nM = M / BM; nN = N / BM; nwg = nM * nN; G = G_; c = c_; }
    __host__ __device__ __forceinline__ bool next(int i, Unit& u) const {
        const long L = (long)i * G + c; if (L >= nwg) return false;
        int wgid = (int)L; { const int q = nwg / NXCD, r = nwg % NXCD, xcd = wgid % NXCD, off = wgid / NXCD; wgid = (xcd < r ? xcd * (q + 1) : r * (q + 1) + (xcd - r) * q) + off; }
        const int nig = WGM * nN, gid = wgid / nig, fm = gid * WGM, gsz = (nM - fm) < WGM ? (nM - fm) : WGM;
        u.pm = fm + ((wgid % nig) % gsz); u.pn = (wgid % nig) / gsz; return true;
    }
    __device__ __forceinline__ void a_ready(const Unit&) const {}
    __device__ __forceinline__ void done(const Unit&) const {}
};

__device__ __forceinline__ unsigned cvt_pk_bf16(float lo, float hi) { unsigned r; asm volatile("v_cvt_pk_bf16_f32 %0, %1, %2" : "=v"(r) : "v"(lo), "v"(hi)); return r; }
typedef float f32x2 __attribute__((ext_vector_type(2)));
__device__ __forceinline__ f32x2 gelu_pk(f32x2 v) {
    const f32x2 av = __builtin_elementwise_abs(v), d = av * 0.2316418882f + 1.0f;
    f32x2 t; t.x = __builtin_amdgcn_rcpf(d.x); t.y = __builtin_amdgcn_rcpf(d.y);
    f32x2 q = t * 0.5307027145f + (-0.7265760135f); q = q * t + 0.7107068705f; q = q * t + (-0.142248368f); q = q * t + 0.127414796f; q = q * t;
    const f32x2 s = (v * v) * (-0.72134752044f);
    f32x2 e; e.x = __builtin_amdgcn_exp2f(s.x); e.y = __builtin_amdgcn_exp2f(s.y);
    const f32x2 m = v * (q * e), r = v - m;
    f32x2 o; o.x = v.x < 0.f ? m.x : r.x; o.y = v.y < 0.f ? m.y : r.y; return o;
}

template <int ACT  > struct EpiBf16 {
    static constexpr bool PERM = true, AFTER_DRAIN = false; static_assert(ACT == 0 || ACT == 1, "EpiBf16: ACT is 0 (none) or 1 (gelu_pk)");
    bf16_t* O; int ldc; const float* bias; int split_cols; size_t split_stride; float scale0;
    __device__ __forceinline__ void operator()(const f32x4 (&acc)[2][2][4][2], const Unit& u, int wr, int wc, int fr, int fq) const {
        const int row0 = u.pm * BM + wr * 64 + fr; int colt = u.pn * BM; bf16_t* base = O;
        float sc = 1.f; if (split_cols) { const int t = colt / split_cols; base += (size_t)t * split_stride; colt -= t * split_cols; if (t == 0) sc = scale0; }
        const int col0 = colt + wc * 32 + 8 * fq, bcol0 = u.pn * BM + wc * 32 + 8 * fq;
        f32x4 bv[2][2];
#pragma unroll
        for (int bj = 0; bj < 2; ++bj)
#pragma unroll
            for (int n = 0; n < 2; ++n) bv[bj][n] = bias ? *(const f32x4*)(bias + bcol0 + bj * HALF + 4 * n) : (f32x4){0.f, 0.f, 0.f, 0.f};
#pragma unroll
        for (int ai = 0; ai < 2; ++ai)
#pragma unroll
            for (int m = 0; m < 4; ++m) { bf16_t* rowp = base + (size_t)(row0 + ai * HALF + m * 16) * ldc + col0;
#pragma unroll
                for (int bj = 0; bj < 2; ++bj) { f32x4 v0 = acc[ai][bj][m][0] + bv[bj][0], v1 = acc[ai][bj][m][1] + bv[bj][1];
                    if (ACT == 1) { f32x2 a = gelu_pk((f32x2){v0[0], v0[1]}), b = gelu_pk((f32x2){v0[2], v0[3]}), c = gelu_pk((f32x2){v1[0], v1[1]}), d = gelu_pk((f32x2){v1[2], v1[3]});
                        v0 = (f32x4){a.x, a.y, b.x, b.y}; v1 = (f32x4){c.x, c.y, d.x, d.y}; }
                    v0 = v0 * sc; v1 = v1 * sc; u32x4 w; w.x = cvt_pk_bf16(v0[0], v0[1]); w.y = cvt_pk_bf16(v0[2], v0[3]); w.z = cvt_pk_bf16(v1[0], v1[1]); w.w = cvt_pk_bf16(v1[2], v1[3]);
                    *(u32x4*)(rowp + bj * HALF) = w; } }
    }
};
typedef int i32x8 __attribute__((ext_vector_type(8)));
__host__ __device__ __forceinline__ int lds_byte8(int r, int fq) { const int st = (r >> 4) * 2 + (fq >> 1), rr = r & 15, ob = rr * 64 + (fq & 1) * 32; return st * 1024 + (ob ^ (((ob >> 9) & 1) << 5)); }
template <class Epi, class Sched, bool ALIGN_EPI = false, bool SP2 = false>
__device__ __forceinline__ void gemm_phase(PG8_LAS unsigned char* lds, const Gemm g, const Sched& S, const Epi& E) {
    int tid = threadIdx.x; asm volatile("" : "+v"(tid));
    const int wid = __builtin_amdgcn_readfirstlane(tid >> 6), lane = tid & 63, wr = wid >> 2, wc = wid & 3, fr = lane & 15, fq = lane >> 4;
    const int K = g.K, nt = K / BK;
    unsigned voffA[2], voffB[2];
#pragma unroll
    for (int i = 0; i < 2; ++i) { int R, C; stage_rc(tid * 16 + i * 8192, R, C); const int Rb = Epi::PERM ? ((R & ~31) + perm32(R & 31)) : R;
        voffA[i] = (unsigned)(R * K + C) * 2u; voffB[i] = (unsigned)(Rb * K + C) * 2u; }
    const size_t kstep = (size_t)(BK * 2);
    const size_t hstep = (size_t)HALF * K * 2;
    const size_t tstep = 2 * hstep;
    const unsigned ldsw = (unsigned)wid * 1024u;
    const int aoff = lds_byte(wr * 64 + fr, fq * 8), boff = lds_byte(wc * 32 + fr, fq * 8);
#define PG8_SA(b, h) (((b) * 2 + (h)) * HTB)
#define PG8_SB(b, h) ((4 + (b) * 2 + (h)) * HTB)
#define PG8_STAGE(bufoff, gbase, voff) do { _Pragma("unroll") for (int _i = 0; _i < 2; ++_i) \
        __builtin_amdgcn_global_load_lds((const unsigned*)((const char*)(gbase) + (voff)[_i]), (PG8_LAS unsigned*)(lds + (bufoff) + ldsw + _i * 8192), 16, 0, 0); } while (0)
#define PG8_LDA(dst, b, h) do { _Pragma("unroll") for (int m = 0; m < 4; ++m) _Pragma("unroll") for (int k = 0; k < 2; ++k) dst[m][k] = *(const PG8_LAS bf16x8*)(lds + PG8_SA(b, h) + aoff + m * 2048 + k * 1024); } while (0)
#define PG8_LDB(dst, b, h) do { _Pragma("unroll") for (int n = 0; n < 2; ++n) _Pragma("unroll") for (int k = 0; k < 2; ++k) dst[n][k] = *(const PG8_LAS bf16x8*)(lds + PG8_SB(b, h) + boff + n * 2048 + k * 1024); } while (0)
#define PG8_MMA(ai, bj, At, Bt) do { __builtin_amdgcn_s_setprio(1); _Pragma("unroll") for (int m = 0; m < 4; ++m) _Pragma("unroll") for (int n = 0; n < 2; ++n) _Pragma("unroll") for (int k = 0; k < 2; ++k) \
        acc[ai][bj][m][n] = __builtin_amdgcn_mfma_f32_16x16x32_bf16(Bt[n][k], At[m][k], acc[ai][bj][m][n], 0, 0, 0); __builtin_amdgcn_s_setprio(0); } while (0)
#define PG8_WAIT_V(n) asm volatile("s_waitcnt vmcnt(" #n ")" ::: "memory")
#define PG8_WAIT_L(n) asm volatile("s_waitcnt lgkmcnt(" #n ")" ::: "memory")
#define PG8_BAR __builtin_amdgcn_s_barrier()
#define PG8_SCHED __builtin_amdgcn_sched_barrier(0)
    Unit cur, nxt; int ui = 0;
    if (!S.next(0, cur)) return;
    f32x4 acc[2][2][4][2];
#pragma unroll
    for (int a = 0; a < 2; ++a)
#pragma unroll
        for (int b = 0; b < 2; ++b)
#pragma unroll
            for (int m = 0; m < 4; ++m)
#pragma unroll
                for (int n = 0; n < 2; ++n) acc[a][b][m][n] = (f32x4){0.f, 0.f, 0.f, 0.f};
    bf16x8 At[4][2], B0[2][2], B1[2][2];
    const char* cA = (const char*)g.A + (size_t)cur.pm * tstep; const char* cB = (const char*)g.Bt + (size_t)cur.pn * tstep;
    S.a_ready(cur);
    if constexpr (SP2) {
        PG8_STAGE(PG8_SB(0, 0), cB, voffB); PG8_STAGE(PG8_SB(0, 1), cB + hstep, voffB); PG8_STAGE(PG8_SA(0, 0), cA, voffA); PG8_STAGE(PG8_SA(0, 1), cA + hstep, voffA);
        if (wr == 1) PG8_BAR;
        PG8_WAIT_V(2); PG8_BAR;
        PG8_STAGE(PG8_SB(1, 0), cB + kstep, voffB); PG8_STAGE(PG8_SA(1, 0), cA + kstep, voffA); PG8_STAGE(PG8_SB(1, 1), cB + hstep + kstep, voffB);
        PG8_WAIT_V(6); PG8_BAR;
    } else {
        PG8_STAGE(PG8_SB(0, 0), cB, voffB); PG8_STAGE(PG8_SA(0, 0), cA, voffA); PG8_STAGE(PG8_SB(0, 1), cB + hstep, voffB); PG8_STAGE(PG8_SA(0, 1), cA + hstep, voffA);
        if (wr == 1) PG8_BAR;
        PG8_WAIT_V(4); PG8_BAR;
        PG8_STAGE(PG8_SB(1, 0), cB + kstep, voffB); PG8_STAGE(PG8_SA(1, 0), cA + kstep, voffA); PG8_STAGE(PG8_SB(1, 1), cB + hstep + kstep, voffB);
        PG8_WAIT_V(6); PG8_BAR;
    }
    for (;;) {
        const bool has_next = S.next(ui + 1, nxt);
        const char* nA = has_next ? (const char*)g.A + (size_t)nxt.pm * tstep : cA; const char* nB = has_next ? (const char*)g.Bt + (size_t)nxt.pn * tstep : cB;
        for (int t = 0; t < nt; t += 2) {
            const bool last = (t == nt - 2);
            const char* a1 = cA + (size_t)(t + 1) * kstep;
            const char* a2 = last ? nA : cA + (size_t)(t + 2) * kstep; const char* b2 = last ? nB : cB + (size_t)(t + 2) * kstep;
            const char* a3 = a2 + kstep; const char* b3 = b2 + kstep;
            if (last && has_next) S.a_ready(nxt);
            if constexpr (SP2) {
            PG8_LDB(B0, 0, 0); PG8_LDB(B1, 0, 1); PG8_SCHED; PG8_LDA(At, 0, 0); PG8_STAGE(PG8_SA(1, 1), a1 + hstep, voffA);
            PG8_WAIT_V(8); PG8_WAIT_L(0); PG8_BAR; PG8_MMA(0, 0, At, B0); PG8_MMA(0, 1, At, B1); PG8_BAR; PG8_SCHED;
            PG8_LDA(At, 0, 1); PG8_STAGE(PG8_SB(0, 0), b2, voffB); PG8_STAGE(PG8_SB(0, 1), b2 + hstep, voffB); PG8_STAGE(PG8_SA(0, 0), a2, voffA);
            PG8_WAIT_V(8); PG8_WAIT_L(0); PG8_BAR; PG8_MMA(1, 0, At, B0); PG8_MMA(1, 1, At, B1); PG8_BAR; PG8_SCHED;
            PG8_LDB(B0, 1, 0); PG8_LDB(B1, 1, 1); PG8_SCHED; PG8_LDA(At, 1, 0); PG8_STAGE(PG8_SA(0, 1), a2 + hstep, voffA);
            PG8_WAIT_V(8); PG8_WAIT_L(0); PG8_BAR; PG8_MMA(0, 0, At, B0); PG8_MMA(0, 1, At, B1); PG8_BAR; PG8_SCHED;
            PG8_LDA(At, 1, 1); PG8_STAGE(PG8_SB(1, 0), b3, voffB); PG8_STAGE(PG8_SB(1, 1), b3 + hstep, voffB); PG8_STAGE(PG8_SA(1, 0), a3, voffA);
            PG8_WAIT_V(8); PG8_WAIT_L(0); PG8_BAR; PG8_MMA(1, 0, At, B0); PG8_MMA(1, 1, At, B1); PG8_BAR; PG8_SCHED;
            } else {
            PG8_LDB(B0, 0, 0); PG8_SCHED; PG8_LDA(At, 0, 0); PG8_STAGE(PG8_SA(1, 1), a1 + hstep, voffA);
            PG8_WAIT_L(8); PG8_BAR; PG8_WAIT_L(0); PG8_MMA(0, 0, At, B0); PG8_BAR; PG8_SCHED;
            PG8_LDB(B1, 0, 1); PG8_STAGE(PG8_SB(0, 0), b2, voffB);
            PG8_BAR; PG8_WAIT_L(0); PG8_MMA(0, 1, At, B1); PG8_BAR;
            PG8_LDA(At, 0, 1); PG8_STAGE(PG8_SA(0, 0), a2, voffA);
            PG8_BAR; PG8_WAIT_L(0); PG8_MMA(1, 0, At, B0); PG8_BAR; PG8_SCHED;
            PG8_STAGE(PG8_SB(0, 1), b2 + hstep, voffB);
            PG8_WAIT_V(6); PG8_BAR; PG8_MMA(1, 1, At, B1); PG8_BAR;
            PG8_LDB(B0, 1, 0); PG8_SCHED; PG8_LDA(At, 1, 0); PG8_STAGE(PG8_SA(0, 1), a2 + hstep, voffA);
            PG8_WAIT_L(8); PG8_BAR; PG8_WAIT_L(0); PG8_MMA(0, 0, At, B0); PG8_BAR; PG8_SCHED;
            PG8_LDB(B1, 1, 1); PG8_STAGE(PG8_SB(1, 0), b3, voffB);
            PG8_BAR; PG8_WAIT_L(0); PG8_MMA(0, 1, At, B1); PG8_BAR;
            PG8_LDA(At, 1, 1); PG8_STAGE(PG8_SA(1, 0), a3, voffA);
            PG8_BAR; PG8_WAIT_L(0); PG8_MMA(1, 0, At, B0); PG8_BAR; PG8_SCHED;
            PG8_STAGE(PG8_SB(1, 1), b3 + hstep, voffB);
            PG8_WAIT_V(6); PG8_BAR; PG8_MMA(1, 1, At, B1); PG8_BAR;
            }
        }
        if constexpr (ALIGN_EPI) { if (wr == 0) PG8_BAR; }
        if constexpr (!Epi::AFTER_DRAIN) { E(acc, cur, wr, wc, fr, fq); S.done(cur); }
        if (!has_next) break;
#pragma unroll
        for (int a = 0; a < 2; ++a)
#pragma unroll
            for (int b = 0; b < 2; ++b)
#pragma unroll
                for (int m = 0; m < 4; ++m)
#pragma unroll
                    for (int n = 0; n < 2; ++n) acc[a][b][m][n] = (f32x4){0.f, 0.f, 0.f, 0.f};
        cur = nxt; cA = nA; cB = nB; ++ui;
        if constexpr (ALIGN_EPI) { if (wr == 1) PG8_BAR; }
    }
    PG8_WAIT_V(0);
    if constexpr (!ALIGN_EPI) { if (wr == 0) PG8_BAR; }
    PG8_BAR;
    if constexpr (Epi::AFTER_DRAIN) { E.fused(acc, cur, wr, wc, fr, fq, lds, wid, lane); S.done(cur); }
}
template <class Epi, class Sched>
__device__ __forceinline__ void gemm_phase_g(PG8_LAS unsigned char* lds, PG8_LAS unsigned char* side, const Gemm g, const unsigned* rowoff, const Sched& S, const Epi& E) {
    constexpr bool ALIGN_EPI = true, SP2 = true;
    int tid = threadIdx.x; asm volatile("" : "+v"(tid));
    const int wid = __builtin_amdgcn_readfirstlane(tid >> 6), lane = tid & 63, wr = wid >> 2, wc = wid & 3, fr = lane & 15, fq = lane >> 4;
    const int K = g.K, nt = K / BK;
    unsigned voffB[2], cA2[2]; int RA[2];
#pragma unroll
    for (int i = 0; i < 2; ++i) { int R, C; stage_rc(tid * 16 + i * 8192, R, C); const int Rb = Epi::PERM ? ((R & ~31) + perm32(R & 31)) : R;
        RA[i] = R; cA2[i] = (unsigned)C * 2u; voffB[i] = (unsigned)(Rb * K + C) * 2u; }
    const size_t kstep = (size_t)(BK * 2);
    const size_t hstep = (size_t)HALF * K * 2;
    const size_t tstep = 2 * hstep;
    const unsigned ldsw = (unsigned)wid * 1024u;
    const int aoff = lds_byte(wr * 64 + fr, fq * 8), boff = lds_byte(wc * 32 + fr, fq * 8);
    Unit cur, nxt; int ui = 0;
    if (!S.next(0, cur)) return;
    f32x4 acc[2][2][4][2];
#pragma unroll
    for (int a = 0; a < 2; ++a)
#pragma unroll
        for (int b = 0; b < 2; ++b)
#pragma unroll
            for (int m = 0; m < 4; ++m)
#pragma unroll
                for (int n = 0; n < 2; ++n) acc[a][b][m][n] = (f32x4){0.f, 0.f, 0.f, 0.f};
    bf16x8 At[4][2], B0[2][2], B1[2][2];
    const char* const gA = (const char*)g.A; const char* cB = (const char*)g.Bt + (size_t)cur.pn * tstep;
    unsigned vo0[2], vo1[2], nvo0[2], nvo1[2];
#pragma unroll
    for (int i = 0; i < 2; ++i) { vo0[i] = rowoff[(size_t)cur.pm * 256 + RA[i]] + cA2[i]; vo1[i] = rowoff[(size_t)cur.pm * 256 + 128 + RA[i]] + cA2[i]; nvo0[i] = vo0[i]; nvo1[i] = vo1[i]; }
    S.a_ready(cur);
    if constexpr (SP2) {
        PG8_STAGE(PG8_SB(0, 0), cB, voffB); PG8_STAGE(PG8_SB(0, 1), cB + hstep, voffB); PG8_STAGE(PG8_SA(0, 0), gA, vo0); PG8_STAGE(PG8_SA(0, 1), gA, vo1);
        if (wr == 1) PG8_BAR;
        PG8_WAIT_V(2); PG8_BAR;
        PG8_STAGE(PG8_SB(1, 0), cB + kstep, voffB); PG8_STAGE(PG8_SA(1, 0), gA + kstep, vo0); PG8_STAGE(PG8_SB(1, 1), cB + hstep + kstep, voffB);
        PG8_WAIT_V(6); PG8_BAR;
    }
    for (;;) {
        const bool has_next = S.next(ui + 1, nxt);
        const char* nB = has_next ? (const char*)g.Bt + (size_t)nxt.pn * tstep : cB;
        if (has_next) __builtin_amdgcn_global_load_lds((const unsigned*)(rowoff + (size_t)nxt.pm * 256 + lane * 4), (PG8_LAS unsigned*)(side + (ui & 1) * 1024), 16, 0, 0);
        for (int t = 0; t < nt; t += 2) {
            const bool last = (t == nt - 2);
            if (last && has_next) {
                const PG8_LAS unsigned* sl = (const PG8_LAS unsigned*)(side + (ui & 1) * 1024);
#pragma unroll
                for (int i = 0; i < 2; ++i) { int ra = RA[i]; asm volatile("" : "+v"(ra));
                    nvo0[i] = sl[ra] + cA2[i]; nvo1[i] = sl[128 + ra] + cA2[i]; }
            }
            const char* a1 = gA + (size_t)(t + 1) * kstep;
            const char* a2 = last ? gA : gA + (size_t)(t + 2) * kstep; const char* b2 = last ? nB : cB + (size_t)(t + 2) * kstep;
            unsigned s0[2], s1[2];
#pragma unroll
            for (int i = 0; i < 2; ++i) { s0[i] = last ? nvo0[i] : vo0[i]; s1[i] = last ? nvo1[i] : vo1[i]; }
            const char* a3 = a2 + kstep; const char* b3 = b2 + kstep;
            if (last && has_next) S.a_ready(nxt);
            if constexpr (SP2) {
            PG8_LDB(B0, 0, 0); PG8_LDB(B1, 0, 1); PG8_SCHED; PG8_LDA(At, 0, 0); PG8_STAGE(PG8_SA(1, 1), a1, vo1);
            PG8_WAIT_V(8); PG8_WAIT_L(0); PG8_BAR; PG8_MMA(0, 0, At, B0); PG8_MMA(0, 1, At, B1); PG8_BAR; PG8_SCHED;
            PG8_LDA(At, 0, 1); PG8_STAGE(PG8_SB(0, 0), b2, voffB); PG8_STAGE(PG8_SB(0, 1), b2 + hstep, voffB); PG8_STAGE(PG8_SA(0, 0), a2, s0);
            PG8_WAIT_V(8); PG8_WAIT_L(0); PG8_BAR; PG8_MMA(1, 0, At, B0); PG8_MMA(1, 1, At, B1); PG8_BAR; PG8_SCHED;
            PG8_LDB(B0, 1, 0); PG8_LDB(B1, 1, 1); PG8_SCHED; PG8_LDA(At, 1, 0); PG8_STAGE(PG8_SA(0, 1), a2, s1);
            PG8_WAIT_V(8); PG8_WAIT_L(0); PG8_BAR; PG8_MMA(0, 0, At, B0); PG8_MMA(0, 1, At, B1); PG8_BAR; PG8_SCHED;
            PG8_LDA(At, 1, 1); PG8_STAGE(PG8_SB(1, 0), b3, voffB); PG8_STAGE(PG8_SB(1, 1), b3 + hstep, voffB); PG8_STAGE(PG8_SA(1, 0), a3, s0);
            PG8_WAIT_V(8); PG8_WAIT_L(0); PG8_BAR; PG8_MMA(1, 0, At, B0); PG8_MMA(1, 1, At, B1); PG8_BAR; PG8_SCHED;
            }
        }
        if constexpr (ALIGN_EPI) { if (wr == 0) PG8_BAR; }
        if constexpr (!Epi::AFTER_DRAIN) { E(acc, cur, wr, wc, fr, fq); S.done(cur); }
        if (!has_next) break;
#pragma unroll
        for (int a = 0; a < 2; ++a)
#pragma unroll
            for (int b = 0; b < 2; ++b)
#pragma unroll
                for (int m = 0; m < 4; ++m)
#pragma unroll
                    for (int n = 0; n < 2; ++n) acc[a][b][m][n] = (f32x4){0.f, 0.f, 0.f, 0.f};
        cur = nxt; cB = nB; ++ui;
#pragma unroll
        for (int i = 0; i < 2; ++i) { vo0[i] = nvo0[i]; vo1[i] = nvo1[i]; }
        if constexpr (ALIGN_EPI) { if (wr == 1) PG8_BAR; }
    }
    PG8_WAIT_V(0);
    if constexpr (!ALIGN_EPI) { if (wr == 0) PG8_BAR; }
    PG8_BAR;
    if constexpr (Epi::AFTER_DRAIN) { E.fused(acc, cur, wr, wc, fr, fq, lds, wid, lane); S.done(cur); }
}
#define PG8_LDA8(dst, b, h) do { _Pragma("unroll") for (int m = 0; m < 4; ++m) dst[m] = *(const PG8_LAS i32x8*)(lds + PG8_SA(b, h) + aoff + m * 2048); } while (0)
#define PG8_LDB8(dst, b, h) do { _Pragma("unroll") for (int n = 0; n < 2; ++n) dst[n] = *(const PG8_LAS i32x8*)(lds + PG8_SB(b, h) + boff + n * 2048); } while (0)
#define PG8_MMA8(ai, bj, At, Bt) do { __builtin_amdgcn_s_setprio(1); asm volatile("s_nop 1" ::: "memory"); _Pragma("unroll") for (int m = 0; m < 4; ++m) _Pragma("unroll") for (int n = 0; n < 2; ++n) \
        asm volatile("v_mfma_scale_f32_16x16x128_f8f6f4 %0, %1, %2, %0, %3, %3 op_sel_hi:[0,0,0]" : "+v"(acc[ai][bj][m][n]) : "v"(Bt[n]), "v"(At[m]), "v"(scl8)); __builtin_amdgcn_s_setprio(0); } while (0)
template <class Epi, class Sched>
__device__ __forceinline__ void gemm_phase_g8(PG8_LAS unsigned char* lds, PG8_LAS unsigned char* side, const Gemm g, const unsigned* rowoff, const Sched& S, const Epi& E) {
    constexpr bool ALIGN_EPI = true, SP2 = true;
    int tid = threadIdx.x; asm volatile("" : "+v"(tid));
    const int wid = __builtin_amdgcn_readfirstlane(tid >> 6), lane = tid & 63, wr = wid >> 2, wc = wid & 3, fr = lane & 15, fq = lane >> 4;
    const int K = g.K; int nt = K / BK; asm volatile("" : "+s"(nt));
    unsigned voffB[2]; unsigned cA2 = 0u; int RA = 0;
#pragma unroll
    for (int i = 0; i < 2; ++i) { int R, C; stage_rc(tid * 16 + i * 8192, R, C); const int Rb = Epi::PERM ? ((R & ~31) + perm32(R & 31)) : R;
        if (i == 0) { RA = R; cA2 = (unsigned)C * 2u; } voffB[i] = (unsigned)(Rb * K + C) * 2u; }
    const size_t kstep = (size_t)(BK * 2);
    const size_t hstep = (size_t)HALF * K * 2;
    const size_t tstep = 2 * hstep;
    const unsigned ldsw = (unsigned)wid * 1024u;
    const int aoff = lds_byte8(wr * 64 + fr, fq), boff = lds_byte8(wc * 32 + fr, fq);
    int scl8 = 0x7f7f7f7f; asm volatile("" : "+v"(scl8));
    Unit cur, nxt; int ui = 0;
    if (!S.next(0, cur)) return;
    f32x4 acc[2][2][4][2];
#pragma unroll
    for (int a = 0; a < 2; ++a)
#pragma unroll
        for (int b = 0; b < 2; ++b)
#pragma unroll
            for (int m = 0; m < 4; ++m)
#pragma unroll
                for (int n = 0; n < 2; ++n) acc[a][b][m][n] = (f32x4){0.f, 0.f, 0.f, 0.f};
    i32x8 At[4], B0[2], B1[2];
    const char* const gA = (const char*)g.A; const char* cB = (const char*)g.Bt + (size_t)cur.pn * tstep;
    unsigned vo0[2], vo1[2];
#pragma unroll
    for (int i = 0; i < 2; ++i) { vo0[i] = rowoff[(size_t)cur.pm * 256 + RA + 64 * i] + cA2; vo1[i] = rowoff[(size_t)cur.pm * 256 + 128 + RA + 64 * i] + cA2; }
    S.a_ready(cur);
    if constexpr (SP2) {
        PG8_STAGE(PG8_SB(0, 0), cB, voffB); PG8_STAGE(PG8_SB(0, 1), cB + hstep, voffB); PG8_STAGE(PG8_SA(0, 0), gA, vo0); PG8_STAGE(PG8_SA(0, 1), gA, vo1);
        if (wr == 1) PG8_BAR;
        PG8_WAIT_V(2); PG8_BAR;
        PG8_STAGE(PG8_SB(1, 0), cB + kstep, voffB); PG8_STAGE(PG8_SA(1, 0), gA + kstep, vo0); PG8_STAGE(PG8_SB(1, 1), cB + hstep + kstep, voffB);
        PG8_WAIT_V(6); PG8_BAR;
    }
    for (;;) {
        const bool has_next = S.next(ui + 1, nxt);
        const char* nB = has_next ? (const char*)g.Bt + (size_t)nxt.pn * tstep : cB;
        if (has_next) __builtin_amdgcn_global_load_lds((const unsigned*)(rowoff + (size_t)nxt.pm * 256 + lane * 4), (PG8_LAS unsigned*)(side + (ui & 1) * 1024), 16, 0, 0);
        for (int t = 0; t < nt; t += 2) {
            const bool last = (t == nt - 2);
            const char* a1 = gA + (size_t)(t + 1) * kstep;
            const char* a2 = last ? gA : gA + (size_t)(t + 2) * kstep; const char* b2 = last ? nB : cB + (size_t)(t + 2) * kstep;
            unsigned s0[2], s1[2];
#pragma unroll
            for (int i = 0; i < 2; ++i) { s0[i] = vo0[i]; s1[i] = vo1[i]; }
            if (last && has_next) {
                const PG8_LAS unsigned* sl = (const PG8_LAS unsigned*)(side + (ui & 1) * 1024);
                int ra = RA; asm volatile("" : "+v"(ra));
#pragma unroll
                for (int i = 0; i < 2; ++i) { s0[i] = sl[ra + 64 * i] + cA2; s1[i] = sl[128 + ra + 64 * i] + cA2; }
            }
            const char* a3 = a2 + kstep; const char* b3 = b2 + kstep;
            if (last && has_next) S.a_ready(nxt);
            if constexpr (SP2) {
            PG8_LDB8(B0, 0, 0); PG8_LDB8(B1, 0, 1); PG8_SCHED; PG8_LDA8(At, 0, 0); PG8_STAGE(PG8_SA(1, 1), a1, vo1);
            PG8_WAIT_V(8); PG8_WAIT_L(0); PG8_BAR; PG8_MMA8(0, 0, At, B0); PG8_MMA8(0, 1, At, B1); PG8_BAR; PG8_SCHED;
            PG8_LDA8(At, 0, 1); PG8_STAGE(PG8_SB(0, 0), b2, voffB); PG8_STAGE(PG8_SB(0, 1), b2 + hstep, voffB); PG8_STAGE(PG8_SA(0, 0), a2, s0);
            PG8_WAIT_V(8); PG8_WAIT_L(0); PG8_BAR; PG8_MMA8(1, 0, At, B0); PG8_MMA8(1, 1, At, B1); PG8_BAR; PG8_SCHED;
            PG8_LDB8(B0, 1, 0); PG8_LDB8(B1, 1, 1); PG8_SCHED; PG8_LDA8(At, 1, 0); PG8_STAGE(PG8_SA(0, 1), a2, s1);
            PG8_WAIT_V(8); PG8_WAIT_L(0); PG8_BAR; PG8_MMA8(0, 0, At, B0); PG8_MMA8(0, 1, At, B1); PG8_BAR; PG8_SCHED;
            PG8_LDA8(At, 1, 1); PG8_STAGE(PG8_SB(1, 0), b3, voffB); PG8_STAGE(PG8_SB(1, 1), b3 + hstep, voffB); PG8_STAGE(PG8_SA(1, 0), a3, s0);
            PG8_WAIT_V(8); PG8_WAIT_L(0); PG8_BAR; PG8_MMA8(1, 0, At, B0); PG8_MMA8(1, 1, At, B1); PG8_BAR; PG8_SCHED;
            }
        }
        asm volatile("s_nop 15\n\ts_nop 15" ::: "memory");
        if constexpr (ALIGN_EPI) { if (wr == 0) PG8_BAR; }
        if constexpr (!Epi::AFTER_DRAIN) { E(acc, cur, wr, wc, fr, fq); S.done(cur); }
        if (!has_next) break;
#pragma unroll
        for (int a = 0; a < 2; ++a)
#pragma unroll
            for (int b = 0; b < 2; ++b)
#pragma unroll
                for (int m = 0; m < 4; ++m)
#pragma unroll
                    for (int n = 0; n < 2; ++n) acc[a][b][m][n] = (f32x4){0.f, 0.f, 0.f, 0.f};
        cur = nxt; cB = nB; ++ui;
        { const PG8_LAS unsigned* sl = (const PG8_LAS unsigned*)(side + ((ui - 1) & 1) * 1024); int ra = RA; asm volatile("" : "+v"(ra));
#pragma unroll
          for (int i = 0; i < 2; ++i) { vo0[i] = sl[ra + 64 * i] + cA2; vo1[i] = sl[128 + ra + 64 * i] + cA2; } }
        if constexpr (ALIGN_EPI) { if (wr == 1) PG8_BAR; }
    }
    PG8_WAIT_V(0);
    if constexpr (!ALIGN_EPI) { if (wr == 0) PG8_BAR; }
    PG8_BAR;
    if constexpr (Epi::AFTER_DRAIN) { E.fused(acc, cur, wr, wc, fr, fq, lds, wid, lane); S.done(cur); }
}
template <class Epi, class Sched, bool ALIGN_EPI = false, bool SP2 = false>
__device__ __forceinline__ void gemm_phase8(PG8_LAS unsigned char* lds, const Gemm g, const Sched& S, const Epi& E) {
    int tid = threadIdx.x; asm volatile("" : "+v"(tid));
    const int wid = __builtin_amdgcn_readfirstlane(tid >> 6), lane = tid & 63, wr = wid >> 2, wc = wid & 3, fr = lane & 15, fq = lane >> 4;
    const int K = g.K; int nt = K / BK; asm volatile("" : "+s"(nt));
    unsigned voffA[2], voffB[2];
#pragma unroll
    for (int i = 0; i < 2; ++i) { int R, C; stage_rc(tid * 16 + i * 8192, R, C); const int Rb = Epi::PERM ? ((R & ~31) + perm32(R & 31)) : R;
        voffA[i] = (unsigned)(R * K + C) * 2u; voffB[i] = (unsigned)(Rb * K + C) * 2u; }
    const size_t kstep = (size_t)(BK * 2);
    const size_t hstep = (size_t)HALF * K * 2;
    const size_t tstep = 2 * hstep;
    const unsigned ldsw = (unsigned)wid * 1024u;
    const int aoff = lds_byte8(wr * 64 + fr, fq), boff = lds_byte8(wc * 32 + fr, fq);
    int scl8 = 0x7f7f7f7f; asm volatile("" : "+v"(scl8));
    Unit cur, nxt; int ui = 0;
    if (!S.next(0, cur)) return;
    f32x4 acc[2][2][4][2];
#pragma unroll
    for (int a = 0; a < 2; ++a)
#pragma unroll
        for (int b = 0; b < 2; ++b)
#pragma unroll
            for (int m = 0; m < 4; ++m)
#pragma unroll
                for (int n = 0; n < 2; ++n) acc[a][b][m][n] = (f32x4){0.f, 0.f, 0.f, 0.f};
    i32x8 At[4], B0[2], B1[2];
    const char* cA = (const char*)g.A + (size_t)cur.pm * tstep; const char* cB = (const char*)g.Bt + (size_t)cur.pn * tstep;
    S.a_ready(cur);
    if constexpr (SP2) {
        PG8_STAGE(PG8_SB(0, 0), cB, voffB); PG8_STAGE(PG8_SB(0, 1), cB + hstep, voffB); PG8_STAGE(PG8_SA(0, 0), cA, voffA); PG8_STAGE(PG8_SA(0, 1), cA + hstep, voffA);
        if (wr == 1) PG8_BAR;
        PG8_WAIT_V(2); PG8_BAR;
        PG8_STAGE(PG8_SB(1, 0), cB + kstep, voffB); PG8_STAGE(PG8_SA(1, 0), cA + kstep, voffA); PG8_STAGE(PG8_SB(1, 1), cB + hstep + kstep, voffB);
        PG8_WAIT_V(6); PG8_BAR;
    } else {
        PG8_STAGE(PG8_SB(0, 0), cB, voffB); PG8_STAGE(PG8_SA(0, 0), cA, voffA); PG8_STAGE(PG8_SB(0, 1), cB + hstep, voffB); PG8_STAGE(PG8_SA(0, 1), cA + hstep, voffA);
        if (wr == 1) PG8_BAR;
        PG8_WAIT_V(4); PG8_BAR;
        PG8_STAGE(PG8_SB(1, 0), cB + kstep, voffB); PG8_STAGE(PG8_SA(1, 0), cA + kstep, voffA); PG8_STAGE(PG8_SB(1, 1), cB + hstep + kstep, voffB);
        PG8_WAIT_V(6); PG8_BAR;
    }
    for (;;) {
        const bool has_next = S.next(ui + 1, nxt);
        const char* nA = has_next ? (const char*)g.A + (size_t)nxt.pm * tstep : cA; const char* nB = has_next ? (const char*)g.Bt + (size_t)nxt.pn * tstep : cB;
        for (int t = 0; t < nt; t += 2) {
            const bool last = (t == nt - 2);
            const char* a1 = cA + (size_t)(t + 1) * kstep;
            const char* a2 = last ? nA : cA + (size_t)(t + 2) * kstep; const char* b2 = last ? nB : cB + (size_t)(t + 2) * kstep;
            const char* a3 = a2 + kstep; const char* b3 = b2 + kstep;
            if (last && has_next) S.a_ready(nxt);
            if constexpr (SP2) {
            PG8_LDB8(B0, 0, 0); PG8_LDB8(B1, 0, 1); PG8_SCHED; PG8_LDA8(At, 0, 0); PG8_STAGE(PG8_SA(1, 1), a1 + hstep, voffA);
            PG8_WAIT_V(8); PG8_WAIT_L(0); PG8_BAR; PG8_MMA8(0, 0, At, B0); PG8_MMA8(0, 1, At, B1); PG8_BAR; PG8_SCHED;
            PG8_LDA8(At, 0, 1); PG8_STAGE(PG8_SB(0, 0), b2, voffB); PG8_STAGE(PG8_SB(0, 1), b2 + hstep, voffB); PG8_STAGE(PG8_SA(0, 0), a2, voffA);
            PG8_WAIT_V(8); PG8_WAIT_L(0); PG8_BAR; PG8_MMA8(1, 0, At, B0); PG8_MMA8(1, 1, At, B1); PG8_BAR; PG8_SCHED;
            PG8_LDB8(B0, 1, 0); PG8_LDB8(B1, 1, 1); PG8_SCHED; PG8_LDA8(At, 1, 0); PG8_STAGE(PG8_SA(0, 1), a2 + hstep, voffA);
            PG8_WAIT_V(8); PG8_WAIT_L(0); PG8_BAR; PG8_MMA8(0, 0, At, B0); PG8_MMA8(0, 1, At, B1); PG8_BAR; PG8_SCHED;
            PG8_LDA8(At, 1, 1); PG8_STAGE(PG8_SB(1, 0), b3, voffB); PG8_STAGE(PG8_SB(1, 1), b3 + hstep, voffB); PG8_STAGE(PG8_SA(1, 0), a3, voffA);
            PG8_WAIT_V(8); PG8_WAIT_L(0); PG8_BAR; PG8_MMA8(1, 0, At, B0); PG8_MMA8(1, 1, At, B1); PG8_BAR; PG8_SCHED;
            } else {
            PG8_LDB8(B0, 0, 0); PG8_SCHED; PG8_LDA8(At, 0, 0); PG8_STAGE(PG8_SA(1, 1), a1 + hstep, voffA);
            PG8_WAIT_L(8); PG8_BAR; PG8_WAIT_L(0); PG8_MMA8(0, 0, At, B0); PG8_BAR; PG8_SCHED;
            PG8_LDB8(B1, 0, 1); PG8_STAGE(PG8_SB(0, 0), b2, voffB);
            PG8_BAR; PG8_WAIT_L(0); PG8_MMA8(0, 1, At, B1); PG8_BAR;
            PG8_LDA8(At, 0, 1); PG8_STAGE(PG8_SA(0, 0), a2, voffA);
            PG8_BAR; PG8_WAIT_L(0); PG8_MMA8(1, 0, At, B0); PG8_BAR; PG8_SCHED;
            PG8_STAGE(PG8_SB(0, 1), b2 + hstep, voffB);
            PG8_WAIT_V(6); PG8_BAR; PG8_MMA8(1, 1, At, B1); PG8_BAR;
            PG8_LDB8(B0, 1, 0); PG8_SCHED; PG8_LDA8(At, 1, 0); PG8_STAGE(PG8_SA(0, 1), a2 + hstep, voffA);
            PG8_WAIT_L(8); PG8_BAR; PG8_WAIT_L(0); PG8_MMA8(0, 0, At, B0); PG8_BAR; PG8_SCHED;
            PG8_LDB8(B1, 1, 1); PG8_STAGE(PG8_SB(1, 0), b3, voffB);
            PG8_BAR; PG8_WAIT_L(0); PG8_MMA8(0, 1, At, B1); PG8_BAR;
            PG8_LDA8(At, 1, 1); PG8_STAGE(PG8_SA(1, 0), a3, voffA);
            PG8_BAR; PG8_WAIT_L(0); PG8_MMA8(1, 0, At, B0); PG8_BAR; PG8_SCHED;
            PG8_STAGE(PG8_SB(1, 1), b3 + hstep, voffB);
            PG8_WAIT_V(6); PG8_BAR; PG8_MMA8(1, 1, At, B1); PG8_BAR;
            }
        }
        asm volatile("s_nop 15\n\ts_nop 15" ::: "memory");
        if constexpr (ALIGN_EPI) { if (wr == 0) PG8_BAR; }
        if constexpr (!Epi::AFTER_DRAIN) { E(acc, cur, wr, wc, fr, fq); S.done(cur); }
        if (!has_next) break;
#pragma unroll
        for (int a = 0; a < 2; ++a)
#pragma unroll
            for (int b = 0; b < 2; ++b)
#pragma unroll
                for (int m = 0; m < 4; ++m)
#pragma unroll
                    for (int n = 0; n < 2; ++n) acc[a][b][m][n] = (f32x4){0.f, 0.f, 0.f, 0.f};
        cur = nxt; cA = nA; cB = nB; ++ui;
        if constexpr (ALIGN_EPI) { if (wr == 1) PG8_BAR; }
    }
    PG8_WAIT_V(0);
    if constexpr (!ALIGN_EPI) { if (wr == 0) PG8_BAR; }
    PG8_BAR;
    if constexpr (Epi::AFTER_DRAIN) { E.fused(acc, cur, wr, wc, fr, fq, lds, wid, lane); S.done(cur); }
}
#undef PG8_LDA8
#undef PG8_LDB8
#undef PG8_MMA8
#undef PG8_SA
#undef PG8_SB
#undef PG8_STAGE
#undef PG8_LDA
#undef PG8_LDB
#undef PG8_MMA
#undef PG8_WAIT_V
#undef PG8_WAIT_L
#undef PG8_BAR
#undef PG8_SCHED
}
#define GAS __attribute__((address_space(1)))
#define LAS __attribute__((address_space(3)))
typedef unsigned short bf16;
typedef unsigned v4u __attribute__((ext_vector_type(4)));
typedef float f32x4 __attribute__((ext_vector_type(4)));
typedef short bf16x8 __attribute__((ext_vector_type(8)));
typedef GAS unsigned gu32;
typedef GAS unsigned long long gu64;
#define RLX_AGENT __ATOMIC_RELAXED, __HIP_MEMORY_SCOPE_AGENT
#define LDS_WAIT() asm volatile("s_waitcnt lgkmcnt(0)" ::: "memory")
#define VM_WAIT() asm volatile("s_waitcnt vmcnt(0)" ::: "memory")
__device__ __forceinline__ unsigned long long rt() { return __builtin_amdgcn_s_memrealtime(); }
__device__ __forceinline__ unsigned f2bf(float f) { unsigned u = __builtin_bit_cast(unsigned, f); return (u + 0x7fffu + ((u >> 16) & 1u)) >> 16; }
__device__ __forceinline__ unsigned pk2(float lo, float hi) { return f2bf(lo) | (f2bf(hi) << 16); }

#define XB_TMO      128
#define XB_XCNT(j)  (256  + 64 * (j))
#define XB_XSUB(j)  (1280 + 64 * (j))
#define XB_XGEN(j)  (2304 + 64 * (j))
#define XB_TOP      3328
#define XB_TOPGEN   3392
#define XCD_BAR_WORDS 3456
#define XB_SPIN_CAP (1u << 18)

__device__ __forceinline__ unsigned xb_ld(unsigned* p)              { return __hip_atomic_load(p, __ATOMIC_RELAXED, __HIP_MEMORY_SCOPE_AGENT); }
__device__ __forceinline__ unsigned xb_add(unsigned* p, unsigned v) { return __hip_atomic_fetch_add(p, v, __ATOMIC_RELAXED, __HIP_MEMORY_SCOPE_AGENT); }
__device__ __forceinline__ unsigned xb_xcc_id() { return (unsigned)__builtin_amdgcn_s_getreg((3 << 11) | 20) & 0xFu; }
#define XB_SPIN(cond, bar) do { unsigned _sp = 0; while (cond) { __builtin_amdgcn_s_sleep(1); \
    if ((++_sp & 255u) == 0u) { if (xb_ld(&(bar)[XB_TMO])) break; if (_sp > XB_SPIN_CAP) { atomicAdd(&(bar)[XB_TMO], 1u); break; } } } } while (0)

struct XcdBarrier {
    unsigned* bar; unsigned x;
    volatile LAS unsigned* st;
};

__device__ __forceinline__ XcdBarrier xcd_barrier_post(unsigned* bar, volatile LAS unsigned* st) {
    XcdBarrier b; b.bar = bar; b.x = xb_xcc_id(); b.st = st;
    if (threadIdx.x == 0) (void)xb_add(&bar[XB_XCNT(b.x)], 1u);
    return b;
}
__device__ __forceinline__ void xcd_barrier_complete(unsigned* bar, unsigned x, unsigned& nloc, unsigned& nx) {
    const unsigned G = gridDim.x * gridDim.y * gridDim.z;
    unsigned sum, cnt, mine, sp = 0u;
    for (;;) {
        sum = 0u; cnt = 0u; mine = 0u;
#pragma unroll
        for (unsigned j = 0; j < 16; ++j) { const unsigned c = xb_ld(&bar[XB_XCNT(j)]); sum += c; cnt += (c > 0u) ? 1u : 0u; mine = (j == x) ? c : mine; }
        if (sum == G) break;
        __builtin_amdgcn_s_sleep(1);
        if ((++sp & 255u) == 0u) { if (xb_ld(&bar[XB_TMO])) break; if (sp > XB_SPIN_CAP) { atomicAdd(&bar[XB_TMO], 1u); break; } }
    }
    nloc = mine > 0u ? mine : 1u; nx = cnt > 0u ? cnt : 1u;
}

__device__ __forceinline__ void xcd_barrier(const XcdBarrier& b) {
    asm volatile("s_waitcnt vmcnt(0)" ::: "memory");
    __syncthreads();
    if (threadIdx.x == 0) {
        unsigned* bar = b.bar;
        __builtin_amdgcn_s_waitcnt(0);
        unsigned nloc = b.st[0], nx = b.st[1];
        if (nloc == 0u) { xcd_barrier_complete(bar, b.x, nloc, nx); b.st[0] = nloc; b.st[1] = nx; }
        const unsigned old = xb_add(&bar[XB_XSUB(b.x)], 1u);
        const unsigned gen = old / nloc;
        if (old + 1u == (gen + 1u) * nloc) {
            __builtin_amdgcn_fence(__ATOMIC_RELEASE, "agent");
            asm volatile("s_waitcnt vmcnt(0)" ::: "memory");
            const unsigned og = xb_add(&bar[XB_TOP], 1u);
            const unsigned tg = og / nx;
            if (og + 1u == (tg + 1u) * nx) xb_add(&bar[XB_TOPGEN], 1u);
            else XB_SPIN(xb_ld(&bar[XB_TOPGEN]) == tg, bar);
            __builtin_amdgcn_fence(__ATOMIC_ACQUIRE, "agent");
            xb_add(&bar[XB_XGEN(b.x)], 1u);
            asm volatile("s_waitcnt vmcnt(0)" ::: "memory");
        } else {
            XB_SPIN(xb_ld(&bar[XB_XGEN(b.x)]) == gen, bar);
            __builtin_amdgcn_fence(__ATOMIC_ACQUIRE, "agent");
            asm volatile("s_waitcnt vmcnt(0)" ::: "memory");
        }
    }
    __syncthreads();
}
typedef unsigned u32x4 __attribute__((ext_vector_type(4)));
#ifndef LRU_NEW2
#define LRU_NEW2 1
#endif
#ifndef LRU_NEW4
#define LRU_NEW4 1
#endif

namespace pg8 {
typedef unsigned u32x2 __attribute__((ext_vector_type(2)));
__device__ __forceinline__ float silu_f(float x) { return x * __builtin_amdgcn_rcpf(1.0f + __expf(-x)); }
__device__ __forceinline__ float gelu_tanh_pg(float x) { const float z2 = 2.302208198144325f * x * (1.0f + 0.044715f * x * x);   return x - x * __builtin_amdgcn_rcpf(1.0f + __builtin_amdgcn_exp2f(z2)); }
struct EpiHS {
    static constexpr bool PERM = true, AFTER_DRAIN = false;
    const float* x; const float* meta; bf16_t* hsb;
    __device__ __forceinline__ void operator()(const f32x4 (&acc)[2][2][4][2], const Unit& u, int wr, int wc, int fr, int fq) const {
        const int col0 = u.pn * BM + wc * 32 + 8 * fq;
#pragma unroll
        for (int ai = 0; ai < 2; ++ai) {
            f32x4 rv[4][2][2]; int tt[4];
#pragma unroll
            for (int m = 0; m < 4; ++m) {
                const int r = u.pm * BM + ai * HALF + wr * 64 + m * 16 + fr;
                const int b = r / 8320, p = r - b * 8320, t = p - 112; tt[m] = t;
                const int tc = t < 0 ? 16 : t;
                const float* src = tc < 16 ? meta + (size_t)tc * 1024 : x + ((size_t)b * 8192 + (size_t)(tc - 16)) * 1024;
#pragma unroll
                for (int bj = 0; bj < 2; ++bj) { rv[m][bj][0] = *(const f32x4*)(src + col0 + bj * HALF); rv[m][bj][1] = *(const f32x4*)(src + col0 + bj * HALF + 4); }
            }
#pragma unroll
            for (int m = 0; m < 4; ++m) {
                const int r = u.pm * BM + ai * HALF + wr * 64 + m * 16 + fr;
                if (tt[m] >= 0) {
                    bf16_t* dst = hsb + (size_t)r * 1024;
#pragma unroll
                    for (int bj = 0; bj < 2; ++bj) { const f32x4 v0 = rv[m][bj][0] + acc[ai][bj][m][0], v1 = rv[m][bj][1] + acc[ai][bj][m][1]; u32x4 w;
                        w.x = cvt_pk_bf16(v0[0], v0[1]); w.y = cvt_pk_bf16(v0[2], v0[3]); w.z = cvt_pk_bf16(v1[0], v1[1]); w.w = cvt_pk_bf16(v1[2], v1[3]);
                        *(u32x4*)(dst + col0 + bj * HALF) = w; }
                }
            }
        }
    }
};
struct EpiAct {
    static constexpr bool PERM = true, AFTER_DRAIN = false;
    bf16_t* act;
    __device__ __forceinline__ void operator()(const f32x4 (&acc)[2][2][4][2], const Unit& u, int wr, int wc, int fr, int fq) const {
        const int row0 = u.pm * BM + wr * 64 + fr; const int j = u.pn & 7; const int col0 = j * 128 + wc * 32 + 8 * fq;
#pragma unroll
        for (int ai = 0; ai < 2; ++ai)
#pragma unroll
            for (int m = 0; m < 4; ++m) {
                unsigned char* rowp = (unsigned char*)act + (size_t)(row0 + ai * HALF + m * 16) * 1024 + col0;
                const f32x4 g0 = acc[ai][0][m][0] * 0.03125f, g1 = acc[ai][0][m][1] * 0.03125f, u0 = acc[ai][1][m][0] * 0.03125f, u1 = acc[ai][1][m][1] * 0.03125f;
                u32x2 w; unsigned t = 0u;
                t = __builtin_amdgcn_cvt_pk_fp8_f32(silu_f(g0[0]) * u0[0], silu_f(g0[1]) * u0[1], t, false); t = __builtin_amdgcn_cvt_pk_fp8_f32(silu_f(g0[2]) * u0[2], silu_f(g0[3]) * u0[3], t, true); w.x = t;
                t = __builtin_amdgcn_cvt_pk_fp8_f32(silu_f(g1[0]) * u1[0], silu_f(g1[1]) * u1[1], t, false); t = __builtin_amdgcn_cvt_pk_fp8_f32(silu_f(g1[2]) * u1[2], silu_f(g1[3]) * u1[3], t, true); w.y = t;
                *(u32x2*)rowp = w;
            }
    }
};
struct EpiYS {
    static constexpr bool PERM = true, AFTER_DRAIN = false;
    unsigned char* ys; const float* gate;
    __device__ __forceinline__ void operator()(const f32x4 (&acc)[2][2][4][2], const Unit& u, int wr, int wc, int fr, int fq) const {
        const int row0 = u.pm * BM + wr * 64 + fr; const int j = u.pn & 3; const int col0 = j * 256 + wc * 32 + 8 * fq;
#pragma unroll
        for (int ai = 0; ai < 2; ++ai)
#pragma unroll
            for (int m = 0; m < 4; ++m) {
                const int row = row0 + ai * HALF + m * 16; const float gv = gate[row] * 0.25f;
                unsigned char* rowp = ys + (size_t)row * 1024 + col0;
#pragma unroll
                for (int bj = 0; bj < 2; ++bj) { const f32x4 v0 = acc[ai][bj][m][0] * gv, v1 = acc[ai][bj][m][1] * gv; u32x2 w; unsigned t = 0u;
                    t = __builtin_amdgcn_cvt_pk_fp8_f32(v0[0], v0[1], t, false); t = __builtin_amdgcn_cvt_pk_fp8_f32(v0[2], v0[3], t, true); w.x = t;
                    t = __builtin_amdgcn_cvt_pk_fp8_f32(v1[0], v1[1], t, false); t = __builtin_amdgcn_cvt_pk_fp8_f32(v1[2], v1[3], t, true); w.y = t;
                    *(u32x2*)(rowp + bj * HALF) = w; }
            }
    }
};

struct EpiZ {
    static constexpr bool PERM = true, AFTER_DRAIN = false;
    bf16_t* Z; const float* cs;
    __device__ __forceinline__ void operator()(const f32x4 (&acc)[2][2][4][2], const Unit& u, int wr, int wc, int fr, int fq) const {
        const int row0 = u.pm * BM + wr * 64 + fr;
        if (u.pn < 4 || u.pn >= 8) {
            const int col0 = u.pn * BM + wc * 32 + 8 * fq;
            const int act = (u.pn == 2 || u.pn == 3) ? 1 : (u.pn >= 10 ? 2 : 0);
#pragma unroll
            for (int ai = 0; ai < 2; ++ai)
#pragma unroll
                for (int m = 0; m < 4; ++m) { bf16_t* rowp = Z + (size_t)(row0 + ai * HALF + m * 16) * 3072 + col0;
#pragma unroll
                    for (int bj = 0; bj < 2; ++bj) { f32x4 v0 = acc[ai][bj][m][0], v1 = acc[ai][bj][m][1]; u32x4 w;
                        if (act == 1) {
#pragma unroll
                            for (int q = 0; q < 4; ++q) { v0[q] = gelu_tanh_pg(v0[q]); v1[q] = gelu_tanh_pg(v1[q]); } }
                        else if (act == 2) {
#pragma unroll
                            for (int q = 0; q < 4; ++q) { v0[q] = silu_f(v0[q]); v1[q] = silu_f(v1[q]); } }
                        w.x = cvt_pk_bf16(v0[0], v0[1]); w.y = cvt_pk_bf16(v0[2], v0[3]); w.z = cvt_pk_bf16(v1[0], v1[1]); w.w = cvt_pk_bf16(v1[2], v1[3]);
                        *(u32x4*)(rowp + bj * HALF) = w; } }
        } else {
            const int x0 = wc * 32 + 8 * fq;
            const int region = (u.pn - 4) >> 1, head = 2 * ((u.pn - 4) & 1) + (x0 >> 6), j0 = x0 & 63;
            const int colA = 1024 + region * 512 + head * 128 + j0;
            const float sc = region == 0 ? 0.08838834764831845f : 1.0f;
#pragma unroll
            for (int ai = 0; ai < 2; ++ai) {
                f32x4 cc[4][4];
#pragma unroll
                for (int m = 0; m < 4; ++m) { const int r = row0 + ai * HALF + m * 16; const int b = r / 8320; int t = r - b * 8320 - 112; t = t < 0 ? 0 : t;
                    const f32x4* cp = (const f32x4*)(cs + ((size_t)t * 64 + j0) * 2); cc[m][0] = cp[0]; cc[m][1] = cp[1]; cc[m][2] = cp[2]; cc[m][3] = cp[3]; }
#pragma unroll
                for (int m = 0; m < 4; ++m) {
                    const int r = row0 + ai * HALF + m * 16;
                    const f32x4 c0 = cc[m][0], c1 = cc[m][1], c2 = cc[m][2], c3 = cc[m][3];
                    const f32x4 a0 = acc[ai][0][m][0], a1 = acc[ai][0][m][1], b0 = acc[ai][1][m][0], b1 = acc[ai][1][m][1];
                    u32x4 w1, w2;
                    w1.x = cvt_pk_bf16((a0[0] * c0[0] - b0[0] * c0[1]) * sc, (a0[1] * c0[2] - b0[1] * c0[3]) * sc); w2.x = cvt_pk_bf16((a0[0] * c0[1] + b0[0] * c0[0]) * sc, (a0[1] * c0[3] + b0[1] * c0[2]) * sc);
                    w1.y = cvt_pk_bf16((a0[2] * c1[0] - b0[2] * c1[1]) * sc, (a0[3] * c1[2] - b0[3] * c1[3]) * sc); w2.y = cvt_pk_bf16((a0[2] * c1[1] + b0[2] * c1[0]) * sc, (a0[3] * c1[3] + b0[3] * c1[2]) * sc);
                    w1.z = cvt_pk_bf16((a1[0] * c2[0] - b1[0] * c2[1]) * sc, (a1[1] * c2[2] - b1[1] * c2[3]) * sc); w2.z = cvt_pk_bf16((a1[0] * c2[1] + b1[0] * c2[0]) * sc, (a1[1] * c2[3] + b1[1] * c2[2]) * sc);
                    w1.w = cvt_pk_bf16((a1[2] * c3[0] - b1[2] * c3[1]) * sc, (a1[3] * c3[2] - b1[3] * c3[3]) * sc); w2.w = cvt_pk_bf16((a1[2] * c3[1] + b1[2] * c3[0]) * sc, (a1[3] * c3[3] + b1[3] * c3[2]) * sc);
                    bf16_t* rowp = Z + (size_t)r * 3072 + colA;
                    *(u32x4*)rowp = w1; *(u32x4*)(rowp + 64) = w2;
                }
            }
        }
    }
};
struct GroupOrder {
    int G, vcu, tm, tn, nwg;
    __device__ __forceinline__ void init(int ne, int tm_, int tn_, int G_, int c) { tm = tm_; tn = tn_; nwg = ne * tm_ * tn_; G = G_; vcu = (G_ % 8 == 0) ? (c % 8) * (G_ / 8) + c / 8 : c; }
    __device__ __forceinline__ bool next(int i, Unit& u) const {
        const long L = (long)i * G + vcu; if (L >= nwg) return false;
        const int per = tm * tn, e = (int)(L / per), rem = (int)(L % per);
        u.pm = e * tm + rem / tn; u.pn = e * tn + rem % tn; return true;
    }
    __device__ __forceinline__ void a_ready(const Unit&) const {}
    __device__ __forceinline__ void done(const Unit&) const {}
};
}

constexpr int NB = 8, SEQ = 8192, DM = 1024, NMETA = 16, TT = SEQ + NMETA, PADL = 112, PP = 8320, NP = NB * PP;
constexpr int NCHUNK = 65, NSEG = 130;
constexpr int ZC = 3072, ZC_LX = 0, ZC_LG = 512, ZC_Q = 1024, ZC_K = 1536, ZC_V = 2048, ZC_G = 2560;
constexpr int NE = 16, CAP = 1026, EROWS = 8448, NROWS = NE * EROWS;
constexpr float EPSN = 1e-6f;
constexpr int NPHASE = 12;

constexpr size_t MiB = 1u << 20;
constexpr size_t WS_CTL = 0, CTL_ZERO_BYTES = 64 * 1024;
constexpr size_t WS_GW = 1 * MiB, WS_GW2 = 1 * MiB + 256 * 1024, WS_HSMETA = 1 * MiB + 512 * 1024;
constexpr size_t WS_CS = 3 * MiB, WS_SUMM = 8 * MiB, WS_CARRY = 17 * MiB, WS_AFF = 22 * MiB, WS_ROWMAP = 27 * MiB, WS_IDX = 32 * MiB, WS_GATE = 33 * MiB;
constexpr size_t WS_WIN = 34 * MiB, WS_WOUT = 40 * MiB, WS_WGU = 42 * MiB, WS_WD = 106 * MiB;
#ifndef ST_INPLACE
#define ST2_BASE WS_ST2
#define CPY_BASE WS_ST
#else
#define ST2_BASE WS_ST
#define CPY_BASE WS_ST2
#endif
constexpr size_t WS_ST2 = 788 * MiB;
constexpr size_t WS_HSB = 400 * MiB;
constexpr size_t WS_H = 138 * MiB, WS_Z = 268 * MiB, WS_ST = 658 * MiB, WS_XS = 658 * MiB, WS_ACT = 268 * MiB, WS_YS = WS_XS, WS_END = 922 * MiB;
static_assert(WS_H + (size_t)NP * 2048 <= WS_Z && WS_Z + (size_t)NP * ZC * 2 <= WS_ST && WS_ST + (size_t)NB * 4 * 2 * NCHUNK * 32768 <= WS_END && WS_XS + (size_t)NROWS * 2048 <= WS_END && WS_ACT + (size_t)NROWS * 2048 <= WS_ST, "ws map");
constexpr int CW_BAR = 1024;

constexpr int LDS_MAIN = 131072, LDS_BYTES = 147456;
constexpr int LDS_SS = LDS_MAIN;
constexpr int LDS_MISC = LDS_MAIN + 4096;
constexpr int LDS_SIDE = LDS_MAIN + 8192;

typedef unsigned short u16x8 __attribute__((ext_vector_type(8)));
typedef unsigned short u16x4 __attribute__((ext_vector_type(4)));
typedef float f32x16 __attribute__((ext_vector_type(16)));
typedef float f32x2 __attribute__((ext_vector_type(2)));
typedef unsigned u32x2 __attribute__((ext_vector_type(2)));
typedef short v4i16_t __attribute__((ext_vector_type(4)));
typedef __bf16 bf16x2_t __attribute__((ext_vector_type(2)));

__device__ __forceinline__ float bf2f(unsigned short v) { return __uint_as_float((unsigned)v << 16); }
__device__ __forceinline__ unsigned cvtpk(float lo, float hi) { f32x2 v = {lo, hi}; bf16x2_t b = __builtin_convertvector(v, bf16x2_t); return __builtin_bit_cast(unsigned, b); }
__device__ __forceinline__ unsigned short f2bf16(float f) { return (unsigned short)(cvtpk(f, 0.f) & 0xffffu); }
__device__ __forceinline__ float wave_sum(float v) {
#pragma unroll
    for (int o = 1; o < 64; o <<= 1) v += __shfl_xor(v, o);
    return v;
}
__device__ __forceinline__ float sigmoid_f(float x) { return __builtin_amdgcn_rcpf(1.0f + __expf(-x)); }
__device__ __forceinline__ float gelu_tanh_f(float x) { const float z2 = 2.302208198144325f * x * (1.0f + 0.044715f * x * x);   return x - x * __builtin_amdgcn_rcpf(1.0f + __builtin_amdgcn_exp2f(z2)); }
__device__ __forceinline__ float softplus_neg(float lam) { const float y = __expf(-lam); return (y < 0.05f) ? y * (1.0f + y * (-0.5f + y * (0.33333333f + y * (-0.25f + y * 0.2f)))) : log1pf(y); }
__device__ __forceinline__ float log2_gamma(int h) { return h == 0 ? -0.04580368961312479f : h == 1 ? -0.02272007650008353f : h == 2 ? -0.011315313227834146f : -0.005646563141142063f; }
__device__ __forceinline__ unsigned off_b(unsigned row, unsigned ch) { return 256u * row + 16u * (ch ^ (((row & 3u) << 2) | ((row >> 2) & 3u))); }
__device__ __forceinline__ pg8::bf16x8 rowfrag(LAS unsigned char* T, int rb, int s, int lane) {
    return *(LAS pg8::bf16x8*)(T + off_b(32 * rb + (lane & 31), 2 * s + (lane >> 5)));
}
__device__ __forceinline__ pg8::bf16x8 rowfrag_x(LAS unsigned char* T, int rb, int s, int lane) {
    return *(LAS pg8::bf16x8*)(T + off_b((32 * rb + (lane & 31)) ^ 1, 2 * s + (lane >> 5)));
}
__device__ __forceinline__ v4i16_t tr_rd(LAS unsigned char* p) { return __builtin_amdgcn_ds_read_tr16_b64_v4i16((LAS v4i16_t*)p); }
__device__ __forceinline__ pg8::bf16x8 trfrag(LAS unsigned char* T, int c, int ks, int lane) {
    const unsigned h = lane >> 5, blk = (lane >> 4) & 1, q = (lane & 15) >> 2, p = lane & 3;
    const v4i16_t lo = tr_rd(T + off_b(16 * ks + 8 * h + q, 4 * c + 2 * blk + (p >> 1)) + 8 * (p & 1));
    const v4i16_t hi = tr_rd(T + off_b(16 * ks + 8 * h + 4 + q, 4 * c + 2 * blk + (p >> 1)) + 8 * (p & 1));
    return (pg8::bf16x8){lo[0], lo[1], lo[2], lo[3], hi[0], hi[1], hi[2], hi[3]};
}
__device__ __forceinline__ pg8::bf16x8 trfrag_perm(LAS unsigned char* T, int c, int rbase, int lane) {
    const unsigned h = lane >> 5, blk = (lane >> 4) & 1, q = (lane & 15) >> 2, p = lane & 3;
    const v4i16_t lo = tr_rd(T + off_b(rbase + 4 * h + q, 4 * c + 2 * blk + (p >> 1)) + 8 * (p & 1));
    const v4i16_t hi = tr_rd(T + off_b(rbase + 8 + 4 * h + q, 4 * c + 2 * blk + (p >> 1)) + 8 * (p & 1));
    return (pg8::bf16x8){lo[0], lo[1], lo[2], lo[3], hi[0], hi[1], hi[2], hi[3]};
}
__device__ __forceinline__ int crow(int reg, int h) { return (reg & 3) + 8 * (reg >> 2) + 4 * h; }
#define MFMA32(a, b, c) __builtin_amdgcn_mfma_f32_32x32x16_bf16((a), (b), (c), 0, 0, 0)
#define MFMA16(a, b, c) __builtin_amdgcn_mfma_f32_16x16x32_bf16((a), (b), (c), 0, 0, 0)

struct Fr {
    LAS unsigned char* lds;
    int tid, lane, wave, G;
    const float *x, *meta, *norm1_g, *w_in, *conv_w, *conv_b, *w_r, *b_r, *w_i, *b_i, *lam, *lru_out_g, *ret_out_g, *w_out, *norm2_g, *w_router, *w_gate, *w_up, *w_down, *final_g;
    float* out;
    unsigned short *GW2; unsigned short *GW, *WIN, *WOUT, *WGU, *WD, *H, *Z, *ST, *XS, *ACT, *YS;
    unsigned char* CTLP; float *HSMETA, *AFF, *GATE, *CARRY; unsigned short* HSB; unsigned short* ST2; f32x2 *CS, *SUMM; int *ROWMAP, *IDX;
};

__device__ __forceinline__ void prep_tile(const Fr& F, const float* W, int ldw, int k0, int n0, unsigned short* WT, int mode) {
    LAS float* scr = (LAS float*)F.lds;
    const int tid = F.tid;
    { const int n = tid & 63, kk = tid >> 6;
#pragma unroll
      for (int i = 0; i < 8; ++i) { const int k = kk + 8 * i; scr[k * 65 + n] = W[(size_t)(k0 + k) * ldw + n0 + n]; } }
    __syncthreads();
    { const int k = tid & 63, nn = tid >> 6;
#pragma unroll
      for (int i = 0; i < 8; ++i) { const int n = n0 + nn + 8 * i; int row;
          if (mode == 0) row = n; else if (mode == 3) { if (n < 1024 || n >= 2048) row = n; else { const int q = n - 1024, region = q >> 9, hd = (q >> 7) & 3, d = q & 127; row = 1024 + region * 512 + (hd >> 1) * 256 + (d >> 6) * 128 + (hd & 1) * 64 + (d & 63); } }
          else row = 256 * (n >> 7) + (n & 127) + (mode == 2 ? 128 : 0);
          WT[(size_t)row * 1024 + k0 + k] = f2bf16(scr[k * 65 + (nn + 8 * i)]); } }
    __syncthreads();
}
__device__ __forceinline__ void prep_tile8(const Fr& F, const float* W, int k0, int n0, unsigned char* WT8, int mode) {
    LAS float* scr = (LAS float*)F.lds;
    const int tid = F.tid;
    { const int n = tid & 63, kk = tid >> 6;
#pragma unroll
      for (int i = 0; i < 8; ++i) { const int k = kk + 8 * i; scr[k * 65 + n] = W[(size_t)(k0 + k) * 1024 + n0 + n]; } }
    __syncthreads();
    { const int k4 = tid & 15, nn = tid >> 4;
#pragma unroll
      for (int i = 0; i < 2; ++i) { const int nl = nn + 32 * i, n = n0 + nl; const int row = mode == 0 ? n : 256 * (n >> 7) + (n & 127) + (mode == 2 ? 128 : 0);
          const float a = scr[(4 * k4 + 0) * 65 + nl] * 32.0f, b = scr[(4 * k4 + 1) * 65 + nl] * 32.0f, c = scr[(4 * k4 + 2) * 65 + nl] * 32.0f, d = scr[(4 * k4 + 3) * 65 + nl] * 32.0f;
          unsigned w = 0u; w = __builtin_amdgcn_cvt_pk_fp8_f32(a, b, w, false); w = __builtin_amdgcn_cvt_pk_fp8_f32(c, d, w, true);
          *(unsigned*)(WT8 + (size_t)row * 1024 + k0 + 4 * k4) = w; } }
    __syncthreads();
}
__device__ __forceinline__ void sincos_tab(int t, int j, float& co, float& si) {
    double f = 1.0, bse = 0.8659643233600653;
    int e = j;
#pragma unroll
    for (int i = 0; i < 6; ++i) { if (e & 1) f *= bse; bse *= bse; e >>= 1; }
    const double xx = (double)t * f;
    const double qd = __builtin_rint(xx * 0.6366197723675814);
    double y = __builtin_fma(-qd, 1.5707963267948966, xx); y = __builtin_fma(-qd, 6.123233995736766e-17, y);
    const double y2 = y * y;
    double sp = -7.647163731819816e-13;
    sp = sp * y2 + 1.6059043836821613e-10;
    sp = sp * y2 - 2.505210838544172e-08;
    sp = sp * y2 + 2.7557319223985893e-06;
    sp = sp * y2 - 1.984126984126984e-04;
    sp = sp * y2 + 8.333333333333333e-03;
    sp = sp * y2 - 1.6666666666666666e-01;
    const double sy = y + y * y2 * sp;
    double cp = 4.779477332387385e-14;
    cp = cp * y2 - 1.1470745597729725e-11;
    cp = cp * y2 + 2.08767569878681e-09;
    cp = cp * y2 - 2.755731922398589e-07;
    cp = cp * y2 + 2.48015873015873e-05;
    cp = cp * y2 - 1.388888888888889e-03;
    cp = cp * y2 + 4.1666666666666664e-02;
    cp = cp * y2 - 0.5;
    const double cy = 1.0 + y2 * cp;
    const int qi = ((int)(long long)qd) & 3;
    const double s_ = (qi == 0) ? sy : (qi == 1) ? cy : (qi == 2) ? -sy : -cy;
    const double c_ = (qi == 0) ? cy : (qi == 1) ? -sy : (qi == 2) ? -cy : sy;
    co = (float)c_; si = (float)s_;
}
__device__ __forceinline__ void rms_row_to_bf16(const float* xrow, const float* g, unsigned short* orow, int lane) {
    const f32x4* xr = (const f32x4*)xrow + lane; const f32x4* gr = (const f32x4*)g + lane;
    f32x4 v[4]; float s = 0.f;
#pragma unroll
    for (int j = 0; j < 4; ++j) { v[j] = xr[64 * j]; s += (v[j].x * v[j].x + v[j].y * v[j].y) + (v[j].z * v[j].z + v[j].w * v[j].w); }
    const float rs = 1.0f / sqrtf(wave_sum(s) * (1.0f / 1024.0f) + EPSN);
    u32x2* o8 = (u32x2*)orow + lane;
#pragma unroll
    for (int j = 0; j < 4; ++j) { const f32x4 gg = gr[64 * j]; u32x2 w; w.x = cvtpk(v[j].x * rs * gg.x, v[j].y * rs * gg.y); w.y = cvtpk(v[j].z * rs * gg.z, v[j].w * rs * gg.w); o8[64 * j] = w; }
}
__device__ __forceinline__ void prep_stream8(const Fr& F, const float* Wall, unsigned char* WT8all, size_t estride, int mode, int vb, int VG) {
    LAS float* scr = (LAS float*)F.lds;
    const int tid = F.tid, n_ = tid & 63, kk = tid >> 6, k4 = tid & 15, nn = tid >> 4;
    int t = vb; if (t < 0 || t >= 4096) return;
    float v[8];
    { const int e = t >> 8, r = t & 255, k0 = 64 * (r >> 4), n0 = 64 * (r & 15); const float* W = Wall + (size_t)e * 1048576;
#pragma unroll
      for (int i = 0; i < 8; ++i) v[i] = W[(size_t)(k0 + kk + 8 * i) * 1024 + n0 + n_]; }
    for (; t < 4096; t += VG) {
        const int e = t >> 8, r = t & 255, k0 = 64 * (r >> 4), n0 = 64 * (r & 15);
        float vn[8];
        { const int t2 = t + VG < 4096 ? t + VG : t; const int e2 = t2 >> 8, r2 = t2 & 255, k2 = 64 * (r2 >> 4), n2 = 64 * (r2 & 15); const float* W = Wall + (size_t)e2 * 1048576;
#pragma unroll
          for (int i = 0; i < 8; ++i) vn[i] = W[(size_t)(k2 + kk + 8 * i) * 1024 + n2 + n_]; }
#pragma unroll
        for (int i = 0; i < 8; ++i) scr[(kk + 8 * i) * 65 + n_] = v[i];
        __syncthreads();
        unsigned char* WT8 = WT8all + (size_t)e * estride;
#pragma unroll
        for (int i = 0; i < 2; ++i) { const int nl = nn + 32 * i, n = n0 + nl; const int row = mode == 0 ? n : 256 * (n >> 7) + (n & 127) + (mode == 2 ? 128 : 0);
            const float a = scr[(4 * k4 + 0) * 65 + nl] * 32.0f, b = scr[(4 * k4 + 1) * 65 + nl] * 32.0f, c = scr[(4 * k4 + 2) * 65 + nl] * 32.0f, d = scr[(4 * k4 + 3) * 65 + nl] * 32.0f;
            unsigned w = 0u; w = __builtin_amdgcn_cvt_pk_fp8_f32(a, b, w, false); w = __builtin_amdgcn_cvt_pk_fp8_f32(c, d, w, true);
            *(unsigned*)(WT8 + (size_t)row * 1024 + k0 + 4 * k4) = w; }
        __syncthreads();
#pragma unroll
        for (int i = 0; i < 8; ++i) v[i] = vn[i];
    }
}
__device__ __forceinline__ void ph_prep(const Fr& F) {
    const int bid = blockIdx.x, G = F.G;
    for (int it = bid; it < 1024; it += G) {
        if (it < 768) { const int kt = it / 48, nt = it % 48; prep_tile(F, F.w_in, 3072, 64 * kt, 64 * nt, F.WIN, 3); }
        else { const int i2 = it - 768, kt = i2 / 16, nt = i2 % 16; prep_tile(F, F.w_out, 1024, 64 * kt, 64 * nt, F.WOUT, 0); }
    }
    const int gt = bid * 512 + F.tid, GT = G * 512;
    for (int idx = gt; idx < 8 * 256 * 64; idx += GT) {
        const int blk = idx >> 14, o = (idx >> 6) & 255, k = idx & 63, g = o >> 6, d = o & 63, dir = g >> 1;
        const float* src = (g & 1) ? F.w_i : F.w_r;
        F.GW[idx] = f2bf16(src[((size_t)(dir * 8 + blk) * 64 + k) * 64 + d]);
    }
#if LRU_NEW2 || LRU_NEW4
    for (int idx = gt; idx < 8 * 256 * 64; idx += GT) {
        const int k = idx & 63, fr = (idx >> 6) & 15, cg = (idx >> 10) & 3, g = (idx >> 12) & 3, blk = idx >> 14;
        const float* src = (g & 1) ? F.w_i : F.w_r;
        F.GW2[idx] = f2bf16(src[((size_t)((g >> 1) * 8 + blk) * 64 + k) * 64 + 16 * cg + fr]);
    }
#endif
    for (int idx = gt; idx < 1024; idx += GT) F.HSMETA[idx] = -8.0f * 1.4426950408889634f * softplus_neg(F.lam[idx]);
    for (int idx = gt; idx < TT * 64; idx += GT) { float co, si; sincos_tab(idx >> 6, idx & 63, co, si); F.CS[idx] = (f32x2){co, si}; }
    const int gw = bid * 8 + F.wave, NGW = G * 8; const int lane = F.lane;
    for (int r = gw; r < NB * PADL; r += NGW) { const int b = r / PADL, p = r - b * PADL; u32x2* o8 = (u32x2*)(F.H + (size_t)(b * PP + p) * 1024) + lane;
#pragma unroll
        for (int j = 0; j < 4; ++j) o8[64 * j] = (u32x2){0u, 0u}; }
    f32x4 gg[4];
#pragma unroll
    for (int j = 0; j < 4; ++j) gg[j] = ((const f32x4*)F.norm1_g + lane)[64 * j];
    f32x4 nx[2][4];
    const int NPAIR = NB * TT / 2;
    if (gw < NPAIR) {
#pragma unroll
        for (int q = 0; q < 2; ++q) { const int v = 2 * gw + q, b = v / TT, t = v - b * TT; const f32x4* xr = (const f32x4*)(t < NMETA ? F.meta + (size_t)t * 1024 : F.x + ((size_t)b * SEQ + (t - NMETA)) * 1024) + lane;
#pragma unroll
            for (int j = 0; j < 4; ++j) nx[q][j] = xr[64 * j]; }
    }
    for (int pr = gw; pr < NPAIR; pr += NGW) {
        f32x4 vv[2][4];
#pragma unroll
        for (int q = 0; q < 2; ++q)
#pragma unroll
            for (int j = 0; j < 4; ++j) vv[q][j] = nx[q][j];
        { const int pn = pr + NGW < NPAIR ? pr + NGW : pr;
#pragma unroll
          for (int q = 0; q < 2; ++q) { const int v = 2 * pn + q, b = v / TT, t = v - b * TT; const f32x4* xr = (const f32x4*)(t < NMETA ? F.meta + (size_t)t * 1024 : F.x + ((size_t)b * SEQ + (t - NMETA)) * 1024) + lane;
#pragma unroll
              for (int j = 0; j < 4; ++j) nx[q][j] = xr[64 * j]; } }
#pragma unroll
        for (int q = 0; q < 2; ++q) {
            const int v = 2 * pr + q, b = v / TT, t = v - b * TT;
            float s = 0.f;
#pragma unroll
            for (int j = 0; j < 4; ++j) s += (vv[q][j].x * vv[q][j].x + vv[q][j].y * vv[q][j].y) + (vv[q][j].z * vv[q][j].z + vv[q][j].w * vv[q][j].w);
            const float rs = __builtin_amdgcn_rsqf(wave_sum(s) * (1.0f / 1024.0f) + EPSN);
            u32x2* o8 = (u32x2*)(F.H + (size_t)(b * PP + PADL + t) * 1024) + lane;
#pragma unroll
            for (int j = 0; j < 4; ++j) { u32x2 wv; wv.x = cvtpk(vv[q][j].x * rs * gg[j].x, vv[q][j].y * rs * gg[j].y); wv.y = cvtpk(vv[q][j].z * rs * gg[j].z, vv[q][j].w * rs * gg[j].w); o8[64 * j] = wv; }
        }
    }
}

struct LruIn { float xv[11]; float gate[8]; float cw0, cw1, cw2, cw3, cbv, k0, k1, br0, bi0, br1, bi1, cf, cb; pg8::bf16x8 bfr[2][2]; };
template <bool FINAL>
__device__ __forceinline__ void lru_load(const Fr& F, size_t rowbase, int pw, int c, size_t sidx, const unsigned short* gwp, LruIn& L) {
#pragma unroll
    for (int i = 0; i < 11; ++i) { const int p = pw - 2 + i; const int pc = p < 0 ? 0 : (p >= PP ? PP - 1 : p); const float v = bf2f(F.Z[(rowbase + pc) * ZC + ZC_LX + c]); L.xv[i] = (p == pc) ? v : 0.f; }
    if (FINAL) {
#pragma unroll
        for (int j = 0; j < 8; ++j) L.gate[j] = bf2f(F.Z[(rowbase + pw + j) * ZC + ZC_LG + c]);
    }
    L.cw0 = F.conv_w[c]; L.cw1 = F.conv_w[512 + c]; L.cw2 = F.conv_w[1024 + c]; L.cw3 = F.conv_w[1536 + c]; L.cbv = F.conv_b[c];
    L.k0 = F.HSMETA[c]; L.k1 = F.HSMETA[512 + c];
    L.br0 = F.b_r[c]; L.bi0 = F.b_i[c]; L.br1 = F.b_r[512 + c]; L.bi1 = F.b_i[512 + c];
    if (FINAL) { L.cf = F.CARRY[sidx]; L.cb = F.CARRY[sidx + 512]; }
#pragma unroll
    for (int ks = 0; ks < 2; ++ks)
#pragma unroll
        for (int n = 0; n < 2; ++n) L.bfr[ks][n] = *(const pg8::bf16x8*)(gwp + (size_t)(16 * n) * 64 + 32 * ks);
}
template <bool FINAL>
__device__ __forceinline__ void lru_item(const Fr& F, int b, int s) {
    int lane = F.lane; asm volatile("" : "+v"(lane));
    const int w = F.wave, fr = lane & 15, fq = lane >> 4;
    LAS unsigned short* U0 = (LAS unsigned short*)F.lds;
    LAS unsigned char* G16 = F.lds + 18432;
    LAS float* SM = (LAS float*)(F.lds + 18432 + 36864);
    LAS unsigned short* YL = (LAS unsigned short*)(F.lds + 18432 + 36864 + 8192);
    const int pw = s * 64 + 8 * w; const size_t rowbase = (size_t)b * PP;
    constexpr float LOG2E = 1.4426950408889634f;
    float ssq[8];
#pragma unroll
    for (int j = 0; j < 8; ++j) ssq[j] = 0.f;
    const size_t sbase = ((size_t)(b * NSEG + s) * 2) * 512;
    const unsigned short* gw0 = F.GW + (size_t)(32 * w + fr) * 64 + 8 * fq;
    LruIn L; lru_load<FINAL>(F, rowbase, pw, lane, sbase + lane, gw0, L);
    float u[8];
#pragma unroll
    for (int j = 0; j < 8; ++j) { u[j] = L.cbv + L.cw0 * L.xv[j] + L.cw1 * L.xv[j + 1] + L.cw2 * L.xv[j + 2] + L.cw3 * L.xv[j + 3]; U0[(8 * w + j) * 72 + lane] = f2bf16(u[j]); }
    __syncthreads();
    for (int blk = 0; blk < 8; ++blk) {
        const int c = blk * 64 + lane;
        LAS unsigned short* U = U0 + (blk & 1) * 4608; LAS unsigned short* Un = U0 + ((blk & 1) ^ 1) * 4608;
        LruIn N; { const int bn = (blk < 7 ? blk + 1 : 7), cn = bn * 64 + lane; lru_load<FINAL>(F, rowbase, pw, cn, sbase + cn, gw0 + (size_t)bn * 16384, N); }
        pg8::f32x4 acc[4][2];
#pragma unroll
        for (int m = 0; m < 4; ++m) { acc[m][0] = (pg8::f32x4){0.f, 0.f, 0.f, 0.f}; acc[m][1] = acc[m][0]; }
#pragma unroll
        for (int ks = 0; ks < 2; ++ks) {
#pragma unroll
            for (int m = 0; m < 4; ++m) { const pg8::bf16x8 a = *(LAS pg8::bf16x8*)(U + (16 * m + fr) * 72 + 32 * ks + 8 * fq);
#pragma unroll
                for (int n = 0; n < 2; ++n) acc[m][n] = MFMA16(a, L.bfr[ks][n], acc[m][n]); }
        }
#pragma unroll
        for (int m = 0; m < 4; ++m)
#pragma unroll
            for (int n = 0; n < 2; ++n) { u32x2 pk; pk.x = __builtin_bit_cast(unsigned, __builtin_amdgcn_cvt_pkrtz(acc[m][n][0], acc[m][n][1])); pk.y = __builtin_bit_cast(unsigned, __builtin_amdgcn_cvt_pkrtz(acc[m][n][2], acc[m][n][3]));
                *(LAS u32x2*)(G16 + (32 * w + 16 * n + fr) * 144 + (16 * m + 4 * fq) * 2) = pk; }
        __syncthreads();
        const float kk0 = L.k0, kk1 = L.k1;
        const float nb_r0 = -LOG2E * L.br0, nb_i0 = -LOG2E * L.bi0, nb_r1 = -LOG2E * L.br1, nb_i1 = -LOG2E * L.bi1;
        typedef _Float16 h16x8 __attribute__((ext_vector_type(8)));
        const h16x8 g0 = *(LAS h16x8*)(G16 + (0 * 64 + lane) * 144 + 16 * w), g1 = *(LAS h16x8*)(G16 + (1 * 64 + lane) * 144 + 16 * w);
        const h16x8 g2 = *(LAS h16x8*)(G16 + (2 * 64 + lane) * 144 + 16 * w), g3 = *(LAS h16x8*)(G16 + (3 * 64 + lane) * 144 + 16 * w);
        float hf[8], pf[8], hb[8], pb[8], af[8], ab[8];
#pragma unroll
        for (int j = 0; j < 8; ++j) {
            const float r0 = __builtin_amdgcn_rcpf(1.0f + __builtin_amdgcn_exp2f(__builtin_fmaf((float)g0[j], -LOG2E, nb_r0))), i0 = __builtin_amdgcn_rcpf(1.0f + __builtin_amdgcn_exp2f(__builtin_fmaf((float)g1[j], -LOG2E, nb_i0)));
            const float r1 = __builtin_amdgcn_rcpf(1.0f + __builtin_amdgcn_exp2f(__builtin_fmaf((float)g2[j], -LOG2E, nb_r1))), i1 = __builtin_amdgcn_rcpf(1.0f + __builtin_amdgcn_exp2f(__builtin_fmaf((float)g3[j], -LOG2E, nb_i1)));
            const float a0 = __builtin_amdgcn_exp2f(kk0 * r0), a1 = __builtin_amdgcn_exp2f(kk1 * r1);
            const float e0 = fmaxf(__builtin_fmaf(-a0, a0, 1.0f), 0.f), e1 = fmaxf(__builtin_fmaf(-a1, a1, 1.0f), 0.f);
            af[j] = a0; ab[j] = a1;
            hf[j] = __builtin_amdgcn_sqrtf(e0) * i0 * u[j]; hb[j] = __builtin_amdgcn_sqrtf(e1) * i1 * u[j];
        }
        if (s < 2) {
#pragma unroll
            for (int j = 0; j < 8; ++j) { const bool padp = (pw + j) < PADL; af[j] = padp ? 1.0f : af[j]; ab[j] = padp ? 1.0f : ab[j]; hf[j] = padp ? 0.0f : hf[j]; hb[j] = padp ? 0.0f : hb[j]; }
        }
        { float h = 0.f, P = 1.f;
#pragma unroll
          for (int j = 0; j < 8; ++j) { h = af[j] * h + hf[j]; hf[j] = h; P *= af[j]; pf[j] = P; } }
        { float h = 0.f, P = 1.f;
#pragma unroll
          for (int j = 7; j >= 0; --j) { h = ab[j] * h + hb[j]; hb[j] = h; P *= ab[j]; pb[j] = P; } }
        SM[((0 * 8 + w) * 2 + 0) * 64 + lane] = pf[7]; SM[((0 * 8 + w) * 2 + 1) * 64 + lane] = hf[7];
        SM[((1 * 8 + w) * 2 + 0) * 64 + lane] = pb[0]; SM[((1 * 8 + w) * 2 + 1) * 64 + lane] = hb[0];
        float un[8];
#pragma unroll
        for (int j = 0; j < 8; ++j) { un[j] = N.cbv + N.cw0 * N.xv[j] + N.cw1 * N.xv[j + 1] + N.cw2 * N.xv[j + 2] + N.cw3 * N.xv[j + 3]; Un[(8 * w + j) * 72 + lane] = f2bf16(un[j]); }
        __syncthreads();
        const size_t sidx = sbase + c;
        if (!FINAL) {
            if (w == 0) {
                float cf = 0.f, Af = 1.f, cb = 0.f, Ab = 1.f;
#pragma unroll
                for (int w2 = 0; w2 < 8; ++w2) { const float A = SM[((0 * 8 + w2) * 2 + 0) * 64 + lane], H = SM[((0 * 8 + w2) * 2 + 1) * 64 + lane]; cf = A * cf + H; Af *= A; }
#pragma unroll
                for (int w2 = 7; w2 >= 0; --w2) { const float A = SM[((1 * 8 + w2) * 2 + 0) * 64 + lane], H = SM[((1 * 8 + w2) * 2 + 1) * 64 + lane]; cb = A * cb + H; Ab *= A; }
                F.SUMM[sidx] = (f32x2){Af, cf}; F.SUMM[sidx + 512] = (f32x2){Ab, cb};
            }
        } else {
            float cf = L.cf, cb = L.cb;
#pragma unroll
            for (int w2 = 0; w2 < 8; ++w2) if (w2 < w) { const float A = SM[((0 * 8 + w2) * 2 + 0) * 64 + lane], H = SM[((0 * 8 + w2) * 2 + 1) * 64 + lane]; cf = A * cf + H; }
#pragma unroll
            for (int w2 = 7; w2 >= 0; --w2) if (w2 > w) { const float A = SM[((1 * 8 + w2) * 2 + 0) * 64 + lane], H = SM[((1 * 8 + w2) * 2 + 1) * 64 + lane]; cb = A * cb + H; }
#pragma unroll
            for (int j = 0; j < 8; ++j) {
                const float y = ((hf[j] + pf[j] * cf) + (hb[j] + pb[j] * cb)) * L.gate[j];
                ssq[j] += y * y; YL[(8 * w + j) * 520 + c] = f2bf16(y);
            }
        }
        L = N;
#pragma unroll
        for (int j = 0; j < 8; ++j) u[j] = un[j];
    }
    if (FINAL) {
        const f32x4 og0 = *(const f32x4*)(F.lru_out_g + 8 * lane), og1 = *(const f32x4*)(F.lru_out_g + 8 * lane + 4);
#pragma unroll
        for (int j = 0; j < 8; ++j) {
            const float rs = __builtin_amdgcn_rsqf(wave_sum(ssq[j]) * (1.0f / 512.0f) + EPSN);
            const u32x4 v = *(LAS u32x4*)(YL + (8 * w + j) * 520 + 8 * lane);
            u32x4 o; o.x = cvtpk(__uint_as_float(v.x << 16) * rs * og0[0], __uint_as_float(v.x & 0xffff0000u) * rs * og0[1]); o.y = cvtpk(__uint_as_float(v.y << 16) * rs * og0[2], __uint_as_float(v.y & 0xffff0000u) * rs * og0[3]);
            o.z = cvtpk(__uint_as_float(v.z << 16) * rs * og1[0], __uint_as_float(v.z & 0xffff0000u) * rs * og1[1]); o.w = cvtpk(__uint_as_float(v.w << 16) * rs * og1[2], __uint_as_float(v.w & 0xffff0000u) * rs * og1[3]);
            *(u32x4*)(F.H + (rowbase + pw + j) * 1024 + 8 * lane) = o;
        }
        __syncthreads();
    }
}

struct Lru2A { float xv[2][11]; float cw[2][5]; };
__device__ __forceinline__ void lru2_loadA(const Fr& F, size_t rowbase, int pw, int it, int lane, Lru2A& A) {
#pragma unroll
    for (int h = 0; h < 2; ++h) { const int c = (2 * it + h) * 64 + lane;
#pragma unroll
        for (int i = 0; i < 11; ++i) { const int p = pw - 2 + i; const int pc = p < 0 ? 0 : (p >= PP ? PP - 1 : p); const float v = bf2f(F.Z[(rowbase + pc) * ZC + ZC_LX + c]); A.xv[h][i] = (p == pc) ? v : 0.f; }
        A.cw[h][0] = F.conv_w[c]; A.cw[h][1] = F.conv_w[512 + c]; A.cw[h][2] = F.conv_w[1024 + c]; A.cw[h][3] = F.conv_w[1536 + c]; A.cw[h][4] = F.conv_b[c]; }
}
__device__ __forceinline__ void lru2_writeU(LAS unsigned short* Upar, int w, int lane, const Lru2A& A) {
#pragma unroll
    for (int h = 0; h < 2; ++h)
#pragma unroll
        for (int j = 0; j < 8; ++j) { const float u = A.cw[h][4] + A.cw[h][0] * A.xv[h][j] + A.cw[h][1] * A.xv[h][j + 1] + A.cw[h][2] * A.xv[h][j + 2] + A.cw[h][3] * A.xv[h][j + 3];
            const int rho = 16 * (2 * (w & 1) + (j >> 2)) + 4 * (w >> 1) + (j & 3);
            Upar[h * 4608 + rho * 72 + lane] = f2bf16(u); }
}
template <bool FINAL>
__device__ __forceinline__ void lru2_item(const Fr& F, int b, int s) {
    int lane = F.lane; asm volatile("" : "+v"(lane));
    const int w = F.wave, fr = lane & 15, fq = lane >> 4, cg = w & 3;
    LAS unsigned short* U0 = (LAS unsigned short*)F.lds;
    LAS unsigned short* YL = (LAS unsigned short*)(F.lds + 36864);
    LAS float* SSP = (LAS float*)(F.lds + 36864 + 66560);
    const int p0 = s * 64, pw = p0 + 8 * w; const size_t rowbase = (size_t)b * PP;
    const size_t sbase = ((size_t)(b * NSEG + s) * 2) * 512;
    constexpr float LOG2E = 1.4426950408889634f;
    float ssq[16];
#pragma unroll
    for (int q = 0; q < 16; ++q) ssq[q] = 0.f;
    { Lru2A A0; lru2_loadA(F, rowbase, pw, 0, lane, A0); lru2_writeU(U0, w, lane, A0); }
    __syncthreads();
    for (int it = 0; it < 4; ++it) {
        const int blk = 2 * it + (w >> 2), c = blk * 64 + 16 * cg + fr;
        LAS unsigned short* U = U0 + ((it & 1) * 2 + (w >> 2)) * 4608;
        pg8::bf16x8 bfr[4][2];
        { const unsigned short* gp = F.GW2 + ((size_t)((blk * 4) * 4 + cg) * 16 + fr) * 64 + 8 * fq;
#pragma unroll
          for (int g = 0; g < 4; ++g)
#pragma unroll
              for (int ks = 0; ks < 2; ++ks) bfr[g][ks] = *(const pg8::bf16x8*)(gp + (size_t)g * 4096 + 32 * ks); }
        const float lam0 = F.lam[c], lam1 = F.lam[512 + c], br0 = F.b_r[c], bi0 = F.b_i[c], br1 = F.b_r[512 + c], bi1 = F.b_i[512 + c];
        float cin0 = 0.f, cin1 = 0.f; if (FINAL) { cin0 = F.CARRY[sbase + c]; cin1 = F.CARRY[sbase + 512 + c]; }
        float gt[16];
        if (FINAL) {
#pragma unroll
            for (int q = 0; q < 16; ++q) gt[q] = bf2f(F.Z[(rowbase + p0 + 16 * fq + q) * ZC + ZC_LG + c]);
        }
        Lru2A N; lru2_loadA(F, rowbase, pw, it < 3 ? it + 1 : 3, lane, N);
        pg8::f32x4 acc[4][4];
#pragma unroll
        for (int g = 0; g < 4; ++g)
#pragma unroll
            for (int m = 0; m < 4; ++m) acc[g][m] = (pg8::f32x4){0.f, 0.f, 0.f, 0.f};
#pragma unroll
        for (int ks = 0; ks < 2; ++ks)
#pragma unroll
            for (int m = 0; m < 4; ++m) {
                const pg8::bf16x8 an = *(LAS pg8::bf16x8*)(U + (16 * m + fr) * 72 + 32 * ks + 8 * fq);
                const pg8::bf16x8 ar = *(LAS pg8::bf16x8*)(U + (63 - 16 * m - fr) * 72 + 32 * ks + 8 * fq);
                acc[0][m] = MFMA16(an, bfr[0][ks], acc[0][m]); acc[1][m] = MFMA16(an, bfr[1][ks], acc[1][m]);
                acc[2][m] = MFMA16(ar, bfr[2][ks], acc[2][m]); acc[3][m] = MFMA16(ar, bfr[3][ks], acc[3][m]);
            }
        float hf[16], hb[16];
#pragma unroll
        for (int d = 0; d < 2; ++d) {
            const float kk = -8.0f * LOG2E * softplus_neg(d ? lam1 : lam0), nbr = -LOG2E * (d ? br1 : br0), nbi = -LOG2E * (d ? bi1 : bi0);
            float al[16], xl[16];
#pragma unroll
            for (int m = 0; m < 4; ++m)
#pragma unroll
                for (int rg = 0; rg < 4; ++rg) { const int q = 4 * m + rg; const int row = d ? 63 - (16 * m + 4 * fq + rg) : (16 * m + 4 * fq + rg);
                    const float uu = bf2f(U[row * 72 + 16 * cg + fr]);
                    const float r = __builtin_amdgcn_rcpf(1.0f + __builtin_amdgcn_exp2f(__builtin_fmaf(acc[2 * d][m][rg], -LOG2E, nbr))), ii = __builtin_amdgcn_rcpf(1.0f + __builtin_amdgcn_exp2f(__builtin_fmaf(acc[2 * d + 1][m][rg], -LOG2E, nbi)));
                    const float a = __builtin_amdgcn_exp2f(kk * r); const float e = fmaxf(__builtin_fmaf(-a, a, 1.0f), 0.f);
                    al[q] = a; xl[q] = __builtin_amdgcn_sqrtf(e) * ii * uu; }
            if (s < 2) {
#pragma unroll
                for (int q = 0; q < 16; ++q) { const int p = d ? p0 + 63 - (16 * fq + q) : p0 + 16 * fq + q; const bool padp = p < PADL; al[q] = padp ? 1.0f : al[q]; xl[q] = padp ? 0.0f : xl[q]; }
            }
            { float h = 0.f, P = 1.f;
#pragma unroll
              for (int q = 0; q < 16; ++q) { h = al[q] * h + xl[q]; xl[q] = h; P *= al[q]; al[q] = P; } }
            const float Ar = al[15], Hr = xl[15];
            const float A0 = __shfl(Ar, fr), H0 = __shfl(Hr, fr), A1 = __shfl(Ar, fr + 16), H1 = __shfl(Hr, fr + 16), A2 = __shfl(Ar, fr + 32), H2 = __shfl(Hr, fr + 32);
            float cc = FINAL ? (d ? cin1 : cin0) : 0.f;
            if (fq > 0) cc = A0 * cc + H0;
            if (fq > 1) cc = A1 * cc + H1;
            if (fq > 2) cc = A2 * cc + H2;
            if (!FINAL) { if (fq == 3) F.SUMM[sbase + d * 512 + c] = (f32x2){A0 * A1 * A2 * Ar, Ar * cc + Hr}; }
            else {
#pragma unroll
                for (int q = 0; q < 16; ++q) { const float hv = xl[q] + al[q] * cc; if (d) hb[q] = hv; else hf[q] = hv; }
            }
        }
        if (FINAL) {
#pragma unroll
            for (int q = 0; q < 16; ++q) { const float hbp = __shfl(hb[15 - q], lane ^ 48);
                const float y = (hf[q] + hbp) * gt[q]; ssq[q] += y * y; YL[(16 * fq + q) * 520 + c] = f2bf16(y); }
        }
        if (it < 3) { lru2_writeU(U0 + ((it & 1) ^ 1) * 9216, w, lane, N); __syncthreads(); }
    }
    if (FINAL) {
#pragma unroll
        for (int q = 0; q < 16; ++q) { float v = ssq[q]; v += __shfl_xor(v, 1); v += __shfl_xor(v, 2); v += __shfl_xor(v, 4); v += __shfl_xor(v, 8); ssq[q] = v; }
        if (fr == 0) {
#pragma unroll
            for (int q = 0; q < 16; ++q) SSP[w * 64 + 16 * fq + q] = ssq[q]; }
        __syncthreads();
        const f32x4 og0 = *(const f32x4*)(F.lru_out_g + 8 * lane), og1 = *(const f32x4*)(F.lru_out_g + 8 * lane + 4);
#pragma unroll
        for (int j = 0; j < 8; ++j) {
            float tot = 0.f;
#pragma unroll
            for (int w2 = 0; w2 < 8; ++w2) tot += SSP[w2 * 64 + 8 * w + j];
            const float rs = __builtin_amdgcn_rsqf(tot * (1.0f / 512.0f) + EPSN);
            const u32x4 v = *(LAS u32x4*)(YL + (8 * w + j) * 520 + 8 * lane);
            u32x4 o; o.x = cvtpk(__uint_as_float(v.x << 16) * rs * og0[0], __uint_as_float(v.x & 0xffff0000u) * rs * og0[1]); o.y = cvtpk(__uint_as_float(v.y << 16) * rs * og0[2], __uint_as_float(v.y & 0xffff0000u) * rs * og0[3]);
            o.z = cvtpk(__uint_as_float(v.z << 16) * rs * og1[0], __uint_as_float(v.z & 0xffff0000u) * rs * og1[1]); o.w = cvtpk(__uint_as_float(v.w << 16) * rs * og1[2], __uint_as_float(v.w & 0xffff0000u) * rs * og1[3]);
            *(u32x4*)(F.H + (rowbase + pw + j) * 1024 + 8 * lane) = o;
        }
        __syncthreads();
    }
}

#ifdef RF_V3
constexpr int LDS_GT = LDS_MAIN + 8192;
#else
constexpr int LDS_GT = LDS_SS + 1024;
#endif
template <int SKIP> __device__ __forceinline__ int ret_count(int w, int G) { if (G != 256) return (2080 - w + G - 1) / G; return (w < 32 + 16 * SKIP) ? 9 : (w >= 240 ? 8 - SKIP : 8); }
template <int SKIP> __device__ __forceinline__ int ret_item(int w, int j, int G) { if (G != 256 || j < 8) return w + G * j; if (w < 32) return 2048 + w; const int k = w - 32; return 240 + (k & 15) + 256 * (7 - (k >> 4)); }
__device__ __forceinline__ void ret_coord(int it, int& b, int& h, int& n) { n = it % NCHUNK; const int bh = it / NCHUNK; b = bh >> 2; h = bh & 3; }
struct RcIn { u32x4 k[4], v[4]; };
__device__ __forceinline__ void rc_load(const Fr& F, int tid, int it, RcIn& R) {
    int b, h, n; ret_coord(it, b, h, n);
    const unsigned short* base = F.Z + ((size_t)b * PP + 128 * n) * ZC + 128 * h;
#pragma unroll
    for (int q = 0; q < 4; ++q) { const int idx = tid + 512 * q, c = idx >> 4, ch = idx & 15; const unsigned short* p = base + (size_t)c * ZC + 8 * ch; R.k[q] = *(const u32x4*)(p + ZC_K); R.v[q] = *(const u32x4*)(p + ZC_V); }
}
__device__ __forceinline__ unsigned scale_pk(unsigned w, float s) { return cvtpk(__uint_as_float(w << 16) * s, __uint_as_float(w & 0xffff0000u) * s); }
__device__ __forceinline__ void ph_ret_contrib(const Fr& F) {
    const int w = F.wave;
    LAS unsigned char* TKF = F.lds; LAS unsigned char* TKB = F.lds + 32768; LAS unsigned char* TV = F.lds + 65536;
    if ((int)blockIdx.x >= 2080) return;
    const int nj = ret_count<2>(blockIdx.x, F.G);
    RcIn R; rc_load(F, F.tid, ret_item<2>(blockIdx.x, 0, F.G), R);
    for (int jj = 0; jj < nj; ++jj) {
        const int it = ret_item<2>(blockIdx.x, jj, F.G);
        int lane = F.lane, tid = threadIdx.x; asm volatile("" : "+v"(lane), "+v"(tid));
        const int r = lane & 31, h2 = lane >> 5;
        int b, h, n; ret_coord(it, b, h, n); const float lg = log2_gamma(h);
#pragma unroll
        for (int q = 0; q < 4; ++q) { const int idx = tid + 512 * q, c = idx >> 4, ch = idx & 15; const float sf = __builtin_amdgcn_exp2f(lg * (float)(127 - c)), sb = __builtin_amdgcn_exp2f(lg * (float)c);
            u32x4 kf, kb; kf.x = scale_pk(R.k[q].x, sf); kf.y = scale_pk(R.k[q].y, sf); kf.z = scale_pk(R.k[q].z, sf); kf.w = scale_pk(R.k[q].w, sf);
            kb.x = scale_pk(R.k[q].x, sb); kb.y = scale_pk(R.k[q].y, sb); kb.z = scale_pk(R.k[q].z, sb); kb.w = scale_pk(R.k[q].w, sb);
            const unsigned o = off_b(c, ch); *(LAS u32x4*)(TKF + o) = kf; *(LAS u32x4*)(TKB + o) = kb; *(LAS u32x4*)(TV + o) = R.v[q]; }
        if (jj + 1 < nj) rc_load(F, tid, ret_item<2>(blockIdx.x, jj + 1, F.G), R);
        __syncthreads();
        const int dir = w >> 2, cb = w & 3; LAS unsigned char* TK = dir ? TKB : TKF;
        f32x16 acc[4];
#pragma unroll
        for (int eb = 0; eb < 4; ++eb)
#pragma unroll
            for (int i = 0; i < 16; ++i) acc[eb][i] = 0.f;
#pragma unroll 2
        for (int ks = 0; ks < 8; ++ks) {
            const pg8::bf16x8 a = trfrag(TK, cb, ks, lane);
#pragma unroll
            for (int eb = 0; eb < 4; ++eb) { const pg8::bf16x8 bv = trfrag(TV, eb, ks, lane); acc[eb] = MFMA32(a, bv, acc[eb]); }
        }
        __syncthreads();
#pragma unroll
        for (int eb = 0; eb < 4; ++eb)
#pragma unroll
            for (int g = 0; g < 4; ++g) { u32x2 v; v.x = cvtpk(acc[eb][4 * g], acc[eb][4 * g + 1]); v.y = cvtpk(acc[eb][4 * g + 2], acc[eb][4 * g + 3]);
                *(LAS u32x2*)(TK + off_b(32 * eb + r, 4 * cb + g) + 8 * h2) = v; }
        __syncthreads();
        unsigned short* dst = F.ST + ((size_t)(((b * 4 + h) * 2) * NCHUNK + n)) * 16384;
#pragma unroll
        for (int q = 0; q < 8; ++q) { const int idx = tid + 512 * q, tile = idx >> 11, rem = idx & 2047, e = rem >> 4, ch = rem & 15;
            const u32x4 v = *(LAS u32x4*)(F.lds + tile * 32768 + off_b(e, ch)); *(u32x4*)(dst + (size_t)tile * NCHUNK * 16384 + (size_t)e * 128 + 8 * ch) = v; }
        __syncthreads();
    }
}
struct RfIn { u32x4 q[4], k[4], v[4]; };
struct RsIn { u32x4 sf[4], sb[4], g[4]; };
__device__ __forceinline__ void rf_load(const Fr& F, int tid, int it, RfIn& R) {
    int b, h, n; ret_coord(it, b, h, n);
    const unsigned short* base = F.Z + ((size_t)b * PP + 128 * n) * ZC + 128 * h;
#pragma unroll
#ifdef RF_V5
    for (int q = 0; q < 4; ++q) { const int idx = tid + 512 * q, c = idx >> 4, ch = idx & 15; const unsigned short* p = base + (size_t)c * ZC + 8 * ch; R.q[q] = *(const u32x4*)(base + (size_t)(c ^ 1) * ZC + 8 * ch + ZC_Q); R.k[q] = *(const u32x4*)(p + ZC_K); R.v[q] = *(const u32x4*)(p + ZC_V); }
#else
    for (int q = 0; q < 4; ++q) { const int idx = tid + 512 * q, c = idx >> 4, ch = idx & 15; const unsigned short* p = base + (size_t)c * ZC + 8 * ch; R.q[q] = *(const u32x4*)(p + ZC_Q); R.k[q] = *(const u32x4*)(p + ZC_K); R.v[q] = *(const u32x4*)(p + ZC_V); }
#endif
}
__device__ __forceinline__ void rs_load(const Fr& F, int tid, int b, int h, int n, RsIn& R) {
    const unsigned short* sf = F.ST2 + ((size_t)(((b * 4 + h) * 2 + 0) * NCHUNK + n)) * 16384; const unsigned short* sb = sf + (size_t)NCHUNK * 16384;
    const unsigned short* gb = F.Z + ((size_t)b * PP + 128 * n) * ZC + ZC_G + 128 * h;
#pragma unroll
    for (int q = 0; q < 4; ++q) { const int idx = tid + 512 * q, c = idx >> 4, ch = idx & 15; R.sf[q] = *(const u32x4*)(sf + (size_t)c * 128 + 8 * ch); R.sb[q] = *(const u32x4*)(sb + (size_t)c * 128 + 8 * ch); R.g[q] = *(const u32x4*)(gb + (size_t)c * ZC + 8 * ch); }
}
#ifdef RF_EXTRA
#define RF_XBAR asm volatile("s_waitcnt vmcnt(0) lgkmcnt(0)" ::: "memory"); __syncthreads();
#else
#define RF_XBAR
#endif
#define RF_FLAG(code_) atomicOr((unsigned*)(F.CTLP + 32768 + 2048), (unsigned)(code_))
#if !defined(RF_GTAB) && !defined(RF_V10) && !defined(RF_V4)
#define RF_GT(d_, c_) __builtin_amdgcn_exp2f(lg * (float)(d_))
#elif defined(RF_V4)
#define RF_GT(d_, c_) ({ const float g_ = GT[d_]; const float e_ = exp2f(lg * (float)(d_)); if (!(fabsf(g_ - e_) <= 1e-5f * e_)) RF_FLAG(c_); g_; })
#else
#define RF_GT(d_, c_) GT[d_]
#endif
#ifdef RF_V8
#define RF_QF rowfrag_x
#else
#define RF_QF rowfrag
#endif
#if !defined(RF_FASTDECAY) && !defined(RF_GTAB) && !defined(RF_V10) && !defined(RF_V4) && !defined(RF_SLOWDECAY)
#define RF_FASTDECAY 1
#endif
#ifndef RF_QHOIST
#define RF_QHOIST 2
#endif
__device__ __forceinline__ void ph_ret_final(const Fr& F) {
    const int w = F.wave;
    LAS unsigned char* R0 = F.lds; LAS unsigned char* R1 = F.lds + 32768; LAS unsigned char* R2 = F.lds + 65536; LAS unsigned char* R3 = F.lds + 98304;
    LAS float* SS = (LAS float*)(F.lds + LDS_SS); LAS float* GT = (LAS float*)(F.lds + LDS_GT); (void)GT;
    if ((int)blockIdx.x >= 2080) return;
    const int nj = ret_count<1>(blockIdx.x, F.G);
#ifdef RF_V9
    const int cb = 3 - (w >> 1), ebase = 2 * (w & 1);
#else
    const int cb = w >> 1, ebase = 2 * (w & 1);
#endif
#ifndef RF_NOPF
    RfIn Rf; rf_load(F, F.tid, ret_item<1>(blockIdx.x, 0, F.G), Rf);
#endif
    for (int jj = 0; jj < nj; ++jj) {
        const int it = ret_item<1>(blockIdx.x, jj, F.G);
        int lane = F.lane, tid = threadIdx.x; asm volatile("" : "+v"(lane), "+v"(tid));
        const int r = lane & 31, h2 = lane >> 5;
        int b, h, n; ret_coord(it, b, h, n); const float lg = log2_gamma(h);
        const size_t row0 = (size_t)b * PP + 128 * n;
#ifdef RF_E1
        __syncthreads();
#endif
#ifndef RF_NOPF
        RsIn Rs; rs_load(F, tid, b, h, n, Rs);
#else
        RfIn Rf; rf_load(F, tid, it, Rf);
        RsIn Rs; rs_load(F, tid, b, h, n, Rs);
#endif
#pragma unroll
#ifdef RF_V5
        for (int q = 0; q < 4; ++q) { const int idx = tid + 512 * q, c = idx >> 4, ch = idx & 15; const unsigned o = off_b(c, ch); *(LAS u32x4*)(R0 + off_b(c ^ 1, ch)) = Rf.q[q]; *(LAS u32x4*)(R1 + o) = Rf.k[q]; *(LAS u32x4*)(R2 + o) = Rf.v[q]; }
#elif defined(RF_V8)
        for (int q = 0; q < 4; ++q) { const int idx = tid + 512 * q, c = idx >> 4, ch = idx & 15; const unsigned o = off_b(c, ch); *(LAS u32x4*)(R0 + off_b(c ^ 1, ch)) = Rf.q[q]; *(LAS u32x4*)(R1 + o) = Rf.k[q]; *(LAS u32x4*)(R2 + o) = Rf.v[q]; }
#else
        for (int q = 0; q < 4; ++q) { const int idx = tid + 512 * q, c = idx >> 4, ch = idx & 15; const unsigned o = off_b(c, ch); *(LAS u32x4*)(R0 + o) = Rf.q[q]; *(LAS u32x4*)(R1 + o) = Rf.k[q]; *(LAS u32x4*)(R2 + o) = Rf.v[q]; }
#endif
#ifdef RF_V10
        { const int gi = tid & 255; GT[gi] = exp2f(lg * (float)gi); }
#elif defined(RF_GTAB)
        if (tid < 129) GT[tid] = exp2f(lg * (float)tid);
#endif
        const float og0 = F.ret_out_g[128 * h + 32 * ebase + r], og1 = F.ret_out_g[128 * h + 32 * (ebase + 1) + r];
        __syncthreads(); RF_XBAR
        f32x16 o[2];
#pragma unroll
        for (int eo = 0; eo < 2; ++eo)
#pragma unroll
            for (int i = 0; i < 16; ++i) o[eo][i] = 0.f;
        {
            const int cpos = 32 * cb + r;
#ifdef RF_FASTDECAY
            const float lgc_pos = lg * (float)(cpos - 4 * h2), lg32 = lg * 32.0f, nlg = -lg;
#endif
#if RF_QHOIST >= 1
            pg8::bf16x8 qfr[8];
#pragma unroll
            for (int s = 0; s < 8; ++s) qfr[s] = RF_QF(R0, cb, s, lane);
#endif
#pragma unroll
            for (int mb = 0; mb < 4; ++mb) {
                f32x16 X;
#pragma unroll
                for (int i = 0; i < 16; ++i) X[i] = 0.f;
#if RF_QHOIST >= 1
#pragma unroll
                for (int s = 0; s < 8; ++s) { const pg8::bf16x8 kf = rowfrag(R1, mb, s, lane); X = MFMA32(kf, qfr[s], X); }
#else
#pragma unroll 2
                for (int s = 0; s < 8; ++s) { const pg8::bf16x8 qf = RF_QF(R0, cb, s, lane); const pg8::bf16x8 kf = rowfrag(R1, mb, s, lane); X = MFMA32(kf, qf, X); }
#endif
                int cpo = cpos, h2o = h2; asm volatile("" : "+v"(cpo), "+v"(h2o));
#ifdef RF_FASTDECAY
                { const float amb = lgc_pos - lg32 * (float)mb;
#pragma unroll
                  for (int i = 0; i < 16; ++i) X[i] *= __builtin_amdgcn_exp2f(-__builtin_fabsf(__builtin_fmaf(nlg, (float)((i & 3) + 8 * (i >> 2)), amb))); }
#else
#pragma unroll
                for (int i = 0; i < 16; ++i) { const int m = 32 * mb + crow(i, h2o); const int dd = cpo > m ? cpo - m : m - cpo; X[i] *= RF_GT(dd, 1); }
#endif
#pragma unroll
                for (int s2 = 0; s2 < 2; ++s2) { u32x4 pk; pk.x = cvtpk(X[8 * s2], X[8 * s2 + 1]); pk.y = cvtpk(X[8 * s2 + 2], X[8 * s2 + 3]); pk.z = cvtpk(X[8 * s2 + 4], X[8 * s2 + 5]); pk.w = cvtpk(X[8 * s2 + 6], X[8 * s2 + 7]);
                    const pg8::bf16x8 pa = __builtin_bit_cast(pg8::bf16x8, pk);
#pragma unroll
                    for (int eo = 0; eo < 2; ++eo) { const pg8::bf16x8 vb = trfrag_perm(R2, ebase + eo, 32 * mb + 16 * s2, lane); o[eo] = MFMA32(pa, vb, o[eo]); } }
            }
        }
        RF_XBAR __syncthreads(); RF_XBAR
#pragma unroll
        for (int q = 0; q < 4; ++q) { const int idx = tid + 512 * q, c = idx >> 4, ch = idx & 15; const unsigned of = off_b(c, ch); *(LAS u32x4*)(R1 + of) = Rs.sf[q]; *(LAS u32x4*)(R3 + of) = Rs.sb[q]; *(LAS u32x4*)(R2 + of) = Rs.g[q]; }
#ifndef RF_NOPF
        rf_load(F, tid, ret_item<1>(blockIdx.x, jj + 1 < nj ? jj + 1 : jj, F.G), Rf);
#endif
        RF_XBAR __syncthreads(); RF_XBAR
#if defined(RF_QHOIST) && RF_QHOIST >= 2
        pg8::bf16x8 qfi[8];
#pragma unroll
        for (int s = 0; s < 8; ++s) qfi[s] = RF_QF(R0, cb, s, lane);
#endif
#pragma unroll
        for (int dirn = 0; dirn < 2; ++dirn) {
            LAS unsigned char* TX = dirn ? R3 : R1;
            f32x16 oi[2];
#pragma unroll
            for (int eo = 0; eo < 2; ++eo)
#pragma unroll
                for (int i = 0; i < 16; ++i) oi[eo][i] = 0.f;
#if defined(RF_QHOIST) && RF_QHOIST >= 2
#pragma unroll
            for (int s = 0; s < 8; ++s) { const pg8::bf16x8 qf = qfi[s];
#else
#pragma unroll 2
            for (int s = 0; s < 8; ++s) { const pg8::bf16x8 qf = RF_QF(R0, cb, s, lane);
#endif
#pragma unroll
                for (int eo = 0; eo < 2; ++eo) { const pg8::bf16x8 f1 = rowfrag(TX, ebase + eo, s, lane); oi[eo] = MFMA32(qf, f1, oi[eo]); } }
            int h2d = h2; asm volatile("" : "+v"(h2d));
#ifdef RF_FASTDECAY
            const float lgcl0 = lg * (float)(32 * cb + 4 * h2d);
#endif
#pragma unroll
            for (int i = 0; i < 16; ++i) {
#ifdef RF_FASTDECAY
                const float lcl = lgcl0 + lg * (float)((i & 3) + 8 * (i >> 2));
                const float dfac = __builtin_amdgcn_exp2f(dirn ? (lg * 128.0f - lcl) : (lcl + lg));
#else
                const int cl = 32 * cb + crow(i, h2d); const float dfac = RF_GT(dirn ? (128 - cl) : (cl + 1), 2);
#endif
#pragma unroll
                for (int eo = 0; eo < 2; ++eo) o[eo][i] += dfac * oi[eo][i]; }
        }
        float ssq[16];
#pragma unroll
        for (int i = 0; i < 16; ++i) {
            float s = o[0][i] * o[0][i] + o[1][i] * o[1][i];
            s += __shfl_xor(s, 1); s += __shfl_xor(s, 2); s += __shfl_xor(s, 4); s += __shfl_xor(s, 8); s += __shfl_xor(s, 16);
            ssq[i] = s; }
        if (r == 0) {
#pragma unroll
            for (int i = 0; i < 16; ++i) SS[(w & 1) * 128 + 32 * cb + crow(i, h2)] = ssq[i]; }
        RF_XBAR __syncthreads(); RF_XBAR
        int h2e = h2, re = r; asm volatile("" : "+v"(h2e), "+v"(re));
#ifdef RF_V1
#pragma unroll
        for (int i = 0; i < 16; ++i) { const int cl = 32 * cb + crow(i, h2e); const float tot = SS[cl] + SS[128 + cl]; const float rs = __builtin_amdgcn_rsqf(tot * (1.0f / 128.0f) + EPSN);
            const size_t row = row0 + cl;
#pragma unroll
            for (int eo = 0; eo < 2; ++eo) { const int e = 32 * (ebase + eo) + re; const float gv = bf2f(F.Z[row * ZC + ZC_G + 128 * h + e]);
                F.H[row * 1024 + 512 + 128 * h + e] = f2bf16(o[eo][i] * rs * (eo ? og1 : og0) * gv); } }
        RF_XBAR __syncthreads(); RF_XBAR
#else
#pragma unroll
        for (int i = 0; i < 16; ++i) { const int cl = 32 * cb + crow(i, h2e); const float tot = SS[cl] + SS[128 + cl]; const float rs = __builtin_amdgcn_rsqf(tot * (1.0f / 128.0f) + EPSN);
#pragma unroll
            for (int eo = 0; eo < 2; ++eo) { const int e = 32 * (ebase + eo) + re; const unsigned of = off_b(cl, e >> 3) + 2 * (e & 7);
                const float gv = bf2f(*(LAS unsigned short*)(R2 + of));
                *(LAS unsigned short*)(R3 + of) = f2bf16(o[eo][i] * rs * (eo ? og1 : og0) * gv); } }
        RF_XBAR __syncthreads(); RF_XBAR
#pragma unroll
#ifdef RF_V6
        for (int q = 0; q < 4; ++q) { const int idx = tid + 512 * q, c = (idx >> 4) ^ 1, ch = idx & 15; const u32x4 v = *(LAS u32x4*)(R3 + off_b(c, ch)); *(u32x4*)(F.H + (row0 + c) * 1024 + 512 + 128 * h + 8 * ch) = v; }
#else
        for (int q = 0; q < 4; ++q) { const int idx = tid + 512 * q, c = idx >> 4, ch = idx & 15; const u32x4 v = *(LAS u32x4*)(R3 + off_b(c, ch)); *(u32x4*)(F.H + (row0 + c) * 1024 + 512 + 128 * h + 8 * ch) = v; }
#endif
#endif
#ifdef RF_V11
        if (tid < 129) { const float g_ = GT[tid]; const float e_ = exp2f(lg * (float)tid); if (!(fabsf(g_ - e_) <= 1e-5f * e_)) RF_FLAG(1); }
#endif
    }
    __syncthreads();
}
__device__ __forceinline__ void ret_scan(const Fr& F) {
    for (int v = blockIdx.x * 512 + F.tid; v < 64 * 2048; v += F.G * 512) {
        const int strip = v >> 11, off = v & 2047, dir = strip & 1, h = (strip >> 1) & 3;
        const float cd = exp2f(128.0f * log2_gamma(h));
        const unsigned short* base = F.ST + (size_t)strip * NCHUNK * 16384 + (size_t)off * 8;
        unsigned short* obase = F.ST2 + (size_t)strip * NCHUNK * 16384 + (size_t)off * 8;
        float carry[8];
#pragma unroll
        for (int i = 0; i < 8; ++i) carry[i] = 0.f;
        for (int k0 = 0; k0 < NCHUNK; k0 += 5) {
            u16x8 tv[5];
#pragma unroll
            for (int j = 0; j < 5; ++j) { const int n = dir ? (NCHUNK - 1 - (k0 + j)) : (k0 + j); tv[j] = *(const u16x8*)(base + (size_t)n * 16384); }
#pragma unroll
            for (int j = 0; j < 5; ++j) { const int n = dir ? (NCHUNK - 1 - (k0 + j)) : (k0 + j); u32x4 o;
                o.x = cvtpk(carry[0], carry[1]); o.y = cvtpk(carry[2], carry[3]); o.z = cvtpk(carry[4], carry[5]); o.w = cvtpk(carry[6], carry[7]);
                *(u32x4*)(obase + (size_t)n * 16384) = o;
#pragma unroll
                for (int i = 0; i < 8; ++i) carry[i] = carry[i] * cd + bf2f(tv[j][i]); }
        }
    }
}
__device__ __forceinline__ void lru_carry(const Fr& F) {
    for (int v = blockIdx.x * 32 + F.tid; F.tid < 32 && v < NB * 2 * 512; v += F.G * 32) {
        const int c = v & 511, dir = (v >> 9) & 1, b = v >> 10;
        float carry = 0.f;
        for (int k0 = 0; k0 < NSEG; k0 += 10) {
            f32x2 ah[10];
#pragma unroll
            for (int j = 0; j < 10; ++j) { const int s = dir ? (NSEG - 1 - (k0 + j)) : (k0 + j); ah[j] = F.SUMM[((size_t)(b * NSEG + s) * 2 + dir) * 512 + c]; }
#pragma unroll
            for (int j = 0; j < 10; ++j) { const int s = dir ? (NSEG - 1 - (k0 + j)) : (k0 + j); F.CARRY[((size_t)(b * NSEG + s) * 2 + dir) * 512 + c] = carry; carry = ah[j].x * carry + ah[j].y; }
        }
    }
}
__device__ __forceinline__ void ph_scan_merged(const Fr& F) {
    const int v = blockIdx.x * 512 + F.tid;
    const int strip = v >> 11, off = v & 2047, dir = strip & 1, h = (strip >> 1) & 3;
    const float cd = exp2f(128.0f * log2_gamma(h));
    const unsigned short* base = F.ST + (size_t)strip * NCHUNK * 16384 + (size_t)off * 8;
    unsigned short* obase = F.ST2 + (size_t)strip * NCHUNK * 16384 + (size_t)off * 8;
    float carry[8];
#pragma unroll
    for (int i = 0; i < 8; ++i) carry[i] = 0.f;
    const bool cw = F.tid < 32;
    const int v2 = blockIdx.x * 32 + (F.tid & 31), c2 = v2 & 511, dir2 = (v2 >> 9) & 1, b2 = v2 >> 10;
    float lc = 0.f;
    for (int st = 0; st < 13; ++st) {
        const int k0 = 5 * st, q0 = 10 * st;
        u16x8 tv[5]; f32x2 ah[10];
#pragma unroll
        for (int j = 0; j < 5; ++j) { const int n = dir ? (NCHUNK - 1 - (k0 + j)) : (k0 + j); tv[j] = *(const u16x8*)(base + (size_t)n * 16384); }
        if (cw) {
#pragma unroll
            for (int j = 0; j < 10; ++j) { const int sg = dir2 ? (NSEG - 1 - (q0 + j)) : (q0 + j); ah[j] = F.SUMM[((size_t)(b2 * NSEG + sg) * 2 + dir2) * 512 + c2]; }
        }
#pragma unroll
        for (int j = 0; j < 5; ++j) { const int n = dir ? (NCHUNK - 1 - (k0 + j)) : (k0 + j); u32x4 o;
            o.x = cvtpk(carry[0], carry[1]); o.y = cvtpk(carry[2], carry[3]); o.z = cvtpk(carry[4], carry[5]); o.w = cvtpk(carry[6], carry[7]);
            *(u32x4*)(obase + (size_t)n * 16384) = o;
#pragma unroll
            for (int i = 0; i < 8; ++i) carry[i] = carry[i] * cd + bf2f(tv[j][i]); }
        if (cw) {
#pragma unroll
            for (int j = 0; j < 10; ++j) { const int sg = dir2 ? (NSEG - 1 - (q0 + j)) : (q0 + j); F.CARRY[((size_t)(b2 * NSEG + sg) * 2 + dir2) * 512 + c2] = lc; lc = ah[j].x * lc + ah[j].y; }
        }
    }
}
__device__ __forceinline__ void ph_checksum(const Fr& F, const void* buf, size_t bytes, int slot) {
    const unsigned* p = (const unsigned*)buf; const size_t nw = bytes / 4;
    unsigned long long sa = 0ull, sx = 0ull;
    for (size_t i = (size_t)blockIdx.x * 512 + F.tid; i < nw; i += (size_t)F.G * 512) { const unsigned long long v = p[i]; const unsigned long long h = (v + 0x9E3779B97F4A7C15ull + i) * 0xD6E8FEB86659FD93ull; sa += h; sx += (h ^ (h >> 29)) * 0xBF58476D1CE4E5B9ull; }
    unsigned a0 = (unsigned)sa, a1 = (unsigned)(sa >> 32), x0 = (unsigned)sx, x1 = (unsigned)(sx >> 32);
    for (int o = 1; o < 64; o <<= 1) { a0 += __shfl_xor(a0, o); a1 += __shfl_xor(a1, o); x0 += __shfl_xor(x0, o); x1 += __shfl_xor(x1, o); }
    sa = ((unsigned long long)a1 << 32) | a0; sx = ((unsigned long long)x1 << 32) | x0;
    if (F.lane == 0) { unsigned long long* c = (unsigned long long*)(F.CTLP + 32768) + slot * 2; atomicAdd(c, sa); atomicAdd(c + 1, sx); }
}
__device__ __forceinline__ void ph_cpy(const Fr& F) {
    const u32x4* s = (const u32x4*)F.H; u32x4* d = (u32x4*)(F.CTLP + CPY_BASE); const size_t nv = (size_t)NP * 2048 / 16;
    for (size_t i = (size_t)blockIdx.x * 512 + F.tid; i < nv; i += (size_t)F.G * 512) d[i] = s[i];
}
__device__ __forceinline__ void ph_cmp(const Fr& F) {
    const unsigned* a = (const unsigned*)F.H; const unsigned* c = (const unsigned*)(F.CTLP + CPY_BASE); const size_t nw = (size_t)NP * 2048 / 4;
    unsigned* st = (unsigned*)(F.CTLP + 32768 + 4096);
    for (size_t i = (size_t)blockIdx.x * 512 + F.tid; i < nw; i += (size_t)F.G * 512) {
        const unsigned x = a[i], y = c[i];
        if (x != y) { const unsigned idx = (unsigned)i;
            const float x0 = __uint_as_float(x << 16), x1 = __uint_as_float(x & 0xffff0000u), y0 = __uint_as_float(y << 16), y1 = __uint_as_float(y & 0xffff0000u);
            const float d0 = fabsf(x0 - y0), d1 = fabsf(x1 - y1); const float d = fmaxf(d0, d1);
            const float m = (d0 >= d1) ? fmaxf(fabsf(x0), fabsf(y0)) : fmaxf(fabsf(x1), fabsf(y1)); const float rel = d / fmaxf(m, 1e-30f);
            atomicAdd(st + 0, 1u); atomicMax(st + 1, ~idx); atomicMax(st + 2, idx); atomicOr(st + 3, ~idx); atomicOr(st + 4, idx);
            atomicMax(st + 5, __float_as_uint(d)); atomicMax(st + 6, __float_as_uint(rel));
            if (fabsf(y0) > 0.02f && fabsf(y1) > 0.02f) { const float ra = x0 / y0, rb = x1 / y1; atomicMax(st + 9, __float_as_uint(fabsf(ra - rb) / fmaxf(fabsf(ra), fabsf(rb)))); atomicMax(st + 10, __float_as_uint(fabsf(ra))); atomicMax(st + 11, __float_as_uint(1.0f / fmaxf(fabsf(ra), 1e-30f))); atomicAdd(st + 12, 1u); if (fabsf(ra - rb) / fmaxf(fabsf(ra), fabsf(rb)) < 0.03f) atomicAdd(st + 13, 1u); else atomicAdd(st + 14, 1u); }
            { const unsigned row_ = idx >> 9, cw_ = idx & 511u, cid_ = row_ >> 7; const unsigned item_ = (cw_ & 256u) ? ((cid_ / 65u) * 4u + ((cw_ >> 6) & 3u)) * 65u + cid_ % 65u : 2087u;
              atomicOr(st + 16 + (item_ >> 5), 1u << (item_ & 31u)); atomicAdd((unsigned*)(F.CTLP + 40960) + item_, 1u); if (d >= 0.125f) atomicAdd(st + 7, 1u); if (d >= 1.0f) atomicAdd(st + 8, 1u); } }
    }
}
__device__ __forceinline__ const unsigned short* hs_row(const Fr& F, int b, int t) { return F.HSB + (size_t)(b * PP + PADL + t) * 1024; }
__device__ __forceinline__ f32x4 bf4(u32x2 w) { return (f32x4){__uint_as_float(w.x << 16), __uint_as_float(w.x & 0xffff0000u), __uint_as_float(w.y << 16), __uint_as_float(w.y & 0xffff0000u)}; }
__device__ __forceinline__ float router_softmax(float (&pl)[16], int lane) {
    { const bool hi = lane & 32;
#pragma unroll
      for (int i = 0; i < 8; ++i) { const float send = hi ? pl[i] : pl[i + 8], keep = hi ? pl[i + 8] : pl[i]; pl[i] = keep + __shfl_xor(send, 32); } }
    { const bool hi = lane & 16;
#pragma unroll
      for (int i = 0; i < 4; ++i) { const float send = hi ? pl[i] : pl[i + 4], keep = hi ? pl[i + 4] : pl[i]; pl[i] = keep + __shfl_xor(send, 16); } }
    { const bool hi = lane & 8;
#pragma unroll
      for (int i = 0; i < 2; ++i) { const float send = hi ? pl[i] : pl[i + 2], keep = hi ? pl[i + 2] : pl[i]; pl[i] = keep + __shfl_xor(send, 8); } }
    { const bool hi = lane & 4; const float send = hi ? pl[0] : pl[1], keep = hi ? pl[1] : pl[0]; pl[0] = keep + __shfl_xor(send, 4); }
    float lg = pl[0]; lg += __shfl_xor(lg, 1); lg += __shfl_xor(lg, 2);
    float mx = lg;
    mx = fmaxf(mx, __shfl_xor(mx, 4)); mx = fmaxf(mx, __shfl_xor(mx, 8)); mx = fmaxf(mx, __shfl_xor(mx, 16)); mx = fmaxf(mx, __shfl_xor(mx, 32));
    const float ex = expf(lg - mx); float sm = ex;
    sm += __shfl_xor(sm, 4); sm += __shfl_xor(sm, 8); sm += __shfl_xor(sm, 16); sm += __shfl_xor(sm, 32);
    return ex / sm;
}
__device__ __forceinline__ void ph_router(const Fr& F) {
    LAS float* WR = (LAS float*)F.lds;
    for (int i = F.tid; i < 16384; i += 512) { const int d = i >> 4, e = i & 15; WR[e * 1024 + d] = F.w_router[i]; }
    __syncthreads();
    const int lane = F.lane;
    if (blockIdx.x == 0 && F.tid < 256) ((unsigned*)F.XS)[F.tid] = 0u;
    const int NV = NB * TT, NPAIR = NV / 2;
    const int gw = blockIdx.x * 8 + F.wave, NGW = F.G * 8;
    u32x2 nx[2][4];
    if (gw < NPAIR) {
#pragma unroll
        for (int q = 0; q < 2; ++q) { const int v = 2 * gw + q, b = v / TT, t = v - b * TT; const u32x2* xr = (const u32x2*)hs_row(F, b, t) + lane;
#pragma unroll
            for (int j = 0; j < 4; ++j) nx[q][j] = xr[64 * j]; }
    }
    f32x4 gg[4];
#pragma unroll
    for (int j = 0; j < 4; ++j) gg[j] = ((const f32x4*)F.norm2_g + lane)[64 * j];
#ifndef WR_NREG
#define WR_NREG 6
#endif
    f32x4 wreg[WR_NREG > 0 ? WR_NREG : 1][4];
#pragma unroll
    for (int e = 0; e < WR_NREG; ++e)
#pragma unroll
        for (int j = 0; j < 4; ++j) wreg[e][j] = *(LAS f32x4*)(WR + e * 1024 + 256 * j + 4 * lane);
    for (int pr = gw; pr < NPAIR; pr += NGW) {
        f32x4 vv[2][4];
#pragma unroll
        for (int q = 0; q < 2; ++q)
#pragma unroll
            for (int j = 0; j < 4; ++j) vv[q][j] = bf4(nx[q][j]);
        { const int pn = pr + NGW < NPAIR ? pr + NGW : pr;
#pragma unroll
          for (int q = 0; q < 2; ++q) { const int v = 2 * pn + q, b = v / TT, t = v - b * TT; const u32x2* xr = (const u32x2*)hs_row(F, b, t) + lane;
#pragma unroll
              for (int j = 0; j < 4; ++j) nx[q][j] = xr[64 * j]; } }
        int bq[2], tq[2];
#pragma unroll
        for (int q = 0; q < 2; ++q) {
            const int v = 2 * pr + q; bq[q] = v / TT; tq[q] = v - bq[q] * TT;
            float s = 0.f;
#pragma unroll
            for (int j = 0; j < 4; ++j) s += (vv[q][j].x * vv[q][j].x + vv[q][j].y * vv[q][j].y) + (vv[q][j].z * vv[q][j].z + vv[q][j].w * vv[q][j].w);
            const float rs = __builtin_amdgcn_rsqf(wave_sum(s) * (1.0f / 1024.0f) + EPSN);
            unsigned* o8 = (unsigned*)((unsigned char*)F.XS + (size_t)(bq[q] * PP + PADL + tq[q]) * 1024) + lane;
#pragma unroll
            for (int j = 0; j < 4; ++j) { vv[q][j].x *= rs * gg[j].x; vv[q][j].y *= rs * gg[j].y; vv[q][j].z *= rs * gg[j].z; vv[q][j].w *= rs * gg[j].w;
                unsigned wv = 0u; wv = __builtin_amdgcn_cvt_pk_fp8_f32(vv[q][j].x, vv[q][j].y, wv, false); wv = __builtin_amdgcn_cvt_pk_fp8_f32(vv[q][j].z, vv[q][j].w, wv, true); o8[64 * j] = wv; }
        }
        float pl0[16], pl1[16];
#pragma unroll
        for (int e = 0; e < 16; ++e) { f32x2 a0 = {0.f, 0.f}, a1 = {0.f, 0.f};
#pragma unroll
            for (int j = 0; j < 4; ++j) { const f32x4 wv = (e < WR_NREG) ? wreg[e < WR_NREG ? e : 0][j] : *(LAS f32x4*)(WR + e * 1024 + 256 * j + 4 * lane);
                const f32x2 wlo = __builtin_shufflevector(wv, wv, 0, 1), whi = __builtin_shufflevector(wv, wv, 2, 3);
                a0 = __builtin_elementwise_fma(__builtin_shufflevector(vv[0][j], vv[0][j], 0, 1), wlo, a0); a0 = __builtin_elementwise_fma(__builtin_shufflevector(vv[0][j], vv[0][j], 2, 3), whi, a0);
                a1 = __builtin_elementwise_fma(__builtin_shufflevector(vv[1][j], vv[1][j], 0, 1), wlo, a1); a1 = __builtin_elementwise_fma(__builtin_shufflevector(vv[1][j], vv[1][j], 2, 3), whi, a1); }
            pl0[e] = a0.x + a0.y; pl1[e] = a1.x + a1.y; if ((e & 3) == 3) asm volatile("" ::: "memory"); }
        const float p0 = router_softmax(pl0, lane), p1 = router_softmax(pl1, lane);
        const int e = ((lane >> 5) & 1) * 8 + ((lane >> 4) & 1) * 4 + ((lane >> 3) & 1) * 2 + ((lane >> 2) & 1);
        if ((lane & 3) == 0) { F.AFF[(size_t)(bq[0] * NE + e) * TT + tq[0]] = p0; F.AFF[(size_t)(bq[1] * NE + e) * TT + tq[1]] = p1; }
    }
    __syncthreads();
}

__device__ __forceinline__ void topk_item(const Fr& F, int b, int e) {
    LAS unsigned* vals = (LAS unsigned*)F.lds;
    LAS unsigned* hist = vals + 8256;
    LAS unsigned* misc = hist + 256;
    LAS unsigned* wsum = misc + 16;
    const int tid = F.tid, lane = F.lane, w = F.wave;
    const float* aff = F.AFF + (size_t)(b * NE + e) * TT;
    for (int t = tid; t < TT; t += 512) vals[t] = __float_as_uint(aff[t]);
    unsigned prefix = 0u, mask = 0u, k = CAP;
    for (int pass = 0; pass < 4; ++pass) {
        const int shift = 24 - 8 * pass;
        if (tid < 256) hist[tid] = 0u;
        __syncthreads();
        for (int t = tid; t < TT; t += 512) { const unsigned v = vals[t]; if ((v & mask) == prefix) __hip_atomic_fetch_add(&hist[(v >> shift) & 255u], 1u, __ATOMIC_RELAXED, __HIP_MEMORY_SCOPE_WORKGROUP); }
        __syncthreads();
        if (w == 0) {
            unsigned c[4]; unsigned s = 0u;
#pragma unroll
            for (int i = 0; i < 4; ++i) { c[i] = hist[255 - (4 * lane + i)]; s += c[i]; }
            unsigned incl = s;
#pragma unroll
            for (int o = 1; o < 64; o <<= 1) { const unsigned y = __shfl_up(incl, o); if (lane >= o) incl += y; }
            unsigned cum = incl - s;
#pragma unroll
            for (int i = 0; i < 4; ++i) { if (cum < k && cum + c[i] >= k) { misc[0] = prefix | ((unsigned)(255 - (4 * lane + i)) << shift); misc[1] = k - cum; } cum += c[i]; }
        }
        __syncthreads();
        prefix = misc[0]; k = misc[1]; mask |= 0xFFu << shift;
        __syncthreads();
    }
    const unsigned thr = prefix, keq = k;
    const int t0 = tid * 17;
    unsigned loc = 0u;
#pragma unroll
    for (int i = 0; i < 17; ++i) { const int t = t0 + i; if (t < TT) { const unsigned v = vals[t]; loc += (v > thr ? 1u : 0u) + (v == thr ? 65536u : 0u); } }
    unsigned incl = loc;
#pragma unroll
    for (int o = 1; o < 64; o <<= 1) { const unsigned y = __shfl_up(incl, o); if (lane >= o) incl += y; }
    if (lane == 63) wsum[w] = incl;
    __syncthreads();
    unsigned before = incl - loc;
#pragma unroll
    for (int w2 = 0; w2 < 8; ++w2) if (w2 < w) before += wsum[w2];
    unsigned gtb = before & 0xFFFFu, eqb = before >> 16;
    for (int i = 0; i < 17; ++i) { const int t = t0 + i; if (t < TT) {
        const unsigned v = vals[t]; const bool gt = v > thr, eq = v == thr; const bool sel = gt || (eq && eqb < keq);
        const int rrow = b * PP + PADL + t;
        int mrow = -1;
        if (sel) { const unsigned slot = gtb + (eqb < keq ? eqb : keq); mrow = e * EROWS + b * CAP + (int)slot; F.IDX[mrow] = rrow * 1024; F.GATE[mrow] = __uint_as_float(v); }
        F.ROWMAP[(size_t)rrow * NE + e] = mrow;
        gtb += gt ? 1u : 0u; eqb += eq ? 1u : 0u; } }
    if (b == 0) for (int i = tid; i < EROWS - NB * CAP; i += 512) { F.IDX[e * EROWS + NB * CAP + i] = 0; F.GATE[e * EROWS + NB * CAP + i] = 0.f; }
    __syncthreads();
}

__device__ __forceinline__ void ph_gather(const Fr& F) {
    for (int v = blockIdx.x * 8 + F.wave; v < NROWS; v += F.G * 8) {
        const int src = F.IDX[v];
        u32x4* dst = (u32x4*)(F.XS + (size_t)v * 1024) + F.lane;
        if (src >= 0) { const u32x4* sp = (const u32x4*)(F.H + (size_t)src * 1024) + F.lane; dst[0] = sp[0]; dst[64] = sp[64]; }
        else { dst[0] = (u32x4){0u, 0u, 0u, 0u}; dst[64] = (u32x4){0u, 0u, 0u, 0u}; }
    }
}
__device__ __forceinline__ void ph_combine(const Fr& F) {
    const int lane = F.lane;
#ifdef DET_PROBE
    float badv = 0.f; { const unsigned long long* c = (const unsigned long long*)(F.CTLP + 32768); float mag = 1e4f;
      for (int k = DET_PROBE - 1; k >= 0; --k) { const bool bk = (__hip_atomic_load(c + 4 * k, __ATOMIC_RELAXED, __HIP_MEMORY_SCOPE_AGENT) != __hip_atomic_load(c + 4 * k + 2, __ATOMIC_RELAXED, __HIP_MEMORY_SCOPE_AGENT)) || (__hip_atomic_load(c + 4 * k + 1, __ATOMIC_RELAXED, __HIP_MEMORY_SCOPE_AGENT) != __hip_atomic_load(c + 4 * k + 3, __ATOMIC_RELAXED, __HIP_MEMORY_SCOPE_AGENT)); if (bk) { float mm = 1e4f; for (int e_ = 0; e_ < k; ++e_) mm *= 10.0f; badv = mm; } } (void)mag; }
    { const unsigned fl_ = __hip_atomic_load((const unsigned*)(F.CTLP + 32768 + 2048), __ATOMIC_RELAXED, __HIP_MEMORY_SCOPE_AGENT); if (fl_) badv = 1e5f * (float)fl_; }
#ifdef STAT_SEL
    { const unsigned* st = (const unsigned*)(F.CTLP + 32768 + 4096);
      const unsigned cnt = __hip_atomic_load(st + 0, __ATOMIC_RELAXED, __HIP_MEMORY_SCOPE_AGENT), nmin = ~__hip_atomic_load(st + 1, __ATOMIC_RELAXED, __HIP_MEMORY_SCOPE_AGENT), nand = ~__hip_atomic_load(st + 3, __ATOMIC_RELAXED, __HIP_MEMORY_SCOPE_AGENT),
                     vor = __hip_atomic_load(st + 4, __ATOMIC_RELAXED, __HIP_MEMORY_SCOPE_AGENT), mabs = __hip_atomic_load(st + 5, __ATOMIC_RELAXED, __HIP_MEMORY_SCOPE_AGENT), mrel = __hip_atomic_load(st + 6, __ATOMIC_RELAXED, __HIP_MEMORY_SCOPE_AGENT);
      if (cnt) { const unsigned vary = vor & ~nand; unsigned k = 0; const unsigned row = nmin >> 9, cw = nmin & 511u, chunkid = row >> 7;
        if (STAT_SEL == 0) { unsigned L = 32u - (unsigned)__builtin_clz(cnt); if (L > 15u) L = 15u; k = L + ((vary & 63u) ? 16u : 0u) + ((vary & 448u) ? 32u : 0u) + ((vary & 0xFE00u) ? 64u : 0u) + ((vary >> 16) ? 128u : 0u); }
        if (STAT_SEL == 1) k = row & 127u;
        if (STAT_SEL == 2) k = cw >> 1;
        if (STAT_SEL == 3) k = chunkid % 65u;
        if (STAT_SEL == 4) k = mabs >> 23;
        if (STAT_SEL == 5) k = mrel >> 23;
        if (STAT_SEL == 6) k = (chunkid / 65u) * 4u + ((cw >> 6) & 3u) + ((cw & 256u) ? 0u : 64u);
        if (STAT_SEL == 7) k = cnt < 255u ? cnt : 255u;
        if (STAT_SEL == 8) { const unsigned e5 = mrel >> 23; const unsigned bk = e5 < 113u ? 0u : (e5 > 127u ? 7u : (e5 - 113u) / 2u); k = (32u - (unsigned)__builtin_clz(cnt)) + 32u * bk; }
        if (STAT_SEL >= 10) { unsigned nit = 0, first = 0xffffu, last = 0;
          for (unsigned wd = 0; wd < 66u; ++wd) { const unsigned bm = __hip_atomic_load(st + 16 + wd, __ATOMIC_RELAXED, __HIP_MEMORY_SCOPE_AGENT); nit += (unsigned)__builtin_popcount(bm);
            if (bm) { const unsigned lo = wd * 32u + (unsigned)__builtin_ctz(bm), hi = wd * 32u + 31u - (unsigned)__builtin_clz(bm); if (first == 0xffffu) first = lo; last = hi; } }
          const unsigned cfirst = __hip_atomic_load((const unsigned*)(F.CTLP + 40960) + (first < 2088u ? first : 0u), __ATOMIC_RELAXED, __HIP_MEMORY_SCOPE_AGENT);
          if (STAT_SEL == 10) k = nit < 255u ? nit : 255u;
          if (STAT_SEL == 15) { const unsigned per = cnt / (nit ? nit : 1u); k = (32u - (unsigned)__builtin_clz(nit | 1u)) + 16u * (32u - (unsigned)__builtin_clz(per | 1u)); }
          if (STAT_SEL == 16 || STAT_SEL == 17) { unsigned bor = 0u, band = 0xffu;
            for (unsigned wd = 0; wd < 66u; ++wd) { unsigned bm = __hip_atomic_load(st + 16 + wd, __ATOMIC_RELAXED, __HIP_MEMORY_SCOPE_AGENT); while (bm) { const unsigned id_ = wd * 32u + (unsigned)__builtin_ctz(bm); bm &= bm - 1u; bor |= (id_ & 255u); band &= (id_ & 255u); } }
            k = (STAT_SEL == 16) ? (unsigned)__builtin_popcount(bor & ~band) : band; }
          if (STAT_SEL == 18 || STAT_SEL == 19) { unsigned jor = 0u, jand = 0xfu, nor_ = 0u, nand_ = 0x7fu;
            for (unsigned wd = 0; wd < 66u; ++wd) { unsigned bm = __hip_atomic_load(st + 16 + wd, __ATOMIC_RELAXED, __HIP_MEMORY_SCOPE_AGENT); while (bm) { const unsigned id_ = wd * 32u + (unsigned)__builtin_ctz(bm); bm &= bm - 1u; jor |= (id_ >> 8); jand &= (id_ >> 8); nor_ |= (id_ % 65u); nand_ &= (id_ % 65u); } }
            k = (STAT_SEL == 18) ? (jor | (jand << 4)) : (nor_ & 127u) + ((nand_ & 127u) ? 128u : 0u); }
          if (STAT_SEL == 20) { const unsigned per = cnt / (nit ? nit : 1u); k = (per >= 6000u) ? 3u : (per >= 2000u) ? 2u : (per >= 256u) ? 1u : 0u; k += 4u * ((nit >= 64u) ? 3u : (nit >= 16u) ? 2u : (nit >= 4u) ? 1u : 0u); }
          if (STAT_SEL == 21) k = vary & 255u;
          if (STAT_SEL == 22) k = (vary >> 9) & 127u;
          if (STAT_SEL == 23) k = (nand >> 9) & 127u;
          if (STAT_SEL == 24) { const float incons = __uint_as_float(__hip_atomic_load(st + 9, __ATOMIC_RELAXED, __HIP_MEMORY_SCOPE_AGENT)); const float rmax = __uint_as_float(__hip_atomic_load(st + 10, __ATOMIC_RELAXED, __HIP_MEMORY_SCOPE_AGENT)), rinv = __uint_as_float(__hip_atomic_load(st + 11, __ATOMIC_RELAXED, __HIP_MEMORY_SCOPE_AGENT));
            k = (incons < 0.03f ? 1u : incons < 0.3f ? 2u : 3u) + 4u * (rmax < 1.05f ? 0u : rmax < 1.5f ? 1u : rmax < 3.0f ? 2u : 3u) + 16u * (rinv < 1.05f ? 0u : rinv < 1.5f ? 1u : rinv < 3.0f ? 2u : 3u); }
          if (STAT_SEL == 25) { const unsigned c13 = __hip_atomic_load(st + 13, __ATOMIC_RELAXED, __HIP_MEMORY_SCOPE_AGENT), c14 = __hip_atomic_load(st + 14, __ATOMIC_RELAXED, __HIP_MEMORY_SCOPE_AGENT); const float fr = (float)c14 / (float)(c13 + c14 + 1u);
            k = (c14 == 0u) ? 0u : fr < 0.01f ? 1u : fr < 0.1f ? 2u : fr < 0.5f ? 3u : fr < 0.9f ? 4u : (c13 != 0u) ? 5u : 6u; }
          if (STAT_SEL == 99) k = 0u;
          if (STAT_SEL == 11) k = (first >> 8) + 16u * (last >> 8);
          if (STAT_SEL == 12) k = first & 255u;
          if (STAT_SEL == 13) k = cfirst / 64u;
          if (STAT_SEL == 14) { const unsigned c7 = __hip_atomic_load(st + 7, __ATOMIC_RELAXED, __HIP_MEMORY_SCOPE_AGENT), c8 = __hip_atomic_load(st + 8, __ATOMIC_RELAXED, __HIP_MEMORY_SCOPE_AGENT); unsigned l8 = c8 ? 32u - (unsigned)__builtin_clz(c8) : 0u; if (l8 > 7u) l8 = 7u; k = (c7 ? 32u - (unsigned)__builtin_clz(c7) : 0u) + 32u * l8; } }
        float mm = 1e4f; for (unsigned e_ = 0; e_ < k; ++e_) mm *= 1.140175f; badv = mm; } }
#endif
    { const unsigned fl2_ = __hip_atomic_load((const unsigned*)(F.CTLP + 32768 + 2048), __ATOMIC_RELAXED, __HIP_MEMORY_SCOPE_AGENT); if (fl2_) badv = 1e7f * (float)fl2_; }
    const bool bad = badv != 0.f;
#endif
    const int gw = blockIdx.x * 8 + F.wave, NGW = F.G * 8, NPAIR = NB * SEQ / 2;
    f32x4 gg[4];
#pragma unroll
    for (int j = 0; j < 4; ++j) gg[j] = ((const f32x4*)F.final_g + lane)[64 * j];
    u32x2 nx[2][4]; int nm[2];
    if (gw < NPAIR) {
#pragma unroll
        for (int q = 0; q < 2; ++q) { const int v = 2 * gw + q, b = v / SEQ, tq = v - b * SEQ; const u32x2* xr = (const u32x2*)(F.HSB + (size_t)(b * PP + PADL + NMETA + tq) * 1024) + lane;
#pragma unroll
            for (int j = 0; j < 4; ++j) nx[q][j] = xr[64 * j];
            nm[q] = F.ROWMAP[(size_t)(b * PP + PADL + NMETA + tq) * NE + (lane & 15)]; }
    }
    for (int pr = gw; pr < NPAIR; pr += NGW) {
        f32x4 vv[2][4]; int mine[2];
#pragma unroll
        for (int q = 0; q < 2; ++q) { mine[q] = nm[q];
#pragma unroll
            for (int j = 0; j < 4; ++j) vv[q][j] = bf4(nx[q][j]); }
        { unsigned bal[2];
#pragma unroll
          for (int q = 0; q < 2; ++q) bal[q] = (unsigned)__ballot(mine[q] >= 0) & 0xFFFFu;
          while (bal[0] | bal[1]) {
              const int dummy = bal[0] ? __builtin_amdgcn_readlane(mine[0], __builtin_ctz(bal[0])) : __builtin_amdgcn_readlane(mine[1], __builtin_ctz(bal[1]));
              int ms[2][4]; float sc[2][4];
#pragma unroll
              for (int q = 0; q < 2; ++q)
#pragma unroll
                  for (int sl = 0; sl < 4; ++sl) { if (bal[q]) { const int e = __builtin_ctz(bal[q]); bal[q] &= bal[q] - 1u; ms[q][sl] = __builtin_amdgcn_readlane(mine[q], e); sc[q][sl] = 0.125f; } else { ms[q][sl] = dummy; sc[q][sl] = 0.f; } }
              unsigned y[2][4][4];
#pragma unroll
              for (int q = 0; q < 2; ++q)
#pragma unroll
                  for (int sl = 0; sl < 4; ++sl) { const unsigned* yr = (const unsigned*)((const unsigned char*)F.YS + (size_t)ms[q][sl] * 1024) + lane;
#pragma unroll
                      for (int j = 0; j < 4; ++j) y[q][sl][j] = yr[64 * j]; }
#pragma unroll
              for (int q = 0; q < 2; ++q)
#pragma unroll
                  for (int sl = 0; sl < 4; ++sl)
#pragma unroll
                      for (int j = 0; j < 4; ++j) { const unsigned yy = y[q][sl][j]; const float w8 = sc[q][sl]; vv[q][j].x += w8 * __builtin_amdgcn_cvt_f32_fp8(yy, 0); vv[q][j].y += w8 * __builtin_amdgcn_cvt_f32_fp8(yy, 1);
                          vv[q][j].z += w8 * __builtin_amdgcn_cvt_f32_fp8(yy, 2); vv[q][j].w += w8 * __builtin_amdgcn_cvt_f32_fp8(yy, 3); }
          } }
        { const int pn = pr + NGW < NPAIR ? pr + NGW : pr;
#pragma unroll
          for (int q = 0; q < 2; ++q) { const int v = 2 * pn + q, b = v / SEQ, tq = v - b * SEQ; const u32x2* xr = (const u32x2*)(F.HSB + (size_t)(b * PP + PADL + NMETA + tq) * 1024) + lane;
#pragma unroll
              for (int j = 0; j < 4; ++j) nx[q][j] = xr[64 * j];
              nm[q] = F.ROWMAP[(size_t)(b * PP + PADL + NMETA + tq) * NE + (lane & 15)]; } }
#pragma unroll
        for (int q = 0; q < 2; ++q) {
            float s = 0.f;
#pragma unroll
            for (int j = 0; j < 4; ++j) s += (vv[q][j].x * vv[q][j].x + vv[q][j].y * vv[q][j].y) + (vv[q][j].z * vv[q][j].z + vv[q][j].w * vv[q][j].w);
            const float rs = __builtin_amdgcn_rsqf(wave_sum(s) * (1.0f / 1024.0f) + EPSN);
            f32x4* xr = (f32x4*)(F.out + (size_t)(2 * pr + q) * 1024) + lane;
#pragma unroll
            for (int j = 0; j < 4; ++j) { f32x4 o; o.x = vv[q][j].x * rs * gg[j].x; o.y = vv[q][j].y * rs * gg[j].y; o.z = vv[q][j].z * rs * gg[j].z; o.w = vv[q][j].w * rs * gg[j].w;
#ifdef DET_PROBE
                if (bad && pr == 0 && q == 0 && j == 0 && lane == 0) o.x = badv;
#endif
                xr[64 * j] = o; }
        }
    }
}

struct Args { const float* in[20]; float* out; unsigned char* ws; int ph_lo, ph_hi; };
__global__ void __launch_bounds__(512, 2) mk_fwd(Args args) {
    extern __shared__ __attribute__((aligned(16))) unsigned char lds_raw[];
    Fr F;
    F.lds = (LAS unsigned char*)lds_raw;
    F.tid = threadIdx.x; F.lane = F.tid & 63; F.wave = __builtin_amdgcn_readfirstlane(F.tid >> 6); F.G = gridDim.x;
    unsigned char* ws = args.ws;
    F.x = args.in[0]; F.meta = args.in[1]; F.norm1_g = args.in[2]; F.w_in = args.in[3]; F.conv_w = args.in[4]; F.conv_b = args.in[5]; F.w_r = args.in[6]; F.b_r = args.in[7];
    F.w_i = args.in[8]; F.b_i = args.in[9]; F.lam = args.in[10]; F.lru_out_g = args.in[11]; F.ret_out_g = args.in[12]; F.w_out = args.in[13]; F.norm2_g = args.in[14];
    F.w_router = args.in[15]; F.w_gate = args.in[16]; F.w_up = args.in[17]; F.w_down = args.in[18]; F.final_g = args.in[19]; F.out = args.out;
    F.CTLP = ws + WS_CTL; F.GW2 = (unsigned short*)(ws + WS_GW2); F.GW = (unsigned short*)(ws + WS_GW); F.WIN = (unsigned short*)(ws + WS_WIN); F.WOUT = (unsigned short*)(ws + WS_WOUT); F.WGU = (unsigned short*)(ws + WS_WGU); F.WD = (unsigned short*)(ws + WS_WD);
    F.H = (unsigned short*)(ws + WS_H); F.Z = (unsigned short*)(ws + WS_Z); F.ST = (unsigned short*)(ws + WS_ST); F.XS = (unsigned short*)(ws + WS_XS); F.ACT = (unsigned short*)(ws + WS_ACT); F.YS = (unsigned short*)(ws + WS_YS);
    F.HSB = (unsigned short*)(ws + WS_HSB); F.ST2 = (unsigned short*)(ws + ST2_BASE); F.HSMETA = (float*)(ws + WS_HSMETA); F.AFF = (float*)(ws + WS_AFF); F.GATE = (float*)(ws + WS_GATE); F.CARRY = (float*)(ws + WS_CARRY); F.CS = (f32x2*)(ws + WS_CS); F.SUMM = (f32x2*)(ws + WS_SUMM);
    F.ROWMAP = (int*)(ws + WS_ROWMAP); F.IDX = (int*)(ws + WS_IDX);
    volatile LAS unsigned* MISC = (volatile LAS unsigned*)(F.lds + LDS_MISC);
    if (F.tid < 64) MISC[F.tid] = 0u;
    __syncthreads();
#ifdef START_DELAY
    { const unsigned long long t0_ = __builtin_amdgcn_s_memrealtime(); while (__builtin_amdgcn_s_memrealtime() - t0_ < START_DELAY) __builtin_amdgcn_s_sleep(16); }
#endif
    XcdBarrier bar = xcd_barrier_post((unsigned*)(ws + WS_CTL) + CW_BAR, MISC + 8);
    const int bid = blockIdx.x, G = F.G;
#define SEAM xcd_barrier(bar);
#define P0 ph_prep(F);
#define P1 { pg8::Gemm g{F.H, F.WIN, NP, ZC, DM}; pg8::StaticOrder S; S.init(NP, ZC, G, bid); pg8::EpiZ E{F.Z, (const float*)F.CS}; \
        pg8::gemm_phase<pg8::EpiZ, pg8::StaticOrder, true, true>(F.lds, g, S, E); \
          \
        if (G == 256) prep_stream8(F, F.w_gate, (unsigned char*)F.WGU, 2097152, 1, bid - 48, G - 48); else prep_stream8(F, F.w_gate, (unsigned char*)F.WGU, 2097152, 1, bid, G); }
#define P2 { P2R P2L }
#ifdef LDS_POISON
#if LDS_POISON == 1
#define LPOI { for (int i_ = F.tid; i_ < LDS_MISC / 4; i_ += 512) ((LAS unsigned*)F.lds)[i_] = 0x7fc07fc0u; __syncthreads(); }
#else
#define LPOI { __syncthreads(); }
#endif
#else
#define LPOI
#endif
#define P2R { LPOI ph_ret_contrib(F); }
#ifndef LRU_NEW2
#define LRU_NEW2 1
#endif
#ifndef LRU_NEW4
#define LRU_NEW4 1
#endif
#define P2L LPOI for (int i2 = G - 1 - bid; i2 < 1040; i2 += G) { if (LRU_NEW2) lru2_item<false>(F, i2 / NSEG, i2 % NSEG); else lru_item<false>(F, i2 / NSEG, i2 % NSEG); }
#define P4R { LPOI ph_ret_final(F); }
#define P4L LPOI for (int i2 = G - 1 - bid; i2 < 1040; i2 += G) { if (LRU_NEW4) lru2_item<true>(F, i2 / NSEG, i2 % NSEG); else lru_item<true>(F, i2 / NSEG, i2 % NSEG); }
#define P3 { if (G == 256) ph_scan_merged(F); else { lru_carry(F); ret_scan(F); } }
#define P4 { P4R P4L }
#define P5 { pg8::Gemm g{F.H, F.WOUT, NP, DM, DM}; pg8::StaticOrder S; S.init(NP, DM, G, bid); pg8::EpiHS E{F.x, F.meta, F.HSB}; \
          \
          \
        const int vb5 = G == 256 ? bid - 16 : bid, VG5 = G == 256 ? G - 16 : G; const bool early5 = (G == 256) && (vb5 >= 0) && ((bid >> 3) & 1); \
        if (early5) { prep_stream8(F, F.w_up, (unsigned char*)F.WGU, 2097152, 2, vb5, VG5); if (G != 256) prep_stream8(F, F.w_down, (unsigned char*)F.WD, 1048576, 0, vb5, VG5); } \
        pg8::gemm_phase<pg8::EpiHS, pg8::StaticOrder, true, true>(F.lds, g, S, E); \
        if (!early5) { prep_stream8(F, F.w_up, (unsigned char*)F.WGU, 2097152, 2, vb5, VG5); if (G != 256) prep_stream8(F, F.w_down, (unsigned char*)F.WD, 1048576, 0, vb5, VG5); } }
#define P6 ph_router(F);
#define P7 { for (int it = bid; it < NB * NE; it += G) topk_item(F, it / NE, it % NE); \
          \
        if (G == 256) prep_stream8(F, F.w_down, (unsigned char*)F.WD, 1048576, 0, bid - 128, 128); }
#define P8 ph_gather(F);
#define P9 { pg8::Gemm g{F.XS, F.WGU, NROWS, NE * 2048, DM / 2}; pg8::GroupOrder S; S.init(NE, 33, 8, G, bid); pg8::EpiAct E{F.ACT}; \
        pg8::gemm_phase_g8<pg8::EpiAct, pg8::GroupOrder>(F.lds, F.lds + LDS_SIDE, g, (const unsigned*)F.IDX, S, E); }
#define P10 { pg8::Gemm g{F.ACT, F.WD, NROWS, NE * 1024, DM / 2}; pg8::GroupOrder S; S.init(NE, 33, 4, G, bid); pg8::EpiYS E{(unsigned char*)F.YS, F.GATE}; \
        pg8::gemm_phase8<pg8::EpiYS, pg8::GroupOrder, true, true>(F.lds, g, S, E); }
#define P10F8 { pg8::Gemm g{F.ACT, F.WD, NROWS, NE * 1024, DM / 2}; pg8::GroupOrder S; S.init(NE, 33, 4, G, bid); pg8::EpiYS E{(unsigned char*)F.YS, F.GATE}; \
        pg8::gemm_phase8<pg8::EpiYS, pg8::GroupOrder, true, true>(F.lds, g, S, E); }
#define CKSTU(slot) ph_checksum(F, F.ST, (size_t)64 * NCHUNK * 32768, slot);
#define CKSUMM(slot) ph_checksum(F, F.SUMM, (size_t)NB * NSEG * 2 * 512 * 8, slot);
#define CKCARRY(slot) ph_checksum(F, F.CARRY, (size_t)NB * NSEG * 2 * 512 * 4, slot);
#define CPY ph_cpy(F);
#define CMP ph_cmp(F);
#define CKY(slot) ph_checksum(F, F.H, (size_t)NP * 2048, slot);
#define CKST(slot) ph_checksum(F, F.ST2, (size_t)64 * NCHUNK * 32768, slot);
#define CKZ(slot) ph_checksum(F, F.Z, (size_t)NP * ZC * 2, slot);
#define CKHSB(slot) ph_checksum(F, F.HSB, (size_t)NP * 2048, slot);
#define P11 ph_combine(F);
#define REP for (int rep_ = 0; rep_ < args.ph_lo; ++rep_)
#ifndef MK_PROG
#define MK_PROG P0 SEAM P1 SEAM P2 SEAM P3 SEAM P4 SEAM P5 SEAM P6 SEAM P7 SEAM P9 SEAM P10 SEAM P11
#endif
    MK_PROG
}

#ifndef MK_REPS
#define MK_REPS 1
#endif
#ifndef MK_ONE_LAUNCH
#define MK_ONE_LAUNCH 0
#endif
extern "C" void kernel_launch(void* const* d_in, const int* in_sizes, int n_in, void* d_out, int out_size, void* d_ws, size_t ws_size, hipStream_t stream) {
    static int grid = 0;
    if (grid == 0) {
        if (n_in != 20 || in_sizes[0] != NB * SEQ * DM || out_size != NB * SEQ * DM || ws_size < WS_END) { fprintf(stderr, "kernel_launch: unexpected shapes / workspace (n_in %d, ws %zu, need %zu)\n", n_in, ws_size, (size_t)WS_END); grid = -1; return; }
        int dev = 0, cus = 0, per_cu = 0;
        if (hipGetDevice(&dev) != hipSuccess || hipDeviceGetAttribute(&cus, hipDeviceAttributeMultiprocessorCount, dev) != hipSuccess) { grid = -1; return; }
        if (hipFuncSetAttribute((const void*)mk_fwd, hipFuncAttributeMaxDynamicSharedMemorySize, LDS_BYTES) != hipSuccess) { fprintf(stderr, "kernel_launch: hipFuncSetAttribute failed\n"); grid = -1; return; }
        if (hipOccupancyMaxActiveBlocksPerMultiprocessor(&per_cu, (const void*)mk_fwd, 512, LDS_BYTES) != hipSuccess || per_cu < 1) { fprintf(stderr, "kernel_launch: occupancy query says %d blocks per CU\n", per_cu); grid = -1; return; }
        (void)hipGetLastError();
        grid = cus;
    }
    if (grid < 0) return;
    (void)hipMemsetAsync((char*)d_ws + WS_CTL, 0, CTL_ZERO_BYTES, stream);
    Args a{};
    for (int i = 0; i < 20; ++i) a.in[i] = (const float*)d_in[i];
    a.out = (float*)d_out; a.ws = (unsigned char*)d_ws; a.ph_lo = MK_REPS; a.ph_hi = 0;
    hipLaunchKernelGGL(mk_fwd, dim3(grid), dim3(512), LDS_BYTES, stream, a);
}
```
